# Optimizing an MI355X kernel written in HIP

```python
import math
import numpy as np
import jax
import jax.numpy as jnp
from jax import lax

D_MODEL = 1024
BATCH = 4
SEQ = 8192
DEPTH = 1

NSA_HEADS = 8
NSA_GROUPS = 2
NSA_HPG = NSA_HEADS // NSA_GROUPS
NSA_DH = 64
CMP_LEN = 32
CMP_STRIDE = 16
CMP_HID = 256
SLC_LEN = 64
SLC_TOPN = 16
WIN = 512
MLA_HEADS = 8
MLA_NOPE = 64
MLA_ROPE = 32
MLA_DV = 64
MLA_Q_LORA = 768
MLA_KV_LORA = 256
ROPE_THETA = 10000.0
MEM_LEN = 256
MEM_HEADS = 4
MEM_DH = 128
N_BRANCH = 3
BRANCH_W = NSA_HEADS * NSA_DH
REL_BUCKETS = 32
REL_MAX_DIST = 128
N_EXPERTS = 256
TOP_K = 8
N_EXPERT_GROUPS = 8
TOPK_GROUPS = 4
D_EXPERT = 256
D_SHARED = 256
ROUTE_SCALE = 2.5
EXPERT_BLOCK = 128
Q_BLOCK = 128
LN_EPS = 1e-5
RMS_EPS = 1e-6
NEG = -1e30
BIG = 1e30
IN_SPLITS = (NSA_HEADS * NSA_DH, 6 * NSA_GROUPS * NSA_DH, 3 * NSA_HEADS, MLA_Q_LORA, MLA_KV_LORA, MLA_ROPE, MEM_HEADS * MEM_DH, N_BRANCH * D_MODEL)
D_IN = sum(IN_SPLITS)

kernel_name = 'hybrid_nsa_mla_mem_moe_deepnorm'


def _split_points():
    pts, acc = [], 0
    for n in IN_SPLITS[:-1]:
        acc += n
        pts.append(acc)
    return pts


def layer_norm(x, g, b):
    xf = x.astype(jnp.float32)
    mu = jnp.mean(xf, -1, keepdims=True)
    var = jnp.mean(jnp.square(xf - mu), -1, keepdims=True)
    return ((xf - mu) * lax.rsqrt(var + LN_EPS) * g + b).astype(x.dtype)


def rms_norm(x, g):
    xf = x.astype(jnp.float32)
    return (xf * lax.rsqrt(jnp.mean(jnp.square(xf), -1, keepdims=True) + RMS_EPS) * g).astype(x.dtype)


def masked_softmax(s, mask):
    s = jnp.where(mask, s.astype(jnp.float32), NEG)
    p = jax.nn.softmax(s, axis=-1)
    return jnp.where(mask, p, 0.0)


def rel_bucket(dist):
    n = jnp.maximum(dist, 0)
    max_exact = REL_BUCKETS // 2
    nf = jnp.maximum(n, 1).astype(jnp.float32)
    large = max_exact + (jnp.log(nf / max_exact) / math.log(REL_MAX_DIST / max_exact) * (REL_BUCKETS - max_exact)).astype(jnp.int32)
    large = jnp.minimum(large, REL_BUCKETS - 1)
    return jnp.where(n < max_exact, n, large)


def rope(x, pos):
    half = x.shape[-1] // 2
    freq = ROPE_THETA ** (-jnp.arange(half, dtype=jnp.float32) / half)
    ang = pos.astype(jnp.float32)[:, None] * freq[None, :]
    cos = jnp.cos(ang)[:, None, :]
    sin = jnp.sin(ang)[:, None, :]
    xf = x.astype(jnp.float32)
    x1, x2 = xf[..., :half], xf[..., half:]
    return jnp.concatenate([x1 * cos - x2 * sin, x2 * cos + x1 * sin], -1).astype(x.dtype)


def swiglu(x, w1, w3, w2):
    return (jax.nn.silu(x @ w1) * (x @ w3)) @ w2


def cmp_to_slc_overlap(n_cmp, n_slc):
    cs = np.arange(n_cmp) * CMP_STRIDE
    ce = cs + CMP_LEN - 1
    js = np.arange(n_slc) * SLC_LEN
    je = js + SLC_LEN - 1
    return ((cs[:, None] <= je[None, :]) & (ce[:, None] >= js[None, :])).astype(np.float32)


def nsa_compress(k, pos_emb, w1, w2):
    B, S, G, DH = k.shape
    n_cmp = (S - CMP_LEN) // CMP_STRIDE + 1
    idx = np.arange(n_cmp)[:, None] * CMP_STRIDE + np.arange(CMP_LEN)[None, :]
    blk = k[:, idx] + pos_emb[:, None, :]
    blk = blk.transpose(0, 1, 3, 2, 4).reshape(B, n_cmp, G, CMP_LEN * DH)
    return jax.nn.gelu(blk @ w1) @ w2


def nsa_attend(q, kc, vc, k_slc, v_slc, k_win, v_win, gates, rel_table):
    B, S = q.shape[0], q.shape[1]
    G, HPG, DH = NSA_GROUPS, NSA_HPG, NSA_DH
    n_cmp = kc.shape[1]
    n_slc = S // SLC_LEN
    n_top = min(SLC_TOPN, n_slc)
    qg = q.reshape(B, S, G, HPG, DH) * (DH ** -0.5)
    cmp_end = jnp.arange(n_cmp) * CMP_STRIDE + CMP_LEN - 1
    overlap = jnp.asarray(cmp_to_slc_overlap(n_cmp, n_slc))
    ks_blk = k_slc.reshape(B, n_slc, SLC_LEN, G, DH).transpose(0, 3, 1, 2, 4)
    vs_blk = v_slc.reshape(B, n_slc, SLC_LEN, G, DH).transpose(0, 3, 1, 2, 4)
    kw_pad = jnp.pad(k_win, ((0, 0), (WIN, 0), (0, 0), (0, 0)))
    vw_pad = jnp.pad(v_win, ((0, 0), (WIN, 0), (0, 0), (0, 0)))
    tab = rel_table.reshape(REL_BUCKETS, G, HPG)
    b_idx = jnp.arange(B)[:, None, None, None]
    g_idx = jnp.arange(G)[None, :, None, None]
    j_all = jnp.arange(n_slc)

    def block(i):
        qs = i * Q_BLOCK
        t = qs + jnp.arange(Q_BLOCK)
        qb = lax.dynamic_slice_in_dim(qg, qs, Q_BLOCK, axis=1)
        gb = lax.dynamic_slice_in_dim(gates, qs, Q_BLOCK, axis=1)

        dist_c = t[:, None] - cmp_end[None, :]
        mask_c = dist_c >= 0
        bias_c = rel_table[rel_bucket(dist_c)].reshape(Q_BLOCK, n_cmp, G, HPG).transpose(2, 3, 0, 1)
        s_c = jnp.einsum('bqghd,bngd->bghqn', qb, kc) + bias_c
        p_c = masked_softmax(s_c, mask_c)
        o_c = jnp.einsum('bghqn,bngd->bqghd', p_c.astype(vc.dtype), vc)

        imp = jnp.einsum('bghqn,nj->bgqj', p_c, overlap)
        cur = t // SLC_LEN
        forced = (j_all[None, :] == 0) | (j_all[None, :] == cur[:, None]) | (j_all[None, :] == cur[:, None] - 1)
        future = j_all[None, :] * SLC_LEN > t[:, None]
        imp = jnp.where(future, NEG, jnp.where(forced, BIG, imp))
        top_score, top_idx = lax.top_k(imp, n_top)
        blk_ok = top_score > 0.5 * NEG
        ks = ks_blk[b_idx, g_idx, top_idx].reshape(B, G, Q_BLOCK, n_top * SLC_LEN, DH)
        vs = vs_blk[b_idx, g_idx, top_idx].reshape(B, G, Q_BLOCK, n_top * SLC_LEN, DH)
        pos_s = top_idx[..., None] * SLC_LEN + jnp.arange(SLC_LEN)
        dist_s = t[None, None, :, None, None] - pos_s
        mask_s = (blk_ok[..., None] & (dist_s >= 0)).reshape(B, G, 1, Q_BLOCK, n_top * SLC_LEN)
        bias_s = tab[rel_bucket(dist_s), g_idx[..., None]]
        bias_s = bias_s.reshape(B, G, Q_BLOCK, n_top * SLC_LEN, HPG).transpose(0, 1, 4, 2, 3)
        s_s = jnp.einsum('bqghd,bgqkd->bghqk', qb, ks) + bias_s
        p_s = masked_softmax(s_s, mask_s)
        o_s = jnp.einsum('bghqk,bgqkd->bqghd', p_s.astype(vs.dtype), vs)

        kw = lax.dynamic_slice_in_dim(kw_pad, qs, Q_BLOCK + WIN, axis=1)
        vw = lax.dynamic_slice_in_dim(vw_pad, qs, Q_BLOCK + WIN, axis=1)
        s_pos = qs - WIN + jnp.arange(Q_BLOCK + WIN)
        dist_w = t[:, None] - s_pos[None, :]
        mask_w = (dist_w >= 0) & (dist_w < WIN) & (s_pos[None, :] >= 0)
        bias_w = rel_table[rel_bucket(dist_w)].reshape(Q_BLOCK, Q_BLOCK + WIN, G, HPG).transpose(2, 3, 0, 1)
        s_w = jnp.einsum('bqghd,bkgd->bghqk', qb, kw) + bias_w
        p_w = masked_softmax(s_w, mask_w)
        o_w = jnp.einsum('bghqk,bkgd->bqghd', p_w.astype(vw.dtype), vw)

        g = jax.nn.sigmoid(gb.astype(jnp.float32)).astype(q.dtype).reshape(B, Q_BLOCK, G, HPG, 3)
        o = g[..., 0:1] * o_c + g[..., 1:2] * o_s + g[..., 2:3] * o_w
        return o.reshape(B, Q_BLOCK, NSA_HEADS * DH)

    out = lax.map(block, jnp.arange(S // Q_BLOCK))
    return out.transpose(1, 0, 2, 3).reshape(B, S, NSA_HEADS * DH)


def mla_attend(c_q, c_kv, k_rope_raw, q_norm, w_uq, kv_norm, w_ukv):
    B, S = c_q.shape[0], c_q.shape[1]
    H = MLA_HEADS
    pos = jnp.arange(S)
    q = (rms_norm(c_q, q_norm) @ w_uq).reshape(B, S, H, MLA_NOPE + MLA_ROPE)
    q = jnp.concatenate([q[..., :MLA_NOPE], rope(q[..., MLA_NOPE:], pos)], -1) * ((MLA_NOPE + MLA_ROPE) ** -0.5)
    kv = (rms_norm(c_kv, kv_norm) @ w_ukv).reshape(B, S, H, MLA_NOPE + MLA_DV)
    k_rope = rope(k_rope_raw[:, :, None, :], pos)
    k = jnp.concatenate([kv[..., :MLA_NOPE], jnp.broadcast_to(k_rope, (B, S, H, MLA_ROPE))], -1)
    v = kv[..., MLA_NOPE:]
    key_pos = jnp.arange(S)

    def block(i):
        qs = i * Q_BLOCK
        t = qs + jnp.arange(Q_BLOCK)
        qb = lax.dynamic_slice_in_dim(q, qs, Q_BLOCK, axis=1)
        s = jnp.einsum('bqhd,bkhd->bhqk', qb, k)
        p = masked_softmax(s, key_pos[None, :] <= t[:, None])
        return jnp.einsum('bhqk,bkhd->bqhd', p.astype(v.dtype), v).reshape(B, Q_BLOCK, H * MLA_DV)

    out = lax.map(block, jnp.arange(S // Q_BLOCK))
    return out.transpose(1, 0, 2, 3).reshape(B, S, H * MLA_DV)


def mem_attend(q, mem, w_mem_kv):
    B, S = q.shape[0], q.shape[1]
    M = mem.shape[1]
    kv = (mem @ w_mem_kv).reshape(B, M, 2, MEM_HEADS, MEM_DH)
    q = q.reshape(B, S, MEM_HEADS, MEM_DH) * (MEM_DH ** -0.5)
    s = jnp.einsum('bshd,bmhd->bhsm', q, kv[:, :, 0]).astype(jnp.float32)
    p = jax.nn.softmax(s, axis=-1)
    o = jnp.einsum('bhsm,bmhd->bshd', p.astype(kv.dtype), kv[:, :, 1])
    return o.reshape(B, S, MEM_HEADS * MEM_DH)


def moe_ffn(h, router_w, router_b, w1, w3, w2, sw1, sw3, sw2):
    B, S, D = h.shape
    N = B * S
    t = h.reshape(N, D)
    s = jax.nn.sigmoid((t @ router_w).astype(jnp.float32))
    sb = s + router_b.astype(jnp.float32)
    grp = sb.reshape(N, N_EXPERT_GROUPS, N_EXPERTS // N_EXPERT_GROUPS)
    grp_score = jnp.sum(lax.top_k(grp, 2)[0], -1)
    _, gsel = lax.top_k(grp_score, TOPK_GROUPS)
    gmask = jnp.any(gsel[..., None] == jnp.arange(N_EXPERT_GROUPS), axis=1)
    emask = jnp.repeat(gmask, N_EXPERTS // N_EXPERT_GROUPS, axis=1)
    _, eidx = lax.top_k(jnp.where(emask, sb, NEG), TOP_K)
    wsel = jnp.take_along_axis(s, eidx, axis=1)
    wsel = wsel / jnp.sum(wsel, -1, keepdims=True) * ROUTE_SCALE

    A = N * TOP_K
    flat_e = eidx.reshape(A)
    order = jnp.argsort(flat_e)
    sorted_e = flat_e[order]
    counts = jnp.bincount(flat_e, length=N_EXPERTS)
    padded = (counts + EXPERT_BLOCK - 1) // EXPERT_BLOCK * EXPERT_BLOCK
    pad_end = jnp.cumsum(padded)
    pad_start = pad_end - padded
    grp_start = jnp.cumsum(counts) - counts
    dest = pad_start[sorted_e] + jnp.arange(A) - grp_start[sorted_e]
    n_blocks = -(-A // EXPERT_BLOCK) + N_EXPERTS
    P = n_blocks * EXPERT_BLOCK
    row_tok = jnp.full((P,), N, jnp.int32).at[dest].set((order // TOP_K).astype(jnp.int32))
    row_w = jnp.zeros((P,), jnp.float32).at[dest].set(wsel.reshape(A)[order])
    blk_e = jnp.minimum(jnp.searchsorted(pad_end, jnp.arange(n_blocks) * EXPERT_BLOCK, side='right'), N_EXPERTS - 1)
    t_pad = jnp.concatenate([t, jnp.zeros((1, D), t.dtype)], 0)

    def run(args):
        rows, e = args
        return swiglu(t_pad[rows], w1[e], w3[e], w2[e])

    y = lax.map(run, (row_tok.reshape(n_blocks, EXPERT_BLOCK), blk_e)).reshape(P, D)
    routed = jax.ops.segment_sum(y * row_w[:, None].astype(y.dtype), row_tok, num_segments=N + 1)[:N]
    return (routed + swiglu(t, sw1, sw3, sw2)).reshape(B, S, D)


def setup_inputs(seed: int = 0) -> dict:
    key = jax.random.key(seed)
    ks = iter(jax.random.split(key, 40))
    beta = (8 * DEPTH) ** -0.25
    f32 = jnp.float32

    def w(shape, fan_in, scale=1.0):
        return jax.random.normal(next(ks), shape, f32) * (scale * fan_in ** -0.5)

    def gain(shape):
        return 1.0 + 0.02 * jax.random.normal(next(ks), shape, f32)

    def small(shape, scale):
        return scale * jax.random.normal(next(ks), shape, f32)

    L, D = DEPTH, D_MODEL
    return {
        'x': jax.random.normal(next(ks), (BATCH, SEQ, D), f32),
        'mem': jax.random.normal(next(ks), (BATCH, MEM_LEN, D), f32),
        'ln0_g': gain((D,)),
        'ln0_b': small((D,), 0.02),
        'rel_bias': small((REL_BUCKETS, NSA_HEADS), 0.2),
        'w_in': w((L, D, D_IN), D),
        'cmp_pos_k': small((L, CMP_LEN, NSA_DH), 0.1),
        'cmp_pos_v': small((L, CMP_LEN, NSA_DH), 0.1),
        'cmp_k_w1': w((L, CMP_LEN * NSA_DH, CMP_HID), CMP_LEN * NSA_DH),
        'cmp_k_w2': w((L, CMP_HID, NSA_DH), CMP_HID),
        'cmp_v_w1': w((L, CMP_LEN * NSA_DH, CMP_HID), CMP_LEN * NSA_DH),
        'cmp_v_w2': w((L, CMP_HID, NSA_DH), CMP_HID),
        'mla_q_norm': gain((L, MLA_Q_LORA)),
        'mla_w_uq': w((L, MLA_Q_LORA, MLA_HEADS * (MLA_NOPE + MLA_ROPE)), MLA_Q_LORA),
        'mla_kv_norm': gain((L, MLA_KV_LORA)),
        'mla_w_ukv': w((L, MLA_KV_LORA, MLA_HEADS * (MLA_NOPE + MLA_DV)), MLA_KV_LORA),
        'mem_w_kv': w((L, D, 2 * MEM_HEADS * MEM_DH), D),
        'w_branch': w((L, N_BRANCH, BRANCH_W, D), BRANCH_W, beta),
        'w_out': w((L, D, D), D, beta),
        'ln1_g': gain((L, D)),
        'ln1_b': small((L, D), 0.02),
        'router_w': w((L, D, N_EXPERTS), D),
        'router_b': small((L, N_EXPERTS), 0.01),
        'exp_w1': w((L, N_EXPERTS, D, D_EXPERT), D),
        'exp_w3': w((L, N_EXPERTS, D, D_EXPERT), D),
        'exp_w2': w((L, N_EXPERTS, D_EXPERT, D), D_EXPERT, beta),
        'sh_w1': w((L, D, D_SHARED), D),
        'sh_w3': w((L, D, D_SHARED), D),
        'sh_w2': w((L, D_SHARED, D), D_SHARED, beta),
        'ln2_g': gain((L, D)),
        'ln2_b': small((L, D), 0.02),
    }


def reference(x, mem, ln0_g, ln0_b, rel_bias, w_in, cmp_pos_k, cmp_pos_v, cmp_k_w1, cmp_k_w2, cmp_v_w1, cmp_v_w2, mla_q_norm, mla_w_uq, mla_kv_norm, mla_w_ukv, mem_w_kv, w_branch, w_out, ln1_g, ln1_b, router_w, router_b, exp_w1, exp_w3, exp_w2, sh_w1, sh_w3, sh_w2, ln2_g, ln2_b):
    alpha = (2 * DEPTH) ** 0.25
    B, S, D = x.shape
    h = layer_norm(x, ln0_g, ln0_b)
    for l in range(DEPTH):
        proj = h @ w_in[l]
        q_nsa, kv_nsa, g_nsa, c_q, c_kv, k_rope, q_mem, g_merge = jnp.split(proj, _split_points(), axis=-1)
        kv_nsa = kv_nsa.reshape(B, S, 6, NSA_GROUPS, NSA_DH)
        kc = nsa_compress(kv_nsa[:, :, 0], cmp_pos_k[l], cmp_k_w1[l], cmp_k_w2[l])
        vc = nsa_compress(kv_nsa[:, :, 1], cmp_pos_v[l], cmp_v_w1[l], cmp_v_w2[l])
        o_nsa = nsa_attend(q_nsa.reshape(B, S, NSA_HEADS, NSA_DH), kc, vc,
                           kv_nsa[:, :, 2], kv_nsa[:, :, 3], kv_nsa[:, :, 4], kv_nsa[:, :, 5],
                           g_nsa.reshape(B, S, NSA_HEADS, 3), rel_bias)
        o_mla = mla_attend(c_q, c_kv, k_rope, mla_q_norm[l], mla_w_uq[l], mla_kv_norm[l], mla_w_ukv[l])
        o_mem = mem_attend(q_mem, mem, mem_w_kv[l])
        gates = jax.nn.sigmoid(g_merge.astype(jnp.float32)).astype(h.dtype).reshape(B, S, N_BRANCH, D)
        merged = (gates[:, :, 0] * (o_nsa @ w_branch[l, 0])
                  + gates[:, :, 1] * (o_mla @ w_branch[l, 1])
                  + gates[:, :, 2] * (o_mem @ w_branch[l, 2]))
        h = layer_norm(alpha * h + merged @ w_out[l], ln1_g[l], ln1_b[l])
        ffn = moe_ffn(h, router_w[l], router_b[l], exp_w1[l], exp_w3[l], exp_w2[l], sh_w1[l], sh_w3[l], sh_w2[l])
        h = layer_norm(alpha * h + ffn, ln2_g[l], ln2_b[l])
    return h
```

```cpp
#include <hip/hip_runtime.h>
#include <stdint.h>
#include <stdio.h>

typedef unsigned short bf16_t;
typedef __attribute__((ext_vector_type(8))) short bf16x8;
typedef __attribute__((ext_vector_type(4))) short bf16x4;
typedef __attribute__((ext_vector_type(4))) float f32x4;

constexpr int NTOK = 32768, SEQ = 8192, DM = 1024, DIN = 5944;
constexpr int C_QNSA = 0, C_KVNSA = 512, C_GNSA = 1280, C_CQ = 1304, C_CKV = 2072, C_KROPE = 2328, C_QMEM = 2360, C_GMERGE = 2872;
constexpr float ALPHA = 1.189207115002721f;
constexpr float LOG2E = 1.4426950408889634f;
constexpr float NEGBIG = -1e30f;

constexpr size_t MBY = 1ull << 20;
constexpr size_t WS_CTL = 0;
constexpr size_t CTL_BYTES = 65536;
constexpr int CTL_Q = 4096;
constexpr int CTL_CNT = 8192;
constexpr size_t WS_COS = 1 * MBY, WS_SIN = WS_COS + 512 * 1024;
constexpr size_t WS_KC = 2 * MBY, WS_VTC = WS_KC + 512 * 1024;
constexpr size_t WS_KMEM = 3 * MBY, WS_VTMEM = 4 * MBY, WS_MEMB = 5 * MBY, WS_EID = 7 * MBY, WS_EW = 8 * MBY;
constexpr size_t WS_A = 16 * MBY;
constexpr size_t WS_PROJ = WS_A, WS_QM = WS_A + 372 * MBY, WS_KM = WS_A + 420 * MBY, WS_VTM = WS_A + 468 * MBY;
constexpr size_t WS_Y1 = WS_A, WS_Y = WS_A;
constexpr size_t WS_B = WS_A + 512 * MBY;
constexpr size_t WS_H0 = WS_B;
constexpr size_t WS_EXPW = WS_B;
constexpr size_t WS_ONSA = WS_B + 64 * MBY, WS_OMLA = WS_B + 96 * MBY, WS_OMEM = WS_B + 128 * MBY;
constexpr size_t WS_LOGITS = WS_A + 128 * MBY, WS_LIST = WS_B + 384 * MBY;
constexpr size_t WS_MERGED = WS_B + 160 * MBY;
constexpr size_t WS_KCS = WS_B + 224 * MBY, WS_VCS = WS_KCS + 8 * MBY, WS_KSLC = WS_KCS + 16 * MBY, WS_KWIN = WS_KCS + 24 * MBY,
                 WS_VTSLC = WS_KCS + 32 * MBY, WS_VTWIN = WS_KCS + 40 * MBY;
constexpr size_t WS_SCR = WS_B + 416 * MBY;
constexpr size_t WS_WB = WS_B + 448 * MBY;
constexpr size_t WB_WIN = WS_WB, WB_WUQ = WB_WIN + 12582912, WB_WUKV = WB_WUQ + 1179648, WB_WMEM = WB_WUKV + 524288, WB_WBR = WB_WMEM + 2097152,
                 WB_WOUT = WB_WBR + 3145728, WB_WRHI = WB_WOUT + 2097152, WB_WRLO = WB_WRHI + 524288, WB_WS1 = WB_WRLO + 524288, WB_WS3 = WB_WS1 + 524288,
                 WB_WS2 = WB_WS3 + 524288, WB_WCK1 = WB_WS2 + 524288, WB_WCV1 = WB_WCK1 + 1048576, WB_WCK2 = WB_WCV1 + 1048576, WB_WCV2 = WB_WCK2 + 65536,
                 WB_POSP = WB_WCV2 + 65536  , WB_END = WB_POSP + 32768;
static_assert(WB_END <= WS_WB + 32 * MBY, "bf16 weight region");
constexpr size_t WS_END = WS_B + 480 * MBY;
constexpr int H1LD = 2048;

struct Params {
    const float *x, *mem, *ln0_g, *ln0_b, *rel_bias, *w_in, *cmp_pos_k, *cmp_pos_v, *cmp_k_w1, *cmp_k_w2, *cmp_v_w1, *cmp_v_w2,
        *mla_q_norm, *mla_w_uq, *mla_kv_norm, *mla_w_ukv, *mem_w_kv, *w_branch, *w_out, *ln1_g, *ln1_b, *router_w, *router_b,
        *exp_w1, *exp_w3, *exp_w2, *sh_w1, *sh_w3, *sh_w2, *ln2_g, *ln2_b;
    float* out;
    char* ws;
    int ph_lo, ph_hi;
};

#define XB_TMO      128
#define XB_XCNT(j)  (256  + 64 * (j))
#define XB_XSUB(j)  (1280 + 64 * (j))
#define XB_XGEN(j)  (2304 + 64 * (j))
#define XB_TOP      3328
#define XB_TOPGEN   3392
#define XCD_BAR_WORDS 3456
#define XB_SPIN_CAP (1u << 18)
#define LAS __attribute__((address_space(3)))

__device__ __forceinline__ unsigned xb_ld(unsigned* p)              { return __hip_atomic_load(p, __ATOMIC_RELAXED, __HIP_MEMORY_SCOPE_AGENT); }
__device__ __forceinline__ unsigned xb_add(unsigned* p, unsigned v) { return __hip_atomic_fetch_add(p, v, __ATOMIC_RELAXED, __HIP_MEMORY_SCOPE_AGENT); }
__device__ __forceinline__ unsigned xb_xcc_id() { return (unsigned)__builtin_amdgcn_s_getreg((3 << 11) | 20) & 0xFu; }
#define XB_SPIN(cond, bar) do { unsigned _sp = 0; while (cond) { __builtin_amdgcn_s_sleep(1); \
    if ((++_sp & 255u) == 0u) { if (xb_ld(&(bar)[XB_TMO])) break; if (_sp > XB_SPIN_CAP) { atomicAdd(&(bar)[XB_TMO], 1u); break; } } } } while (0)

struct XcdBarrier { unsigned* bar; unsigned x; volatile LAS unsigned* st; };

__device__ __forceinline__ XcdBarrier xcd_barrier_post(unsigned* bar, volatile LAS unsigned* st) {
    XcdBarrier b; b.bar = bar; b.x = xb_xcc_id(); b.st = st;
    if (threadIdx.x == 0) (void)xb_add(&bar[XB_XCNT(b.x)], 1u);
    return b;
}
__device__ __forceinline__ void xcd_barrier_complete(unsigned* bar, unsigned x, unsigned& nloc, unsigned& nx) {
    const unsigned G = gridDim.x * gridDim.y * gridDim.z;
    unsigned sum, cnt, mine, sp = 0u;
    for (;;) {
        sum = 0u; cnt = 0u; mine = 0u;
#pragma unroll
        for (unsigned j = 0; j < 16; ++j) { const unsigned c = xb_ld(&bar[XB_XCNT(j)]); sum += c; cnt += (c > 0u) ? 1u : 0u; mine = (j == x) ? c : mine; }
        if (sum == G) break;
        __builtin_amdgcn_s_sleep(1);
        if ((++sp & 255u) == 0u) { if (xb_ld(&bar[XB_TMO])) break; if (sp > XB_SPIN_CAP) { atomicAdd(&bar[XB_TMO], 1u); break; } }
    }
    nloc = mine > 0u ? mine : 1u; nx = cnt > 0u ? cnt : 1u;
}
__device__ __forceinline__ void xcd_barrier(const XcdBarrier& b) {
    asm volatile("s_waitcnt vmcnt(0)" ::: "memory");
    __syncthreads();
    if (threadIdx.x == 0) {
        unsigned* bar = b.bar;
        __builtin_amdgcn_s_waitcnt(0);
        unsigned nloc = b.st[0], nx = b.st[1];
        if (nloc == 0u) { xcd_barrier_complete(bar, b.x, nloc, nx); b.st[0] = nloc; b.st[1] = nx; }
        const unsigned old = xb_add(&bar[XB_XSUB(b.x)], 1u);
        const unsigned gen = old / nloc;
        if (old + 1u == (gen + 1u) * nloc) {
            __builtin_amdgcn_fence(__ATOMIC_RELEASE, "agent");
            asm volatile("s_waitcnt vmcnt(0)" ::: "memory");
            const unsigned og = xb_add(&bar[XB_TOP], 1u);
            const unsigned tg = og / nx;
            if (og + 1u == (tg + 1u) * nx) xb_add(&bar[XB_TOPGEN], 1u);
            else XB_SPIN(xb_ld(&bar[XB_TOPGEN]) == tg, bar);
            __builtin_amdgcn_fence(__ATOMIC_ACQUIRE, "agent");
            xb_add(&bar[XB_XGEN(b.x)], 1u);
            asm volatile("s_waitcnt vmcnt(0)" ::: "memory");
        } else {
            XB_SPIN(xb_ld(&bar[XB_XGEN(b.x)]) == gen, bar);
            __builtin_amdgcn_fence(__ATOMIC_ACQUIRE, "agent");
            asm volatile("s_waitcnt vmcnt(0)" ::: "memory");
        }
    }
    __syncthreads();
}

__device__ __forceinline__ float bf2f(bf16_t v) { return __uint_as_float(((uint32_t)v) << 16); }
__device__ __forceinline__ float bflo(uint32_t v) { return __uint_as_float(v << 16); }
__device__ __forceinline__ float bfhi(uint32_t v) { return __uint_as_float(v & 0xffff0000u); }
__device__ __forceinline__ uint32_t pack2(float a, float b) {
    typedef __attribute__((ext_vector_type(2))) __bf16 bf2_t; typedef __attribute__((ext_vector_type(2))) float f2_t;
    f2_t v = {a, b}; bf2_t r = __builtin_convertvector(v, bf2_t); return __builtin_bit_cast(uint32_t, r);
}
__device__ __forceinline__ bf16_t f2bf(float a) { return (bf16_t)(pack2(a, 0.f) & 0xffffu); }
__device__ __forceinline__ uint2 pack4(f32x4 v) { return make_uint2(pack2(v[0], v[1]), pack2(v[2], v[3])); }
__device__ __forceinline__ float fexp2(float x) { return __builtin_amdgcn_exp2f(x); }
__device__ __forceinline__ float frcp(float x) { return __builtin_amdgcn_rcpf(x); }
__device__ __forceinline__ float sigmoidf_(float x) { return frcp(1.f + fexp2(-x * LOG2E)); }
__device__ __forceinline__ float siluf_(float x) { return x * frcp(1.f + fexp2(-x * LOG2E)); }
__device__ __forceinline__ float geluf_(float x) {
    const float u = 0.7978845608028654f * (x + 0.044715f * x * x * x);
    const float t = 1.f - 2.f * frcp(1.f + fexp2(2.f * u * LOG2E));
    return 0.5f * x * (1.f + t);
}
__device__ __forceinline__ float wave_sum(float v) {
    v += __uint_as_float(__builtin_amdgcn_update_dpp(0u, __float_as_uint(v), 0xB1, 0xF, 0xF, true));
    v += __uint_as_float(__builtin_amdgcn_update_dpp(0u, __float_as_uint(v), 0x4E, 0xF, 0xF, true));
    v += __uint_as_float(__builtin_amdgcn_update_dpp(0u, __float_as_uint(v), 0x141, 0xF, 0xF, true));
    v += __uint_as_float(__builtin_amdgcn_update_dpp(0u, __float_as_uint(v), 0x140, 0xF, 0xF, true));
    auto r = __builtin_amdgcn_permlane16_swap(__float_as_uint(v), __float_as_uint(v), false, false);
    v = __uint_as_float(r[0]) + __uint_as_float(r[1]);
    auto q = __builtin_amdgcn_permlane32_swap(__float_as_uint(v), __float_as_uint(v), false, false);
    return __uint_as_float(q[0]) + __uint_as_float(q[1]);
}
__device__ __forceinline__ float wave_max(float v) {
    v = fmaxf(v, __uint_as_float(__builtin_amdgcn_update_dpp(0u, __float_as_uint(v), 0xB1, 0xF, 0xF, true)));
    v = fmaxf(v, __uint_as_float(__builtin_amdgcn_update_dpp(0u, __float_as_uint(v), 0x4E, 0xF, 0xF, true)));
    v = fmaxf(v, __uint_as_float(__builtin_amdgcn_update_dpp(0u, __float_as_uint(v), 0x141, 0xF, 0xF, true)));
    v = fmaxf(v, __uint_as_float(__builtin_amdgcn_update_dpp(0u, __float_as_uint(v), 0x140, 0xF, 0xF, true)));
    auto r = __builtin_amdgcn_permlane16_swap(__float_as_uint(v), __float_as_uint(v), false, false);
    v = fmaxf(__uint_as_float(r[0]), __uint_as_float(r[1]));
    auto q = __builtin_amdgcn_permlane32_swap(__float_as_uint(v), __float_as_uint(v), false, false);
    return fmaxf(__uint_as_float(q[0]), __uint_as_float(q[1]));
}
__device__ __forceinline__ float quad_max(float x) {
    auto r = __builtin_amdgcn_permlane16_swap(__float_as_uint(x), __float_as_uint(x), false, false);
    x = fmaxf(__uint_as_float(r[0]), __uint_as_float(r[1]));
    auto q = __builtin_amdgcn_permlane32_swap(__float_as_uint(x), __float_as_uint(x), false, false);
    return fmaxf(__uint_as_float(q[0]), __uint_as_float(q[1]));
}
__device__ __forceinline__ float quad_min(float x) {
    auto r = __builtin_amdgcn_permlane16_swap(__float_as_uint(x), __float_as_uint(x), false, false);
    x = fminf(__uint_as_float(r[0]), __uint_as_float(r[1]));
    auto q = __builtin_amdgcn_permlane32_swap(__float_as_uint(x), __float_as_uint(x), false, false);
    return fminf(__uint_as_float(q[0]), __uint_as_float(q[1]));
}
__device__ __forceinline__ float quad_sum(float x) {
    auto r = __builtin_amdgcn_permlane16_swap(__float_as_uint(x), __float_as_uint(x), false, false);
    x = __uint_as_float(r[0]) + __uint_as_float(r[1]);
    auto q = __builtin_amdgcn_permlane32_swap(__float_as_uint(x), __float_as_uint(x), false, false);
    return __uint_as_float(q[0]) + __uint_as_float(q[1]);
}
__device__ __forceinline__ float quad4_sum(float x) {
    x += __uint_as_float(__builtin_amdgcn_update_dpp(0u, __float_as_uint(x), 0xB1, 0xF, 0xF, true));
    x += __uint_as_float(__builtin_amdgcn_update_dpp(0u, __float_as_uint(x), 0x4E, 0xF, 0xF, true));
    return x;
}
__device__ __forceinline__ float max16(const f32x4 (&s)[4]) {
    const float a = fmaxf(fmaxf(s[0][0], s[0][1]), fmaxf(s[0][2], s[0][3])), b = fmaxf(fmaxf(s[1][0], s[1][1]), fmaxf(s[1][2], s[1][3]));
    const float c = fmaxf(fmaxf(s[2][0], s[2][1]), fmaxf(s[2][2], s[2][3])), d = fmaxf(fmaxf(s[3][0], s[3][1]), fmaxf(s[3][2], s[3][3]));
    return fmaxf(fmaxf(a, b), fmaxf(c, d));
}
__device__ __forceinline__ float sum16(const f32x4 (&s)[4]) {
    const f32x4 v = (s[0] + s[1]) + (s[2] + s[3]);
    return (v[0] + v[1]) + (v[2] + v[3]);
}
__device__ __forceinline__ void lds_fadd(float* p, float v) {
    asm volatile("ds_add_f32 %0, %1" :: "v"((unsigned)(size_t)(LAS float*)p), "v"(v) : "memory");
}
__device__ __forceinline__ f32x4 mfma16(bf16x8 a, bf16x8 b, f32x4 c) { return __builtin_amdgcn_mfma_f32_16x16x32_bf16(a, b, c, 0, 0, 0); }

constexpr int NTHR = 512, NWV = 8;
constexpr int LDS_BYTES = 163840;
constexpr int LDS_MISC = 147456;
constexpr int LDS_LUT = LDS_MISC;
constexpr int LDS_SEL = LDS_MISC + 8192;
constexpr int LDS_WOR = LDS_SEL + 1024;
constexpr int LDS_TL = LDS_WOR + 128;
constexpr int LDS_ITEM = LDS_TL + 256;
constexpr int LDS_ROWS = LDS_ITEM + 64;
constexpr int LDS_PRE = LDS_ROWS + 2048;
constexpr int LDS_KSC = LDS_PRE + 256;
constexpr int LDS_BARW = 163824;
static_assert(LDS_KSC + 1024 <= LDS_BARW, "LDS map");

__device__ __forceinline__ int queue_pop(unsigned* head, char* lds) {
    __syncthreads();
    if (threadIdx.x == 0) *(volatile int*)(lds + LDS_ITEM) = (int)atomicAdd(head, 1u);
    __syncthreads();
    return __builtin_amdgcn_readfirstlane(*(volatile int*)(lds + LDS_ITEM));
}

__device__ __forceinline__ int swz(int row, int chunk) { return (row << 7) + (((chunk ^ (row >> 1) ^ ((row >> 4) & 1)) & 7) << 4); }
constexpr int TILE_B = 16384;

struct GemmA { const char* base; unsigned off[4]; };

constexpr int STAGE_B = 49152, STAGE_BOFF = 32768;
__device__ __forceinline__ int gl_row(int i, int t) { return 8 * ((t >> 6) + 8 * i) + ((t & 63) >> 3); }
__device__ __forceinline__ int gl_chunk(int row, int t) { return ((t & 7) ^ (row >> 1) ^ ((row >> 4) & 1)) & 7; }
__device__ __forceinline__ int perm32_(int rho) { const int n = rho >> 4, i = rho & 15; return 8 * (i >> 2) + 4 * n + (i & 3); }
template <int NP, bool PERM = false>
__device__ __forceinline__ GemmA make_op(const bf16_t* base, long ld, int r0, int rmax) {
    GemmA a; const int t = threadIdx.x;
    a.base = (const char*)base;
#pragma unroll
    for (int i = 0; i < NP; ++i) { const int lr_ = gl_row(i, t); int r = r0 + (PERM ? ((lr_ & ~31) + perm32_(lr_ & 31)) : lr_); r = r < rmax ? r : rmax - 1; a.off[i] = (unsigned)(((size_t)r * ld + gl_chunk(lr_, t) * 8) * 2); }
    return a;
}
__device__ __forceinline__ void gemm_mainloop_g(char* lds, const GemmA& A, const GemmA& B, int nk, f32x4 (&acc)[4][4]) {
    int t = threadIdx.x; asm volatile("" : "+v"(t));
    const int lane = t & 63, w = t >> 6, wm = w >> 1, wn = w & 1;
    const int lr = lane & 15, lq = lane >> 4;
    const int wu = __builtin_amdgcn_readfirstlane(w);
    const int xr = (lr >> 1) & 7;
    unsigned ardA[2][2], ardB[2][2];
#pragma unroll
    for (int kk = 0; kk < 2; ++kk)
#pragma unroll
        for (int par = 0; par < 2; ++par) {
            const int ch = ((kk * 4 + lq) ^ xr ^ par) & 7;
            ardA[kk][par] = (unsigned)((wm * 64 + par * 16 + lr) * 128 + ch * 16);
            ardB[kk][par] = (unsigned)(STAGE_BOFF + (wn * 64 + par * 16 + lr) * 128 + ch * 16);
        }
    const char* abase = A.base; const char* bbase = B.base;
    LAS char* ldsl = (LAS char*)lds;
#define GI_(so_) { \
        _Pragma("unroll") for (int i = 0; i < 4; ++i) \
            __builtin_amdgcn_global_load_lds((const unsigned*)(abase + A.off[i]), (LAS unsigned*)(ldsl + (so_) + (wu + 8 * i) * 1024), 16, 0, 0); \
        _Pragma("unroll") for (int i = 0; i < 2; ++i) \
            __builtin_amdgcn_global_load_lds((const unsigned*)(bbase + B.off[i]), (LAS unsigned*)(ldsl + (so_) + STAGE_BOFF + (wu + 8 * i) * 1024), 16, 0, 0); \
        abase += 128; bbase += 128; }
    __syncthreads();
    GI_(0);
    if (nk > 1) GI_(STAGE_B);
    int cso = 0, lso = 2 * STAGE_B;
#pragma unroll 1
    for (int kt = 0; kt < nk; ++kt) {
        if (kt + 1 < nk) asm volatile("s_waitcnt vmcnt(6)" ::: "memory");
        else asm volatile("s_waitcnt vmcnt(0)" ::: "memory");
        __builtin_amdgcn_s_barrier();
        if (kt + 2 < nk) GI_(lso);
#pragma unroll
        for (int kk = 0; kk < 2; ++kk) {
            bf16x8 af[4], bfr[4];
#pragma unroll
            for (int i = 0; i < 4; ++i) af[i] = *(const bf16x8*)(lds + cso + ardA[kk][i & 1] + (i >> 1) * 4096);
#pragma unroll
            for (int j = 0; j < 4; ++j) bfr[j] = *(const bf16x8*)(lds + cso + ardB[kk][j & 1] + (j >> 1) * 4096);
#pragma unroll
            for (int i = 0; i < 4; ++i)
#pragma unroll
                for (int j = 0; j < 4; ++j) acc[i][j] = mfma16(bfr[j], af[i], acc[i][j]);
        }
        cso = (cso == 2 * STAGE_B) ? 0 : cso + STAGE_B;
        lso = (lso == 2 * STAGE_B) ? 0 : lso + STAGE_B;
    }
    __syncthreads();
#undef GI_
}

template <bool SWAPW1 = false>
__device__ __forceinline__ void gemm_mainloop_c(char* lds, const GemmA& A, const GemmA& B, int nk, f32x4 (&acc)[4][4], int& ring, bool primed, bool chain, const GemmA& An, const GemmA& Bn) {
    int t = threadIdx.x; asm volatile("" : "+v"(t));
    const int lane = t & 63, w = t >> 6, wm = w >> 1, wn = w & 1;
    const int lr = lane & 15, lq = lane >> 4;
    const int wu = __builtin_amdgcn_readfirstlane(w);
    const int xr = (lr >> 1) & 7;
    unsigned ardA[2][2], ardB[2][2];
#pragma unroll
    for (int kk = 0; kk < 2; ++kk)
#pragma unroll
        for (int par = 0; par < 2; ++par) {
            const int ch = ((kk * 4 + lq) ^ xr ^ par) & 7;
            ardA[kk][par] = (unsigned)((wm * 64 + par * 16 + lr) * 128 + ch * 16);
            ardB[kk][par] = (unsigned)(STAGE_BOFF + (wn * 64 + par * 16 + lr) * 128 + ch * 16);
        }
    const char* abase = A.base; const char* bbase = B.base;
    const char* anb = An.base; const char* bnb = Bn.base;
    LAS char* ldsl = (LAS char*)lds;
#define GI_(so_) { \
        _Pragma("unroll") for (int i = 0; i < 4; ++i) \
            __builtin_amdgcn_global_load_lds((const unsigned*)(abase + A.off[i]), (LAS unsigned*)(ldsl + (so_) + (wu + 8 * i) * 1024), 16, 0, 0); \
        _Pragma("unroll") for (int i = 0; i < 2; ++i) \
            __builtin_amdgcn_global_load_lds((const unsigned*)(bbase + B.off[i]), (LAS unsigned*)(ldsl + (so_) + STAGE_BOFF + (wu + 8 * i) * 1024), 16, 0, 0); \
        abase += 128; bbase += 128; }
#define GIN_(so_) { \
        _Pragma("unroll") for (int i = 0; i < 4; ++i) \
            __builtin_amdgcn_global_load_lds((const unsigned*)(anb + An.off[i]), (LAS unsigned*)(ldsl + (so_) + (wu + 8 * i) * 1024), 16, 0, 0); \
        _Pragma("unroll") for (int i = 0; i < 2; ++i) \
            __builtin_amdgcn_global_load_lds((const unsigned*)(bnb + Bn.off[i]), (LAS unsigned*)(ldsl + (so_) + STAGE_BOFF + (wu + 8 * i) * 1024), 16, 0, 0); \
        anb += 128; bnb += 128; }
    int cso = ring, lso = (ring == 0) ? 2 * STAGE_B : ring - STAGE_B;
    if (!primed) {
        __syncthreads();
        GI_(cso);
        { const int s1 = (cso == 2 * STAGE_B) ? 0 : cso + STAGE_B; GI_(s1); }
    } else { abase += 256; bbase += 256; }
#pragma unroll 1
    for (int kt = 0; kt < nk; ++kt) {
        if (kt + 1 < nk || chain) asm volatile("s_waitcnt vmcnt(6)" ::: "memory");
        else asm volatile("s_waitcnt vmcnt(0)" ::: "memory");
        __builtin_amdgcn_s_barrier();
        if (kt + 2 < nk) GI_(lso) else if (chain) GIN_(lso)
#pragma unroll
        for (int kk = 0; kk < 2; ++kk) {
            bf16x8 af[4], bfr[4];
#pragma unroll
            for (int i = 0; i < 4; ++i) af[i] = *(const bf16x8*)(lds + cso + ardA[kk][i & 1] + (i >> 1) * 4096);
#pragma unroll
            for (int j = 0; j < 4; ++j) bfr[j] = *(const bf16x8*)(lds + cso + ardB[kk][j & 1] + (j >> 1) * 4096);
            if (SWAPW1 && wn == 1) {
#pragma unroll
                for (int i = 0; i < 4; ++i)
#pragma unroll
                    for (int j = 0; j < 4; ++j) acc[i][j] = mfma16(af[i], bfr[j], acc[i][j]);
            } else {
#pragma unroll
                for (int i = 0; i < 4; ++i)
#pragma unroll
                    for (int j = 0; j < 4; ++j) acc[i][j] = mfma16(bfr[j], af[i], acc[i][j]);
            }
        }
        cso = (cso == 2 * STAGE_B) ? 0 : cso + STAGE_B;
        lso = (lso == 2 * STAGE_B) ? 0 : lso + STAGE_B;
    }
    ring = cso;
    if (!chain) __syncthreads();
#undef GI_
#undef GIN_
}

template <bool LO>
__device__ __forceinline__ void conv_wT(const float* src, int K, int N, bf16_t* dst, int ldd, const float* gain) {
    const int t = threadIdx.x & 255, kg = t >> 5, n4 = t & 31;
    const int ntn = (N + 127) >> 7, ntiles = (K >> 6) * ntn;
    for (int tile = blockIdx.x * 2 + (threadIdx.x >> 8); tile < ntiles; tile += gridDim.x * 2) {
        const int k0 = (tile / ntn) * 64 + kg * 8, n = (tile % ntn) * 128 + n4 * 4;
        if (n < N) {
            float4 r[8];
#pragma unroll
            for (int kk = 0; kk < 8; ++kk) r[kk] = *(const float4*)(src + (size_t)(k0 + kk) * N + n);
            if (gain) {
#pragma unroll
                for (int kk = 0; kk < 8; ++kk) { const float g = gain[k0 + kk]; r[kk].x *= g; r[kk].y *= g; r[kk].z *= g; r[kk].w *= g; }
            }
#pragma unroll
            for (int c = 0; c < 4; ++c) {
                float v[8];
#pragma unroll
                for (int kk = 0; kk < 8; ++kk) { float f = (c == 0) ? r[kk].x : (c == 1) ? r[kk].y : (c == 2) ? r[kk].z : r[kk].w; if (LO) f = f - bf2f(f2bf(f)); v[kk] = f; }
                *(uint4*)(dst + (size_t)(n + c) * ldd + k0) = make_uint4(pack2(v[0], v[1]), pack2(v[2], v[3]), pack2(v[4], v[5]), pack2(v[6], v[7]));
            }
        }
    }
}

__device__ __forceinline__ void zero_acc(f32x4 (&acc)[4][4]) {
#pragma unroll
    for (int i = 0; i < 4; ++i)
#pragma unroll
        for (int j = 0; j < 4; ++j) acc[i][j] = (f32x4){0.f, 0.f, 0.f, 0.f};
}

namespace pg8 {
constexpr int BM = 256, BK = 64, HALF = 128, HTB = HALF * BK * 2, STAGE_BYTES = 8 * HTB;
__device__ __forceinline__ int lds_byte(int r, int c) { const int st = (r >> 4) * 2 + (c >> 5), rr = r & 15, cc = c & 31, ob = rr * 64 + cc * 2; return st * 1024 + (ob ^ (((ob >> 9) & 1) << 5)); }
__device__ __forceinline__ void stage_rc(int b, int& R, int& C) { const int st = b / 1024, sb = b % 1024, swz_ = sb ^ (((sb >> 9) & 1) << 5); R = (st >> 1) * 16 + swz_ / 64; C = (st & 1) * 32 + (swz_ % 64) / 2; }
__device__ __forceinline__ int perm32(int rho) { const int n = rho >> 4, i = rho & 15; return 8 * (i >> 2) + 4 * n + (i & 3); }
struct Unit { int pm, pn; };
struct Ops { const char* A; const char* B; };
template <class Prov, class Epi>
__device__ __forceinline__ void gemm_phase(LAS unsigned char* lds, const int K, Prov& PV, const Epi& E) {
    int tid = threadIdx.x; asm volatile("" : "+v"(tid));
    const int wid = __builtin_amdgcn_readfirstlane(tid >> 6), lane = tid & 63, wr = wid >> 2, wc = wid & 3, fr = lane & 15, fq = lane >> 4;
    int nt = K / BK; asm volatile("" : "+s"(nt));
    int sR[2], sC[2];
#pragma unroll
    for (int i = 0; i < 2; ++i) stage_rc(tid * 16 + i * 8192, sR[i], sC[i]);
    const size_t kstep = (size_t)(BK * 2);
    const unsigned ldsw = (unsigned)wid * 1024u;
    const int aoff = lds_byte(wr * 64 + fr, fq * 8), boff = lds_byte(wc * 32 + fr, fq * 8);
#define PG8_SA(b, h) (((b) * 2 + (h)) * HTB)
#define PG8_SB(b, h) ((4 + (b) * 2 + (h)) * HTB)
#define PG8_STAGE(bufoff, gbase, voff) do { _Pragma("unroll") for (int _i = 0; _i < 2; ++_i) \
        __builtin_amdgcn_global_load_lds((const unsigned*)((const char*)(gbase) + (voff)[_i]), (LAS unsigned*)(lds + (bufoff) + ldsw + _i * 8192), 16, 0, 0); } while (0)
#define PG8_LDA(dst, b, h) do { _Pragma("unroll") for (int m = 0; m < 4; ++m) _Pragma("unroll") for (int k = 0; k < 2; ++k) dst[m][k] = *(const LAS bf16x8*)(lds + PG8_SA(b, h) + aoff + m * 2048 + k * 1024); } while (0)
#define PG8_LDB(dst, b, h) do { _Pragma("unroll") for (int n = 0; n < 2; ++n) _Pragma("unroll") for (int k = 0; k < 2; ++k) dst[n][k] = *(const LAS bf16x8*)(lds + PG8_SB(b, h) + boff + n * 2048 + k * 1024); } while (0)
#define PG8_MMA(ai, bj, At, Bt) do { __builtin_amdgcn_s_setprio(1); _Pragma("unroll") for (int m = 0; m < 4; ++m) _Pragma("unroll") for (int n = 0; n < 2; ++n) _Pragma("unroll") for (int k = 0; k < 2; ++k) \
        acc[ai][bj][m][n] = __builtin_amdgcn_mfma_f32_16x16x32_bf16(Bt[n][k], At[m][k], acc[ai][bj][m][n], 0, 0, 0); __builtin_amdgcn_s_setprio(0); } while (0)
#define PG8_WAIT_V(n) asm volatile("s_waitcnt vmcnt(" #n ")" ::: "memory")
#define PG8_WAIT_L(n) asm volatile("s_waitcnt lgkmcnt(" #n ")" ::: "memory")
#define PG8_BAR __builtin_amdgcn_s_barrier()
#define PG8_SCHED __builtin_amdgcn_sched_barrier(0)
    Unit cur, nxt; Ops oc, on; int ui = 0;
    unsigned va[2][2], vb[2][2];
    PV.offsets(va, vb, sR, sC);
    if (!PV.get(0, cur, oc)) return;
    f32x4 acc[2][2][4][2];
#pragma unroll
    for (int a = 0; a < 2; ++a)
#pragma unroll
        for (int b = 0; b < 2; ++b)
#pragma unroll
            for (int m = 0; m < 4; ++m)
#pragma unroll
                for (int n = 0; n < 2; ++n) acc[a][b][m][n] = (f32x4){0.f, 0.f, 0.f, 0.f};
    bf16x8 At[4][2], B0[2][2], B1[2][2];
    PG8_STAGE(PG8_SB(0, 0), oc.B, vb[0]); PG8_STAGE(PG8_SA(0, 0), oc.A, va[0]); PG8_STAGE(PG8_SB(0, 1), oc.B, vb[1]); PG8_STAGE(PG8_SA(0, 1), oc.A, va[1]);
    if (wr == 1) PG8_BAR;
    PG8_WAIT_V(4); PG8_BAR;
    PG8_STAGE(PG8_SB(1, 0), oc.B + kstep, vb[0]); PG8_STAGE(PG8_SA(1, 0), oc.A + kstep, va[0]); PG8_STAGE(PG8_SB(1, 1), oc.B + kstep, vb[1]);
    PG8_WAIT_V(6); PG8_BAR;
    for (;;) {
        const bool has_next = PV.get(ui + 1, nxt, on);
        if (!has_next) on = oc;
#pragma unroll 1
        for (int t = 0; t < nt; t += 2) {
            const bool last = (t == nt - 2);
            const char* a1 = oc.A + (size_t)(t + 1) * kstep;
            const char* a2 = last ? on.A : oc.A + (size_t)(t + 2) * kstep; const char* b2 = last ? on.B : oc.B + (size_t)(t + 2) * kstep;
            const char* a3 = a2 + kstep; const char* b3 = b2 + kstep;
            PG8_LDB(B0, 0, 0); PG8_SCHED; PG8_LDA(At, 0, 0); PG8_STAGE(PG8_SA(1, 1), a1, va[1]);
            PG8_WAIT_L(8); PG8_BAR; PG8_WAIT_L(0); PG8_MMA(0, 0, At, B0); PG8_BAR; PG8_SCHED;
            PG8_LDB(B1, 0, 1); PG8_STAGE(PG8_SB(0, 0), b2, vb[0]);
            PG8_BAR; PG8_WAIT_L(0); PG8_MMA(0, 1, At, B1); PG8_BAR;
            PG8_LDA(At, 0, 1); PG8_STAGE(PG8_SA(0, 0), a2, va[0]);
            PG8_BAR; PG8_WAIT_L(0); PG8_MMA(1, 0, At, B0); PG8_BAR; PG8_SCHED;
            PG8_STAGE(PG8_SB(0, 1), b2, vb[1]);
            PG8_WAIT_V(6); PG8_BAR; PG8_MMA(1, 1, At, B1); PG8_BAR;
            PG8_LDB(B0, 1, 0); PG8_SCHED; PG8_LDA(At, 1, 0); PG8_STAGE(PG8_SA(0, 1), a2, va[1]);
            PG8_WAIT_L(8); PG8_BAR; PG8_WAIT_L(0); PG8_MMA(0, 0, At, B0); PG8_BAR; PG8_SCHED;
            PG8_LDB(B1, 1, 1); PG8_STAGE(PG8_SB(1, 0), b3, vb[0]);
            PG8_BAR; PG8_WAIT_L(0); PG8_MMA(0, 1, At, B1); PG8_BAR;
            PG8_LDA(At, 1, 1); PG8_STAGE(PG8_SA(1, 0), a3, va[0]);
            PG8_BAR; PG8_WAIT_L(0); PG8_MMA(1, 0, At, B0); PG8_BAR; PG8_SCHED;
            PG8_STAGE(PG8_SB(1, 1), b3, vb[1]);
            PG8_WAIT_V(6); PG8_BAR; PG8_MMA(1, 1, At, B1); PG8_BAR;
        }
        bool keep;
        { int tz = threadIdx.x; asm volatile("" : "+v"(tz));
          keep = E(acc, cur, ui, wr, wc, tz & 15, (tz >> 4) & 3); }
        if (!has_next) break;
        if (!keep)
#pragma unroll
        for (int a = 0; a < 2; ++a)
#pragma unroll
            for (int b = 0; b < 2; ++b)
#pragma unroll
                for (int m = 0; m < 4; ++m)
#pragma unroll
                    for (int n = 0; n < 2; ++n) acc[a][b][m][n] = (f32x4){0.f, 0.f, 0.f, 0.f};
        cur = nxt; oc = on; ++ui;
    }
    PG8_WAIT_V(0);
    if (wr == 0) PG8_BAR;
    PG8_BAR;
#undef PG8_SA
#undef PG8_SB
#undef PG8_STAGE
#undef PG8_LDA
#undef PG8_LDB
#undef PG8_MMA
#undef PG8_WAIT_V
#undef PG8_WAIT_L
#undef PG8_BAR
#undef PG8_SCHED
}
struct StaticOrder {
    int nM, nN, nwg, G, c;
    __device__ void init(int M, int N, int G_, int c_) { nM = M / BM; nN = N / BM; nwg = nM * nN; G = G_; c = c_; }
    __device__ bool next(int i, Unit& u) const {
        const long L = (long)i * G + c; if (L >= nwg) return false;
        int wgid = (int)L; { const int q = nwg / 8, r = nwg % 8, xcd = wgid % 8, off = wgid / 8; wgid = (xcd < r ? xcd * (q + 1) : r * (q + 1) + (xcd - r) * q) + off; }
        const int nig = 8 * nN, gid = wgid / nig, fm = gid * 8, gsz = (nM - fm) < 8 ? (nM - fm) : 8;
        u.pm = fm + ((wgid % nig) % gsz); u.pn = (wgid % nig) / gsz; return true;
    }
};
struct DenseProv {
    StaticOrder S; const bf16_t* A; const bf16_t* Bt; long lda, ldb; bool perm;
    __device__ __forceinline__ void offsets(unsigned (&va)[2][2], unsigned (&vb)[2][2], const int (&sR)[2], const int (&sC)[2]) const {
#pragma unroll
        for (int h = 0; h < 2; ++h)
#pragma unroll
            for (int p = 0; p < 2; ++p) { const int rb = perm ? ((sR[p] & ~31) + perm32(sR[p] & 31)) : sR[p];
                va[h][p] = (unsigned)(((size_t)(h * HALF + sR[p]) * lda + sC[p]) * 2); vb[h][p] = (unsigned)(((size_t)(h * HALF + rb) * ldb + sC[p]) * 2); }
    }
    __device__ __forceinline__ bool get(int i, Unit& u, Ops& o) const {
        if (!S.next(i, u)) return false;
        o.A = (const char*)(A + (size_t)u.pm * BM * lda); o.B = (const char*)(Bt + (size_t)u.pn * BM * ldb);
        return true;
    }
};
}

__device__ __forceinline__ void phase0(const Params& P) {
    const int t = threadIdx.x, lane = t & 63, w = t >> 6;
    const int gw = blockIdx.x * NWV + w, nw = gridDim.x * NWV;
    bf16_t* H0 = (bf16_t*)(P.ws + WS_H0);
    for (int row0 = gw; row0 < NTOK; row0 += 2 * nw) {
        const int row1 = row0 + nw; const bool has1 = row1 < NTOK;
        const float4* xr0 = (const float4*)(P.x + (size_t)row0 * DM); const float4* xr1 = (const float4*)(P.x + (size_t)(has1 ? row1 : row0) * DM);
        float4 v[2][4]; float s0 = 0.f, s1 = 0.f;
#pragma unroll
        for (int i = 0; i < 4; ++i) { v[0][i] = xr0[lane + 64 * i]; v[1][i] = xr1[lane + 64 * i]; }
#pragma unroll
        for (int i = 0; i < 4; ++i) { s0 += v[0][i].x + v[0][i].y + v[0][i].z + v[0][i].w; s1 += v[1][i].x + v[1][i].y + v[1][i].z + v[1][i].w; }
        const float mu0 = wave_sum(s0) * (1.f / DM), mu1 = wave_sum(s1) * (1.f / DM);
        float q0 = 0.f, q1 = 0.f;
#pragma unroll
        for (int i = 0; i < 4; ++i) {
            { float a = v[0][i].x - mu0, b = v[0][i].y - mu0, c = v[0][i].z - mu0, d = v[0][i].w - mu0; q0 += a * a + b * b + c * c + d * d; }
            { float a = v[1][i].x - mu1, b = v[1][i].y - mu1, c = v[1][i].z - mu1, d = v[1][i].w - mu1; q1 += a * a + b * b + c * c + d * d; }
        }
        const float rstd0 = rsqrtf(wave_sum(q0) * (1.f / DM) + 1e-5f), rstd1 = rsqrtf(wave_sum(q1) * (1.f / DM) + 1e-5f);
#pragma unroll
        for (int i = 0; i < 4; ++i) {
            const float4 g = ((const float4*)P.ln0_g)[lane + 64 * i], bb = ((const float4*)P.ln0_b)[lane + 64 * i];
            *(uint2*)(H0 + (size_t)row0 * DM + 4 * (lane + 64 * i)) =
                make_uint2(pack2((v[0][i].x - mu0) * rstd0 * g.x + bb.x, (v[0][i].y - mu0) * rstd0 * g.y + bb.y), pack2((v[0][i].z - mu0) * rstd0 * g.z + bb.z, (v[0][i].w - mu0) * rstd0 * g.w + bb.w));
            if (has1) *(uint2*)(H0 + (size_t)row1 * DM + 4 * (lane + 64 * i)) =
                make_uint2(pack2((v[1][i].x - mu1) * rstd1 * g.x + bb.x, (v[1][i].y - mu1) * rstd1 * g.y + bb.y), pack2((v[1][i].z - mu1) * rstd1 * g.z + bb.z, (v[1][i].w - mu1) * rstd1 * g.w + bb.w));
        }
    }
    const int gt = blockIdx.x * NTHR + t, nt = gridDim.x * NTHR;
    bf16_t* MEMB = (bf16_t*)(P.ws + WS_MEMB);
    for (int i = gt; i < 4 * 256 * DM / 4; i += nt) {
        const float4 v = ((const float4*)P.mem)[i];
        *(uint2*)(MEMB + (size_t)i * 4) = make_uint2(pack2(v.x, v.y), pack2(v.z, v.w));
    }
    float* COS = (float*)(P.ws + WS_COS); float* SIN = (float*)(P.ws + WS_SIN);
    for (int i = gt; i < SEQ * 16; i += nt) {
        const int pos = i >> 4, j = i & 15;
        const float freq = exp2f(-(float)j * (13.287712379549449f / 16.f));
        const float ang = (float)pos * freq;
        float sn, cs; sincosf(ang, &sn, &cs);
        COS[i] = cs; SIN[i] = sn;
    }
    {
        char* wsb = P.ws;
        const int tt = t & 255, kg = tt >> 5, n4 = tt & 31;
        constexpr int NJ = 17;
        const int jK[NJ]  = {1024, 768, 256, 1024, 512, 512, 512, 1024, 1024, 1024, 1024, 1024, 256, 2048, 2048, 256, 256};
        const int jN[NJ]  = {DIN, 768, 1024, 1024, 1024, 1024, 1024, 1024, 256, 256, 256, 256, 1024, 256, 256, 64, 64};
        int first[NJ + 1]; first[0] = 0;
#pragma unroll
        for (int j = 0; j < NJ; ++j) first[j + 1] = first[j] + (jK[j] >> 6) * ((jN[j] + 127) >> 7);
        for (int g = blockIdx.x * 2 + (t >> 8); g < first[NJ]; g += gridDim.x * 2) {
            int j = 0;
#pragma unroll
            for (int q = 1; q < NJ; ++q) j += (g >= first[q]) ? 1 : 0;
            const float* src; bf16_t* dst; const float* gain = nullptr; bool lo = false; int K, N, ldd, f0;
            switch (j) {
                case 0: src = P.w_in; dst = (bf16_t*)(wsb + WB_WIN); break;
                case 1: src = P.mla_w_uq; dst = (bf16_t*)(wsb + WB_WUQ); gain = P.mla_q_norm; break;
                case 2: src = P.mla_w_ukv; dst = (bf16_t*)(wsb + WB_WUKV); gain = P.mla_kv_norm; break;
                case 3: src = P.mem_w_kv; dst = (bf16_t*)(wsb + WB_WMEM); break;
                case 4: src = P.w_branch; dst = (bf16_t*)(wsb + WB_WBR); break;
                case 5: src = P.w_branch + 512 * 1024; dst = (bf16_t*)(wsb + WB_WBR) + 1024 * 512; break;
                case 6: src = P.w_branch + 2 * 512 * 1024; dst = (bf16_t*)(wsb + WB_WBR) + 2 * 1024 * 512; break;
                case 7: src = P.w_out; dst = (bf16_t*)(wsb + WB_WOUT); break;
                case 8: src = P.router_w; dst = (bf16_t*)(wsb + WB_WRHI); break;
                case 9: src = P.router_w; dst = (bf16_t*)(wsb + WB_WRLO); lo = true; break;
                case 10: src = P.sh_w1; dst = (bf16_t*)(wsb + WB_WS1); break;
                case 11: src = P.sh_w3; dst = (bf16_t*)(wsb + WB_WS3); break;
                case 12: src = P.sh_w2; dst = (bf16_t*)(wsb + WB_WS2); break;
                case 13: src = P.cmp_k_w1; dst = (bf16_t*)(wsb + WB_WCK1); break;
                case 14: src = P.cmp_v_w1; dst = (bf16_t*)(wsb + WB_WCV1); break;
                case 15: src = P.cmp_k_w2; dst = (bf16_t*)(wsb + WB_WCK2); break;
                default: src = P.cmp_v_w2; dst = (bf16_t*)(wsb + WB_WCV2); break;
            }
            K = jK[0]; N = jN[0]; f0 = first[0];
#pragma unroll
            for (int q = 1; q < NJ; ++q) if (j == q) { K = jK[q]; N = jN[q]; f0 = first[q]; }
            ldd = K;
            const int ntn = (N + 127) >> 7, tile = g - f0;
            const int k0 = (tile / ntn) * 64 + kg * 8, n = (tile % ntn) * 128 + n4 * 4;
            if (n < N) {
                float4 r[8];
#pragma unroll
                for (int kk = 0; kk < 8; ++kk) r[kk] = *(const float4*)(src + (size_t)(k0 + kk) * N + n);
                if (gain) {
#pragma unroll
                    for (int kk = 0; kk < 8; ++kk) { const float gg = gain[k0 + kk]; r[kk].x *= gg; r[kk].y *= gg; r[kk].z *= gg; r[kk].w *= gg; }
                }
#pragma unroll
                for (int c = 0; c < 4; ++c) {
                    float v[8];
#pragma unroll
                    for (int kk = 0; kk < 8; ++kk) { float f = (c == 0) ? r[kk].x : (c == 1) ? r[kk].y : (c == 2) ? r[kk].z : r[kk].w; if (lo) f = f - bf2f(f2bf(f)); v[kk] = f; }
                    *(uint4*)(dst + (size_t)(n + c) * ldd + k0) = make_uint4(pack2(v[0], v[1]), pack2(v[2], v[3]), pack2(v[4], v[5]), pack2(v[6], v[7]));
                }
            }
        }
        float* POSP = (float*)(wsb + WB_POSP);
        for (int i = gt; i < 2 * 16 * 256 * 16; i += nt) {
            const int o = i >> 4, part = i & 15, kv = o >> 12, kc = (o >> 8) & 15, c = o & 255;
            const float* pos = kv ? P.cmp_pos_v : P.cmp_pos_k; const float* w1 = kv ? P.cmp_v_w1 : P.cmp_k_w1;
            float a = 0.f;
#pragma unroll
            for (int k8 = 0; k8 < 8; ++k8) { const int k = kc * 128 + part * 8 + k8; a += pos[k] * w1[(size_t)k * 256 + c]; }
            a += __uint_as_float(__builtin_amdgcn_update_dpp(0u, __float_as_uint(a), 0xB1, 0xF, 0xF, true));
            a += __uint_as_float(__builtin_amdgcn_update_dpp(0u, __float_as_uint(a), 0x4E, 0xF, 0xF, true));
            a += __uint_as_float(__builtin_amdgcn_update_dpp(0u, __float_as_uint(a), 0x141, 0xF, 0xF, true));
            a += __uint_as_float(__builtin_amdgcn_update_dpp(0u, __float_as_uint(a), 0x140, 0xF, 0xF, true));
            if (part == 0) POSP[o] = a;
        }
    }
    bf16_t* KC = (bf16_t*)(P.ws + WS_KC); bf16_t* VTC = (bf16_t*)(P.ws + WS_VTC);
    for (int i = gt; i < 8 * 64; i += nt) { const int bg = i >> 6, d = i & 63; KC[((size_t)bg * 512 + 511) * 64 + d] = 0; VTC[((size_t)bg * 64 + d) * 512 + 511] = 0; }
}

__device__ __forceinline__ void proj_store8(const Params& P, int tok, int n0, f32x4 v0, f32x4 v1) {
    if (n0 >= DIN) return;
    const int nt = n0 >> 7;
    if (nt >= 4 && nt < 10) {
        const int j = nt - 4, g = (n0 >> 6) & 1, d = n0 & 63, b = tok >> 13, sq = tok & 8191;
        bf16_t* dstk = (bf16_t*)(P.ws + (j == 0 ? WS_KCS : j == 1 ? WS_VCS : j == 2 ? WS_KSLC : j == 4 ? WS_KWIN : j == 3 ? WS_VTSLC : WS_VTWIN));
        if (j == 3 || j == 5) {
#pragma unroll
            for (int r = 0; r < 4; ++r) { dstk[((size_t)(b * 2 + g) * 64 + d + r) * SEQ + sq] = f2bf(v0[r]); dstk[((size_t)(b * 2 + g) * 64 + d + 4 + r) * SEQ + sq] = f2bf(v1[r]); }
        } else { const uint2 a = pack4(v0), c = pack4(v1); *(uint4*)(dstk + (((size_t)(b * 2 + g) * SEQ + sq) * 64 + d)) = make_uint4(a.x, a.y, c.x, c.y); }
    } else {
        float sc = 1.f;
        if (nt < 4) sc = 0.125f * LOG2E;
        else if (n0 >= C_QMEM && n0 < C_GMERGE) sc = 0.08838834764831845f * LOG2E;
        v0 *= sc; v1 *= sc;
        if (n0 >= C_GMERGE || (n0 >= C_GNSA && n0 < C_CQ)) {
#pragma unroll
            for (int r = 0; r < 4; ++r) { v0[r] = sigmoidf_(v0[r]); v1[r] = sigmoidf_(v1[r]); }
        }
        const uint2 a = pack4(v0), c = pack4(v1);
        *(uint4*)((bf16_t*)(P.ws + WS_PROJ) + (size_t)tok * DIN + n0) = make_uint4(a.x, a.y, c.x, c.y);
    }
}
template <bool LIGHT>
struct EpiProj {
    const Params* P;
    __device__ __forceinline__ bool operator()(f32x4 (&acc)[2][2][4][2], const pg8::Unit& u, int, int wr, int wc, int fr, int fq) const {
#pragma unroll
        for (int ai = 0; ai < 2; ++ai)
#pragma unroll
            for (int m = 0; m < 4; ++m) {
                const int tok = u.pm * 256 + ai * 128 + wr * 64 + m * 16 + fr;
#pragma unroll
                for (int bj = 0; bj < 2; ++bj) {
                    if (!LIGHT) proj_store8(*P, tok, u.pn * 256 + bj * 128 + wc * 32 + 8 * fq, acc[ai][bj][m][0], acc[ai][bj][m][1]);
                    else asm volatile("" :: "v"(acc[ai][bj][m][0][0]), "v"(acc[ai][bj][m][1][3]));
                }
            }
        return false;
    }
};
template <bool LIGHT>
__device__ __forceinline__ void phase1(const Params& P, char* lds) {
    {
        pg8::DenseProv PV; PV.S.init(NTOK, 6144, gridDim.x, blockIdx.x);
        PV.A = (const bf16_t*)(P.ws + WS_H0); PV.Bt = (const bf16_t*)(P.ws + WB_WIN); PV.lda = DM; PV.ldb = DM; PV.perm = true;
        EpiProj<LIGHT> E; E.P = &P;
        pg8::gemm_phase((LAS unsigned char*)lds, DM, PV, E);
    }
    for (int tile = blockIdx.x; tile < 32; tile += gridDim.x) {
        int t = threadIdx.x; asm volatile("" : "+v"(t)); const int lane = t & 63, w = t >> 6, wm = w >> 1, wn = w & 1, lr = lane & 15, lq = lane >> 4;
        f32x4 acc[4][4]; zero_acc(acc);
        {
            const int mt = tile >> 3, nt = tile & 7, m0 = mt * 256, n0 = nt * 128;
            GemmA A = make_op<4>((const bf16_t*)(P.ws + WS_MEMB), DM, m0, 1024);
            GemmA B = make_op<2>((const bf16_t*)(P.ws + WB_WMEM), 1024, n0, 1024);
            gemm_mainloop_g(lds, A, B, DM / 64, acc);
            bf16_t* KMEM = (bf16_t*)(P.ws + WS_KMEM); bf16_t* VTMEM = (bf16_t*)(P.ws + WS_VTMEM);
#pragma unroll
            for (int i = 0; i < 4; ++i) {
                const int row = m0 + wm * 64 + i * 16 + lr, b = row >> 8, m = row & 255;
#pragma unroll
                for (int jj = 0; jj < 4; ++jj) {
                    const int n = n0 + wn * 64 + jj * 16 + 4 * lq;
                    const int two = n >> 9, h = (n >> 7) & 3, d = n & 127;
                    if (two == 0) *(uint2*)(KMEM + (((size_t)(b * 4 + h) * 256 + m) * 128 + d)) = pack4(acc[i][jj]);
                    else {
#pragma unroll
                        for (int r = 0; r < 4; ++r) VTMEM[((size_t)(b * 4 + h) * 128 + d + r) * 256 + m] = f2bf(acc[i][jj][r]);
                    }
                }
            }
        }
    }
}

template <int LEN>
__device__ __forceinline__ void rows_rstd(const bf16_t* base, long ld, int m0, float* dst) {
    const int t = threadIdx.x, row = t >> 1, part = t & 1;
    const uint4* p = (const uint4*)(base + (size_t)(m0 + row) * ld + part * (LEN / 2));
    float ss = 0.f;
#pragma unroll 1
    for (int i0 = 0; i0 < LEN / 16; i0 += 16) {
        uint4 v[16];
#pragma unroll
        for (int i = 0; i < 16; ++i) v[i] = p[i0 + i];
#pragma unroll
        for (int i = 0; i < 16; ++i) {
            float a;
            a = bflo(v[i].x); ss += a * a; a = bfhi(v[i].x); ss += a * a; a = bflo(v[i].y); ss += a * a; a = bfhi(v[i].y); ss += a * a;
            a = bflo(v[i].z); ss += a * a; a = bfhi(v[i].z); ss += a * a; a = bflo(v[i].w); ss += a * a; a = bfhi(v[i].w); ss += a * a;
        }
    }
    ss += __shfl_xor(ss, 1);
    if (part == 0) dst[row] = rsqrtf(ss * (1.f / LEN) + 1e-6f);
}

template <int QOFF>
__device__ __forceinline__ void phase2(const Params& P, char* lds) {
    unsigned* ctl = (unsigned*)(P.ws + WS_CTL);
    bf16_t* PROJ = (bf16_t*)(P.ws + WS_PROJ);
    float* rsc = (float*)(lds + LDS_ROWS + 1024);
    float* gsc = (float*)(lds + LDS_KSC);
    const float* COS = (const float*)(P.ws + WS_COS); const float* SIN = (const float*)(P.ws + WS_SIN);
#define P2_TID int t = threadIdx.x; asm volatile("" : "+v"(t)); const int lane = t & 63, w = t >> 6, wm = w >> 1, wn = w & 1, lr = lane & 15, lq = lane >> 4;
#ifndef P2SEL
#define P2SEL 7
#endif
    if (P2SEL & 1) for (;;) {
        const int it = queue_pop(&ctl[QOFF + CTL_Q + 0], lds);
        if (it >= 32) break;
        P2_TID
        {
            const int kv = it >> 4, mt = it & 15, m0 = mt * 256;
            const bf16_t* SRC = (const bf16_t*)(P.ws + (kv ? WS_VCS : WS_KCS));
            const bf16_t* w1t = (const bf16_t*)(P.ws + (kv ? WB_WCV1 : WB_WCK1)); const bf16_t* w2t = (const bf16_t*)(P.ws + (kv ? WB_WCV2 : WB_WCK2));
            {
                const float* pp = (const float*)(P.ws + WB_POSP) + kv * 4096 + (t & 255);
                float a = 0.f;
#pragma unroll
                for (int kc = 0; kc < 16; ++kc) a += pp[kc * 256];
                if (t < 256) gsc[t] = a;
            }
            __syncthreads();
            bf16_t* HID = (bf16_t*)(P.ws + WS_SCR + (size_t)blockIdx.x * 131072);
            GemmA A;
#pragma unroll
            for (int i = 0; i < 4; ++i) {
                const int lr_ = gl_row(i, t); int r = m0 + lr_; r = r < 4088 ? r : 4087;
                const int b = r / 1022, rem = r - b * 1022, n = rem >> 1, g = rem & 1;
                A.off[i] = (unsigned)((((size_t)(b * 2 + g) * SEQ + 16 * n) * 64 + gl_chunk(lr_, t) * 8) * 2);
            }
            A.base = (const char*)SRC;
            for (int nt = 0; nt < 2; ++nt) {
                f32x4 acc[4][4]; zero_acc(acc);
                GemmA B = make_op<2>(w1t, 2048, nt * 128, 256);
                gemm_mainloop_g(lds, A, B, 2048 / 64, acc);
#pragma unroll
                for (int i = 0; i < 4; ++i)
#pragma unroll
                    for (int j = 0; j < 4; ++j) {
                        f32x4 v = acc[i][j];
                        const f32x4 pb = *(const f32x4*)(gsc + nt * 128 + wn * 64 + j * 16 + 4 * lq);
#pragma unroll
                        for (int r = 0; r < 4; ++r) v[r] = geluf_(v[r] + pb[r]);
                        *(uint2*)(HID + (wm * 64 + i * 16 + lr) * 256 + nt * 128 + wn * 64 + j * 16 + 4 * lq) = pack4(v);
                    }
            }
            asm volatile("s_waitcnt vmcnt(0)" ::: "memory");
            __syncthreads();
            {
                f32x4 acc[4][4]; zero_acc(acc);
                GemmA A2 = make_op<4>(HID, 256, 0, 256);
                GemmA B2 = make_op<2>(w2t, 256, 0, 64);
                gemm_mainloop_g(lds, A2, B2, 256 / 64, acc);
                if (wn == 0) {
                    bf16_t* KC = (bf16_t*)(P.ws + WS_KC); bf16_t* VTC = (bf16_t*)(P.ws + WS_VTC);
#pragma unroll
                    for (int i = 0; i < 4; ++i) {
                        const int r = m0 + wm * 64 + i * 16 + lr;
                        if (r < 4088) {
                            const int b = r / 1022, rem = r - b * 1022, n = rem >> 1, g = rem & 1;
#pragma unroll
                            for (int j = 0; j < 4; ++j) {
                                const int d = j * 16 + 4 * lq;
                                if (!kv) *(uint2*)(KC + ((size_t)(b * 2 + g) * 512 + n) * 64 + d) = pack4(acc[i][j]);
                                else {
#pragma unroll
                                    for (int rr = 0; rr < 4; ++rr) VTC[((size_t)(b * 2 + g) * 64 + d + rr) * 512 + n] = f2bf(acc[i][j][rr]);
                                }
                            }
                        }
                    }
                }
            }
        }
    }
    if (P2SEL & 2) for (;;) {
        const int it = queue_pop(&ctl[QOFF + CTL_Q + 256], lds);
        if (it >= 256) break;
        P2_TID
        {
            const int mt = it >> 1, half = it & 1, m0 = mt * 256;
            rows_rstd<768>(PROJ + C_CQ, DIN, m0, rsc);
            __syncthreads();
            GemmA A = make_op<4>(PROJ + C_CQ, DIN, m0, NTOK);
            bf16_t* QM = (bf16_t*)(P.ws + WS_QM);
            int ring = 0;
#pragma unroll 1
            for (int k3 = 0; k3 < 3; ++k3) {
                const int n0 = (half * 3 + k3) * 128;
                f32x4 acc[4][4]; zero_acc(acc);
                GemmA B = make_op<2>((const bf16_t*)(P.ws + WB_WUQ), 768, n0, 768);
                GemmA Bn = make_op<2>((const bf16_t*)(P.ws + WB_WUQ), 768, n0 + (k3 < 2 ? 128 : 0), 768);
                gemm_mainloop_c(lds, A, B, 768 / 64, acc, ring, k3 > 0, k3 < 2, A, Bn);
                const int c16 = (n0 + wn * 64) >> 4;
                const bool rp0 = (c16 % 6) == 4, rp2 = ((c16 + 2) % 6) == 4;
                int lrz = lr; asm volatile("" : "+v"(lrz));
#pragma unroll
                for (int i = 0; i < 4; ++i) {
                    const int tl = wm * 64 + i * 16 + lrz, tok = m0 + tl, pos = tok & (SEQ - 1);
                    const float sc = rsc[tl] * (0.10206207261596575f * LOG2E);
                    const float4 cs = *(const float4*)(COS + pos * 16 + 4 * lq), sn = *(const float4*)(SIN + pos * 16 + 4 * lq);
                    const float csa[4] = {cs.x, cs.y, cs.z, cs.w}, sna[4] = {sn.x, sn.y, sn.z, sn.w};
#pragma unroll
                    for (int j = 0; j < 4; ++j) acc[i][j] *= sc;
#pragma unroll
                    for (int j = 0; j < 4; j += 2) {
                        if (j == 0 ? rp0 : rp2) {
#pragma unroll
                            for (int r = 0; r < 4; ++r) {
                                const float x1 = acc[i][j][r], x2 = acc[i][j + 1][r];
                                acc[i][j][r] = x1 * csa[r] - x2 * sna[r]; acc[i][j + 1][r] = x2 * csa[r] + x1 * sna[r];
                            }
                        }
                    }
#pragma unroll
                    for (int j = 0; j < 4; ++j) *(uint2*)(QM + (size_t)tok * 768 + n0 + wn * 64 + j * 16 + 4 * lq) = pack4(acc[i][j]);
                }
            }
        }
    }
    if (P2SEL & 4) for (;;) {
        const int it = queue_pop(&ctl[QOFF + CTL_Q + 320], lds);
        if (it >= 128) break;
        P2_TID
        {
            const int mt = it, m0 = mt * 256;
            rows_rstd<256>(PROJ + C_CKV, DIN, m0, rsc);
            __syncthreads();
            GemmA A = make_op<4>(PROJ + C_CKV, DIN, m0, NTOK);
            bf16_t* KM = (bf16_t*)(P.ws + WS_KM); bf16_t* VTM = (bf16_t*)(P.ws + WS_VTM);
            int ring = 0;
#pragma unroll 1
            for (int h = 0; h < 8; ++h) {
                f32x4 acc[4][4]; zero_acc(acc);
                GemmA B = make_op<2>((const bf16_t*)(P.ws + WB_WUKV), 256, h * 128, 1024);
                GemmA Bn = make_op<2>((const bf16_t*)(P.ws + WB_WUKV), 256, (h < 7 ? h + 1 : h) * 128, 1024);
                gemm_mainloop_c<true>(lds, A, B, 256 / 64, acc, ring, h > 0, h < 7, A, Bn);
                if (wn == 0) {
#pragma unroll
                    for (int i = 0; i < 4; ++i) {
                        const int tl = wm * 64 + i * 16 + lr, tok = m0 + tl, b = tok >> 13, s = tok & (SEQ - 1);
                        const float sc = rsc[tl];
#pragma unroll
                        for (int j = 0; j < 4; ++j) *(uint2*)(KM + ((size_t)(b * 8 + h) * SEQ + s) * 96 + j * 16 + 4 * lq) = pack4(acc[i][j] * sc);
                    }
                } else {
#pragma unroll
                    for (int i = 0; i < 4; ++i) {
                        const int tl = wm * 64 + i * 16 + 4 * lq, tok = m0 + tl, b = tok >> 13, s = tok & (SEQ - 1);
                        const f32x4 sc = *(const f32x4*)(rsc + tl);
#pragma unroll
                        for (int j = 0; j < 4; ++j) *(uint2*)(VTM + ((size_t)(b * 8 + h) * 64 + j * 16 + lr) * SEQ + s) = pack4(acc[i][j] * sc);
                    }
                }
            }
        }
    }
    {
        const int t = threadIdx.x;
        bf16_t* KM = (bf16_t*)(P.ws + WS_KM);
        const int gt = blockIdx.x * NTHR + t, nt = gridDim.x * NTHR;
        for (int i = gt; i < NTOK * 16; i += nt) {
            const int tok = i >> 4, j = i & 15, b = tok >> 13, s = tok & (SEQ - 1);
            const float x1 = bf2f(PROJ[(size_t)tok * DIN + C_KROPE + j]), x2 = bf2f(PROJ[(size_t)tok * DIN + C_KROPE + 16 + j]);
            const float cs = COS[s * 16 + j], sn = SIN[s * 16 + j];
            const bf16_t o1 = f2bf(x1 * cs - x2 * sn), o2 = f2bf(x2 * cs + x1 * sn);
#pragma unroll
            for (int h = 0; h < 8; ++h) {
                bf16_t* kr = KM + ((size_t)(b * 8 + h) * SEQ + s) * 96 + 64;
                kr[j] = o1; kr[16 + j] = o2;
            }
        }
    }
}

__device__ __forceinline__ int offk(int sub, int key, int c) { return sub * 4096 + key * 64 + (((c ^ (-(key >> 2))) & 3) << 4); }
__device__ __forceinline__ int offv(int dv, int ch) { return dv * 128 + (((ch ^ (dv >> 1)) & 7) << 4); }

template <int DK, int DV, bool NEEDV, class KP, class VP, class TL, class FN>
__device__ __forceinline__ void kv_loop(char* lds, int n, KP kp, VP vp, TL tl, FN fn) {
    if (n <= 0) return;
    int t = threadIdx.x; asm volatile("" : "+v"(t));
    const int lane = t & 63, wu = __builtin_amdgcn_readfirstlane(t >> 6);
    constexpr int KPN = DK / 8, VPN = DV / 8, KPT = (KPN + 7) / 8, VPT = (VPN + 7) / 8;
    constexpr int KB = DK * 128, VB = DV * 128;
    LAS char* ldsl = (LAS char*)lds;
#define KVI_(tile, buf) { \
        _Pragma("unroll") for (int i = 0; i < KPT; ++i) { const int p_ = wu + 8 * i, key_ = 16 * (p_ & 3) + (lane >> 2), c_ = ((lane & 3) ^ (-(key_ >> 2))) & 3; \
            if (p_ < KPN) __builtin_amdgcn_global_load_lds((const unsigned*)(kp(tile, key_) + (p_ >> 2) * 32 + c_ * 8), (LAS unsigned*)(ldsl + (buf) * KB + p_ * 1024), 16, 0, 0); } \
        if (NEEDV) { _Pragma("unroll") for (int i = 0; i < VPT; ++i) { const int p_ = wu + 8 * i, dv_ = 8 * p_ + (lane >> 3), ch_ = ((lane & 7) ^ (dv_ >> 1)) & 7; \
            if (p_ < VPN) __builtin_amdgcn_global_load_lds((const unsigned*)(vp(tile, dv_) + ch_ * 8), (LAS unsigned*)(ldsl + 2 * KB + (buf) * VB + p_ * 1024), 16, 0, 0); } } }
    __syncthreads();
    { const int t0 = tl(0); KVI_(t0, 0); }
    asm volatile("s_waitcnt vmcnt(0)" ::: "memory");
    __syncthreads();
#pragma unroll 1
    for (int i = 0; i < n; ++i) {
        const int cur = i & 1, tile = tl(i);
        if (i + 1 < n) { const int tn = tl(i + 1); if (cur) KVI_(tn, 0) else KVI_(tn, 1) }
        fn(tile, (const char*)(lds + cur * KB), (const char*)(lds + 2 * KB + cur * VB));
        asm volatile("s_waitcnt vmcnt(0)" ::: "memory");
        __syncthreads();
    }
#undef KVI_
}

template <int DK, int DV, class KP, class VP, class TL, class FN>
__device__ __forceinline__ void kv_loop2(char* lds, int n, KP kp, VP vp, TL tl, FN fn) {
    if (n <= 0) return;
    int t = threadIdx.x; asm volatile("" : "+v"(t));
    const int lane = t & 63, wu = __builtin_amdgcn_readfirstlane(t >> 6);
    constexpr int KPN = DK / 8, VPN = DV / 8, KPT = (KPN + 7) / 8, VPT = (VPN + 7) / 8;
    constexpr int KB = DK * 128, VB = DV * 128, TB = KB + VB, SB = 2 * TB;
    LAS char* ldsl = (LAS char*)lds;
#define KVI2_(tile, off_) { \
        _Pragma("unroll") for (int i = 0; i < KPT; ++i) { const int p_ = wu + 8 * i, key_ = 16 * (p_ & 3) + (lane >> 2), c_ = ((lane & 3) ^ (-(key_ >> 2))) & 3; \
            if (p_ < KPN) __builtin_amdgcn_global_load_lds((const unsigned*)(kp(tile, key_) + (p_ >> 2) * 32 + c_ * 8), (LAS unsigned*)(ldsl + (off_) + p_ * 1024), 16, 0, 0); } \
        _Pragma("unroll") for (int i = 0; i < VPT; ++i) { const int p_ = wu + 8 * i, dv_ = 8 * p_ + (lane >> 3), ch_ = ((lane & 7) ^ (dv_ >> 1)) & 7; \
            if (p_ < VPN) __builtin_amdgcn_global_load_lds((const unsigned*)(vp(tile, dv_) + ch_ * 8), (LAS unsigned*)(ldsl + (off_) + KB + p_ * 1024), 16, 0, 0); } }
    const int np = (n + 1) >> 1;
    __syncthreads();
    { const int ta = tl(0), tb = tl(n > 1 ? 1 : 0); KVI2_(ta, 0); KVI2_(tb, TB); }
    asm volatile("s_waitcnt vmcnt(0)" ::: "memory");
    __syncthreads();
#pragma unroll 1
    for (int i = 0; i < np; ++i) {
        const int cur = i & 1;
        if (i + 1 < np) { const int ia = 2 * i + 2, ib = (2 * i + 3 < n) ? 2 * i + 3 : ia; const int ta = tl(ia), tb = tl(ib);
            if (cur) { KVI2_(ta, 0); KVI2_(tb, TB); } else { KVI2_(ta, SB); KVI2_(tb, SB + TB); } }
        const char* base = lds + cur * SB;
        const bool hasB = 2 * i + 1 < n;
        fn(tl(2 * i), base, base + KB, tl(hasB ? 2 * i + 1 : 2 * i), base + TB, base + TB + KB, hasB);
        asm volatile("s_waitcnt vmcnt(0)" ::: "memory");
        __syncthreads();
    }
#undef KVI2_
}

template <int DK, int NST>
__device__ __forceinline__ void qk_tile(const char* Kb, const bf16x8 (&qf)[NST][DK / 32], f32x4 (&s)[NST][4], int lane) {
    const int lr = lane & 15, lq = lane >> 4;
#pragma unroll
    for (int kt = 0; kt < 4; ++kt) {
#pragma unroll
        for (int st = 0; st < NST; ++st) s[st][kt] = (f32x4){0.f, 0.f, 0.f, 0.f};
#pragma unroll
        for (int ks = 0; ks < DK / 32; ++ks) {
            const bf16x8 kf = *(const bf16x8*)(Kb + offk(ks, kt * 16 + lr, lq));
#pragma unroll
            for (int st = 0; st < NST; ++st) s[st][kt] = mfma16(kf, qf[st][ks], s[st][kt]);
        }
    }
}
template <int DV, int NST>
__device__ __forceinline__ void pv_tile(const char* Vb, const f32x4 (&p)[NST][4], f32x4 (&O)[NST][DV / 16], int lane) {
    const int lr = lane & 15, lq = lane >> 4;
#pragma unroll
    for (int h2 = 0; h2 < 2; ++h2) {
        bf16x8 pf[NST];
#pragma unroll
        for (int st = 0; st < NST; ++st) {
            const uint2 a = pack4(p[st][2 * h2]), b = pack4(p[st][2 * h2 + 1]);
            const uint4 u = make_uint4(a.x, a.y, b.x, b.y);
            pf[st] = __builtin_bit_cast(bf16x8, u);
        }
#pragma unroll
        for (int dvt = 0; dvt < DV / 16; ++dvt) {
            const int dv = dvt * 16 + lr;
            const bf16x4 v0 = *(const bf16x4*)(Vb + offv(dv, 4 * h2 + (lq >> 1)) + (lq & 1) * 8);
            const bf16x4 v1 = *(const bf16x4*)(Vb + offv(dv, 4 * h2 + 2 + (lq >> 1)) + (lq & 1) * 8);
            const bf16x8 vf = __builtin_shufflevector(v0, v1, 0, 1, 2, 3, 4, 5, 6, 7);
#pragma unroll
            for (int st = 0; st < NST; ++st) O[st][dvt] = mfma16(vf, pf[st], O[st][dvt]);
        }
    }
}
constexpr float RESCALE_AT = 1099511627776.f, RESCALE_BY = 1.f / 1099511627776.f;
template <int DV, int NST>
__device__ __forceinline__ void softmax_online(f32x4 (&s)[NST][4], float (&c)[NST], float (&l)[NST], f32x4 (&O)[NST][DV / 16]) {
    bool scaled = false, big = false;
#pragma unroll
    for (int st = 0; st < NST; ++st) scaled = scaled || (c[st] != 1.f);
#pragma unroll
    for (int st = 0; st < NST; ++st)
#pragma unroll
        for (int kt = 0; kt < 4; ++kt)
#pragma unroll
            for (int r = 0; r < 4; ++r) s[st][kt][r] = fexp2(s[st][kt][r]);
    if (__any(scaled)) {
#pragma unroll
        for (int st = 0; st < NST; ++st)
#pragma unroll
            for (int kt = 0; kt < 4; ++kt) s[st][kt] *= c[st];
    }
#pragma unroll
    for (int st = 0; st < NST; ++st) { l[st] += sum16(s[st]); big = big || (l[st] > RESCALE_AT); }
    if (__any(big)) {
#pragma unroll
        for (int st = 0; st < NST; ++st) {
            const float f = l[st] > RESCALE_AT ? RESCALE_BY : 1.f;
            const float g = quad_min(f);
            l[st] *= g; c[st] *= g;
#pragma unroll
            for (int kt = 0; kt < 4; ++kt) s[st][kt] *= g;
#pragma unroll
            for (int dvt = 0; dvt < DV / 16; ++dvt) O[st][dvt] *= g;
        }
    }
}
__device__ __forceinline__ float quad_lsum(float l) { return quad_sum(l); }

__device__ __forceinline__ void mla_item(const Params& P, char* lds, int b, int h, int qblk) {
    int t = threadIdx.x; asm volatile("" : "+v"(t));
    const int lane = t & 63, w = t >> 6, lr = lane & 15, lq = lane >> 4;
    const bf16_t* QM = (const bf16_t*)(P.ws + WS_QM);
    const bf16_t* KM = (const bf16_t*)(P.ws + WS_KM) + (size_t)(b * 8 + h) * SEQ * 96;
    const bf16_t* VTM = (const bf16_t*)(P.ws + WS_VTM) + (size_t)(b * 8 + h) * 64 * SEQ;
    const int wq0 = qblk * 256 + w * 32;
    bf16x8 qf[2][3];
#pragma unroll
    for (int st = 0; st < 2; ++st)
#pragma unroll
        for (int ks = 0; ks < 3; ++ks) qf[st][ks] = *(const bf16x8*)(QM + (size_t)(b * SEQ + wq0 + st * 16 + lr) * 768 + h * 96 + ks * 32 + lq * 8);
    float m[2] = {1.f, 1.f}, l[2] = {0.f, 0.f};
    f32x4 O[2][4];
#pragma unroll
    for (int st = 0; st < 2; ++st)
#pragma unroll
        for (int d = 0; d < 4; ++d) O[st][d] = (f32x4){0.f, 0.f, 0.f, 0.f};
    auto mla_tile = [&](int tile, const char* Kb, const char* Vb) __attribute__((always_inline)) {
        if (tile * 64 > wq0 + 31) return;
        f32x4 s[2][4];
        qk_tile<96, 2>(Kb, qf, s, lane);
        if (tile * 64 + 63 > wq0) {
#pragma unroll
            for (int st = 0; st < 2; ++st)
#pragma unroll
                for (int kt = 0; kt < 4; ++kt)
#pragma unroll
                    for (int r = 0; r < 4; ++r)
                        if (tile * 64 + kt * 16 + 4 * lq + r > wq0 + st * 16 + lr) s[st][kt][r] = NEGBIG;
        }
        softmax_online<64, 2>(s, m, l, O);
        pv_tile<64, 2>(Vb, s, O, lane);
    };
    kv_loop2<96, 64>(lds, 4 * qblk + 4,
        [&](int tile, int key) __attribute__((always_inline)) { return KM + (size_t)(tile * 64 + key) * 96; },
        [&](int tile, int dv) __attribute__((always_inline)) { return VTM + (size_t)dv * SEQ + tile * 64; },
        [&](int i) __attribute__((always_inline)) { return i; },
        [&](int ta, const char* Ka, const char* Va, int tb, const char* Kb, const char* Vb, bool hasB) __attribute__((always_inline)) {
            mla_tile(ta, Ka, Va);
            if (hasB) mla_tile(tb, Kb, Vb);
        });
    bf16_t* OM = (bf16_t*)(P.ws + WS_OMLA);
#pragma unroll
    for (int st = 0; st < 2; ++st) {
        const float inv = 1.f / quad_lsum(l[st]);
        const size_t tok = (size_t)b * SEQ + wq0 + st * 16 + lr;
#pragma unroll
        for (int d = 0; d < 4; ++d) *(uint2*)(OM + tok * 512 + h * 64 + d * 16 + 4 * lq) = pack4(O[st][d] * inv);
    }
}

__device__ __forceinline__ void mem_item(const Params& P, char* lds, int b, int h, int qblk) {
    int t = threadIdx.x; asm volatile("" : "+v"(t));
    const int lane = t & 63, w = t >> 6, lr = lane & 15, lq = lane >> 4;
    const bf16_t* PROJ = (const bf16_t*)(P.ws + WS_PROJ);
    const bf16_t* KMEM = (const bf16_t*)(P.ws + WS_KMEM) + (size_t)(b * 4 + h) * 256 * 128;
    const bf16_t* VTMEM = (const bf16_t*)(P.ws + WS_VTMEM) + (size_t)(b * 4 + h) * 128 * 256;
    const size_t tok = (size_t)b * SEQ + qblk * 128 + w * 16 + lr;
    bf16x8 qf[1][4];
#pragma unroll
    for (int ks = 0; ks < 4; ++ks) qf[0][ks] = *(const bf16x8*)(PROJ + tok * DIN + C_QMEM + h * 128 + ks * 32 + lq * 8);
    float m[1] = {1.f}, l[1] = {0.f};
    f32x4 O[1][8];
#pragma unroll
    for (int d = 0; d < 8; ++d) O[0][d] = (f32x4){0.f, 0.f, 0.f, 0.f};
    kv_loop<128, 128, true>(lds, 4,
        [&](int tile, int key) __attribute__((always_inline)) { return KMEM + (size_t)(tile * 64 + key) * 128; },
        [&](int tile, int dv) __attribute__((always_inline)) { return VTMEM + (size_t)dv * 256 + tile * 64; },
        [&](int i) __attribute__((always_inline)) { return i; },
        [&](int tile, const char* Kb, const char* Vb) __attribute__((always_inline)) {
            f32x4 s[1][4];
            qk_tile<128, 1>(Kb, qf, s, lane);
            softmax_online<128, 1>(s, m, l, O);
            pv_tile<128, 1>(Vb, s, O, lane);
        });
    bf16_t* OM = (bf16_t*)(P.ws + WS_OMEM);
    const float inv = 1.f / quad_lsum(l[0]);
#pragma unroll
    for (int d = 0; d < 8; ++d) *(uint2*)(OM + tok * 512 + h * 128 + d * 16 + 4 * lq) = pack4(O[0][d] * inv);
}

__device__ __forceinline__ void softmax_stats(const f32x4 (&s)[2][4], float (&c)[2], float (&l)[2]) {
#pragma unroll
    for (int st = 0; st < 2; ++st) {
        f32x4 e[4];
#pragma unroll
        for (int kt = 0; kt < 4; ++kt)
#pragma unroll
            for (int r = 0; r < 4; ++r) e[kt][r] = fexp2(s[st][kt][r]);
        l[st] += sum16(e) * c[st];
        const float g = quad_min(l[st] > RESCALE_AT ? RESCALE_BY : 1.f);
        l[st] *= g; c[st] *= g;
    }
}

template <int NMASK>
__device__ __forceinline__ void nsa_item(const Params& P, char* lds, int b, int g, int q0) {
    int t = threadIdx.x; asm volatile("" : "+v"(t));
    const int lane = t & 63, w = t >> 6, lr = lane & 15, lq = lane >> 4;
    const int hg = g * 4 + (lr & 3);
    const bf16_t* PROJ = (const bf16_t*)(P.ws + WS_PROJ);
    const size_t bg = (size_t)(b * 2 + g);
    const bf16_t* KC = (const bf16_t*)(P.ws + WS_KC) + bg * 512 * 64;
    const bf16_t* VTC = (const bf16_t*)(P.ws + WS_VTC) + bg * 64 * 512;
    const bf16_t* KSLC = (const bf16_t*)(P.ws + WS_KSLC) + bg * SEQ * 64;
    const bf16_t* VTSLC = (const bf16_t*)(P.ws + WS_VTSLC) + bg * 64 * SEQ;
    const bf16_t* KWIN = (const bf16_t*)(P.ws + WS_KWIN) + bg * SEQ * 64;
    const bf16_t* VTWIN = (const bf16_t*)(P.ws + WS_VTWIN) + bg * 64 * SEQ;
    float* imp = (float*)(lds + 65536);
    const float* LUT = (const float*)(lds + LDS_LUT) + 64 * 8;
    unsigned* SEL = (unsigned*)(lds + LDS_SEL);
    unsigned* WOR = (unsigned*)(lds + LDS_WOR);
    unsigned char* TL = (unsigned char*)(lds + LDS_TL);
    int* TLN = (int*)(lds + LDS_TL + 128);
    int tpos[2];
    tpos[0] = q0 + 8 * w + (lr >> 2); tpos[1] = tpos[0] + 4;
    bf16x8 qf[2][2];
#pragma unroll
    for (int st = 0; st < 2; ++st)
#pragma unroll
        for (int ks = 0; ks < 2; ++ks) qf[st][ks] = *(const bf16x8*)(PROJ + (size_t)(b * SEQ + tpos[st]) * DIN + C_QNSA + hg * 64 + ks * 32 + lq * 8);
    auto gate = [&](int st, int k) __attribute__((always_inline)) { return bf2f(PROJ[(size_t)(b * SEQ + tpos[st]) * DIN + C_GNSA + hg * 3 + k]); };
    f32x4 OT[2][4];
#pragma unroll
    for (int i = 0; i < 16; ++i) imp[(8 * w) * 128 + i * 64 + lane] = 0.f;

    const float bfar = LUT[128 * 8 + hg];
    const int ntc = (((q0 + 32) >> 4) >> 6) + 1;
    float m[2] = {1.f, 1.f}, l[2] = {0.f, 0.f};
    auto cmp_mask = [&](int tile, f32x4 (&s)[2][4]) __attribute__((always_inline)) {
#pragma unroll
        for (int st = 0; st < 2; ++st)
#pragma unroll
            for (int kt = 0; kt < 4; ++kt)
#pragma unroll
                for (int r = 0; r < 4; ++r) {
                    const int n = tile * 64 + kt * 16 + 4 * lq + r;
                    const int dist = tpos[st] - (16 * n + 31);
                    const int di = dist < -1 ? -1 : (dist < 128 ? dist : 128);
                    s[st][kt][r] += LUT[di * 8 + hg];
                }
    };
    kv_loop<64, 64, false>(lds, ntc,
        [&](int tile, int key) __attribute__((always_inline)) { return KC + (size_t)(tile * 64 + key) * 64; },
        [&](int tile, int dv) __attribute__((always_inline)) { return VTC; },
        [&](int i) __attribute__((always_inline)) { return i; },
        [&](int tile, const char* Kb, const char* Vb) __attribute__((always_inline)) {
            f32x4 s[2][4];
            const bool farc = q0 + 8 * w - (16 * (tile * 64 + 63) + 31) >= 128;
            qk_tile<64, 2>(Kb, qf, s, lane);
            if (farc) {
#pragma unroll
                for (int st = 0; st < 2; ++st)
#pragma unroll
                    for (int kt = 0; kt < 4; ++kt) s[st][kt] += bfar;
            } else cmp_mask(tile, s);
            softmax_stats(s, m, l);
        });
    float invl[2];
#pragma unroll
    for (int st = 0; st < 2; ++st) { const float lt = quad_lsum(l[st]); invl[st] = lt > 0.f ? m[st] / lt : 0.f; }
#pragma unroll
    for (int st = 0; st < 2; ++st)
#pragma unroll
        for (int d = 0; d < 4; ++d) OT[st][d] = (f32x4){0.f, 0.f, 0.f, 0.f};
    kv_loop<64, 64, true>(lds, ntc,
        [&](int tile, int key) __attribute__((always_inline)) { return KC + (size_t)(tile * 64 + key) * 64; },
        [&](int tile, int dv) __attribute__((always_inline)) { return VTC + (size_t)dv * 512 + tile * 64; },
        [&](int i) __attribute__((always_inline)) { return i; },
        [&](int tile, const char* Kb, const char* Vb) __attribute__((always_inline)) {
            f32x4 s[2][4];
            const bool farc = q0 + 8 * w - (16 * (tile * 64 + 63) + 31) >= 128;
            qk_tile<64, 2>(Kb, qf, s, lane);
            if (farc) {
#pragma unroll
                for (int st = 0; st < 2; ++st)
#pragma unroll
                    for (int kt = 0; kt < 4; ++kt) s[st][kt] += bfar;
            } else cmp_mask(tile, s);
#pragma unroll
            for (int st = 0; st < 2; ++st)
#pragma unroll
                for (int kt = 0; kt < 4; ++kt) {
#pragma unroll
                    for (int r = 0; r < 4; ++r) {
                        s[st][kt][r] = fexp2(s[st][kt][r]) * invl[st];
                    }
                    float ps = (s[st][kt][0] + s[st][kt][1]) + (s[st][kt][2] + s[st][kt][3]);
                    float pc = s[st][kt][3];
                    ps = quad4_sum(ps);
                    pc = quad4_sum(pc);
                    const int j = tile * 16 + kt * 4 + lq;
                    float* row = imp + (8 * w + 4 * st + (lr >> 2)) * 128;
                    if ((lr & 3) == 0) lds_fadd(&row[j], ps);
                    if ((lr & 3) == 0 && j + 1 < 128) lds_fadd(&row[j + 1], pc);
                }
            pv_tile<64, 2>(Vb, s, OT, lane);
        });
#pragma unroll
    for (int st = 0; st < 2; ++st) {
        const float g0 = gate(st, 0);
#pragma unroll
        for (int d = 0; d < 4; ++d) OT[st][d] *= g0;
    }

    {
        unsigned wo0 = 0, wo1 = 0, wo2 = 0, wo3 = 0;
        for (int qi = 0; qi < 8; ++qi) {
            const int tq = q0 + 8 * w + qi, cur = tq >> 6;
            const float v0 = imp[(8 * w + qi) * 128 + lane], v1 = imp[(8 * w + qi) * 128 + 64 + lane];
            const int j0 = lane, j1 = lane + 64;
            bool s0 = (j0 == 0) || (j0 == cur) || (j0 + 1 == cur);
            bool s1 = (j1 == cur) || (j1 + 1 == cur);
            const bool c0 = (j0 >= 1) && (j0 + 2 <= cur), c1 = (j1 + 2 <= cur);
            if (cur - 2 <= 13) { s0 = s0 || c0; s1 = s1 || c1; }
            else {
                const unsigned k0 = c0 ? __float_as_uint(v0) + 1u : 0u, k1 = c1 ? __float_as_uint(v1) + 1u : 0u;
                unsigned T = 0u;
                for (int bit = 30; bit >= 0; --bit) {
                    const unsigned cand = T | (1u << bit);
                    const int cnt = __popcll(__ballot(k0 >= cand)) + __popcll(__ballot(k1 >= cand));
                    if (cnt >= 13) { T = cand; if (cnt == 13) break; }
                }
                const unsigned long long gt0 = __ballot(k0 > T), gt1 = __ballot(k1 > T);
                unsigned long long eq0 = __ballot(k0 == T), eq1 = __ballot(k1 == T);
                int need = 13 - (__popcll(gt0) + __popcll(gt1));
                unsigned long long tk0 = 0ull, tk1 = 0ull;
                while (need > 0 && eq0) { const unsigned long long lowb = eq0 & (0ull - eq0); tk0 |= lowb; eq0 ^= lowb; --need; }
                while (need > 0 && eq1) { const unsigned long long lowb = eq1 & (0ull - eq1); tk1 |= lowb; eq1 ^= lowb; --need; }
                s0 = s0 || ((gt0 | tk0) >> lane) & 1ull;
                s1 = s1 || ((gt1 | tk1) >> lane) & 1ull;
            }
            const unsigned long long b0 = __ballot(s0), b1 = __ballot(s1);
            if (lane == 0) {
                SEL[(8 * w + qi) * 4 + 0] = (unsigned)b0; SEL[(8 * w + qi) * 4 + 1] = (unsigned)(b0 >> 32);
                SEL[(8 * w + qi) * 4 + 2] = (unsigned)b1; SEL[(8 * w + qi) * 4 + 3] = (unsigned)(b1 >> 32);
            }
            wo0 |= (unsigned)b0; wo1 |= (unsigned)(b0 >> 32); wo2 |= (unsigned)b1; wo3 |= (unsigned)(b1 >> 32);
        }
        if (lane == 0) { WOR[w * 4 + 0] = wo0; WOR[w * 4 + 1] = wo1; WOR[w * 4 + 2] = wo2; WOR[w * 4 + 3] = wo3; }
    }
    __syncthreads();
    if (w == 0) {
        unsigned o0 = 0u, o1 = 0u, o2 = 0u, o3 = 0u;
#pragma unroll
        for (int ww = 0; ww < NWV; ++ww) { o0 |= WOR[ww * 4 + 0]; o1 |= WOR[ww * 4 + 1]; o2 |= WOR[ww * 4 + 2]; o3 |= WOR[ww * 4 + 3]; }
        const bool n0 = ((lane < 32 ? o0 : o1) >> (lane & 31)) & 1u, n1 = ((lane < 32 ? o2 : o3) >> (lane & 31)) & 1u;
        const unsigned long long m0 = __ballot(n0), m1 = __ballot(n1);
        const unsigned long long below = (1ull << lane) - 1ull;
        const int c0 = __popcll(m0);
        if (n0) TL[__popcll(m0 & below)] = (unsigned char)lane;
        if (n1) TL[c0 + __popcll(m1 & below)] = (unsigned char)(64 + lane);
        if (lane == 0) *TLN = c0 + __popcll(m1);
    }
    __syncthreads();
    const int nts = *TLN;
    f32x4* ST = (f32x4*)(lds + 65536);
#pragma unroll
    for (int k = 0; k < 8; ++k) ST[k * NTHR + t] = OT[k >> 2][k & 3];

    if (NMASK & 2)
    {
        f32x4 Oa[1][4], Ob[1][4];
#pragma unroll
        for (int d = 0; d < 4; ++d) { Oa[0][d] = (f32x4){0.f, 0.f, 0.f, 0.f}; Ob[0][d] = (f32x4){0.f, 0.f, 0.f, 0.f}; }
        float ca[1] = {1.f}, cb[1] = {1.f}, la[1] = {0.f}, lb[1] = {0.f};
        bf16x8 qfa[1][2], qfb[1][2];
#pragma unroll
        for (int ks = 0; ks < 2; ++ks) { qfa[0][ks] = qf[0][ks]; qfb[0][ks] = qf[1][ks]; }
        auto proc = [&](int tile, const char* Kb, const char* Vb, const bf16x8 (&q1)[1][2], f32x4 (&O1)[1][4], float (&c1)[1], float (&l1)[1], bool on, int tp) __attribute__((always_inline)) {
            f32x4 s[1][4];
            qk_tile<64, 1>(Kb, q1, s, lane);
            const bool far = tile * 64 + 63 + 128 <= q0 + 8 * w;
            if (far) {
                const float ab = on ? bfar : NEGBIG;
#pragma unroll
                for (int kt = 0; kt < 4; ++kt) s[0][kt] += ab;
            } else {
                int D = tp - (tile * 64 + 4 * lq); D = D < 191 ? D : 191; D = on ? D : -1;
                const float* lp = LUT + (D - 63) * 8 + hg;
#pragma unroll
                for (int kt = 0; kt < 4; ++kt)
#pragma unroll
                    for (int r = 0; r < 4; ++r) s[0][kt][r] += lp[(63 - (kt * 16 + r)) * 8];
            }
            softmax_online<64, 1>(s, c1, l1, O1);
            pv_tile<64, 1>(Vb, s, O1, lane);
        };
        auto s_tile = [&](int tile, const char* Kb, const char* Vb) __attribute__((always_inline)) {
            const unsigned wv = WOR[w * 4 + (tile >> 5)];
            if (!((wv >> (tile & 31)) & 1u)) return;
            const bool on0 = (SEL[(8 * w + (lr >> 2)) * 4 + (tile >> 5)] >> (tile & 31)) & 1u;
            const bool on1 = (SEL[(8 * w + 4 + (lr >> 2)) * 4 + (tile >> 5)] >> (tile & 31)) & 1u;
            if (__any(on0)) proc(tile, Kb, Vb, qfa, Oa, ca, la, on0, tpos[0]);
            if (__any(on1)) proc(tile, Kb, Vb, qfb, Ob, cb, lb, on1, tpos[1]);
        };
        kv_loop2<64, 64>(lds, nts,
            [&](int tile, int key) __attribute__((always_inline)) { return KSLC + (size_t)(tile * 64 + key) * 64; },
            [&](int tile, int dv) __attribute__((always_inline)) { return VTSLC + (size_t)dv * SEQ + tile * 64; },
            [&](int i) __attribute__((always_inline)) { return (int)TL[i]; },
            [&](int ta, const char* Ka, const char* Va, int tb, const char* Kb, const char* Vb, bool hasB) __attribute__((always_inline)) {
                s_tile(ta, Ka, Va);
                if (hasB) s_tile(tb, Kb, Vb);
            });
        {
            const float lt = quad_lsum(la[0]);
            const float f = lt > 0.f ? gate(0, 1) / lt : 0.f;
#pragma unroll
            for (int d = 0; d < 4; ++d) ST[d * NTHR + t] += Oa[0][d] * f;
        }
        {
            const float lt = quad_lsum(lb[0]);
            const float f = lt > 0.f ? gate(1, 1) / lt : 0.f;
#pragma unroll
            for (int d = 0; d < 4; ++d) ST[(4 + d) * NTHR + t] += Ob[0][d] * f;
        }
    }
    if (NMASK & 4) {
        f32x4 O[2][4];
#pragma unroll
        for (int st = 0; st < 2; ++st)
#pragma unroll
            for (int d = 0; d < 4; ++d) O[st][d] = (f32x4){0.f, 0.f, 0.f, 0.f};
        m[0] = 1.f; m[1] = 1.f; l[0] = 0.f; l[1] = 0.f;
        const int tw0 = (q0 - 511 > 0 ? q0 - 511 : 0) >> 6, tw1 = (q0 + 63) >> 6;
        kv_loop<64, 64, true>(lds, tw1 - tw0 + 1,
            [&](int tile, int key) __attribute__((always_inline)) { return KWIN + (size_t)(tile * 64 + key) * 64; },
            [&](int tile, int dv) __attribute__((always_inline)) { return VTWIN + (size_t)dv * SEQ + tile * 64; },
            [&](int i) __attribute__((always_inline)) { return tw0 + i; },
            [&](int tile, const char* Kb, const char* Vb) __attribute__((always_inline)) {
                f32x4 s[2][4];
                const bool mid = q0 + 8 * w - (tile * 64 + 63) >= 128 && q0 + 8 * w + 7 - tile * 64 < 512;
                qk_tile<64, 2>(Kb, qf, s, lane);
                if (mid) {
#pragma unroll
                    for (int st = 0; st < 2; ++st)
#pragma unroll
                        for (int kt = 0; kt < 4; ++kt) s[st][kt] += bfar;
                } else if (q0 + 8 * w - (tile * 64 + 63) < 128) {
#pragma unroll
                    for (int st = 0; st < 2; ++st) {
                        int D = tpos[st] - (tile * 64 + 4 * lq); D = D < 191 ? D : 191;
                        const float* lp = LUT + (D - 63) * 8 + hg;
#pragma unroll
                        for (int kt = 0; kt < 4; ++kt)
#pragma unroll
                            for (int r = 0; r < 4; ++r) s[st][kt][r] += lp[(63 - (kt * 16 + r)) * 8];
                    }
                } else {
#pragma unroll
                    for (int st = 0; st < 2; ++st)
#pragma unroll
                        for (int kt = 0; kt < 4; ++kt)
#pragma unroll
                            for (int r = 0; r < 4; ++r) {
                                const int dist = tpos[st] - (tile * 64 + kt * 16 + 4 * lq + r);
                                s[st][kt][r] = dist < 512 ? s[st][kt][r] + bfar : NEGBIG;
                            }
                }
                softmax_online<64, 2>(s, m, l, O);
                pv_tile<64, 2>(Vb, s, O, lane);
            });
#pragma unroll
        for (int st = 0; st < 2; ++st) {
            const float lt = quad_lsum(l[st]);
            const float f = lt > 0.f ? gate(st, 2) / lt : 0.f;
            bf16_t* ON = (bf16_t*)(P.ws + WS_ONSA);
#pragma unroll
            for (int d = 0; d < 4; ++d)
                *(uint2*)(ON + (size_t)(b * SEQ + tpos[st]) * 512 + hg * 64 + d * 16 + 4 * lq) = pack4(ST[(st * 4 + d) * NTHR + t] + O[st][d] * f);
        }
    }
}

#ifndef P3SEL
#define P3SEL 7
#endif
#ifndef NSADUP
#define NSADUP 7
#endif
template <int QOFF, int SEL>
__device__ __forceinline__ void phase3(const Params& P, char* lds) {
    unsigned* ctl = (unsigned*)(P.ws + WS_CTL);
#define P3_QUEUE(head_, n_, call_) { int it = queue_pop(head_, lds); while (it < (n_)) { \
        unsigned nx_ = 0u; if (threadIdx.x == 0) nx_ = atomicAdd(head_, 1u); \
        call_; \
        __syncthreads(); if (threadIdx.x == 0) *(volatile int*)(lds + LDS_ITEM) = (int)nx_; __syncthreads(); \
        it = __builtin_amdgcn_readfirstlane(*(volatile int*)(lds + LDS_ITEM)); } }
    if (SEL & 1) P3_QUEUE(&ctl[QOFF + CTL_Q + 64], 1024, mla_item(P, lds, (it & 31) >> 3, it & 7, 31 - (it >> 5)))
    if (SEL & 2) P3_QUEUE(&ctl[QOFF + CTL_Q + 128], 1024, (nsa_item<(QOFF == 0 ? 7 : NSADUP)>(P, lds, (it & 7) >> 1, it & 1, (127 - (it >> 3)) * 64)))
    if (SEL & 4) P3_QUEUE(&ctl[QOFF + CTL_Q + 192], 1024, mem_item(P, lds, it >> 8, (it >> 6) & 3, it & 63))
#undef P3_QUEUE
}

__device__ __forceinline__ void phase4(const Params& P, char* lds) {
    const bf16_t* PROJ = (const bf16_t*)(P.ws + WS_PROJ);
    bf16_t* MERGED = (bf16_t*)(P.ws + WS_MERGED);
    int ring = 0; bool primed = false;
    auto tile_mn = [&](int tile, int& m0, int& n0) __attribute__((always_inline)) {
        const int bb = tile & 255, rnd = tile >> 8, xg = bb & 7, rr = bb >> 3;
        const int mt = (xg + 8 * rnd) * 4 + (rr & 3), nt = rr >> 2; m0 = mt * 256; n0 = nt * 128;
    };
    for (int tile = blockIdx.x; tile < 1024; tile += gridDim.x) {
        int t = threadIdx.x; asm volatile("" : "+v"(t)); const int lane = t & 63, w = t >> 6, wm = w >> 1, wn = w & 1, lr = lane & 15, lq = lane >> 4;
        int m0, n0; tile_mn(tile, m0, n0);
        const bool last_tile = tile + (int)gridDim.x >= 1024;
        f32x4 tot[4][4]; zero_acc(tot);
#pragma unroll 1
        for (int br = 0; br < 3; ++br) {
            f32x4 acc[4][4]; zero_acc(acc);
            GemmA A = make_op<4>((const bf16_t*)(P.ws + WS_ONSA + (size_t)br * 32 * MBY), 512, m0, NTOK);
            GemmA B = make_op<2, true>((const bf16_t*)(P.ws + WB_WBR) + (size_t)br * 1024 * 512, 512, n0, 1024);
            const bool chain = !(br == 2 && last_tile);
            int m1 = m0, n1 = n0; const int br1 = br == 2 ? 0 : br + 1;
            if (br == 2 && !last_tile) tile_mn(tile + gridDim.x, m1, n1);
            GemmA An = make_op<4>((const bf16_t*)(P.ws + WS_ONSA + (size_t)br1 * 32 * MBY), 512, m1, NTOK);
            GemmA Bn = make_op<2, true>((const bf16_t*)(P.ws + WB_WBR) + (size_t)br1 * 1024 * 512, 512, n1, 1024);
            gemm_mainloop_c(lds, A, B, 512 / 64, acc, ring, primed, chain, An, Bn);
            primed = chain;
#pragma unroll
            for (int i = 0; i < 4; ++i) {
                const size_t tok = m0 + wm * 64 + i * 16 + lr;
#pragma unroll
                for (int jp = 0; jp < 2; ++jp) {
                    const int n = n0 + wn * 64 + jp * 32 + 8 * lq;
                    const uint4 gv = *(const uint4*)(PROJ + tok * DIN + C_GMERGE + br * 1024 + n);
                    tot[i][2 * jp][0] += bflo(gv.x) * acc[i][2 * jp][0]; tot[i][2 * jp][1] += bfhi(gv.x) * acc[i][2 * jp][1];
                    tot[i][2 * jp][2] += bflo(gv.y) * acc[i][2 * jp][2]; tot[i][2 * jp][3] += bfhi(gv.y) * acc[i][2 * jp][3];
                    tot[i][2 * jp + 1][0] += bflo(gv.z) * acc[i][2 * jp + 1][0]; tot[i][2 * jp + 1][1] += bfhi(gv.z) * acc[i][2 * jp + 1][1];
                    tot[i][2 * jp + 1][2] += bflo(gv.w) * acc[i][2 * jp + 1][2]; tot[i][2 * jp + 1][3] += bfhi(gv.w) * acc[i][2 * jp + 1][3];
                }
            }
        }
#pragma unroll
        for (int i = 0; i < 4; ++i) {
            const size_t tok = m0 + wm * 64 + i * 16 + lr;
#pragma unroll
            for (int jp = 0; jp < 2; ++jp) { const uint2 x = pack4(tot[i][2 * jp]), y = pack4(tot[i][2 * jp + 1]); *(uint4*)(MERGED + tok * DM + n0 + wn * 64 + jp * 32 + 8 * lq) = make_uint4(x.x, x.y, y.x, y.y); }
        }
    }
}

struct EpiY1 {
    const bf16_t* H0; bf16_t* Y1;
    __device__ __forceinline__ bool operator()(f32x4 (&acc)[2][2][4][2], const pg8::Unit& u, int, int wr, int wc, int fr, int fq) const {
#pragma unroll
        for (int ai = 0; ai < 2; ++ai)
#pragma unroll
            for (int m = 0; m < 4; ++m) {
                const size_t tok = (size_t)u.pm * 256 + ai * 128 + wr * 64 + m * 16 + fr;
#pragma unroll
                for (int bj = 0; bj < 2; ++bj) {
                    const int col = u.pn * 256 + bj * 128 + wc * 32 + 8 * fq;
                    const uint4 hv = *(const uint4*)(H0 + tok * DM + col);
                    f32x4 v0 = acc[ai][bj][m][0], v1 = acc[ai][bj][m][1];
                    v0[0] += ALPHA * bflo(hv.x); v0[1] += ALPHA * bfhi(hv.x); v0[2] += ALPHA * bflo(hv.y); v0[3] += ALPHA * bfhi(hv.y);
                    v1[0] += ALPHA * bflo(hv.z); v1[1] += ALPHA * bfhi(hv.z); v1[2] += ALPHA * bflo(hv.w); v1[3] += ALPHA * bfhi(hv.w);
                    const uint2 a = pack4(v0), c = pack4(v1);
                    *(uint4*)(Y1 + tok * H1LD + col) = make_uint4(a.x, a.y, c.x, c.y);
                }
            }
        return false;
    }
};
__device__ __forceinline__ void phase5a(const Params& P, char* lds) {
    pg8::DenseProv PV; PV.S.init(NTOK, DM, gridDim.x, blockIdx.x);
    PV.A = (const bf16_t*)(P.ws + WS_MERGED); PV.Bt = (const bf16_t*)(P.ws + WB_WOUT); PV.lda = DM; PV.ldb = DM; PV.perm = true;
    EpiY1 E; E.H0 = (const bf16_t*)(P.ws + WS_H0); E.Y1 = (bf16_t*)(P.ws + WS_Y1);
    pg8::gemm_phase((LAS unsigned char*)lds, DM, PV, E);
}

template <int MODE>
__device__ __forceinline__ void phase5b(const Params& P, char* lds) {
    const int t = threadIdx.x, lane = t & 63, w = t >> 6;
    const int gw = blockIdx.x * NWV + w, nw = gridDim.x * NWV;
    bf16_t* H1 = (bf16_t*)P.out; bf16_t* H1LO = (bf16_t*)(P.ws + WS_Y1);
    if (MODE == 0) for (int row0 = gw; row0 < NTOK; row0 += 2 * nw) {
        const int row1 = row0 + nw; const bool has1 = row1 < NTOK;
        const bf16_t* yb = (const bf16_t*)(P.ws + WS_Y1);
        uint4 raw[2][2];
#pragma unroll
        for (int u = 0; u < 2; ++u)
#pragma unroll
            for (int i = 0; i < 2; ++i) raw[u][i] = *(const uint4*)(yb + (size_t)((u && has1) ? row1 : row0) * H1LD + i * 512 + 8 * lane);
        float v[2][16]; float s[2] = {0.f, 0.f};
#pragma unroll
        for (int u = 0; u < 2; ++u)
#pragma unroll
            for (int i = 0; i < 2; ++i) {
                v[u][8 * i + 0] = bflo(raw[u][i].x); v[u][8 * i + 1] = bfhi(raw[u][i].x); v[u][8 * i + 2] = bflo(raw[u][i].y); v[u][8 * i + 3] = bfhi(raw[u][i].y);
                v[u][8 * i + 4] = bflo(raw[u][i].z); v[u][8 * i + 5] = bfhi(raw[u][i].z); v[u][8 * i + 6] = bflo(raw[u][i].w); v[u][8 * i + 7] = bfhi(raw[u][i].w);
            }
#pragma unroll
        for (int u = 0; u < 2; ++u)
#pragma unroll
            for (int k = 0; k < 16; ++k) s[u] += v[u][k];
        const float mu[2] = {wave_sum(s[0]) * (1.f / DM), wave_sum(s[1]) * (1.f / DM)};
        float q[2] = {0.f, 0.f};
#pragma unroll
        for (int u = 0; u < 2; ++u)
#pragma unroll
            for (int k = 0; k < 16; ++k) { const float d = v[u][k] - mu[u]; q[u] += d * d; }
        const float rstd[2] = {rsqrtf(wave_sum(q[0]) * (1.f / DM) + 1e-5f), rsqrtf(wave_sum(q[1]) * (1.f / DM) + 1e-5f)};
#pragma unroll
        for (int i = 0; i < 2; ++i) {
            const float4 g0 = ((const float4*)P.ln1_g)[i * 128 + 2 * lane], g1 = ((const float4*)P.ln1_g)[i * 128 + 2 * lane + 1];
            const float4 b0 = ((const float4*)P.ln1_b)[i * 128 + 2 * lane], b1 = ((const float4*)P.ln1_b)[i * 128 + 2 * lane + 1];
            const float gg[8] = {g0.x, g0.y, g0.z, g0.w, g1.x, g1.y, g1.z, g1.w}, bb[8] = {b0.x, b0.y, b0.z, b0.w, b1.x, b1.y, b1.z, b1.w};
#pragma unroll
            for (int u = 0; u < 2; ++u) {
                const int row = u ? row1 : row0;
                float h[8];
#pragma unroll
                for (int k = 0; k < 8; ++k) h[k] = (v[u][8 * i + k] - mu[u]) * rstd[u] * gg[k] + bb[k];
                const uint4 hi = make_uint4(pack2(h[0], h[1]), pack2(h[2], h[3]), pack2(h[4], h[5]), pack2(h[6], h[7]));
                const uint4 lo = make_uint4(pack2(h[0] - bflo(hi.x), h[1] - bfhi(hi.x)), pack2(h[2] - bflo(hi.y), h[3] - bfhi(hi.y)),
                                            pack2(h[4] - bflo(hi.z), h[5] - bfhi(hi.z)), pack2(h[6] - bflo(hi.w), h[7] - bfhi(hi.w)));
                if (u == 0 || has1) {
                    *(uint4*)(H1 + (size_t)row * H1LD + i * 512 + 8 * lane) = hi;
                    *(uint4*)(H1LO + (size_t)row * H1LD + i * 512 + 8 * lane) = lo;
                }
            }
        }
    }
    {
        const int tt = t & 255, sub = t >> 8, kg = tt >> 5, n4 = tt & 31;
        char* tb = lds + sub * 16384;
        bf16_t* EXPW = (bf16_t*)(P.ws + WS_EXPW);
        for (int tile0 = blockIdx.x * 2; tile0 < 768 * 32; tile0 += gridDim.x * 2) {
            const int tile = tile0 + sub;
            const int mat = tile >> 5, loc = tile & 31, e = mat / 3, which = mat - e * 3;
            const float* src = (which == 0 ? P.exp_w1 : which == 1 ? P.exp_w3 : P.exp_w2) + (size_t)e * 262144;
            bf16_t* dst = EXPW + (size_t)e * 786432 + which * 262144;
            const int N = which == 2 ? 1024 : 256, ldd = which == 2 ? 256 : 1024;
            const int kt0 = (which == 2 ? (loc >> 3) : (loc >> 1)) * 64, nt0 = (which == 2 ? (loc & 7) : (loc & 1)) * 128;
            const int k0 = kt0 + kg * 8, n = nt0 + n4 * 4;
            float4 r[8];
#pragma unroll
            for (int kk = 0; kk < 8; ++kk) r[kk] = *(const float4*)(src + (size_t)(k0 + kk) * N + n);
            if (MODE == 2) {
#pragma unroll
                for (int kk = 0; kk < 8; ++kk) asm volatile("" :: "v"(r[kk].x), "v"(r[kk].y), "v"(r[kk].z), "v"(r[kk].w));
            } else {
#pragma unroll
                for (int c = 0; c < 4; ++c) {
                    float v[8];
#pragma unroll
                    for (int kk = 0; kk < 8; ++kk) v[kk] = (c == 0) ? r[kk].x : (c == 1) ? r[kk].y : (c == 2) ? r[kk].z : r[kk].w;
                    *(uint4*)(tb + swz(4 * n4 + c, kg)) = make_uint4(pack2(v[0], v[1]), pack2(v[2], v[3]), pack2(v[4], v[5]), pack2(v[6], v[7]));
                }
                __syncthreads();
#pragma unroll
                for (int i = 0; i < 4; ++i) {
                    const int row = (tt >> 3) + 32 * i, ch = tt & 7;
                    *(uint4*)(dst + (size_t)(nt0 + row) * ldd + kt0 + ch * 8) = *(const uint4*)(tb + swz(row, ch));
                }
                __syncthreads();
            }
        }
    }
}

__device__ __forceinline__ unsigned long long ord_key(float v, int e) {
    unsigned u = __float_as_uint(v); u = (u & 0x80000000u) ? ~u : (u | 0x80000000u);
    return ((unsigned long long)u << 8) | (unsigned)(255 - e);
}
template <bool NOWRITE>
__device__ __forceinline__ void phase5d(const Params& P) {
    const int t = threadIdx.x, lane = t & 63, w = t >> 6;
    const int gw = blockIdx.x * NWV + w, nw = gridDim.x * NWV;
    const float* LOGITS = (const float*)(P.ws + WS_LOGITS);
    unsigned* ctl = (unsigned*)(P.ws + WS_CTL);
    int* EID = (int*)(P.ws + WS_EID); float* EW = (float*)(P.ws + WS_EW); int* LIST = (int*)(P.ws + WS_LIST);
    const float4 rb = ((const float4*)P.router_b)[lane];
    float4 lgn = ((const float4*)(LOGITS + (size_t)(gw < NTOK ? gw : 0) * 256))[lane];
    for (int tok = gw; tok < NTOK; tok += nw) {
        const float4 lg = lgn;
        { const int tn = tok + nw < NTOK ? tok + nw : tok; lgn = ((const float4*)(LOGITS + (size_t)tn * 256))[lane]; }
        float s[4] = {sigmoidf_(lg.x), sigmoidf_(lg.y), sigmoidf_(lg.z), sigmoidf_(lg.w)};
        float sb[4] = {s[0] + rb.x, s[1] + rb.y, s[2] + rb.z, s[3] + rb.w};
        float a = fmaxf(sb[0], sb[1]), bq = fminf(sb[0], sb[1]);
        { const float a2 = fmaxf(sb[2], sb[3]), b2 = fminf(sb[2], sb[3]); const float na = fmaxf(a, a2); bq = fmaxf(fminf(a, a2), fmaxf(bq, b2)); a = na; }
#define DPPF_(x, ctrl) __uint_as_float(__builtin_amdgcn_update_dpp(0u, __float_as_uint(x), ctrl, 0xF, 0xF, true))
        { const float a2 = DPPF_(a, 0xB1), b2 = DPPF_(bq, 0xB1); const float na = fmaxf(a, a2); bq = fmaxf(fminf(a, a2), fmaxf(bq, b2)); a = na; }
        { const float a2 = DPPF_(a, 0x4E), b2 = DPPF_(bq, 0x4E); const float na = fmaxf(a, a2); bq = fmaxf(fminf(a, a2), fmaxf(bq, b2)); a = na; }
        { const float a2 = DPPF_(a, 0x141), b2 = DPPF_(bq, 0x141); const float na = fmaxf(a, a2); bq = fmaxf(fminf(a, a2), fmaxf(bq, b2)); a = na; }
#undef DPPF_
        const float gs = a + bq; const int grp = lane >> 3;
        int rank = 0;
#pragma unroll
        for (int g2 = 0; g2 < 8; ++g2) { const float o = __uint_as_float(__builtin_amdgcn_readlane(__float_as_uint(gs), g2 * 8)); rank += (o > gs || (o == gs && g2 < grp)) ? 1 : 0; }
        const bool gsel = rank < 4;
        float v[4];
#pragma unroll
        for (int i = 0; i < 4; ++i) v[i] = gsel ? sb[i] : -3.0e38f;
        int my_e = 0; float my_s = 0.f, wsum = 0.f;
        for (int r = 0; r < 8; ++r) {
            float bv = v[0]; int bi = 0;
#pragma unroll
            for (int i = 1; i < 4; ++i) if (v[i] > bv) { bv = v[i]; bi = i; }
            const float wm = wave_max(bv);
            const int wl = __builtin_amdgcn_readfirstlane(__ffsll((long long)__ballot(bv == wm)) - 1);
            const int wi = __builtin_amdgcn_readlane(bi, wl);
            const float mine = bi == 0 ? s[0] : bi == 1 ? s[1] : bi == 2 ? s[2] : s[3];
            const float sv = __uint_as_float(__builtin_amdgcn_readlane(__float_as_uint(mine), wl));
            if (lane == wl) { if (bi == 0) v[0] = -3.0e38f; else if (bi == 1) v[1] = -3.0e38f; else if (bi == 2) v[2] = -3.0e38f; else v[3] = -3.0e38f; }
            wsum += sv;
            if (lane == r) { my_e = wl * 4 + wi; my_s = sv; }
        }
        if (NOWRITE) { asm volatile("" :: "v"(my_e), "v"(my_s), "v"(wsum)); }
        else if (lane < 8) {
            const float wv = my_s / wsum * 2.5f;
            EID[tok * 8 + lane] = my_e; EW[tok * 8 + lane] = wv;
            const unsigned pos = atomicAdd(&ctl[CTL_CNT + my_e * 16], 1u);
            LIST[(size_t)my_e * NTOK + pos] = tok * 8 + lane;
        }
    }
}

struct ProvUp {
    const char* h1; const char* wb; const int* aid;
    __device__ __forceinline__ void offsets(unsigned (&va)[2][2], unsigned (&vb)[2][2], const int (&sR)[2], const int (&sC)[2]) const {
#pragma unroll
        for (int h = 0; h < 2; ++h)
#pragma unroll
            for (int p = 0; p < 2; ++p) {
                va[h][p] = (unsigned)(((size_t)(aid[h * 128 + sR[p]] >> 3) * H1LD + sC[p]) * 2);
                vb[h][p] = (unsigned)(((size_t)h * 262144 + (size_t)((sR[p] & ~31) + pg8::perm32(sR[p] & 31)) * 1024 + sC[p]) * 2);
            }
    }
    __device__ __forceinline__ bool get(int i, pg8::Unit& u, pg8::Ops& o) const {
        if (i >= 2) return false;
        u.pm = 0; u.pn = i; o.A = h1; o.B = wb + (size_t)i * 128 * 1024 * 2;
        return true;
    }
};
struct EpiUp {
    bf16_t* scr;
    __device__ __forceinline__ bool operator()(f32x4 (&acc)[2][2][4][2], const pg8::Unit& u, int, int wr, int wc, int fr, int fq) const {
#pragma unroll
        for (int ai = 0; ai < 2; ++ai)
#pragma unroll
            for (int m = 0; m < 4; ++m) {
                const int row = ai * 128 + wr * 64 + m * 16 + fr;
                f32x4 v0, v1;
#pragma unroll
                for (int r = 0; r < 4; ++r) { v0[r] = siluf_(acc[ai][0][m][0][r]) * acc[ai][1][m][0][r]; v1[r] = siluf_(acc[ai][0][m][1][r]) * acc[ai][1][m][1][r]; }
                const uint2 a = pack4(v0), c = pack4(v1);
                *(uint4*)(scr + row * 256 + u.pn * 128 + wc * 32 + 8 * fq) = make_uint4(a.x, a.y, c.x, c.y);
            }
        return false;
    }
};
struct ProvDown {
    const char* scr; const char* w2t;
    __device__ __forceinline__ void offsets(unsigned (&va)[2][2], unsigned (&vb)[2][2], const int (&sR)[2], const int (&sC)[2]) const {
#pragma unroll
        for (int h = 0; h < 2; ++h)
#pragma unroll
            for (int p = 0; p < 2; ++p) { va[h][p] = (unsigned)(((h * 128 + sR[p]) * 256 + sC[p]) * 2); vb[h][p] = (unsigned)(((h * 128 + (sR[p] & ~31) + pg8::perm32(sR[p] & 31)) * 256 + sC[p]) * 2); }
    }
    __device__ __forceinline__ bool get(int i, pg8::Unit& u, pg8::Ops& o) const {
        if (i >= 4) return false;
        u.pm = 0; u.pn = i; o.A = scr; o.B = w2t + (size_t)i * 256 * 256 * 2;
        return true;
    }
};
struct EpiDown {
    bf16_t* Y; bf16_t* SHOUT; const int* aid; int rows; bool routed;
    __device__ __forceinline__ bool operator()(f32x4 (&acc)[2][2][4][2], const pg8::Unit& u, int, int wr, int wc, int fr, int fq) const {
#pragma unroll
        for (int ai = 0; ai < 2; ++ai)
#pragma unroll
            for (int m = 0; m < 4; ++m) {
                const int row = ai * 128 + wr * 64 + m * 16 + fr;
                if (row < rows) {
                    const int a = aid[row];
                    bf16_t* dst = (routed ? (Y + (size_t)a * DM) : (SHOUT + (size_t)(a >> 3) * H1LD)) + u.pn * 256 + wc * 32 + 8 * fq;
#pragma unroll
                    for (int bj = 0; bj < 2; ++bj) { const uint2 x = pack4(acc[ai][bj][m][0]), y = pack4(acc[ai][bj][m][1]); *(uint4*)(dst + bj * 128) = make_uint4(x.x, x.y, y.x, y.y); }
                }
            }
        return false;
    }
};
struct ProvRouter {
    const char* hi; const char* lo; const char* whi; const char* wlo; int tile0, tstep;
    __device__ __forceinline__ void offsets(unsigned (&va)[2][2], unsigned (&vb)[2][2], const int (&sR)[2], const int (&sC)[2]) const {
#pragma unroll
        for (int h = 0; h < 2; ++h)
#pragma unroll
            for (int p = 0; p < 2; ++p) { va[h][p] = (unsigned)(((size_t)(h * 128 + sR[p]) * H1LD + sC[p]) * 2); vb[h][p] = (unsigned)(((size_t)(h * 128 + sR[p]) * 1024 + sC[p]) * 2); }
    }
    __device__ __forceinline__ bool get(int i, pg8::Unit& u, pg8::Ops& o) const {
        const int q = i / 3, seg = i - q * 3, ot = tile0 + q * tstep;
        if (ot >= 128) return false;
        u.pm = ot; u.pn = seg;
        o.A = (seg == 1 ? lo : hi) + (size_t)ot * 256 * H1LD * 2; o.B = seg == 0 ? wlo : whi;
        return true;
    }
};
struct EpiRouter {
    float* LOGITS;
    __device__ __forceinline__ bool operator()(f32x4 (&acc)[2][2][4][2], const pg8::Unit& u, int, int wr, int wc, int fr, int fq) const {
        if (u.pn < 2) return true;
#pragma unroll
        for (int ai = 0; ai < 2; ++ai)
#pragma unroll
            for (int m = 0; m < 4; ++m) {
                const size_t tok = (size_t)u.pm * 256 + ai * 128 + wr * 64 + m * 16 + fr;
#pragma unroll
                for (int bj = 0; bj < 2; ++bj)
#pragma unroll
                    for (int n = 0; n < 2; ++n) *(f32x4*)(LOGITS + tok * 256 + bj * 128 + wc * 32 + n * 16 + 4 * fq) = acc[ai][bj][m][n];
            }
        return false;
    }
};
__device__ __forceinline__ void phase5c(const Params& P, char* lds) {
    const int xg = blockIdx.x & 7, rk = blockIdx.x >> 3, G8 = gridDim.x >> 3;
    const bool two = G8 >= 2; const int nr = two ? (G8 >> 1) : G8, ns = two ? G8 - nr : G8;
    if (!two || rk < nr) {
        ProvRouter PV; PV.hi = (const char*)P.out; PV.lo = (const char*)(P.ws + WS_Y1); PV.whi = (const char*)(P.ws + WB_WRHI); PV.wlo = (const char*)(P.ws + WB_WRLO);
        PV.tile0 = xg * 16 + rk; PV.tstep = 0;
        EpiRouter E; E.LOGITS = (float*)(P.ws + WS_LOGITS);
        for (int j = rk; j < 16; j += nr) { PV.tile0 = xg * 16 + j; PV.tstep = 128; pg8::gemm_phase((LAS unsigned char*)lds, DM, PV, E); }
    }
    if (!two || rk >= nr) {
        int* aid = (int*)(lds + LDS_ROWS);
        bf16_t* SCR = (bf16_t*)(P.ws + WS_SCR + (size_t)blockIdx.x * 131072);
        const bf16_t* wb = (const bf16_t*)(P.ws + WB_WS1);
        for (int j = two ? rk - nr : rk; j < 16; j += ns) {
            const int t = threadIdx.x;
            __syncthreads();
            if (t < 256) aid[t] = ((xg * 16 + j) * 256 + t) * 8;
            __syncthreads();
            {
                ProvUp PV; PV.h1 = (const char*)P.out; PV.wb = (const char*)wb; PV.aid = aid;
                EpiUp E; E.scr = SCR;
                pg8::gemm_phase((LAS unsigned char*)lds, DM, PV, E);
            }
            asm volatile("s_waitcnt vmcnt(0)" ::: "memory");
            __syncthreads();
            {
                ProvDown PV; PV.scr = (const char*)SCR; PV.w2t = (const char*)(wb + 524288);
                EpiDown E; E.Y = (bf16_t*)(P.ws + WS_Y); E.SHOUT = (bf16_t*)P.out + 1024; E.aid = aid; E.rows = 256; E.routed = false;
                pg8::gemm_phase((LAS unsigned char*)lds, 256, PV, E);
            }
            __syncthreads();
        }
    }
}

__device__ __forceinline__ void phase7(const Params& P, char* lds) {
    const int t0_ = threadIdx.x;
    unsigned* ctl = (unsigned*)(P.ws + WS_CTL);
    int* pre = (int*)(lds + LDS_PRE);
    int* aid = (int*)(lds + LDS_ROWS);
    const int* LIST = (const int*)(P.ws + WS_LIST);
    bf16_t* SCR = (bf16_t*)(P.ws + WS_SCR + (size_t)blockIdx.x * 131072);
    const int xg = blockIdx.x & 7, rk = blockIdx.x >> 3, G8 = gridDim.x >> 3;
    __syncthreads();
    if (t0_ == 0) {
        int s = 0;
        for (int k = 0; k < 32; ++k) { pre[k] = s; s += ((int)ctl[CTL_CNT + (xg + 8 * k) * 16] + 255) >> 8; }
        pre[32] = s;
    }
    __syncthreads();
    const int T = pre[32];
    for (int g = rk; g < T; g += G8) {
        const int t = threadIdx.x;
        const bf16_t* wb; int rows; const bool routed = true;
        {
            int lo = 0, hi = 32;
            while (hi - lo > 1) { const int mid = (lo + hi) >> 1; if (pre[mid] <= g) lo = mid; else hi = mid; }
            const int e = xg + 8 * lo, tile = g - pre[lo], cnt = (int)ctl[CTL_CNT + e * 16];
            rows = cnt - tile * 256; rows = rows < 256 ? rows : 256; rows = __builtin_amdgcn_readfirstlane(rows);
            if (t < 256) aid[t] = LIST[(size_t)e * NTOK + tile * 256 + (t < rows ? t : rows - 1)];
            wb = (const bf16_t*)(P.ws + WS_EXPW) + (size_t)e * 786432;
        }
        __syncthreads();
        {
            ProvUp PV; PV.h1 = (const char*)P.out; PV.wb = (const char*)wb; PV.aid = aid;
            EpiUp E; E.scr = SCR;
            pg8::gemm_phase((LAS unsigned char*)lds, DM, PV, E);
        }
        asm volatile("s_waitcnt vmcnt(0)" ::: "memory");
        __syncthreads();
        {
            ProvDown PV; PV.scr = (const char*)SCR; PV.w2t = (const char*)(wb + 524288);
            EpiDown E; E.Y = (bf16_t*)(P.ws + WS_Y); E.SHOUT = (bf16_t*)P.out + 1024; E.aid = aid; E.rows = rows; E.routed = routed;
            pg8::gemm_phase((LAS unsigned char*)lds, 256, PV, E);
        }
        __syncthreads();
    }
}

__device__ __forceinline__ void phase8(const Params& P) {
    const int t = threadIdx.x, lane = t & 63, w = t >> 6;
    const int gw = blockIdx.x * NWV + w, nw = gridDim.x * NWV;
    const bf16_t* H1 = (const bf16_t*)P.out; const bf16_t* SHOUT = (const bf16_t*)P.out + 1024;
    const bf16_t* Y = (const bf16_t*)(P.ws + WS_Y); const float* EW = (const float*)(P.ws + WS_EW);
    for (int tok = gw; tok < NTOK; tok += nw) {
        float v[4][4];
#pragma unroll
        for (int i = 0; i < 4; ++i) {
            const uint2 h = *(const uint2*)(H1 + (size_t)tok * H1LD + 4 * (lane + 64 * i));
            const uint2 s = *(const uint2*)(SHOUT + (size_t)tok * H1LD + 4 * (lane + 64 * i));
            v[i][0] = ALPHA * bflo(h.x) + bflo(s.x); v[i][1] = ALPHA * bfhi(h.x) + bfhi(s.x);
            v[i][2] = ALPHA * bflo(h.y) + bflo(s.y); v[i][3] = ALPHA * bfhi(h.y) + bfhi(s.y);
        }
#pragma unroll
        for (int k = 0; k < 8; ++k) {
            const float wk = EW[tok * 8 + k];
            const bf16_t* yr = Y + ((size_t)tok * 8 + k) * DM;
#pragma unroll
            for (int i = 0; i < 4; ++i) {
                const uint2 y = *(const uint2*)(yr + 4 * (lane + 64 * i));
                v[i][0] += wk * bflo(y.x); v[i][1] += wk * bfhi(y.x); v[i][2] += wk * bflo(y.y); v[i][3] += wk * bfhi(y.y);
            }
        }
        float s = 0.f;
#pragma unroll
        for (int i = 0; i < 4; ++i) s += v[i][0] + v[i][1] + v[i][2] + v[i][3];
        const float mu = wave_sum(s) * (1.f / DM);
        float q = 0.f;
#pragma unroll
        for (int i = 0; i < 4; ++i)
#pragma unroll
            for (int c = 0; c < 4; ++c) { const float d = v[i][c] - mu; q += d * d; }
        const float rstd = rsqrtf(wave_sum(q) * (1.f / DM) + 1e-5f);
#pragma unroll
        for (int i = 0; i < 4; ++i) {
            const float4 g = ((const float4*)P.ln2_g)[lane + 64 * i], bb = ((const float4*)P.ln2_b)[lane + 64 * i];
            float4 o;
            o.x = (v[i][0] - mu) * rstd * g.x + bb.x; o.y = (v[i][1] - mu) * rstd * g.y + bb.y;
            o.z = (v[i][2] - mu) * rstd * g.z + bb.z; o.w = (v[i][3] - mu) * rstd * g.w + bb.w;
            ((float4*)(P.out + (size_t)tok * DM))[lane + 64 * i] = o;
        }
    }
}

constexpr int N_PHASES = 11;
__global__ void __launch_bounds__(512, 2) fwd_kernel(Params P) {
    extern __shared__ __attribute__((aligned(16))) char lds[];
    const int t = threadIdx.x;
    if (t == 0) *(uint4*)(lds + LDS_BARW) = make_uint4(0u, 0u, 0u, 0u);
    {
        float* LUT = (float*)(lds + LDS_LUT);
        for (int i = t; i < 256 * 8; i += NTHR) {
            const int d = (i >> 3) - 64, h = i & 7;
            float v = NEGBIG;
            if (d >= 0) {
                int bucket = d;
                if (d >= 16) { bucket = 16 + (int)(log2f((float)d * (1.f / 16.f)) * (16.f / 3.f)); bucket = bucket < 31 ? bucket : 31; }
                v = P.rel_bias[bucket * 8 + h] * LOG2E;
            }
            LUT[i] = v;
        }
    }
    __syncthreads();
    XcdBarrier bar = xcd_barrier_post((unsigned*)(P.ws + WS_CTL), (volatile LAS unsigned*)(lds + LDS_BARW));
#ifndef ONLY_PHASE
#define ONLY_PHASE -1
#endif
#ifndef PROBE_DUP
#define PROBE_DUP -1
#endif
#define PHASE(k, call) if ((ONLY_PHASE < 0 || ONLY_PHASE == (k)) && P.ph_lo <= (k) && (k) < P.ph_hi) { call; if ((k) + 1 < P.ph_hi) xcd_barrier(bar); }
#define PHASE_DUP(k, call) if (PROBE_DUP == (k)) { call; xcd_barrier(bar); }
    PHASE(0, phase0(P))
    PHASE_DUP(1, phase1<true>(P, lds))
    PHASE(1, phase1<false>(P, lds))
    PHASE_DUP(2, phase2<1024>(P, lds))
    PHASE(2, phase2<0>(P, lds))
#ifndef P3DUP
#define P3DUP 7
#endif
    PHASE_DUP(3, (phase3<1024, P3DUP>(P, lds)))
    PHASE(3, (phase3<0, 7>(P, lds)))
    PHASE_DUP(4, phase4(P, lds))
    PHASE(4, phase4(P, lds))
    PHASE_DUP(5, phase5a(P, lds))
    PHASE(5, phase5a(P, lds))
#ifndef P6DUP
#define P6DUP 1
#endif
    PHASE_DUP(6, phase5b<P6DUP>(P, lds))
    PHASE(6, phase5b<0>(P, lds))
    PHASE_DUP(7, phase5c(P, lds))
    PHASE(7, phase5c(P, lds))
    PHASE_DUP(8, phase5d<true>(P))
    PHASE(8, phase5d<false>(P))
    PHASE_DUP(9, phase7(P, lds))
    PHASE(9, phase7(P, lds))
    PHASE_DUP(10, phase8(P))
#ifdef PROBE_BAR
    for (int i = 0; i < 16; ++i) xcd_barrier(bar);
#endif
    PHASE(10, phase8(P))
#undef PHASE
}

#ifndef MK_LAUNCHES
#define MK_LAUNCHES 1
#endif

extern "C" void kernel_launch(void* const* d_in, const int* in_sizes, int n_in, void* d_out, int out_size, void* d_ws, size_t ws_size,
                              hipStream_t stream) {
    static int grid = 0;
    if (grid == 0) {
        if (n_in != 31 || in_sizes[0] != NTOK * DM || out_size != NTOK * DM || ws_size < WS_END) {
            fprintf(stderr, "kernel_launch: unexpected shapes (n_in %d, in0 %d, out %d, ws %zu < %zu)\n", n_in, n_in > 0 ? in_sizes[0] : -1, out_size, ws_size, (size_t)WS_END);
            grid = -1; return;
        }
        int dev = 0, cus = 0, per_cu = 0;
        if (hipGetDevice(&dev) != hipSuccess || hipDeviceGetAttribute(&cus, hipDeviceAttributeMultiprocessorCount, dev) != hipSuccess) { grid = -1; return; }
        if (hipFuncSetAttribute((const void*)fwd_kernel, hipFuncAttributeMaxDynamicSharedMemorySize, LDS_BYTES) != hipSuccess) { grid = -1; return; }
        if (hipOccupancyMaxActiveBlocksPerMultiprocessor(&per_cu, (const void*)fwd_kernel, NTHR, LDS_BYTES) != hipSuccess || per_cu < 1) per_cu = 1;
        (void)hipGetLastError();
        grid = cus;
    }
    if (grid < 0) return;
    if (hipMemsetAsync((char*)d_ws + WS_CTL, 0, CTL_BYTES, stream) != hipSuccess) return;
    Params p{};
    const float** pp = (const float**)&p;
    for (int i = 0; i < 31; ++i) pp[i] = (const float*)d_in[i];
    p.out = (float*)d_out; p.ws = (char*)d_ws;
#if MK_LAUNCHES == 1
    p.ph_lo = 0; p.ph_hi = N_PHASES;
    hipLaunchKernelGGL(fwd_kernel, dim3(grid), dim3(NTHR), LDS_BYTES, stream, p);
#else
    for (int k = 0; k < N_PHASES; ++k) { p.ph_lo = k; p.ph_hi = k + 1; hipLaunchKernelGGL(fwd_kernel, dim3(grid), dim3(NTHR), LDS_BYTES, stream, p); }
#endif
}
```

```cpp
#include <hip/hip_runtime.h>
#include <stdint.h>
#include <stdio.h>

typedef unsigned short bf16_t;
typedef __attribute__((ext_vector_type(8))) short bf16x8;
typedef __attribute__((ext_vector_type(4))) short bf16x4;
typedef __attribute__((ext_vector_type(4))) float f32x4;

constexpr int NTOK = 32768, SEQ = 8192, DM = 1024, DIN = 5944;
constexpr int C_QNSA = 0, C_KVNSA = 512, C_GNSA = 1280, C_CQ = 1304, C_CKV = 2072, C_KROPE = 2328, C_QMEM = 2360, C_GMERGE = 2872;
constexpr float ALPHA = 1.189207115002721f;
constexpr float LOG2E = 1.4426950408889634f;
constexpr float NEGBIG = -1e30f;

constexpr size_t MBY = 1ull << 20;
constexpr size_t WS_CTL = 0;
constexpr size_t CTL_BYTES = 65536;
constexpr int CTL_Q = 4096;
constexpr int CTL_CNT = 8192;
constexpr size_t WS_COS = 1 * MBY, WS_SIN = WS_COS + 512 * 1024;
constexpr size_t WS_KC = 2 * MBY, WS_VTC = WS_KC + 512 * 1024;
constexpr size_t WS_KMEM = 3 * MBY, WS_VTMEM = 4 * MBY, WS_MEMB = 5 * MBY, WS_EID = 7 * MBY, WS_EW = 8 * MBY;
constexpr size_t WS_A = 16 * MBY;
constexpr size_t WS_PROJ = WS_A, WS_QM = WS_A + 372 * MBY, WS_KM = WS_A + 420 * MBY, WS_VTM = WS_A + 468 * MBY;
constexpr size_t WS_Y1 = WS_A, WS_Y = WS_A;
constexpr size_t WS_B = WS_A + 512 * MBY;
constexpr size_t WS_H0 = WS_B;
constexpr size_t WS_EXPW = WS_B;
constexpr size_t WS_ONSA = WS_B + 64 * MBY, WS_OMLA = WS_B + 96 * MBY, WS_OMEM = WS_B + 128 * MBY;
constexpr size_t WS_LOGITS = WS_A + 128 * MBY, WS_LIST = WS_B + 384 * MBY;
constexpr size_t WS_MERGED = WS_B + 160 * MBY;
constexpr size_t WS_KCS = WS_B + 224 * MBY, WS_VCS = WS_KCS + 8 * MBY, WS_KSLC = WS_KCS + 16 * MBY, WS_KWIN = WS_KCS + 24 * MBY,
                 WS_VTSLC = WS_KCS + 32 * MBY, WS_VTWIN = WS_KCS + 40 * MBY;
constexpr size_t WS_SCR = WS_B + 416 * MBY;
constexpr size_t WS_WB = WS_B + 448 * MBY;
constexpr size_t WB_WIN = WS_WB, WB_WUQ = WB_WIN + 12582912, WB_WUKV = WB_WUQ + 1179648, WB_WMEM = WB_WUKV + 524288, WB_WBR = WB_WMEM + 2097152,
                 WB_WOUT = WB_WBR + 3145728, WB_WRHI = WB_WOUT + 2097152, WB_WRLO = WB_WRHI + 524288, WB_WS1 = WB_WRLO + 524288, WB_WS3 = WB_WS1 + 524288,
                 WB_WS2 = WB_WS3 + 524288, WB_WCK1 = WB_WS2 + 524288, WB_WCV1 = WB_WCK1 + 1048576, WB_WCK2 = WB_WCV1 + 1048576, WB_WCV2 = WB_WCK2 + 65536,
                 WB_POSP = WB_WCV2 + 65536  , WB_END = WB_POSP + 32768;
static_assert(WB_END <= WS_WB + 32 * MBY, "bf16 weight region");
constexpr size_t WS_END = WS_B + 480 * MBY;
constexpr int H1LD = 2048;

struct Params {
    const float *x, *mem, *ln0_g, *ln0_b, *rel_bias, *w_in, *cmp_pos_k, *cmp_pos_v, *cmp_k_w1, *cmp_k_w2, *cmp_v_w1, *cmp_v_w2,
        *mla_q_norm, *mla_w_uq, *mla_kv_norm, *mla_w_ukv, *mem_w_kv, *w_branch, *w_out, *ln1_g, *ln1_b, *router_w, *router_b,
        *exp_w1, *exp_w3, *exp_w2, *sh_w1, *sh_w3, *sh_w2, *ln2_g, *ln2_b;
    float* out;
    char* ws;
    int ph_lo, ph_hi;
};

#define XB_TMO      128
#define XB_XCNT(j)  (256  + 64 * (j))
#define XB_XSUB(j)  (1280 + 64 * (j))
#define XB_XGEN(j)  (2304 + 64 * (j))
#define XB_TOP      3328
#define XB_TOPGEN   3392
#define XCD_BAR_WORDS 3456
#define XB_SPIN_CAP (1u << 18)
#define LAS __attribute__((address_space(3)))

__device__ __forceinline__ unsigned xb_ld(unsigned* p)              { return __hip_atomic_load(p, __ATOMIC_RELAXED, __HIP_MEMORY_SCOPE_AGENT); }
__device__ __forceinline__ unsigned xb_add(unsigned* p, unsigned v) { return __hip_atomic_fetch_add(p, v, __ATOMIC_RELAXED, __HIP_MEMORY_SCOPE_AGENT); }
__device__ __forceinline__ unsigned xb_xcc_id() { return (unsigned)__builtin_amdgcn_s_getreg((3 << 11) | 20) & 0xFu; }
#define XB_SPIN(cond, bar) do { unsigned _sp = 0; while (cond) { __builtin_amdgcn_s_sleep(1); \
    if ((++_sp & 255u) == 0u) { if (xb_ld(&(bar)[XB_TMO])) break; if (_sp > XB_SPIN_CAP) { atomicAdd(&(bar)[XB_TMO], 1u); break; } } } } while (0)

struct XcdBarrier { unsigned* bar; unsigned x; volatile LAS unsigned* st; };

__device__ __forceinline__ XcdBarrier xcd_barrier_post(unsigned* bar, volatile LAS unsigned* st) {
    XcdBarrier b; b.bar = bar; b.x = xb_xcc_id(); b.st = st;
    if (threadIdx.x == 0) (void)xb_add(&bar[XB_XCNT(b.x)], 1u);
    return b;
}
__device__ __forceinline__ void xcd_barrier_complete(unsigned* bar, unsigned x, unsigned& nloc, unsigned& nx) {
    const unsigned G = gridDim.x * gridDim.y * gridDim.z;
    unsigned sum, cnt, mine, sp = 0u;
    for (;;) {
        sum = 0u; cnt = 0u; mine = 0u;
#pragma unroll
        for (unsigned j = 0; j < 16; ++j) { const unsigned c = xb_ld(&bar[XB_XCNT(j)]); sum += c; cnt += (c > 0u) ? 1u : 0u; mine = (j == x) ? c : mine; }
        if (sum == G) break;
        __builtin_amdgcn_s_sleep(1);
        if ((++sp & 255u) == 0u) { if (xb_ld(&bar[XB_TMO])) break; if (sp > XB_SPIN_CAP) { atomicAdd(&bar[XB_TMO], 1u); break; } }
    }
    nloc = mine > 0u ? mine : 1u; nx = cnt > 0u ? cnt : 1u;
}
__device__ __forceinline__ void xcd_barrier(const XcdBarrier& b) {
    asm volatile("s_waitcnt vmcnt(0)" ::: "memory");
    __syncthreads();
    if (threadIdx.x == 0) {
        unsigned* bar = b.bar;
        __builtin_amdgcn_s_waitcnt(0);
        unsigned nloc = b.st[0], nx = b.st[1];
        if (nloc == 0u) { xcd_barrier_complete(bar, b.x, nloc, nx); b.st[0] = nloc; b.st[1] = nx; }
        const unsigned old = xb_add(&bar[XB_XSUB(b.x)], 1u);
        const unsigned gen = old / nloc;
        if (old + 1u == (gen + 1u) * nloc) {
            __builtin_amdgcn_fence(__ATOMIC_RELEASE, "agent");
            asm volatile("s_waitcnt vmcnt(0)" ::: "memory");
            const unsigned og = xb_add(&bar[XB_TOP], 1u);
            const unsigned tg = og / nx;
            if (og + 1u == (tg + 1u) * nx) xb_add(&bar[XB_TOPGEN], 1u);
            else XB_SPIN(xb_ld(&bar[XB_TOPGEN]) == tg, bar);
            __builtin_amdgcn_fence(__ATOMIC_ACQUIRE, "agent");
            xb_add(&bar[XB_XGEN(b.x)], 1u);
            asm volatile("s_waitcnt vmcnt(0)" ::: "memory");
        } else {
            XB_SPIN(xb_ld(&bar[XB_XGEN(b.x)]) == gen, bar);
            __builtin_amdgcn_fence(__ATOMIC_ACQUIRE, "agent");
            asm volatile("s_waitcnt vmcnt(0)" ::: "memory");
        }
    }
    __syncthreads();
}

__device__ __forceinline__ float bf2f(bf16_t v) { return __uint_as_float(((uint32_t)v) << 16); }
__device__ __forceinline__ float bflo(uint32_t v) { return __uint_as_float(v << 16); }
__device__ __forceinline__ float bfhi(uint32_t v) { return __uint_as_float(v & 0xffff0000u); }
__device__ __forceinline__ uint32_t pack2(float a, float b) {
    typedef __attribute__((ext_vector_type(2))) __bf16 bf2_t; typedef __attribute__((ext_vector_type(2))) float f2_t;
    f2_t v = {a, b}; bf2_t r = __builtin_convertvector(v, bf2_t); return __builtin_bit_cast(uint32_t, r);
}
__device__ __forceinline__ bf16_t f2bf(float a) { return (bf16_t)(pack2(a, 0.f) & 0xffffu); }
__device__ __forceinline__ uint2 pack4(f32x4 v) { return make_uint2(pack2(v[0], v[1]), pack2(v[2], v[3])); }
__device__ __forceinline__ float fexp2(float x) { return __builtin_amdgcn_exp2f(x); }
__device__ __forceinline__ float frcp(float x) { return __builtin_amdgcn_rcpf(x); }
__device__ __forceinline__ float sigmoidf_(float x) { return frcp(1.f + fexp2(-x * LOG2E)); }
__device__ __forceinline__ float siluf_(float x) { return x * frcp(1.f + fexp2(-x * LOG2E)); }
__device__ __forceinline__ float geluf_(float x) {
    const float u = 0.7978845608028654f * (x + 0.044715f * x * x * x);
    const float t = 1.f - 2.f * frcp(1.f + fexp2(2.f * u * LOG2E));
    return 0.5f * x * (1.f + t);
}
__device__ __forceinline__ float wave_sum(float v) {
    v += __uint_as_float(__builtin_amdgcn_update_dpp(0u, __float_as_uint(v), 0xB1, 0xF, 0xF, true));
    v += __uint_as_float(__builtin_amdgcn_update_dpp(0u, __float_as_uint(v), 0x4E, 0xF, 0xF, true));
    v += __uint_as_float(__builtin_amdgcn_update_dpp(0u, __float_as_uint(v), 0x141, 0xF, 0xF, true));
    v += __uint_as_float(__builtin_amdgcn_update_dpp(0u, __float_as_uint(v), 0x140, 0xF, 0xF, true));
    auto r = __builtin_amdgcn_permlane16_swap(__float_as_uint(v), __float_as_uint(v), false, false);
    v = __uint_as_float(r[0]) + __uint_as_float(r[1]);
    auto q = __builtin_amdgcn_permlane32_swap(__float_as_uint(v), __float_as_uint(v), false, false);
    return __uint_as_float(q[0]) + __uint_as_float(q[1]);
}
__device__ __forceinline__ float wave_max(float v) {
    v = fmaxf(v, __uint_as_float(__builtin_amdgcn_update_dpp(0u, __float_as_uint(v), 0xB1, 0xF, 0xF, true)));
    v = fmaxf(v, __uint_as_float(__builtin_amdgcn_update_dpp(0u, __float_as_uint(v), 0x4E, 0xF, 0xF, true)));
    v = fmaxf(v, __uint_as_float(__builtin_amdgcn_update_dpp(0u, __float_as_uint(v), 0x141, 0xF, 0xF, true)));
    v = fmaxf(v, __uint_as_float(__builtin_amdgcn_update_dpp(0u, __float_as_uint(v), 0x140, 0xF, 0xF, true)));
    auto r = __builtin_amdgcn_permlane16_swap(__float_as_uint(v), __float_as_uint(v), false, false);
    v = fmaxf(__uint_as_float(r[0]), __uint_as_float(r[1]));
    auto q = __builtin_amdgcn_permlane32_swap(__float_as_uint(v), __float_as_uint(v), false, false);
    return fmaxf(__uint_as_float(q[0]), __uint_as_float(q[1]));
}
__device__ __forceinline__ float quad_max(float x) {
    auto r = __builtin_amdgcn_permlane16_swap(__float_as_uint(x), __float_as_uint(x), false, false);
    x = fmaxf(__uint_as_float(r[0]), __uint_as_float(r[1]));
    auto q = __builtin_amdgcn_permlane32_swap(__float_as_uint(x), __float_as_uint(x), false, false);
    return fmaxf(__uint_as_float(q[0]), __uint_as_float(q[1]));
}
__device__ __forceinline__ float quad_min(float x) {
    auto r = __builtin_amdgcn_permlane16_swap(__float_as_uint(x), __float_as_uint(x), false, false);
    x = fminf(__uint_as_float(r[0]), __uint_as_float(r[1]));
    auto q = __builtin_amdgcn_permlane32_swap(__float_as_uint(x), __float_as_uint(x), false, false);
    return fminf(__uint_as_float(q[0]), __uint_as_float(q[1]));
}
__device__ __forceinline__ float quad_sum(float x) {
    auto r = __builtin_amdgcn_permlane16_swap(__float_as_uint(x), __float_as_uint(x), false, false);
    x = __uint_as_float(r[0]) + __uint_as_float(r[1]);
    auto q = __builtin_amdgcn_permlane32_swap(__float_as_uint(x), __float_as_uint(x), false, false);
    return __uint_as_float(q[0]) + __uint_as_float(q[1]);
}
__device__ __forceinline__ float quad4_sum(float x) {
    x += __uint_as_float(__builtin_amdgcn_update_dpp(0u, __float_as_uint(x), 0xB1, 0xF, 0xF, true));
    x += __uint_as_float(__builtin_amdgcn_update_dpp(0u, __float_as_uint(x), 0x4E, 0xF, 0xF, true));
    return x;
}
__device__ __forceinline__ float max16(const f32x4 (&s)[4]) {
    const float a = fmaxf(fmaxf(s[0][0], s[0][1]), fmaxf(s[0][2], s[0][3])), b = fmaxf(fmaxf(s[1][0], s[1][1]), fmaxf(s[1][2], s[1][3]));
    const float c = fmaxf(fmaxf(s[2][0], s[2][1]), fmaxf(s[2][2], s[2][3])), d = fmaxf(fmaxf(s[3][0], s[3][1]), fmaxf(s[3][2], s[3][3]));
    return fmaxf(fmaxf(a, b), fmaxf(c, d));
}
__device__ __forceinline__ float sum16(const f32x4 (&s)[4]) {
    const f32x4 v = (s[0] + s[1]) + (s[2] + s[3]);
    return (v[0] + v[1]) + (v[2] + v[3]);
}
__device__ __forceinline__ void lds_fadd(float* p, float v) {
    asm volatile("ds_add_f32 %0, %1" :: "v"((unsigned)(size_t)(LAS float*)p), "v"(v) : "memory");
}
__device__ __forceinline__ f32x4 mfma16(bf16x8 a, bf16x8 b, f32x4 c) { return __builtin_amdgcn_mfma_f32_16x16x32_bf16(a, b, c, 0, 0, 0); }

constexpr int NTHR = 512, NWV = 8;
constexpr int LDS_BYTES = 163840;
constexpr int LDS_MISC = 147456;
constexpr int LDS_LUT = LDS_MISC;
constexpr int LDS_SEL = LDS_MISC + 8192;
constexpr int LDS_WOR = LDS_SEL + 1024;
constexpr int LDS_TL = LDS_WOR + 128;
constexpr int LDS_ITEM = LDS_TL + 256;
constexpr int LDS_ROWS = LDS_ITEM + 64;
constexpr int LDS_PRE = LDS_ROWS + 2048;
constexpr int LDS_KSC = LDS_PRE + 256;
constexpr int LDS_BARW = 163824;
static_assert(LDS_KSC + 1024 <= LDS_BARW, "LDS map");

__device__ __forceinline__ int queue_pop(unsigned* head, char* lds) {
    __syncthreads();
    if (threadIdx.x == 0) *(volatile int*)(lds + LDS_ITEM) = (int)atomicAdd(head, 1u);
    __syncthreads();
    return __builtin_amdgcn_readfirstlane(*(volatile int*)(lds + LDS_ITEM));
}

__device__ __forceinline__ int swz(int row, int chunk) { return (row << 7) + (((chunk ^ (row >> 1) ^ ((row >> 4) & 1)) & 7) << 4); }
constexpr int TILE_B = 16384;

struct GemmA { const char* base; unsigned off[4]; };

constexpr int STAGE_B = 49152, STAGE_BOFF = 32768;
__device__ __forceinline__ int gl_row(int i, int t) { return 8 * ((t >> 6) + 8 * i) + ((t & 63) >> 3); }
__device__ __forceinline__ int gl_chunk(int row, int t) { return ((t & 7) ^ (row >> 1) ^ ((row >> 4) & 1)) & 7; }
__device__ __forceinline__ int perm32_(int rho) { const int n = rho >> 4, i = rho & 15; return 8 * (i >> 2) + 4 * n + (i & 3); }
template <int NP, bool PERM = false>
__device__ __forceinline__ GemmA make_op(const bf16_t* base, long ld, int r0, int rmax) {
    GemmA a; const int t = threadIdx.x;
    a.base = (const char*)base;
#pragma unroll
    for (int i = 0; i < NP; ++i) { const int lr_ = gl_row(i, t); int r = r0 + (PERM ? ((lr_ & ~31) + perm32_(lr_ & 31)) : lr_); r = r < rmax ? r : rmax - 1; a.off[i] = (unsigned)(((size_t)r * ld + gl_chunk(lr_, t) * 8) * 2); }
    return a;
}
__device__ __forceinline__ void gemm_mainloop_g(char* lds, const GemmA& A, const GemmA& B, int nk, f32x4 (&acc)[4][4]) {
    int t = threadIdx.x; asm volatile("" : "+v"(t));
    const int lane = t & 63, w = t >> 6, wm = w >> 1, wn = w & 1;
    const int lr = lane & 15, lq = lane >> 4;
    const int wu = __builtin_amdgcn_readfirstlane(w);
    const int xr = (lr >> 1) & 7;
    unsigned ardA[2][2], ardB[2][2];
#pragma unroll
    for (int kk = 0; kk < 2; ++kk)
#pragma unroll
        for (int par = 0; par < 2; ++par) {
            const int ch = ((kk * 4 + lq) ^ xr ^ par) & 7;
            ardA[kk][par] = (unsigned)((wm * 64 + par * 16 + lr) * 128 + ch * 16);
            ardB[kk][par] = (unsigned)(STAGE_BOFF + (wn * 64 + par * 16 + lr) * 128 + ch * 16);
        }
    const char* abase = A.base; const char* bbase = B.base;
    LAS char* ldsl = (LAS char*)lds;
#define GI_(so_) { \
        _Pragma("unroll") for (int i = 0; i < 4; ++i) \
            __builtin_amdgcn_global_load_lds((const unsigned*)(abase + A.off[i]), (LAS unsigned*)(ldsl + (so_) + (wu + 8 * i) * 1024), 16, 0, 0); \
        _Pragma("unroll") for (int i = 0; i < 2; ++i) \
            __builtin_amdgcn_global_load_lds((const unsigned*)(bbase + B.off[i]), (LAS unsigned*)(ldsl + (so_) + STAGE_BOFF + (wu + 8 * i) * 1024), 16, 0, 0); \
        abase += 128; bbase += 128; }
    __syncthreads();
    GI_(0);
    if (nk > 1) GI_(STAGE_B);
    int cso = 0, lso = 2 * STAGE_B;
#pragma unroll 1
    for (int kt = 0; kt < nk; ++kt) {
        if (kt + 1 < nk) asm volatile("s_waitcnt vmcnt(6)" ::: "memory");
        else asm volatile("s_waitcnt vmcnt(0)" ::: "memory");
        __builtin_amdgcn_s_barrier();
        if (kt + 2 < nk) GI_(lso);
#pragma unroll
        for (int kk = 0; kk < 2; ++kk) {
            bf16x8 af[4], bfr[4];
#pragma unroll
            for (int i = 0; i < 4; ++i) af[i] = *(const bf16x8*)(lds + cso + ardA[kk][i & 1] + (i >> 1) * 4096);
#pragma unroll
            for (int j = 0; j < 4; ++j) bfr[j] = *(const bf16x8*)(lds + cso + ardB[kk][j & 1] + (j >> 1) * 4096);
#pragma unroll
            for (int i = 0; i < 4; ++i)
#pragma unroll
                for (int j = 0; j < 4; ++j) acc[i][j] = mfma16(bfr[j], af[i], acc[i][j]);
        }
        cso = (cso == 2 * STAGE_B) ? 0 : cso + STAGE_B;
        lso = (lso == 2 * STAGE_B) ? 0 : lso + STAGE_B;
    }
    __syncthreads();
#undef GI_
}

template <bool SWAPW1 = false>
__device__ __forceinline__ void gemm_mainloop_c(char* lds, const GemmA& A, const GemmA& B, int nk, f32x4 (&acc)[4][4], int& ring, bool primed, bool chain, const GemmA& An, const GemmA& Bn) {
    int t = threadIdx.x; asm volatile("" : "+v"(t));
    const int lane = t & 63, w = t >> 6, wm = w >> 1, wn = w & 1;
    const int lr = lane & 15, lq = lane >> 4;
    const int wu = __builtin_amdgcn_readfirstlane(w);
    const int xr = (lr >> 1) & 7;
    unsigned ardA[2][2], ardB[2][2];
#pragma unroll
    for (int kk = 0; kk < 2; ++kk)
#pragma unroll
        for (int par = 0; par < 2; ++par) {
            const int ch = ((kk * 4 + lq) ^ xr ^ par) & 7;
            ardA[kk][par] = (unsigned)((wm * 64 + par * 16 + lr) * 128 + ch * 16);
            ardB[kk][par] = (unsigned)(STAGE_BOFF + (wn * 64 + par * 16 + lr) * 128 + ch * 16);
        }
    const char* abase = A.base; const char* bbase = B.base;
    const char* anb = An.base; const char* bnb = Bn.base;
    LAS char* ldsl = (LAS char*)lds;
#define GI_(so_) { \
        _Pragma("unroll") for (int i = 0; i < 4; ++i) \
            __builtin_amdgcn_global_load_lds((const unsigned*)(abase + A.off[i]), (LAS unsigned*)(ldsl + (so_) + (wu + 8 * i) * 1024), 16, 0, 0); \
        _Pragma("unroll") for (int i = 0; i < 2; ++i) \
            __builtin_amdgcn_global_load_lds((const unsigned*)(bbase + B.off[i]), (LAS unsigned*)(ldsl + (so_) + STAGE_BOFF + (wu + 8 * i) * 1024), 16, 0, 0); \
        abase += 128; bbase += 128; }
#define GIN_(so_) { \
        _Pragma("unroll") for (int i = 0; i < 4; ++i) \
            __builtin_amdgcn_global_load_lds((const unsigned*)(anb + An.off[i]), (LAS unsigned*)(ldsl + (so_) + (wu + 8 * i) * 1024), 16, 0, 0); \
        _Pragma("unroll") for (int i = 0; i < 2; ++i) \
            __builtin_amdgcn_global_load_lds((const unsigned*)(bnb + Bn.off[i]), (LAS unsigned*)(ldsl + (so_) + STAGE_BOFF + (wu + 8 * i) * 1024), 16, 0, 0); \
        anb += 128; bnb += 128; }
    int cso = ring, lso = (ring == 0) ? 2 * STAGE_B : ring - STAGE_B;
    if (!primed) {
        __syncthreads();
        GI_(cso);
        { const int s1 = (cso == 2 * STAGE_B) ? 0 : cso + STAGE_B; GI_(s1); }
    } else { abase += 256; bbase += 256; }
#pragma unroll 1
    for (int kt = 0; kt < nk; ++kt) {
        if (kt + 1 < nk || chain) asm volatile("s_waitcnt vmcnt(6)" ::: "memory");
        else asm volatile("s_waitcnt vmcnt(0)" ::: "memory");
        __builtin_amdgcn_s_barrier();
        if (kt + 2 < nk) GI_(lso) else if (chain) GIN_(lso)
#pragma unroll
        for (int kk = 0; kk < 2; ++kk) {
            bf16x8 af[4], bfr[4];
#pragma unroll
            for (int i = 0; i < 4; ++i) af[i] = *(const bf16x8*)(lds + cso + ardA[kk][i & 1] + (i >> 1) * 4096);
#pragma unroll
            for (int j = 0; j < 4; ++j) bfr[j] = *(const bf16x8*)(lds + cso + ardB[kk][j & 1] + (j >> 1) * 4096);
            if (SWAPW1 && wn == 1) {
#pragma unroll
                for (int i = 0; i < 4; ++i)
#pragma unroll
                    for (int j = 0; j < 4; ++j) acc[i][j] = mfma16(af[i], bfr[j], acc[i][j]);
            } else {
#pragma unroll
                for (int i = 0; i < 4; ++i)
#pragma unroll
                    for (int j = 0; j < 4; ++j) acc[i][j] = mfma16(bfr[j], af[i], acc[i][j]);
            }
        }
        cso = (cso == 2 * STAGE_B) ? 0 : cso + STAGE_B;
        lso = (lso == 2 * STAGE_B) ? 0 : lso + STAGE_B;
    }
    ring = cso;
    if (!chain) __syncthreads();
#undef GI_
#undef GIN_
}

template <bool LO>
__device__ __forceinline__ void conv_wT(const float* src, int K, int N, bf16_t* dst, int ldd, const float* gain) {
    const int t = threadIdx.x & 255, kg = t >> 5, n4 = t & 31;
    const int ntn = (N + 127) >> 7, ntiles = (K >> 6) * ntn;
    for (int tile = blockIdx.x * 2 + (threadIdx.x >> 8); tile < ntiles; tile += gridDim.x * 2) {
        const int k0 = (tile / ntn) * 64 + kg * 8, n = (tile % ntn) * 128 + n4 * 4;
        if (n < N) {
            float4 r[8];
#pragma unroll
            for (int kk = 0; kk < 8; ++kk) r[kk] = *(const float4*)(src + (size_t)(k0 + kk) * N + n);
            if (gain) {
#pragma unroll
                for (int kk = 0; kk < 8; ++kk) { const float g = gain[k0 + kk]; r[kk].x *= g; r[kk].y *= g; r[kk].z *= g; r[kk].w *= g; }
            }
#pragma unroll
            for (int c = 0; c < 4; ++c) {
                float v[8];
#pragma unroll
                for (int kk = 0; kk < 8; ++kk) { float f = (c == 0) ? r[kk].x : (c == 1) ? r[kk].y : (c == 2) ? r[kk].z : r[kk].w; if (LO) f = f - bf2f(f2bf(f)); v[kk] = f; }
                *(uint4*)(dst + (size_t)(n + c) * ldd + k0) = make_uint4(pack2(v[0], v[1]), pack2(v[2], v[3]), pack2(v[4], v[5]), pack2(v[6], v[7]));
            }
        }
    }
}

__device__ __forceinline__ void zero_acc(f32x4 (&acc)[4][4]) {
#pragma unroll
    for (int i = 0; i < 4; ++i)
#pragma unroll
        for (int j = 0; j < 4; ++j) acc[i][j] = (f32x4){0.f, 0.f, 0.f, 0.f};
}

namespace pg8 {
constexpr int BM = 256, BK = 64, HALF = 128, HTB = HALF * BK * 2, STAGE_BYTES = 8 * HTB;
__device__ __forceinline__ int lds_byte(int r, int c) { const int st = (r >> 4) * 2 + (c >> 5), rr = r & 15, cc = c & 31, ob = rr * 64 + cc * 2; return st * 1024 + (ob ^ (((ob >> 9) & 1) << 5)); }
__device__ __forceinline__ void stage_rc(int b, int& R, int& C) { const int st = b / 1024, sb = b % 1024, swz_ = sb ^ (((sb >> 9) & 1) << 5); R = (st >> 1) * 16 + swz_ / 64; C = (st & 1) * 32 + (swz_ % 64) / 2; }
__device__ __forceinline__ int perm32(int rho) { const int n = rho >> 4, i = rho & 15; return 8 * (i >> 2) + 4 * n + (i & 3); }
struct Unit { int pm, pn; };
struct Ops { const char* A; const char* B; };
template <class Prov, class Epi>
__device__ __forceinline__ void gemm_phase(LAS unsigned char* lds, const int K, Prov& PV, const Epi& E) {
    int tid = threadIdx.x; asm volatile("" : "+v"(tid));
    const int wid = __builtin_amdgcn_readfirstlane(tid >> 6), lane = tid & 63, wr = wid >> 2, wc = wid & 3, fr = lane & 15, fq = lane >> 4;
    int nt = K / BK; asm volatile("" : "+s"(nt));
    int sR[2], sC[2];
#pragma unroll
    for (int i = 0; i < 2; ++i) stage_rc(tid * 16 + i * 8192, sR[i], sC[i]);
    const size_t kstep = (size_t)(BK * 2);
    const unsigned ldsw = (unsigned)wid * 1024u;
    const int aoff = lds_byte(wr * 64 + fr, fq * 8), boff = lds_byte(wc * 32 + fr, fq * 8);
#define PG8_SA(b, h) (((b) * 2 + (h)) * HTB)
#define PG8_SB(b, h) ((4 + (b) * 2 + (h)) * HTB)
#define PG8_STAGE(bufoff, gbase, voff) do { _Pragma("unroll") for (int _i = 0; _i < 2; ++_i) \
        __builtin_amdgcn_global_load_lds((const unsigned*)((const char*)(gbase) + (voff)[_i]), (LAS unsigned*)(lds + (bufoff) + ldsw + _i * 8192), 16, 0, 0); } while (0)
#define PG8_LDA(dst, b, h) do { _Pragma("unroll") for (int m = 0; m < 4; ++m) _Pragma("unroll") for (int k = 0; k < 2; ++k) dst[m][k] = *(const LAS bf16x8*)(lds + PG8_SA(b, h) + aoff + m * 2048 + k * 1024); } while (0)
#define PG8_LDB(dst, b, h) do { _Pragma("unroll") for (int n = 0; n < 2; ++n) _Pragma("unroll") for (int k = 0; k < 2; ++k) dst[n][k] = *(const LAS bf16x8*)(lds + PG8_SB(b, h) + boff + n * 2048 + k * 1024); } while (0)
#define PG8_MMA(ai, bj, At, Bt) do { __builtin_amdgcn_s_setprio(1); _Pragma("unroll") for (int m = 0; m < 4; ++m) _Pragma("unroll") for (int n = 0; n < 2; ++n) _Pragma("unroll") for (int k = 0; k < 2; ++k) \
        acc[ai][bj][m][n] = __builtin_amdgcn_mfma_f32_16x16x32_bf16(Bt[n][k], At[m][k], acc[ai][bj][m][n], 0, 0, 0); __builtin_amdgcn_s_setprio(0); } while (0)
#define PG8_WAIT_V(n) asm volatile("s_waitcnt vmcnt(" #n ")" ::: "memory")
#define PG8_WAIT_L(n) asm volatile("s_waitcnt lgkmcnt(" #n ")" ::: "memory")
#define PG8_BAR __builtin_amdgcn_s_barrier()
#define PG8_SCHED __builtin_amdgcn_sched_barrier(0)
    Unit cur, nxt; Ops oc, on; int ui = 0;
    unsigned va[2][2], vb[2][2];
    PV.offsets(va, vb, sR, sC);
    if (!PV.get(0, cur, oc)) return;
    f32x4 acc[2][2][4][2];
#pragma unroll
    for (int a = 0; a < 2; ++a)
#pragma unroll
        for (int b = 0; b < 2; ++b)
#pragma unroll
            for (int m = 0; m < 4; ++m)
#pragma unroll
                for (int n = 0; n < 2; ++n) acc[a][b][m][n] = (f32x4){0.f, 0.f, 0.f, 0.f};
    bf16x8 At[4][2], B0[2][2], B1[2][2];
    PG8_STAGE(PG8_SB(0, 0), oc.B, vb[0]); PG8_STAGE(PG8_SA(0, 0), oc.A, va[0]); PG8_STAGE(PG8_SB(0, 1), oc.B, vb[1]); PG8_STAGE(PG8_SA(0, 1), oc.A, va[1]);
    if (wr == 1) PG8_BAR;
    PG8_WAIT_V(4); PG8_BAR;
    PG8_STAGE(PG8_SB(1, 0), oc.B + kstep, vb[0]); PG8_STAGE(PG8_SA(1, 0), oc.A + kstep, va[0]); PG8_STAGE(PG8_SB(1, 1), oc.B + kstep, vb[1]);
    PG8_WAIT_V(6); PG8_BAR;
    for (;;) {
        const bool has_next = PV.get(ui + 1, nxt, on);
        if (!has_next) on = oc;
#pragma unroll 1
        for (int t = 0; t < nt; t += 2) {
            const bool last = (t == nt - 2);
            const char* a1 = oc.A + (size_t)(t + 1) * kstep;
            const char* a2 = last ? on.A : oc.A + (size_t)(t + 2) * kstep; const char* b2 = last ? on.B : oc.B + (size_t)(t + 2) * kstep;
            const char* a3 = a2 + kstep; const char* b3 = b2 + kstep;
            PG8_LDB(B0, 0, 0); PG8_SCHED; PG8_LDA(At, 0, 0); PG8_STAGE(PG8_SA(1, 1), a1, va[1]);
            PG8_WAIT_L(8); PG8_BAR; PG8_WAIT_L(0); PG8_MMA(0, 0, At, B0); PG8_BAR; PG8_SCHED;
            PG8_LDB(B1, 0, 1); PG8_STAGE(PG8_SB(0, 0), b2, vb[0]);
            PG8_BAR; PG8_WAIT_L(0); PG8_MMA(0, 1, At, B1); PG8_BAR;
            PG8_LDA(At, 0, 1); PG8_STAGE(PG8_SA(0, 0), a2, va[0]);
            PG8_BAR; PG8_WAIT_L(0); PG8_MMA(1, 0, At, B0); PG8_BAR; PG8_SCHED;
            PG8_STAGE(PG8_SB(0, 1), b2, vb[1]);
            PG8_WAIT_V(6); PG8_BAR; PG8_MMA(1, 1, At, B1); PG8_BAR;
            PG8_LDB(B0, 1, 0); PG8_SCHED; PG8_LDA(At, 1, 0); PG8_STAGE(PG8_SA(0, 1), a2, va[1]);
            PG8_WAIT_L(8); PG8_BAR; PG8_WAIT_L(0); PG8_MMA(0, 0, At, B0); PG8_BAR; PG8_SCHED;
            PG8_LDB(B1, 1, 1); PG8_STAGE(PG8_SB(1, 0), b3, vb[0]);
            PG8_BAR; PG8_WAIT_L(0); PG8_MMA(0, 1, At, B1); PG8_BAR;
            PG8_LDA(At, 1, 1); PG8_STAGE(PG8_SA(1, 0), a3, va[0]);
            PG8_BAR; PG8_WAIT_L(0); PG8_MMA(1, 0, At, B0); PG8_BAR; PG8_SCHED;
            PG8_STAGE(PG8_SB(1, 1), b3, vb[1]);
            PG8_WAIT_V(6); PG8_BAR; PG8_MMA(1, 1, At, B1); PG8_BAR;
        }
        bool keep;
        { int tz = threadIdx.x; asm volatile("" : "+v"(tz));
          keep = E(acc, cur, ui, wr, wc, tz & 15, (tz >> 4) & 3); }
        if (!has_next) break;
        if (!keep)
#pragma unroll
        for (int a = 0; a < 2; ++a)
#pragma unroll
            for (int b = 0; b < 2; ++b)
#pragma unroll
                for (int m = 0; m < 4; ++m)
#pragma unroll
                    for (int n = 0; n < 2; ++n) acc[a][b][m][n] = (f32x4){0.f, 0.f, 0.f, 0.f};
        cur = nxt; oc = on; ++ui;
    }
    PG8_WAIT_V(0);
    if (wr == 0) PG8_BAR;
    PG8_BAR;
#undef PG8_SA
#undef PG8_SB
#undef PG8_STAGE
#undef PG8_LDA
#undef PG8_LDB
#undef PG8_MMA
#undef PG8_WAIT_V
#undef PG8_WAIT_L
#undef PG8_BAR
#undef PG8_SCHED
}
struct StaticOrder {
    int nM, nN, nwg, G, c;
    __device__ void init(int M, int N, int G_, int c_) { nM = M / BM; nN = N / BM; nwg = nM * nN; G = G_; c = c_; }
    __device__ bool next(int i, Unit& u) const {
        const long L = (long)i * G + c; if (L >= nwg) return false;
        int wgid = (int)L; { const int q = nwg / 8, r = nwg % 8, xcd = wgid % 8, off = wgid / 8; wgid = (xcd < r ? xcd * (q + 1) : r * (q + 1) + (xcd - r) * q) + off; }
        const int nig = 8 * nN, gid = wgid / nig, fm = gid * 8, gsz = (nM - fm) < 8 ? (nM - fm) : 8;
        u.pm = fm + ((wgid % nig) % gsz); u.pn = (wgid % nig) / gsz; return true;
    }
};
struct DenseProv {
    StaticOrder S; const bf16_t* A; const bf16_t* Bt; long lda, ldb; bool perm;
    __device__ __forceinline__ void offsets(unsigned (&va)[2][2], unsigned (&vb)[2][2], const int (&sR)[2], const int (&sC)[2]) const {
#pragma unroll
        for (int h = 0; h < 2; ++h)
#pragma unroll
            for (int p = 0; p < 2; ++p) { const int rb = perm ? ((sR[p] & ~31) + perm32(sR[p] & 31)) : sR[p];
                va[h][p] = (unsigned)(((size_t)(h * HALF + sR[p]) * lda + sC[p]) * 2); vb[h][p] = (unsigned)(((size_t)(h * HALF + rb) * ldb + sC[p]) * 2); }
    }
    __device__ __forceinline__ bool get(int i, Unit& u, Ops& o) const {
        if (!S.next(i, u)) return false;
        o.A = (const char*)(A + (size_t)u.pm * BM * lda); o.B = (const char*)(Bt + (size_t)u.pn * BM * ldb);
        return true;
    }
};
}

__device__ __forceinline__ void phase0(const Params& P) {
    const int t = threadIdx.x, lane = t & 63, w = t >> 6;
    const int gw = blockIdx.x * NWV + w, nw = gridDim.x * NWV;
    bf16_t* H0 = (bf16_t*)(P.ws + WS_H0);
    for (int row0 = gw; row0 < NTOK; row0 += 2 * nw) {
        const int row1 = row0 + nw; const bool has1 = row1 < NTOK;
        const float4* xr0 = (const float4*)(P.x + (size_t)row0 * DM); const float4* xr1 = (const float4*)(P.x + (size_t)(has1 ? row1 : row0) * DM);
        float4 v[2][4]; float s0 = 0.f, s1 = 0.f;
#pragma unroll
        for (int i = 0; i < 4; ++i) { v[0][i] = xr0[lane + 64 * i]; v[1][i] = xr1[lane + 64 * i]; }
#pragma unroll
        for (int i = 0; i < 4; ++i) { s0 += v[0][i].x + v[0][i].y + v[0][i].z + v[0][i].w; s1 += v[1][i].x + v[1][i].y + v[1][i].z + v[1][i].w; }
        const float mu0 = wave_sum(s0) * (1.f / DM), mu1 = wave_sum(s1) * (1.f / DM);
        float q0 = 0.f, q1 = 0.f;
#pragma unroll
        for (int i = 0; i < 4; ++i) {
            { float a = v[0][i].x - mu0, b = v[0][i].y - mu0, c = v[0][i].z - mu0, d = v[0][i].w - mu0; q0 += a * a + b * b + c * c + d * d; }
            { float a = v[1][i].x - mu1, b = v[1][i].y - mu1, c = v[1][i].z - mu1, d = v[1][i].w - mu1; q1 += a * a + b * b + c * c + d * d; }
        }
        const float rstd0 = rsqrtf(wave_sum(q0) * (1.f / DM) + 1e-5f), rstd1 = rsqrtf(wave_sum(q1) * (1.f / DM) + 1e-5f);
#pragma unroll
        for (int i = 0; i < 4; ++i) {
            const float4 g = ((const float4*)P.ln0_g)[lane + 64 * i], bb = ((const float4*)P.ln0_b)[lane + 64 * i];
            *(uint2*)(H0 + (size_t)row0 * DM + 4 * (lane + 64 * i)) =
                make_uint2(pack2((v[0][i].x - mu0) * rstd0 * g.x + bb.x, (v[0][i].y - mu0) * rstd0 * g.y + bb.y), pack2((v[0][i].z - mu0) * rstd0 * g.z + bb.z, (v[0][i].w - mu0) * rstd0 * g.w + bb.w));
            if (has1) *(uint2*)(H0 + (size_t)row1 * DM + 4 * (lane + 64 * i)) =
                make_uint2(pack2((v[1][i].x - mu1) * rstd1 * g.x + bb.x, (v[1][i].y - mu1) * rstd1 * g.y + bb.y), pack2((v[1][i].z - mu1) * rstd1 * g.z + bb.z, (v[1][i].w - mu1) * rstd1 * g.w + bb.w));
        }
    }
    const int gt = blockIdx.x * NTHR + t, nt = gridDim.x * NTHR;
    bf16_t* MEMB = (bf16_t*)(P.ws + WS_MEMB);
    for (int i = gt; i < 4 * 256 * DM / 4; i += nt) {
        const float4 v = ((const float4*)P.mem)[i];
        *(uint2*)(MEMB + (size_t)i * 4) = make_uint2(pack2(v.x, v.y), pack2(v.z, v.w));
    }
    float* COS = (float*)(P.ws + WS_COS); float* SIN = (float*)(P.ws + WS_SIN);
    for (int i = gt; i < SEQ * 16; i += nt) {
        const int pos = i >> 4, j = i & 15;
        const float freq = exp2f(-(float)j * (13.287712379549449f / 16.f));
        const float ang = (float)pos * freq;
        float sn, cs; sincosf(ang, &sn, &cs);
        COS[i] = cs; SIN[i] = sn;
    }
    {
        char* wsb = P.ws;
        const int tt = t & 255, kg = tt >> 5, n4 = tt & 31;
        constexpr int NJ = 17;
        const int jK[NJ]  = {1024, 768, 256, 1024, 512, 512, 512, 1024, 1024, 1024, 1024, 1024, 256, 2048, 2048, 256, 256};
        const int jN[NJ]  = {DIN, 768, 1024, 1024, 1024, 1024, 1024, 1024, 256, 256, 256, 256, 1024, 256, 256, 64, 64};
        int first[NJ + 1]; first[0] = 0;
#pragma unroll
        for (int j = 0; j < NJ; ++j) first[j + 1] = first[j] + (jK[j] >> 6) * ((jN[j] + 127) >> 7);
        for (int g = blockIdx.x * 2 + (t >> 8); g < first[NJ]; g += gridDim.x * 2) {
            int j = 0;
#pragma unroll
            for (int q = 1; q < NJ; ++q) j += (g >= first[q]) ? 1 : 0;
            const float* src; bf16_t* dst; const float* gain = nullptr; bool lo = false; int K, N, ldd, f0;
            switch (j) {
                case 0: src = P.w_in; dst = (bf16_t*)(wsb + WB_WIN); break;
                case 1: src = P.mla_w_uq; dst = (bf16_t*)(wsb + WB_WUQ); gain = P.mla_q_norm; break;
                case 2: src = P.mla_w_ukv; dst = (bf16_t*)(wsb + WB_WUKV); gain = P.mla_kv_norm; break;
                case 3: src = P.mem_w_kv; dst = (bf16_t*)(wsb + WB_WMEM); break;
                case 4: src = P.w_branch; dst = (bf16_t*)(wsb + WB_WBR); break;
                case 5: src = P.w_branch + 512 * 1024; dst = (bf16_t*)(wsb + WB_WBR) + 1024 * 512; break;
                case 6: src = P.w_branch + 2 * 512 * 1024; dst = (bf16_t*)(wsb + WB_WBR) + 2 * 1024 * 512; break;
                case 7: src = P.w_out; dst = (bf16_t*)(wsb + WB_WOUT); break;
                case 8: src = P.router_w; dst = (bf16_t*)(wsb + WB_WRHI); break;
                case 9: src = P.router_w; dst = (bf16_t*)(wsb + WB_WRLO); lo = true; break;
                case 10: src = P.sh_w1; dst = (bf16_t*)(wsb + WB_WS1); break;
                case 11: src = P.sh_w3; dst = (bf16_t*)(wsb + WB_WS3); break;
                case 12: src = P.sh_w2; dst = (bf16_t*)(wsb + WB_WS2); break;
                case 13: src = P.cmp_k_w1; dst = (bf16_t*)(wsb + WB_WCK1); break;
                case 14: src = P.cmp_v_w1; dst = (bf16_t*)(wsb + WB_WCV1); break;
                case 15: src = P.cmp_k_w2; dst = (bf16_t*)(wsb + WB_WCK2); break;
                default: src = P.cmp_v_w2; dst = (bf16_t*)(wsb + WB_WCV2); break;
            }
            K = jK[0]; N = jN[0]; f0 = first[0];
#pragma unroll
            for (int q = 1; q < NJ; ++q) if (j == q) { K = jK[q]; N = jN[q]; f0 = first[q]; }
            ldd = K;
            const int ntn = (N + 127) >> 7, tile = g - f0;
            const int k0 = (tile / ntn) * 64 + kg * 8, n = (tile % ntn) * 128 + n4 * 4;
            if (n < N) {
                float4 r[8];
#pragma unroll
                for (int kk = 0; kk < 8; ++kk) r[kk] = *(const float4*)(src + (size_t)(k0 + kk) * N + n);
                if (gain) {
#pragma unroll
                    for (int kk = 0; kk < 8; ++kk) { const float gg = gain[k0 + kk]; r[kk].x *= gg; r[kk].y *= gg; r[kk].z *= gg; r[kk].w *= gg; }
                }
#pragma unroll
                for (int c = 0; c < 4; ++c) {
                    float v[8];
#pragma unroll
                    for (int kk = 0; kk < 8; ++kk) { float f = (c == 0) ? r[kk].x : (c == 1) ? r[kk].y : (c == 2) ? r[kk].z : r[kk].w; if (lo) f = f - bf2f(f2bf(f)); v[kk] = f; }
                    *(uint4*)(dst + (size_t)(n + c) * ldd + k0) = make_uint4(pack2(v[0], v[1]), pack2(v[2], v[3]), pack2(v[4], v[5]), pack2(v[6], v[7]));
                }
            }
        }
        float* POSP = (float*)(wsb + WB_POSP);
        for (int i = gt; i < 2 * 16 * 256 * 16; i += nt) {
            const int o = i >> 4, part = i & 15, kv = o >> 12, kc = (o >> 8) & 15, c = o & 255;
            const float* pos = kv ? P.cmp_pos_v : P.cmp_pos_k; const float* w1 = kv ? P.cmp_v_w1 : P.cmp_k_w1;
            float a = 0.f;
#pragma unroll
            for (int k8 = 0; k8 < 8; ++k8) { const int k = kc * 128 + part * 8 + k8; a += pos[k] * w1[(size_t)k * 256 + c]; }
            a += __uint_as_float(__builtin_amdgcn_update_dpp(0u, __float_as_uint(a), 0xB1, 0xF, 0xF, true));
            a += __uint_as_float(__builtin_amdgcn_update_dpp(0u, __float_as_uint(a), 0x4E, 0xF, 0xF, true));
            a += __uint_as_float(__builtin_amdgcn_update_dpp(0u, __float_as_uint(a), 0x141, 0xF, 0xF, true));
            a += __uint_as_float(__builtin_amdgcn_update_dpp(0u, __float_as_uint(a), 0x140, 0xF, 0xF, true));
            if (part == 0) POSP[o] = a;
        }
    }
    bf16_t* KC = (bf16_t*)(P.ws + WS_KC); bf16_t* VTC = (bf16_t*)(P.ws + WS_VTC);
    for (int i = gt; i < 8 * 64; i += nt) { const int bg = i >> 6, d = i & 63; KC[((size_t)bg * 512 + 511) * 64 + d] = 0; VTC[((size_t)bg * 64 + d) * 512 + 511] = 0; }
}

__device__ __forceinline__ void proj_store8(const Params& P, int tok, int n0, f32x4 v0, f32x4 v1) {
    if (n0 >= DIN) return;
    const int nt = n0 >> 7;
    if (nt >= 4 && nt < 10) {
        const int j = nt - 4, g = (n0 >> 6) & 1, d = n0 & 63, b = tok >> 13, sq = tok & 8191;
        bf16_t* dstk = (bf16_t*)(P.ws + (j == 0 ? WS_KCS : j == 1 ? WS_VCS : j == 2 ? WS_KSLC : j == 4 ? WS_KWIN : j == 3 ? WS_VTSLC : WS_VTWIN));
        if (j == 3 || j == 5) {
#pragma unroll
            for (int r = 0; r < 4; ++r) { dstk[((size_t)(b * 2 + g) * 64 + d + r) * SEQ + sq] = f2bf(v0[r]); dstk[((size_t)(b * 2 + g) * 64 + d + 4 + r) * SEQ + sq] = f2bf(v1[r]); }
        } else { const uint2 a = pack4(v0), c = pack4(v1); *(uint4*)(dstk + (((size_t)(b * 2 + g) * SEQ + sq) * 64 + d)) = make_uint4(a.x, a.y, c.x, c.y); }
    } else {
        float sc = 1.f;
        if (nt < 4) sc = 0.125f * LOG2E;
        else if (n0 >= C_QMEM && n0 < C_GMERGE) sc = 0.08838834764831845f * LOG2E;
        v0 *= sc; v1 *= sc;
        if (n0 >= C_GMERGE || (n0 >= C_GNSA && n0 < C_CQ)) {
#pragma unroll
            for (int r = 0; r < 4; ++r) { v0[r] = sigmoidf_(v0[r]); v1[r] = sigmoidf_(v1[r]); }
        }
        const uint2 a = pack4(v0), c = pack4(v1);
        *(uint4*)((bf16_t*)(P.ws + WS_PROJ) + (size_t)tok * DIN + n0) = make_uint4(a.x, a.y, c.x, c.y);
    }
}
template <bool LIGHT>
struct EpiProj {
    const Params* P;
    __device__ __forceinline__ bool operator()(f32x4 (&acc)[2][2][4][2], const pg8::Unit& u, int, int wr, int wc, int fr, int fq) const {
#pragma unroll
        for (int ai = 0; ai < 2; ++ai)
#pragma unroll
            for (int m = 0; m < 4; ++m) {
                const int tok = u.pm * 256 + ai * 128 + wr * 64 + m * 16 + fr;
#pragma unroll
                for (int bj = 0; bj < 2; ++bj) {
                    if (!LIGHT) proj_store8(*P, tok, u.pn * 256 + bj * 128 + wc * 32 + 8 * fq, acc[ai][bj][m][0], acc[ai][bj][m][1]);
                    else asm volatile("" :: "v"(acc[ai][bj][m][0][0]), "v"(acc[ai][bj][m][1][3]));
                }
            }
        return false;
    }
};
template <bool LIGHT>
__device__ __forceinline__ void phase1(const Params& P, char* lds) {
    {
        pg8::DenseProv PV; PV.S.init(NTOK, 6144, gridDim.x, blockIdx.x);
        PV.A = (const bf16_t*)(P.ws + WS_H0); PV.Bt = (const bf16_t*)(P.ws + WB_WIN); PV.lda = DM; PV.ldb = DM; PV.perm = true;
        EpiProj<LIGHT> E; E.P = &P;
        pg8::gemm_phase((LAS unsigned char*)lds, DM, PV, E);
    }
    for (int tile = blockIdx.x; tile < 32; tile += gridDim.x) {
        int t = threadIdx.x; asm volatile("" : "+v"(t)); const int lane = t & 63, w = t >> 6, wm = w >> 1, wn = w & 1, lr = lane & 15, lq = lane >> 4;
        f32x4 acc[4][4]; zero_acc(acc);
        {
            const int mt = tile >> 3, nt = tile & 7, m0 = mt * 256, n0 = nt * 128;
            GemmA A = make_op<4>((const bf16_t*)(P.ws + WS_MEMB), DM, m0, 1024);
            GemmA B = make_op<2>((const bf16_t*)(P.ws + WB_WMEM), 1024, n0, 1024);
            gemm_mainloop_g(lds, A, B, DM / 64, acc);
            bf16_t* KMEM = (bf16_t*)(P.ws + WS_KMEM); bf16_t* VTMEM = (bf16_t*)(P.ws + WS_VTMEM);
#pragma unroll
            for (int i = 0; i < 4; ++i) {
                const int row = m0 + wm * 64 + i * 16 + lr, b = row >> 8, m = row & 255;
#pragma unroll
                for (int jj = 0; jj < 4; ++jj) {
                    const int n = n0 + wn * 64 + jj * 16 + 4 * lq;
                    const int two = n >> 9, h = (n >> 7) & 3, d = n & 127;
                    if (two == 0) *(uint2*)(KMEM + (((size_t)(b * 4 + h) * 256 + m) * 128 + d)) = pack4(acc[i][jj]);
                    else {
#pragma unroll
                        for (int r = 0; r < 4; ++r) VTMEM[((size_t)(b * 4 + h) * 128 + d + r) * 256 + m] = f2bf(acc[i][jj][r]);
                    }
                }
            }
        }
    }
}

template <int LEN>
__device__ __forceinline__ void rows_rstd(const bf16_t* base, long ld, int m0, float* dst) {
    const int t = threadIdx.x, row = t >> 1, part = t & 1;
    const uint4* p = (const uint4*)(base + (size_t)(m0 + row) * ld + part * (LEN / 2));
    float ss = 0.f;
#pragma unroll 1
    for (int i0 = 0; i0 < LEN / 16; i0 += 16) {
        uint4 v[16];
#pragma unroll
        for (int i = 0; i < 16; ++i) v[i] = p[i0 + i];
#pragma unroll
        for (int i = 0; i < 16; ++i) {
            float a;
            a = bflo(v[i].x); ss += a * a; a = bfhi(v[i].x); ss += a * a; a = bflo(v[i].y); ss += a * a; a = bfhi(v[i].y); ss += a * a;
            a = bflo(v[i].z); ss += a * a; a = bfhi(v[i].z); ss += a * a; a = bflo(v[i].w); ss += a * a; a = bfhi(v[i].w); ss += a * a;
        }
    }
    ss += __shfl_xor(ss, 1);
    if (part == 0) dst[row] = rsqrtf(ss * (1.f / LEN) + 1e-6f);
}

template <int QOFF>
__device__ __forceinline__ void phase2(const Params& P, char* lds) {
    unsigned* ctl = (unsigned*)(P.ws + WS_CTL);
    bf16_t* PROJ = (bf16_t*)(P.ws + WS_PROJ);
    float* rsc = (float*)(lds + LDS_ROWS + 1024);
    float* gsc = (float*)(lds + LDS_KSC);
    const float* COS = (const float*)(P.ws + WS_COS); const float* SIN = (const float*)(P.ws + WS_SIN);
#define P2_TID int t = threadIdx.x; asm volatile("" : "+v"(t)); const int lane = t & 63, w = t >> 6, wm = w >> 1, wn = w & 1, lr = lane & 15, lq = lane >> 4;
#ifndef P2SEL
#define P2SEL 7
#endif
    if (P2SEL & 1) for (;;) {
        const int it = queue_pop(&ctl[QOFF + CTL_Q + 0], lds);
        if (it >= 32) break;
        P2_TID
        {
            const int kv = it >> 4, mt = it & 15, m0 = mt * 256;
            const bf16_t* SRC = (const bf16_t*)(P.ws + (kv ? WS_VCS : WS_KCS));
            const bf16_t* w1t = (const bf16_t*)(P.ws + (kv ? WB_WCV1 : WB_WCK1)); const bf16_t* w2t = (const bf16_t*)(P.ws + (kv ? WB_WCV2 : WB_WCK2));
            {
                const float* pp = (const float*)(P.ws + WB_POSP) + kv * 4096 + (t & 255);
                float a = 0.f;
#pragma unroll
                for (int kc = 0; kc < 16; ++kc) a += pp[kc * 256];
                if (t < 256) gsc[t] = a;
            }
            __syncthreads();
            bf16_t* HID = (bf16_t*)(P.ws + WS_SCR + (size_t)blockIdx.x * 131072);
            GemmA A;
#pragma unroll
            for (int i = 0; i < 4; ++i) {
                const int lr_ = gl_row(i, t); int r = m0 + lr_; r = r < 4088 ? r : 4087;
                const int b = r / 1022, rem = r - b * 1022, n = rem >> 1, g = rem & 1;
                A.off[i] = (unsigned)((((size_t)(b * 2 + g) * SEQ + 16 * n) * 64 + gl_chunk(lr_, t) * 8) * 2);
            }
            A.base = (const char*)SRC;
            for (int nt = 0; nt < 2; ++nt) {
                f32x4 acc[4][4]; zero_acc(acc);
                GemmA B = make_op<2>(w1t, 2048, nt * 128, 256);
                gemm_mainloop_g(lds, A, B, 2048 / 64, acc);
#pragma unroll
                for (int i = 0; i < 4; ++i)
#pragma unroll
                    for (int j = 0; j < 4; ++j) {
                        f32x4 v = acc[i][j];
                        const f32x4 pb = *(const f32x4*)(gsc + nt * 128 + wn * 64 + j * 16 + 4 * lq);
#pragma unroll
                        for (int r = 0; r < 4; ++r) v[r] = geluf_(v[r] + pb[r]);
                        *(uint2*)(HID + (wm * 64 + i * 16 + lr) * 256 + nt * 128 + wn * 64 + j * 16 + 4 * lq) = pack4(v);
                    }
            }
            asm volatile("s_waitcnt vmcnt(0)" ::: "memory");
            __syncthreads();
            {
                f32x4 acc[4][4]; zero_acc(acc);
                GemmA A2 = make_op<4>(HID, 256, 0, 256);
                GemmA B2 = make_op<2>(w2t, 256, 0, 64);
                gemm_mainloop_g(lds, A2, B2, 256 / 64, acc);
                if (wn == 0) {
                    bf16_t* KC = (bf16_t*)(P.ws + WS_KC); bf16_t* VTC = (bf16_t*)(P.ws + WS_VTC);
#pragma unroll
                    for (int i = 0; i < 4; ++i) {
                        const int r = m0 + wm * 64 + i * 16 + lr;
                        if (r < 4088) {
                            const int b = r / 1022, rem = r - b * 1022, n = rem >> 1, g = rem & 1;
#pragma unroll
                            for (int j = 0; j < 4; ++j) {
                                const int d = j * 16 + 4 * lq;
                                if (!kv) *(uint2*)(KC + ((size_t)(b * 2 + g) * 512 + n) * 64 + d) = pack4(acc[i][j]);
                                else {
#pragma unroll
                                    for (int rr = 0; rr < 4; ++rr) VTC[((size_t)(b * 2 + g) * 64 + d + rr) * 512 + n] = f2bf(acc[i][j][rr]);
                                }
                            }
                        }
                    }
                }
            }
        }
    }
    if (P2SEL & 2) for (;;) {
        const int it = queue_pop(&ctl[QOFF + CTL_Q + 256], lds);
        if (it >= 256) break;
        P2_TID
        {
            const int mt = it >> 1, half = it & 1, m0 = mt * 256;
            rows_rstd<768>(PROJ + C_CQ, DIN, m0, rsc);
            __syncthreads();
            GemmA A = make_op<4>(PROJ + C_CQ, DIN, m0, NTOK);
            bf16_t* QM = (bf16_t*)(P.ws + WS_QM);
            int ring = 0;
#pragma unroll 1
            for (int k3 = 0; k3 < 3; ++k3) {
                const int n0 = (half * 3 + k3) * 128;
                f32x4 acc[4][4]; zero_acc(acc);
                GemmA B = make_op<2>((const bf16_t*)(P.ws + WB_WUQ), 768, n0, 768);
                GemmA Bn = make_op<2>((const bf16_t*)(P.ws + WB_WUQ), 768, n0 + (k3 < 2 ? 128 : 0), 768);
                gemm_mainloop_c(lds, A, B, 768 / 64, acc, ring, k3 > 0, k3 < 2, A, Bn);
                const int c16 = (n0 + wn * 64) >> 4;
                const bool rp0 = (c16 % 6) == 4, rp2 = ((c16 + 2) % 6) == 4;
                int lrz = lr; asm volatile("" : "+v"(lrz));
#pragma unroll
                for (int i = 0; i < 4; ++i) {
                    const int tl = wm * 64 + i * 16 + lrz, tok = m0 + tl, pos = tok & (SEQ - 1);
                    const float sc = rsc[tl] * (0.10206207261596575f * LOG2E);
                    const float4 cs = *(const float4*)(COS + pos * 16 + 4 * lq), sn = *(const float4*)(SIN + pos * 16 + 4 * lq);
                    const float csa[4] = {cs.x, cs.y, cs.z, cs.w}, sna[4] = {sn.x, sn.y, sn.z, sn.w};
#pragma unroll
                    for (int j = 0; j < 4; ++j) acc[i][j] *= sc;
#pragma unroll
                    for (int j = 0; j < 4; j += 2) {
                        if (j == 0 ? rp0 : rp2) {
#pragma unroll
                            for (int r = 0; r < 4; ++r) {
                                const float x1 = acc[i][j][r], x2 = acc[i][j + 1][r];
                                acc[i][j][r] = x1 * csa[r] - x2 * sna[r]; acc[i][j + 1][r] = x2 * csa[r] + x1 * sna[r];
                            }
                        }
                    }
#pragma unroll
                    for (int j = 0; j < 4; ++j) *(uint2*)(QM + (size_t)tok * 768 + n0 + wn * 64 + j * 16 + 4 * lq) = pack4(acc[i][j]);
                }
            }
        }
    }
    if (P2SEL & 4) for (;;) {
        const int it = queue_pop(&ctl[QOFF + CTL_Q + 320], lds);
        if (it >= 128) break;
        P2_TID
        {
            const int mt = it, m0 = mt * 256;
            rows_rstd<256>(PROJ + C_CKV, DIN, m0, rsc);
            __syncthreads();
            GemmA A = make_op<4>(PROJ + C_CKV, DIN, m0, NTOK);
            bf16_t* KM = (bf16_t*)(P.ws + WS_KM); bf16_t* VTM = (bf16_t*)(P.ws + WS_VTM);
            int ring = 0;
#pragma unroll 1
            for (int h = 0; h < 8; ++h) {
                f32x4 acc[4][4]; zero_acc(acc);
                GemmA B = make_op<2>((const bf16_t*)(P.ws + WB_WUKV), 256, h * 128, 1024);
                GemmA Bn = make_op<2>((const bf16_t*)(P.ws + WB_WUKV), 256, (h < 7 ? h + 1 : h) * 128, 1024);
                gemm_mainloop_c<true>(lds, A, B, 256 / 64, acc, ring, h > 0, h < 7, A, Bn);
                if (wn == 0) {
#pragma unroll
                    for (int i = 0; i < 4; ++i) {
                        const int tl = wm * 64 + i * 16 + lr, tok = m0 + tl, b = tok >> 13, s = tok & (SEQ - 1);
                        const float sc = rsc[tl];
#pragma unroll
                        for (int j = 0; j < 4; ++j) *(uint2*)(KM + ((size_t)(b * 8 + h) * SEQ + s) * 96 + j * 16 + 4 * lq) = pack4(acc[i][j] * sc);
                    }
                } else {
#pragma unroll
                    for (int i = 0; i < 4; ++i) {
                        const int tl = wm * 64 + i * 16 + 4 * lq, tok = m0 + tl, b = tok >> 13, s = tok & (SEQ - 1);
                        const f32x4 sc = *(const f32x4*)(rsc + tl);
#pragma unroll
                        for (int j = 0; j < 4; ++j) *(uint2*)(VTM + ((size_t)(b * 8 + h) * 64 + j * 16 + lr) * SEQ + s) = pack4(acc[i][j] * sc);
                    }
                }
            }
        }
    }
    {
        const int t = threadIdx.x;
        bf16_t* KM = (bf16_t*)(P.ws + WS_KM);
        const int gt = blockIdx.x * NTHR + t, nt = gridDim.x * NTHR;
        for (int i = gt; i < NTOK * 16; i += nt) {
            const int tok = i >> 4, j = i & 15, b = tok >> 13, s = tok & (SEQ - 1);
            const float x1 = bf2f(PROJ[(size_t)tok * DIN + C_KROPE + j]), x2 = bf2f(PROJ[(size_t)tok * DIN + C_KROPE + 16 + j]);
            const float cs = COS[s * 16 + j], sn = SIN[s * 16 + j];
            const bf16_t o1 = f2bf(x1 * cs - x2 * sn), o2 = f2bf(x2 * cs + x1 * sn);
#pragma unroll
            for (int h = 0; h < 8; ++h) {
                bf16_t* kr = KM + ((size_t)(b * 8 + h) * SEQ + s) * 96 + 64;
                kr[j] = o1; kr[16 + j] = o2;
            }
        }
    }
}

__device__ __forceinline__ int offk(int sub, int key, int c) { return sub * 4096 + key * 64 + (((c ^ (-(key >> 2))) & 3) << 4); }
__device__ __forceinline__ int offv(int dv, int ch) { return dv * 128 + (((ch ^ (dv >> 1)) & 7) << 4); }

template <int DK, int DV, bool NEEDV, class KP, class VP, class TL, class FN>
__device__ __forceinline__ void kv_loop(char* lds, int n, KP kp, VP vp, TL tl, FN fn) {
    if (n <= 0) return;
    int t = threadIdx.x; asm volatile("" : "+v"(t));
    const int lane = t & 63, wu = __builtin_amdgcn_readfirstlane(t >> 6);
    constexpr int KPN = DK / 8, VPN = DV / 8, KPT = (KPN + 7) / 8, VPT = (VPN + 7) / 8;
    constexpr int KB = DK * 128, VB = DV * 128;
    LAS char* ldsl = (LAS char*)lds;
#define KVI_(tile, buf) { \
        _Pragma("unroll") for (int i = 0; i < KPT; ++i) { const int p_ = wu + 8 * i, key_ = 16 * (p_ & 3) + (lane >> 2), c_ = ((lane & 3) ^ (-(key_ >> 2))) & 3; \
            if (p_ < KPN) __builtin_amdgcn_global_load_lds((const unsigned*)(kp(tile, key_) + (p_ >> 2) * 32 + c_ * 8), (LAS unsigned*)(ldsl + (buf) * KB + p_ * 1024), 16, 0, 0); } \
        if (NEEDV) { _Pragma("unroll") for (int i = 0; i < VPT; ++i) { const int p_ = wu + 8 * i, dv_ = 8 * p_ + (lane >> 3), ch_ = ((lane & 7) ^ (dv_ >> 1)) & 7; \
            if (p_ < VPN) __builtin_amdgcn_global_load_lds((const unsigned*)(vp(tile, dv_) + ch_ * 8), (LAS unsigned*)(ldsl + 2 * KB + (buf) * VB + p_ * 1024), 16, 0, 0); } } }
    __syncthreads();
    { const int t0 = tl(0); KVI_(t0, 0); }
    asm volatile("s_waitcnt vmcnt(0)" ::: "memory");
    __syncthreads();
#pragma unroll 1
    for (int i = 0; i < n; ++i) {
        const int cur = i & 1, tile = tl(i);
        if (i + 1 < n) { const int tn = tl(i + 1); if (cur) KVI_(tn, 0) else KVI_(tn, 1) }
        fn(tile, (const char*)(lds + cur * KB), (const char*)(lds + 2 * KB + cur * VB));
        asm volatile("s_waitcnt vmcnt(0)" ::: "memory");
        __syncthreads();
    }
#undef KVI_
}

template <int DK, int DV, class KP, class VP, class TL, class FN>
__device__ __forceinline__ void kv_loop2(char* lds, int n, KP kp, VP vp, TL tl, FN fn) {
    if (n <= 0) return;
    int t = threadIdx.x; asm volatile("" : "+v"(t));
    const int lane = t & 63, wu = __builtin_amdgcn_readfirstlane(t >> 6);
    constexpr int KPN = DK / 8, VPN = DV / 8, KPT = (KPN + 7) / 8, VPT = (VPN + 7) / 8;
    constexpr int KB = DK * 128, VB = DV * 128, TB = KB + VB, SB = 2 * TB;
    LAS char* ldsl = (LAS char*)lds;
#define KVI2_(tile, off_) { \
        _Pragma("unroll") for (int i = 0; i < KPT; ++i) { const int p_ = wu + 8 * i, key_ = 16 * (p_ & 3) + (lane >> 2), c_ = ((lane & 3) ^ (-(key_ >> 2))) & 3; \
            if (p_ < KPN) __builtin_amdgcn_global_load_lds((const unsigned*)(kp(tile, key_) + (p_ >> 2) * 32 + c_ * 8), (LAS unsigned*)(ldsl + (off_) + p_ * 1024), 16, 0, 0); } \
        _Pragma("unroll") for (int i = 0; i < VPT; ++i) { const int p_ = wu + 8 * i, dv_ = 8 * p_ + (lane >> 3), ch_ = ((lane & 7) ^ (dv_ >> 1)) & 7; \
            if (p_ < VPN) __builtin_amdgcn_global_load_lds((const unsigned*)(vp(tile, dv_) + ch_ * 8), (LAS unsigned*)(ldsl + (off_) + KB + p_ * 1024), 16, 0, 0); } }
    const int np = (n + 1) >> 1;
    __syncthreads();
    { const int ta = tl(0), tb = tl(n > 1 ? 1 : 0); KVI2_(ta, 0); KVI2_(tb, TB); }
    asm volatile("s_waitcnt vmcnt(0)" ::: "memory");
    __syncthreads();
#pragma unroll 1
    for (int i = 0; i < np; ++i) {
        const int cur = i & 1;
        if (i + 1 < np) { const int ia = 2 * i + 2, ib = (2 * i + 3 < n) ? 2 * i + 3 : ia; const int ta = tl(ia), tb = tl(ib);
            if (cur) { KVI2_(ta, 0); KVI2_(tb, TB); } else { KVI2_(ta, SB); KVI2_(tb, SB + TB); } }
        const char* base = lds + cur * SB;
        const bool hasB = 2 * i + 1 < n;
        fn(tl(2 * i), base, base + KB, tl(hasB ? 2 * i + 1 : 2 * i), base + TB, base + TB + KB, hasB);
        asm volatile("s_waitcnt vmcnt(0)" ::: "memory");
        __syncthreads();
    }
#undef KVI2_
}

template <int DK, int NST>
__device__ __forceinline__ void qk_tile(const char* Kb, const bf16x8 (&qf)[NST][DK / 32], f32x4 (&s)[NST][4], int lane) {
    const int lr = lane & 15, lq = lane >> 4;
#pragma unroll
    for (int kt = 0; kt < 4; ++kt) {
#pragma unroll
        for (int st = 0; st < NST; ++st) s[st][kt] = (f32x4){0.f, 0.f, 0.f, 0.f};
#pragma unroll
        for (int ks = 0; ks < DK / 32; ++ks) {
            const bf16x8 kf = *(const bf16x8*)(Kb + offk(ks, kt * 16 + lr, lq));
#pragma unroll
            for (int st = 0; st < NST; ++st) s[st][kt] = mfma16(kf, qf[st][ks], s[st][kt]);
        }
    }
}
template <int DV, int NST>
__device__ __forceinline__ void pv_tile(const char* Vb, const f32x4 (&p)[NST][4], f32x4 (&O)[NST][DV / 16], int lane) {
    const int lr = lane & 15, lq = lane >> 4;
#pragma unroll
    for (int h2 = 0; h2 < 2; ++h2) {
        bf16x8 pf[NST];
#pragma unroll
        for (int st = 0; st < NST; ++st) {
            const uint2 a = pack4(p[st][2 * h2]), b = pack4(p[st][2 * h2 + 1]);
            const uint4 u = make_uint4(a.x, a.y, b.x, b.y);
            pf[st] = __builtin_bit_cast(bf16x8, u);
        }
#pragma unroll
        for (int dvt = 0; dvt < DV / 16; ++dvt) {
            const int dv = dvt * 16 + lr;
            const bf16x4 v0 = *(const bf16x4*)(Vb + offv(dv, 4 * h2 + (lq >> 1)) + (lq & 1) * 8);
            const bf16x4 v1 = *(const bf16x4*)(Vb + offv(dv, 4 * h2 + 2 + (lq >> 1)) + (lq & 1) * 8);
            const bf16x8 vf = __builtin_shufflevector(v0, v1, 0, 1, 2, 3, 4, 5, 6, 7);
#pragma unroll
            for (int st = 0; st < NST; ++st) O[st][dvt] = mfma16(vf, pf[st], O[st][dvt]);
        }
    }
}
constexpr float RESCALE_AT = 1099511627776.f, RESCALE_BY = 1.f / 1099511627776.f;
template <int DV, int NST>
__device__ __forceinline__ void softmax_online(f32x4 (&s)[NST][4], float (&c)[NST], float (&l)[NST], f32x4 (&O)[NST][DV / 16]) {
    bool scaled = false, big = false;
#pragma unroll
    for (int st = 0; st < NST; ++st) scaled = scaled || (c[st] != 1.f);
#pragma unroll
    for (int st = 0; st < NST; ++st)
#pragma unroll
        for (int kt = 0; kt < 4; ++kt)
#pragma unroll
            for (int r = 0; r < 4; ++r) s[st][kt][r] = fexp2(s[st][kt][r]);
    if (__any(scaled)) {
#pragma unroll
        for (int st = 0; st < NST; ++st)
#pragma unroll
            for (int kt = 0; kt < 4; ++kt) s[st][kt] *= c[st];
    }
#pragma unroll
    for (int st = 0; st < NST; ++st) { l[st] += sum16(s[st]); big = big || (l[st] > RESCALE_AT); }
    if (__any(big)) {
#pragma unroll
        for (int st = 0; st < NST; ++st) {
            const float f = l[st] > RESCALE_AT ? RESCALE_BY : 1.f;
            const float g = quad_min(f);
            l[st] *= g; c[st] *= g;
#pragma unroll
            for (int kt = 0; kt < 4; ++kt) s[st][kt] *= g;
#pragma unroll
            for (int dvt = 0; dvt < DV / 16; ++dvt) O[st][dvt] *= g;
        }
    }
}
__device__ __forceinline__ float quad_lsum(float l) { return quad_sum(l); }

__device__ __forceinline__ void mla_item(const Params& P, char* lds, int b, int h, int qblk) {
    int t = threadIdx.x; asm volatile("" : "+v"(t));
    const int lane = t & 63, w = t >> 6, lr = lane & 15, lq = lane >> 4;
    const bf16_t* QM = (const bf16_t*)(P.ws + WS_QM);
    const bf16_t* KM = (const bf16_t*)(P.ws + WS_KM) + (size_t)(b * 8 + h) * SEQ * 96;
    const bf16_t* VTM = (const bf16_t*)(P.ws + WS_VTM) + (size_t)(b * 8 + h) * 64 * SEQ;
    const int wq0 = qblk * 256 + w * 32;
    bf16x8 qf[2][3];
#pragma unroll
    for (int st = 0; st < 2; ++st)
#pragma unroll
        for (int ks = 0; ks < 3; ++ks) qf[st][ks] = *(const bf16x8*)(QM + (size_t)(b * SEQ + wq0 + st * 16 + lr) * 768 + h * 96 + ks * 32 + lq * 8);
    float m[2] = {1.f, 1.f}, l[2] = {0.f, 0.f};
    f32x4 O[2][4];
#pragma unroll
    for (int st = 0; st < 2; ++st)
#pragma unroll
        for (int d = 0; d < 4; ++d) O[st][d] = (f32x4){0.f, 0.f, 0.f, 0.f};
    auto mla_tile = [&](int tile, const char* Kb, const char* Vb) __attribute__((always_inline)) {
        if (tile * 64 > wq0 + 31) return;
        f32x4 s[2][4];
        qk_tile<96, 2>(Kb, qf, s, lane);
        if (tile * 64 + 63 > wq0) {
#pragma unroll
            for (int st = 0; st < 2; ++st)
#pragma unroll
                for (int kt = 0; kt < 4; ++kt)
#pragma unroll
                    for (int r = 0; r < 4; ++r)
                        if (tile * 64 + kt * 16 + 4 * lq + r > wq0 + st * 16 + lr) s[st][kt][r] = NEGBIG;
        }
        softmax_online<64, 2>(s, m, l, O);
        pv_tile<64, 2>(Vb, s, O, lane);
    };
    kv_loop2<96, 64>(lds, 4 * qblk + 4,
        [&](int tile, int key) __attribute__((always_inline)) { return KM + (size_t)(tile * 64 + key) * 96; },
        [&](int tile, int dv) __attribute__((always_inline)) { return VTM + (size_t)dv * SEQ + tile * 64; },
        [&](int i) __attribute__((always_inline)) { return i; },
        [&](int ta, const char* Ka, const char* Va, int tb, const char* Kb, const char* Vb, bool hasB) __attribute__((always_inline)) {
            mla_tile(ta, Ka, Va);
            if (hasB) mla_tile(tb, Kb, Vb);
        });
    bf16_t* OM = (bf16_t*)(P.ws + WS_OMLA);
#pragma unroll
    for (int st = 0; st < 2; ++st) {
        const float inv = 1.f / quad_lsum(l[st]);
        const size_t tok = (size_t)b * SEQ + wq0 + st * 16 + lr;
#pragma unroll
        for (int d = 0; d < 4; ++d) *(uint2*)(OM + tok * 512 + h * 64 + d * 16 + 4 * lq) = pack4(O[st][d] * inv);
    }
}

__device__ __forceinline__ void mem_item(const Params& P, char* lds, int b, int h, int qblk) {
    int t = threadIdx.x; asm volatile("" : "+v"(t));
    const int lane = t & 63, w = t >> 6, lr = lane & 15, lq = lane >> 4;
    const bf16_t* PROJ = (const bf16_t*)(P.ws + WS_PROJ);
    const bf16_t* KMEM = (const bf16_t*)(P.ws + WS_KMEM) + (size_t)(b * 4 + h) * 256 * 128;
    const bf16_t* VTMEM = (const bf16_t*)(P.ws + WS_VTMEM) + (size_t)(b * 4 + h) * 128 * 256;
    const size_t tok = (size_t)b * SEQ + qblk * 128 + w * 16 + lr;
    bf16x8 qf[1][4];
#pragma unroll
    for (int ks = 0; ks < 4; ++ks) qf[0][ks] = *(const bf16x8*)(PROJ + tok * DIN + C_QMEM + h * 128 + ks * 32 + lq * 8);
    float m[1] = {1.f}, l[1] = {0.f};
    f32x4 O[1][8];
#pragma unroll
    for (int d = 0; d < 8; ++d) O[0][d] = (f32x4){0.f, 0.f, 0.f, 0.f};
    kv_loop<128, 128, true>(lds, 4,
        [&](int tile, int key) __attribute__((always_inline)) { return KMEM + (size_t)(tile * 64 + key) * 128; },
        [&](int tile, int dv) __attribute__((always_inline)) { return VTMEM + (size_t)dv * 256 + tile * 64; },
        [&](int i) __attribute__((always_inline)) { return i; },
        [&](int tile, const char* Kb, const char* Vb) __attribute__((always_inline)) {
            f32x4 s[1][4];
            qk_tile<128, 1>(Kb, qf, s, lane);
            softmax_online<128, 1>(s, m, l, O);
            pv_tile<128, 1>(Vb, s, O, lane);
        });
    bf16_t* OM = (bf16_t*)(P.ws + WS_OMEM);
    const float inv = 1.f / quad_lsum(l[0]);
#pragma unroll
    for (int d = 0; d < 8; ++d) *(uint2*)(OM + tok * 512 + h * 128 + d * 16 + 4 * lq) = pack4(O[0][d] * inv);
}

__device__ __forceinline__ void softmax_stats(const f32x4 (&s)[2][4], float (&c)[2], float (&l)[2]) {
#pragma unroll
    for (int st = 0; st < 2; ++st) {
        f32x4 e[4];
#pragma unroll
        for (int kt = 0; kt < 4; ++kt)
#pragma unroll
            for (int r = 0; r < 4; ++r) e[kt][r] = fexp2(s[st][kt][r]);
        l[st] += sum16(e) * c[st];
        const float g = quad_min(l[st] > RESCALE_AT ? RESCALE_BY : 1.f);
        l[st] *= g; c[st] *= g;
    }
}

template <int NMASK>
__device__ __forceinline__ void nsa_item(const Params& P, char* lds, int b, int g, int q0) {
    int t = threadIdx.x; asm volatile("" : "+v"(t));
    const int lane = t & 63, w = t >> 6, lr = lane & 15, lq = lane >> 4;
    const int hg = g * 4 + (lr & 3);
    const bf16_t* PROJ = (const bf16_t*)(P.ws + WS_PROJ);
    const size_t bg = (size_t)(b * 2 + g);
    const bf16_t* KC = (const bf16_t*)(P.ws + WS_KC) + bg * 512 * 64;
    const bf16_t* VTC = (const bf16_t*)(P.ws + WS_VTC) + bg * 64 * 512;
    const bf16_t* KSLC = (const bf16_t*)(P.ws + WS_KSLC) + bg * SEQ * 64;
    const bf16_t* VTSLC = (const bf16_t*)(P.ws + WS_VTSLC) + bg * 64 * SEQ;
    const bf16_t* KWIN = (const bf16_t*)(P.ws + WS_KWIN) + bg * SEQ * 64;
    const bf16_t* VTWIN = (const bf16_t*)(P.ws + WS_VTWIN) + bg * 64 * SEQ;
    float* imp = (float*)(lds + 65536);
    const float* LUT = (const float*)(lds + LDS_LUT) + 64 * 8;
    unsigned* SEL = (unsigned*)(lds + LDS_SEL);
    unsigned* WOR = (unsigned*)(lds + LDS_WOR);
    unsigned char* TL = (unsigned char*)(lds + LDS_TL);
    int* TLN = (int*)(lds + LDS_TL + 128);
    int tpos[2];
    tpos[0] = q0 + 8 * w + (lr >> 2); tpos[1] = tpos[0] + 4;
    bf16x8 qf[2][2];
#pragma unroll
    for (int st = 0; st < 2; ++st)
#pragma unroll
        for (int ks = 0; ks < 2; ++ks) qf[st][ks] = *(const bf16x8*)(PROJ + (size_t)(b * SEQ + tpos[st]) * DIN + C_QNSA + hg * 64 + ks * 32 + lq * 8);
    auto gate = [&](int st, int k) __attribute__((always_inline)) { return bf2f(PROJ[(size_t)(b * SEQ + tpos[st]) * DIN + C_GNSA + hg * 3 + k]); };
    f32x4 OT[2][4];
#pragma unroll
    for (int i = 0; i < 16; ++i) imp[(8 * w) * 128 + i * 64 + lane] = 0.f;

    const float bfar = LUT[128 * 8 + hg];
    const int ntc = (((q0 + 32) >> 4) >> 6) + 1;
    float m[2] = {1.f, 1.f}, l[2] = {0.f, 0.f};
    auto cmp_mask = [&](int tile, f32x4 (&s)[2][4]) __attribute__((always_inline)) {
#pragma unroll
        for (int st = 0; st < 2; ++st)
#pragma unroll
            for (int kt = 0; kt < 4; ++kt)
#pragma unroll
                for (int r = 0; r < 4; ++r) {
                    const int n = tile * 64 + kt * 16 + 4 * lq + r;
                    const int dist = tpos[st] - (16 * n + 31);
                    const int di = dist < -1 ? -1 : (dist < 128 ? dist : 128);
                    s[st][kt][r] += LUT[di * 8 + hg];
                }
    };
    kv_loop<64, 64, false>(lds, ntc,
        [&](int tile, int key) __attribute__((always_inline)) { return KC + (size_t)(tile * 64 + key) * 64; },
        [&](int tile, int dv) __attribute__((always_inline)) { return VTC; },
        [&](int i) __attribute__((always_inline)) { return i; },
        [&](int tile, const char* Kb, const char* Vb) __attribute__((always_inline)) {
            f32x4 s[2][4];
            const bool farc = q0 + 8 * w - (16 * (tile * 64 + 63) + 31) >= 128;
            qk_tile<64, 2>(Kb, qf, s, lane);
            if (farc) {
#pragma unroll
                for (int st = 0; st < 2; ++st)
#pragma unroll
                    for (int kt = 0; kt < 4; ++kt) s[st][kt] += bfar;
            } else cmp_mask(tile, s);
            softmax_stats(s, m, l);
        });
    float invl[2];
#pragma unroll
    for (int st = 0; st < 2; ++st) { const float lt = quad_lsum(l[st]); invl[st] = lt > 0.f ? m[st] / lt : 0.f; }
#pragma unroll
    for (int st = 0; st < 2; ++st)
#pragma unroll
        for (int d = 0; d < 4; ++d) OT[st][d] = (f32x4){0.f, 0.f, 0.f, 0.f};
    kv_loop<64, 64, true>(lds, ntc,
        [&](int tile, int key) __attribute__((always_inline)) { return KC + (size_t)(tile * 64 + key) * 64; },
        [&](int tile, int dv) __attribute__((always_inline)) { return VTC + (size_t)dv * 512 + tile * 64; },
        [&](int i) __attribute__((always_inline)) { return i; },
        [&](int tile, const char* Kb, const char* Vb) __attribute__((always_inline)) {
            f32x4 s[2][4];
            const bool farc = q0 + 8 * w - (16 * (tile * 64 + 63) + 31) >= 128;
            qk_tile<64, 2>(Kb, qf, s, lane);
            if (farc) {
#pragma unroll
                for (int st = 0; st < 2; ++st)
#pragma unroll
                    for (int kt = 0; kt < 4; ++kt) s[st][kt] += bfar;
            } else cmp_mask(tile, s);
#pragma unroll
            for (int st = 0; st < 2; ++st)
#pragma unroll
                for (int kt = 0; kt < 4; ++kt) {
#pragma unroll
                    for (int r = 0; r < 4; ++r) {
                        s[st][kt][r] = fexp2(s[st][kt][r]) * invl[st];
                    }
                    float ps = (s[st][kt][0] + s[st][kt][1]) + (s[st][kt][2] + s[st][kt][3]);
                    float pc = s[st][kt][3];
                    ps = quad4_sum(ps);
                    pc = quad4_sum(pc);
                    const int j = tile * 16 + kt * 4 + lq;
                    float* row = imp + (8 * w + 4 * st + (lr >> 2)) * 128;
                    if ((lr & 3) == 0) lds_fadd(&row[j], ps);
                    if ((lr & 3) == 0 && j + 1 < 128) lds_fadd(&row[j + 1], pc);
                }
            pv_tile<64, 2>(Vb, s, OT, lane);
        });
#pragma unroll
    for (int st = 0; st < 2; ++st) {
        const float g0 = gate(st, 0);
#pragma unroll
        for (int d = 0; d < 4; ++d) OT[st][d] *= g0;
    }

    {
        unsigned wo0 = 0, wo1 = 0, wo2 = 0, wo3 = 0;
        for (int qi = 0; qi < 8; ++qi) {
            const int tq = q0 + 8 * w + qi, cur = tq >> 6;
            const float v0 = imp[(8 * w + qi) * 128 + lane], v1 = imp[(8 * w + qi) * 128 + 64 + lane];
            const int j0 = lane, j1 = lane + 64;
            bool s0 = (j0 == 0) || (j0 == cur) || (j0 + 1 == cur);
            bool s1 = (j1 == cur) || (j1 + 1 == cur);
            const bool c0 = (j0 >= 1) && (j0 + 2 <= cur), c1 = (j1 + 2 <= cur);
            if (cur - 2 <= 13) { s0 = s0 || c0; s1 = s1 || c1; }
            else {
                const unsigned k0 = c0 ? __float_as_uint(v0) + 1u : 0u, k1 = c1 ? __float_as_uint(v1) + 1u : 0u;
                unsigned T = 0u;
                for (int bit = 30; bit >= 0; --bit) {
                    const unsigned cand = T | (1u << bit);
                    const int cnt = __popcll(__ballot(k0 >= cand)) + __popcll(__ballot(k1 >= cand));
                    if (cnt >= 13) { T = cand; if (cnt == 13) break; }
                }
                const unsigned long long gt0 = __ballot(k0 > T), gt1 = __ballot(k1 > T);
                unsigned long long eq0 = __ballot(k0 == T), eq1 = __ballot(k1 == T);
                int need = 13 - (__popcll(gt0) + __popcll(gt1));
                unsigned long long tk0 = 0ull, tk1 = 0ull;
                while (need > 0 && eq0) { const unsigned long long lowb = eq0 & (0ull - eq0); tk0 |= lowb; eq0 ^= lowb; --need; }
                while (need > 0 && eq1) { const unsigned long long lowb = eq1 & (0ull - eq1); tk1 |= lowb; eq1 ^= lowb; --need; }
                s0 = s0 || ((gt0 | tk0) >> lane) & 1ull;
                s1 = s1 || ((gt1 | tk1) >> lane) & 1ull;
            }
            const unsigned long long b0 = __ballot(s0), b1 = __ballot(s1);
            if (lane == 0) {
                SEL[(8 * w + qi) * 4 + 0] = (unsigned)b0; SEL[(8 * w + qi) * 4 + 1] = (unsigned)(b0 >> 32);
                SEL[(8 * w + qi) * 4 + 2] = (unsigned)b1; SEL[(8 * w + qi) * 4 + 3] = (unsigned)(b1 >> 32);
            }
            wo0 |= (unsigned)b0; wo1 |= (unsigned)(b0 >> 32); wo2 |= (unsigned)b1; wo3 |= (unsigned)(b1 >> 32);
        }
        if (lane == 0) { WOR[w * 4 + 0] = wo0; WOR[w * 4 + 1] = wo1; WOR[w * 4 + 2] = wo2; WOR[w * 4 + 3] = wo3; }
    }
    __syncthreads();
    if (w == 0) {
        unsigned o0 = 0u, o1 = 0u, o2 = 0u, o3 = 0u;
#pragma unroll
        for (int ww = 0; ww < NWV; ++ww) { o0 |= WOR[ww * 4 + 0]; o1 |= WOR[ww * 4 + 1]; o2 |= WOR[ww * 4 + 2]; o3 |= WOR[ww * 4 + 3]; }
        const bool n0 = ((lane < 32 ? o0 : o1) >> (lane & 31)) & 1u, n1 = ((lane < 32 ? o2 : o3) >> (lane & 31)) & 1u;
        const unsigned long long m0 = __ballot(n0), m1 = __ballot(n1);
        const unsigned long long below = (1ull << lane) - 1ull;
        const int c0 = __popcll(m0);
        if (n0) TL[__popcll(m0 & below)] = (unsigned char)lane;
        if (n1) TL[c0 + __popcll(m1 & below)] = (unsigned char)(64 + lane);
        if (lane == 0) *TLN = c0 + __popcll(m1);
    }
    __syncthreads();
    const int nts = *TLN;
    f32x4* ST = (f32x4*)(lds + 65536);
#pragma unroll
    for (int k = 0; k < 8; ++k) ST[k * NTHR + t] = OT[k >> 2][k & 3];

    if (NMASK & 2)
    {
        f32x4 Oa[1][4], Ob[1][4];
#pragma unroll
        for (int d = 0; d < 4; ++d) { Oa[0][d] = (f32x4){0.f, 0.f, 0.f, 0.f}; Ob[0][d] = (f32x4){0.f, 0.f, 0.f, 0.f}; }
        float ca[1] = {1.f}, cb[1] = {1.f}, la[1] = {0.f}, lb[1] = {0.f};
        bf16x8 qfa[1][2], qfb[1][2];
#pragma unroll
        for (int ks = 0; ks < 2; ++ks) { qfa[0][ks] = qf[0][ks]; qfb[0][ks] = qf[1][ks]; }
        auto proc = [&](int tile, const char* Kb, const char* Vb, const bf16x8 (&q1)[1][2], f32x4 (&O1)[1][4], float (&c1)[1], float (&l1)[1], bool on, int tp) __attribute__((always_inline)) {
            f32x4 s[1][4];
            qk_tile<64, 1>(Kb, q1, s, lane);
            const bool far = tile * 64 + 63 + 128 <= q0 + 8 * w;
            if (far) {
                const float ab = on ? bfar : NEGBIG;
#pragma unroll
                for (int kt = 0; kt < 4; ++kt) s[0][kt] += ab;
            } else {
                int D = tp - (tile * 64 + 4 * lq); D = D < 191 ? D : 191; D = on ? D : -1;
                const float* lp = LUT + (D - 63) * 8 + hg;
#pragma unroll
                for (int kt = 0; kt < 4; ++kt)
#pragma unroll
                    for (int r = 0; r < 4; ++r) s[0][kt][r] += lp[(63 - (kt * 16 + r)) * 8];
            }
            softmax_online<64, 1>(s, c1, l1, O1);
            pv_tile<64, 1>(Vb, s, O1, lane);
        };
        auto s_tile = [&](int tile, const char* Kb, const char* Vb) __attribute__((always_inline)) {
            const unsigned wv = WOR[w * 4 + (tile >> 5)];
            if (!((wv >> (tile & 31)) & 1u)) return;
            const bool on0 = (SEL[(8 * w + (lr >> 2)) * 4 + (tile >> 5)] >> (tile & 31)) & 1u;
            const bool on1 = (SEL[(8 * w + 4 + (lr >> 2)) * 4 + (tile >> 5)] >> (tile & 31)) & 1u;
            if (__any(on0)) proc(tile, Kb, Vb, qfa, Oa, ca, la, on0, tpos[0]);
            if (__any(on1)) proc(tile, Kb, Vb, qfb, Ob, cb, lb, on1, tpos[1]);
        };
        kv_loop2<64, 64>(lds, nts,
            [&](int tile, int key) __attribute__((always_inline)) { return KSLC + (size_t)(tile * 64 + key) * 64; },
            [&](int tile, int dv) __attribute__((always_inline)) { return VTSLC + (size_t)dv * SEQ + tile * 64; },
            [&](int i) __attribute__((always_inline)) { return (int)TL[i]; },
            [&](int ta, const char* Ka, const char* Va, int tb, const char* Kb, const char* Vb, bool hasB) __attribute__((always_inline)) {
                s_tile(ta, Ka, Va);
                if (hasB) s_tile(tb, Kb, Vb);
            });
        {
            const float lt = quad_lsum(la[0]);
            const float f = lt > 0.f ? gate(0, 1) / lt : 0.f;
#pragma unroll
            for (int d = 0; d < 4; ++d) ST[d * NTHR + t] += Oa[0][d] * f;
        }
        {
            const float lt = quad_lsum(lb[0]);
            const float f = lt > 0.f ? gate(1, 1) / lt : 0.f;
#pragma unroll
            for (int d = 0; d < 4; ++d) ST[(4 + d) * NTHR + t] += Ob[0][d] * f;
        }
    }
    if (NMASK & 4) {
        f32x4 O[2][4];
#pragma unroll
        for (int st = 0; st < 2; ++st)
#pragma unroll
            for (int d = 0; d < 4; ++d) O[st][d] = (f32x4){0.f, 0.f, 0.f, 0.f};
        m[0] = 1.f; m[1] = 1.f; l[0] = 0.f; l[1] = 0.f;
        const int tw0 = (q0 - 511 > 0 ? q0 - 511 : 0) >> 6, tw1 = (q0 + 63) >> 6;
        kv_loop<64, 64, true>(lds, tw1 - tw0 + 1,
            [&](int tile, int key) __attribute__((always_inline)) { return KWIN + (size_t)(tile * 64 + key) * 64; },
            [&](int tile, int dv) __attribute__((always_inline)) { return VTWIN + (size_t)dv * SEQ + tile * 64; },
            [&](int i) __attribute__((always_inline)) { return tw0 + i; },
            [&](int tile, const char* Kb, const char* Vb) __attribute__((always_inline)) {
                f32x4 s[2][4];
                const bool mid = q0 + 8 * w - (tile * 64 + 63) >= 128 && q0 + 8 * w + 7 - tile * 64 < 512;
                qk_tile<64, 2>(Kb, qf, s, lane);
                if (mid) {
#pragma unroll
                    for (int st = 0; st < 2; ++st)
#pragma unroll
                        for (int kt = 0; kt < 4; ++kt) s[st][kt] += bfar;
                } else if (q0 + 8 * w - (tile * 64 + 63) < 128) {
#pragma unroll
                    for (int st = 0; st < 2; ++st) {
                        int D = tpos[st] - (tile * 64 + 4 * lq); D = D < 191 ? D : 191;
                        const float* lp = LUT + (D - 63) * 8 + hg;
#pragma unroll
                        for (int kt = 0; kt < 4; ++kt)
#pragma unroll
                            for (int r = 0; r < 4; ++r) s[st][kt][r] += lp[(63 - (kt * 16 + r)) * 8];
                    }
                } else {
#pragma unroll
                    for (int st = 0; st < 2; ++st)
#pragma unroll
                        for (int kt = 0; kt < 4; ++kt)
#pragma unroll
                            for (int r = 0; r < 4; ++r) {
                                const int dist = tpos[st] - (tile * 64 + kt * 16 + 4 * lq + r);
                                s[st][kt][r] = dist < 512 ? s[st][kt][r] + bfar : NEGBIG;
                            }
                }
                softmax_online<64, 2>(s, m, l, O);
                pv_tile<64, 2>(Vb, s, O, lane);
            });
#pragma unroll
        for (int st = 0; st < 2; ++st) {
            const float lt = quad_lsum(l[st]);
            const float f = lt > 0.f ? gate(st, 2) / lt : 0.f;
            bf16_t* ON = (bf16_t*)(P.ws + WS_ONSA);
#pragma unroll
            for (int d = 0; d < 4; ++d)
                *(uint2*)(ON + (size_t)(b * SEQ + tpos[st]) * 512 + hg * 64 + d * 16 + 4 * lq) = pack4(ST[(st * 4 + d) * NTHR + t] + O[st][d] * f);
        }
    }
}

#ifndef P3SEL
#define P3SEL 7
#endif
#ifndef NSADUP
#define NSADUP 7
#endif
template <int QOFF, int SEL>
__device__ __forceinline__ void phase3(const Params& P, char* lds) {
    unsigned* ctl = (unsigned*)(P.ws + WS_CTL);
#define P3_QUEUE(head_, n_, call_) { int it = queue_pop(head_, lds); while (it < (n_)) { \
        unsigned nx_ = 0u; if (threadIdx.x == 0) nx_ = atomicAdd(head_, 1u); \
        call_; \
        __syncthreads(); if (threadIdx.x == 0) *(volatile int*)(lds + LDS_ITEM) = (int)nx_; __syncthreads(); \
        it = __builtin_amdgcn_readfirstlane(*(volatile int*)(lds + LDS_ITEM)); } }
    if (SEL & 1) P3_QUEUE(&ctl[QOFF + CTL_Q + 64], 1024, mla_item(P, lds, (it & 31) >> 3, it & 7, 31 - (it >> 5)))
    if (SEL & 2) P3_QUEUE(&ctl[QOFF + CTL_Q + 128], 1024, (nsa_item<(QOFF == 0 ? 7 : NSADUP)>(P, lds, (it & 7) >> 1, it & 1, (127 - (it >> 3)) * 64)))
    if (SEL & 4) P3_QUEUE(&ctl[QOFF + CTL_Q + 192], 1024, mem_item(P, lds, it >> 8, (it >> 6) & 3, it & 63))
#undef P3_QUEUE
}

__device__ __forceinline__ void phase4(const Params& P, char* lds) {
    const bf16_t* PROJ = (const bf16_t*)(P.ws + WS_PROJ);
    bf16_t* MERGED = (bf16_t*)(P.ws + WS_MERGED);
    int ring = 0; bool primed = false;
    auto tile_mn = [&](int tile, int& m0, int& n0) __attribute__((always_inline)) {
        const int bb = tile & 255, rnd = tile >> 8, xg = bb & 7, rr = bb >> 3;
        const int mt = (xg + 8 * rnd) * 4 + (rr & 3), nt = rr >> 2; m0 = mt * 256; n0 = nt * 128;
    };
    for (int tile = blockIdx.x; tile < 1024; tile += gridDim.x) {
        int t = threadIdx.x; asm volatile("" : "+v"(t)); const int lane = t & 63, w = t >> 6, wm = w >> 1, wn = w & 1, lr = lane & 15, lq = lane >> 4;
        int m0, n0; tile_mn(tile, m0, n0);
        const bool last_tile = tile + (int)gridDim.x >= 1024;
        f32x4 tot[4][4]; zero_acc(tot);
#pragma unroll 1
        for (int br = 0; br < 3; ++br) {
            f32x4 acc[4][4]; zero_acc(acc);
            GemmA A = make_op<4>((const bf16_t*)(P.ws + WS_ONSA + (size_t)br * 32 * MBY), 512, m0, NTOK);
            GemmA B = make_op<2, true>((const bf16_t*)(P.ws + WB_WBR) + (size_t)br * 1024 * 512, 512, n0, 1024);
            const bool chain = !(br == 2 && last_tile);
            int m1 = m0, n1 = n0; const int br1 = br == 2 ? 0 : br + 1;
            if (br == 2 && !last_tile) tile_mn(tile + gridDim.x, m1, n1);
            GemmA An = make_op<4>((const bf16_t*)(P.ws + WS_ONSA + (size_t)br1 * 32 * MBY), 512, m1, NTOK);
            GemmA Bn = make_op<2, true>((const bf16_t*)(P.ws + WB_WBR) + (size_t)br1 * 1024 * 512, 512, n1, 1024);
            gemm_mainloop_c(lds, A, B, 512 / 64, acc, ring, primed, chain, An, Bn);
            primed = chain;
#pragma unroll
            for (int i = 0; i < 4; ++i) {
                const size_t tok = m0 + wm * 64 + i * 16 + lr;
#pragma unroll
                for (int jp = 0; jp < 2; ++jp) {
                    const int n = n0 + wn * 64 + jp * 32 + 8 * lq;
                    const uint4 gv = *(const uint4*)(PROJ + tok * DIN + C_GMERGE + br * 1024 + n);
                    tot[i][2 * jp][0] += bflo(gv.x) * acc[i][2 * jp][0]; tot[i][2 * jp][1] += bfhi(gv.x) * acc[i][2 * jp][1];
                    tot[i][2 * jp][2] += bflo(gv.y) * acc[i][2 * jp][2]; tot[i][2 * jp][3] += bfhi(gv.y) * acc[i][2 * jp][3];
                    tot[i][2 * jp + 1][0] += bflo(gv.z) * acc[i][2 * jp + 1][0]; tot[i][2 * jp + 1][1] += bfhi(gv.z) * acc[i][2 * jp + 1][1];
                    tot[i][2 * jp + 1][2] += bflo(gv.w) * acc[i][2 * jp + 1][2]; tot[i][2 * jp + 1][3] += bfhi(gv.w) * acc[i][2 * jp + 1][3];
                }
            }
        }
#pragma unroll
        for (int i = 0; i < 4; ++i) {
            const size_t tok = m0 + wm * 64 + i * 16 + lr;
#pragma unroll
            for (int jp = 0; jp < 2; ++jp) { const uint2 x = pack4(tot[i][2 * jp]), y = pack4(tot[i][2 * jp + 1]); *(uint4*)(MERGED + tok * DM + n0 + wn * 64 + jp * 32 + 8 * lq) = make_uint4(x.x, x.y, y.x, y.y); }
        }
    }
}

struct EpiY1 {
    const bf16_t* H0; bf16_t* Y1;
    __device__ __forceinline__ bool operator()(f32x4 (&acc)[2][2][4][2], const pg8::Unit& u, int, int wr, int wc, int fr, int fq) const {
#pragma unroll
        for (int ai = 0; ai < 2; ++ai)
#pragma unroll
            for (int m = 0; m < 4; ++m) {
                const size_t tok = (size_t)u.pm * 256 + ai * 128 + wr * 64 + m * 16 + fr;
#pragma unroll
                for (int bj = 0; bj < 2; ++bj) {
                    const int col = u.pn * 256 + bj * 128 + wc * 32 + 8 * fq;
                    const uint4 hv = *(const uint4*)(H0 + tok * DM + col);
                    f32x4 v0 = acc[ai][bj][m][0], v1 = acc[ai][bj][m][1];
                    v0[0] += ALPHA * bflo(hv.x); v0[1] += ALPHA * bfhi(hv.x); v0[2] += ALPHA * bflo(hv.y); v0[3] += ALPHA * bfhi(hv.y);
                    v1[0] += ALPHA * bflo(hv.z); v1[1] += ALPHA * bfhi(hv.z); v1[2] += ALPHA * bflo(hv.w); v1[3] += ALPHA * bfhi(hv.w);
                    const uint2 a = pack4(v0), c = pack4(v1);
                    *(uint4*)(Y1 + tok * H1LD + col) = make_uint4(a.x, a.y, c.x, c.y);
                }
            }
        return false;
    }
};
__device__ __forceinline__ void phase5a(const Params& P, char* lds) {
    pg8::DenseProv PV; PV.S.init(NTOK, DM, gridDim.x, blockIdx.x);
    PV.A = (const bf16_t*)(P.ws + WS_MERGED); PV.Bt = (const bf16_t*)(P.ws + WB_WOUT); PV.lda = DM; PV.ldb = DM; PV.perm = true;
    EpiY1 E; E.H0 = (const bf16_t*)(P.ws + WS_H0); E.Y1 = (bf16_t*)(P.ws + WS_Y1);
    pg8::gemm_phase((LAS unsigned char*)lds, DM, PV, E);
}

template <int MODE>
__device__ __forceinline__ void phase5b(const Params& P, char* lds) {
    const int t = threadIdx.x, lane = t & 63, w = t >> 6;
    const int gw = blockIdx.x * NWV + w, nw = gridDim.x * NWV;
    bf16_t* H1 = (bf16_t*)P.out; bf16_t* H1LO = (bf16_t*)(P.ws + WS_Y1);
    if (MODE == 0) for (int row0 = gw; row0 < NTOK; row0 += 2 * nw) {
        const int row1 = row0 + nw; const bool has1 = row1 < NTOK;
        const bf16_t* yb = (const bf16_t*)(P.ws + WS_Y1);
        uint4 raw[2][2];
#pragma unroll
        for (int u = 0; u < 2; ++u)
#pragma unroll
            for (int i = 0; i < 2; ++i) raw[u][i] = *(const uint4*)(yb + (size_t)((u && has1) ? row1 : row0) * H1LD + i * 512 + 8 * lane);
        float v[2][16]; float s[2] = {0.f, 0.f};
#pragma unroll
        for (int u = 0; u < 2; ++u)
#pragma unroll
            for (int i = 0; i < 2; ++i) {
                v[u][8 * i + 0] = bflo(raw[u][i].x); v[u][8 * i + 1] = bfhi(raw[u][i].x); v[u][8 * i + 2] = bflo(raw[u][i].y); v[u][8 * i + 3] = bfhi(raw[u][i].y);
                v[u][8 * i + 4] = bflo(raw[u][i].z); v[u][8 * i + 5] = bfhi(raw[u][i].z); v[u][8 * i + 6] = bflo(raw[u][i].w); v[u][8 * i + 7] = bfhi(raw[u][i].w);
            }
#pragma unroll
        for (int u = 0; u < 2; ++u)
#pragma unroll
            for (int k = 0; k < 16; ++k) s[u] += v[u][k];
        const float mu[2] = {wave_sum(s[0]) * (1.f / DM), wave_sum(s[1]) * (1.f / DM)};
        float q[2] = {0.f, 0.f};
#pragma unroll
        for (int u = 0; u < 2; ++u)
#pragma unroll
            for (int k = 0; k < 16; ++k) { const float d = v[u][k] - mu[u]; q[u] += d * d; }
        const float rstd[2] = {rsqrtf(wave_sum(q[0]) * (1.f / DM) + 1e-5f), rsqrtf(wave_sum(q[1]) * (1.f / DM) + 1e-5f)};
#pragma unroll
        for (int i = 0; i < 2; ++i) {
            const float4 g0 = ((const float4*)P.ln1_g)[i * 128 + 2 * lane], g1 = ((const float4*)P.ln1_g)[i * 128 + 2 * lane + 1];
            const float4 b0 = ((const float4*)P.ln1_b)[i * 128 + 2 * lane], b1 = ((const float4*)P.ln1_b)[i * 128 + 2 * lane + 1];
            const float gg[8] = {g0.x, g0.y, g0.z, g0.w, g1.x, g1.y, g1.z, g1.w}, bb[8] = {b0.x, b0.y, b0.z, b0.w, b1.x, b1.y, b1.z, b1.w};
#pragma unroll
            for (int u = 0; u < 2; ++u) {
                const int row = u ? row1 : row0;
                float h[8];
#pragma unroll
                for (int k = 0; k < 8; ++k) h[k] = (v[u][8 * i + k] - mu[u]) * rstd[u] * gg[k] + bb[k];
                const uint4 hi = make_uint4(pack2(h[0], h[1]), pack2(h[2], h[3]), pack2(h[4], h[5]), pack2(h[6], h[7]));
                const uint4 lo = make_uint4(pack2(h[0] - bflo(hi.x), h[1] - bfhi(hi.x)), pack2(h[2] - bflo(hi.y), h[3] - bfhi(hi.y)),
                                            pack2(h[4] - bflo(hi.z), h[5] - bfhi(hi.z)), pack2(h[6] - bflo(hi.w), h[7] - bfhi(hi.w)));
                if (u == 0 || has1) {
                    *(uint4*)(H1 + (size_t)row * H1LD + i * 512 + 8 * lane) = hi;
                    *(uint4*)(H1LO + (size_t)row * H1LD + i * 512 + 8 * lane) = lo;
                }
            }
        }
    }
}

__device__ __forceinline__ void convert_experts(const Params& P, char* lds) {
    const int t = threadIdx.x;
    const int tt = t & 255, sub = t >> 8, kg = tt >> 5, n4 = tt & 31;
    char* tb = lds + sub * 16384;
    bf16_t* EXPW = (bf16_t*)(P.ws + WS_EXPW);
    const int NT_ = 768 * 32, step = gridDim.x * 2;
    __syncthreads();
    for (int tile0 = blockIdx.x * 2; tile0 < NT_; tile0 += 2 * step) {
        float4 r[2][8]; const float* srcs[2]; bf16_t* dsts[2]; int lddv[2], kt0v[2], nt0v[2]; bool hasv[2];
#pragma unroll
        for (int q = 0; q < 2; ++q) {
            const int tile_ = tile0 + q * step + sub; hasv[q] = tile_ < NT_;
            const int tile = hasv[q] ? tile_ : tile0 + sub;
            const int mat = tile >> 5, loc = tile & 31, e = mat / 3, which = mat - e * 3;
            srcs[q] = (which == 0 ? P.exp_w1 : which == 1 ? P.exp_w3 : P.exp_w2) + (size_t)e * 262144;
            dsts[q] = EXPW + (size_t)e * 786432 + which * 262144;
            const int N = which == 2 ? 1024 : 256; lddv[q] = which == 2 ? 256 : 1024;
            kt0v[q] = (which == 2 ? (loc >> 3) : (loc >> 1)) * 64; nt0v[q] = (which == 2 ? (loc & 7) : (loc & 1)) * 128;
            const int k0 = kt0v[q] + kg * 8, n = nt0v[q] + n4 * 4;
#pragma unroll
            for (int kk = 0; kk < 8; ++kk) r[q][kk] = *(const float4*)(srcs[q] + (size_t)(k0 + kk) * N + n);
        }
#pragma unroll
        for (int q = 0; q < 2; ++q) {
#pragma unroll
            for (int c = 0; c < 4; ++c) {
                float v[8];
#pragma unroll
                for (int kk = 0; kk < 8; ++kk) v[kk] = (c == 0) ? r[q][kk].x : (c == 1) ? r[q][kk].y : (c == 2) ? r[q][kk].z : r[q][kk].w;
                *(uint4*)(tb + swz(4 * n4 + c, kg)) = make_uint4(pack2(v[0], v[1]), pack2(v[2], v[3]), pack2(v[4], v[5]), pack2(v[6], v[7]));
            }
            __syncthreads();
            if (hasv[q]) {
#pragma unroll
                for (int i = 0; i < 4; ++i) {
                    const int row = (tt >> 3) + 32 * i, ch = tt & 7;
                    *(uint4*)(dsts[q] + (size_t)(nt0v[q] + row) * lddv[q] + kt0v[q] + ch * 8) = *(const uint4*)(tb + swz(row, ch));
                }
            }
            __syncthreads();
        }
    }
}

__device__ __forceinline__ unsigned long long ord_key(float v, int e) {
    unsigned u = __float_as_uint(v); u = (u & 0x80000000u) ? ~u : (u | 0x80000000u);
    return ((unsigned long long)u << 8) | (unsigned)(255 - e);
}
template <bool NOWRITE>
__device__ __forceinline__ void phase5d(const Params& P) {
    const int t = threadIdx.x, lane = t & 63, w = t >> 6;
    const int gw = blockIdx.x * NWV + w, nw = gridDim.x * NWV;
    const float* LOGITS = (const float*)(P.ws + WS_LOGITS);
    unsigned* ctl = (unsigned*)(P.ws + WS_CTL);
    int* EID = (int*)(P.ws + WS_EID); float* EW = (float*)(P.ws + WS_EW); int* LIST = (int*)(P.ws + WS_LIST);
    const float4 rb = ((const float4*)P.router_b)[lane];
    float4 lgn = ((const float4*)(LOGITS + (size_t)(gw < NTOK ? gw : 0) * 256))[lane];
    for (int tok = gw; tok < NTOK; tok += nw) {
        const float4 lg = lgn;
        { const int tn = tok + nw < NTOK ? tok + nw : tok; lgn = ((const float4*)(LOGITS + (size_t)tn * 256))[lane]; }
        float s[4] = {sigmoidf_(lg.x), sigmoidf_(lg.y), sigmoidf_(lg.z), sigmoidf_(lg.w)};
        float sb[4] = {s[0] + rb.x, s[1] + rb.y, s[2] + rb.z, s[3] + rb.w};
        float a = fmaxf(sb[0], sb[1]), bq = fminf(sb[0], sb[1]);
        { const float a2 = fmaxf(sb[2], sb[3]), b2 = fminf(sb[2], sb[3]); const float na = fmaxf(a, a2); bq = fmaxf(fminf(a, a2), fmaxf(bq, b2)); a = na; }
#define DPPF_(x, ctrl) __uint_as_float(__builtin_amdgcn_update_dpp(0u, __float_as_uint(x), ctrl, 0xF, 0xF, true))
        { const float a2 = DPPF_(a, 0xB1), b2 = DPPF_(bq, 0xB1); const float na = fmaxf(a, a2); bq = fmaxf(fminf(a, a2), fmaxf(bq, b2)); a = na; }
        { const float a2 = DPPF_(a, 0x4E), b2 = DPPF_(bq, 0x4E); const float na = fmaxf(a, a2); bq = fmaxf(fminf(a, a2), fmaxf(bq, b2)); a = na; }
        { const float a2 = DPPF_(a, 0x141), b2 = DPPF_(bq, 0x141); const float na = fmaxf(a, a2); bq = fmaxf(fminf(a, a2), fmaxf(bq, b2)); a = na; }
#undef DPPF_
        const float gs = a + bq; const int grp = lane >> 3;
        int rank = 0;
#pragma unroll
        for (int g2 = 0; g2 < 8; ++g2) { const float o = __uint_as_float(__builtin_amdgcn_readlane(__float_as_uint(gs), g2 * 8)); rank += (o > gs || (o == gs && g2 < grp)) ? 1 : 0; }
        const bool gsel = rank < 4;
        float v[4];
#pragma unroll
        for (int i = 0; i < 4; ++i) v[i] = gsel ? sb[i] : -3.0e38f;
        int my_e = 0; float my_s = 0.f, wsum = 0.f;
        for (int r = 0; r < 8; ++r) {
            float bv = v[0]; int bi = 0;
#pragma unroll
            for (int i = 1; i < 4; ++i) if (v[i] > bv) { bv = v[i]; bi = i; }
            const float wm = wave_max(bv);
            const int wl = __builtin_amdgcn_readfirstlane(__ffsll((long long)__ballot(bv == wm)) - 1);
            const int wi = __builtin_amdgcn_readlane(bi, wl);
            const float mine = bi == 0 ? s[0] : bi == 1 ? s[1] : bi == 2 ? s[2] : s[3];
            const float sv = __uint_as_float(__builtin_amdgcn_readlane(__float_as_uint(mine), wl));
            if (lane == wl) { if (bi == 0) v[0] = -3.0e38f; else if (bi == 1) v[1] = -3.0e38f; else if (bi == 2) v[2] = -3.0e38f; else v[3] = -3.0e38f; }
            wsum += sv;
            if (lane == r) { my_e = wl * 4 + wi; my_s = sv; }
        }
        if (NOWRITE) { asm volatile("" :: "v"(my_e), "v"(my_s), "v"(wsum)); }
        else if (lane < 8) {
            const float wv = my_s / wsum * 2.5f;
            EID[tok * 8 + lane] = my_e; EW[tok * 8 + lane] = wv;
            const unsigned pos = atomicAdd(&ctl[CTL_CNT + my_e * 16], 1u);
            LIST[(size_t)my_e * NTOK + pos] = tok * 8 + lane;
        }
    }
}

struct ProvUp {
    const char* h1; const char* wb; const int* aid;
    __device__ __forceinline__ void offsets(unsigned (&va)[2][2], unsigned (&vb)[2][2], const int (&sR)[2], const int (&sC)[2]) const {
#pragma unroll
        for (int h = 0; h < 2; ++h)
#pragma unroll
            for (int p = 0; p < 2; ++p) {
                va[h][p] = (unsigned)(((size_t)(aid[h * 128 + sR[p]] >> 3) * H1LD + sC[p]) * 2);
                vb[h][p] = (unsigned)(((size_t)h * 262144 + (size_t)((sR[p] & ~31) + pg8::perm32(sR[p] & 31)) * 1024 + sC[p]) * 2);
            }
    }
    __device__ __forceinline__ bool get(int i, pg8::Unit& u, pg8::Ops& o) const {
        if (i >= 2) return false;
        u.pm = 0; u.pn = i; o.A = h1; o.B = wb + (size_t)i * 128 * 1024 * 2;
        return true;
    }
};
struct EpiUp {
    bf16_t* scr;
    __device__ __forceinline__ bool operator()(f32x4 (&acc)[2][2][4][2], const pg8::Unit& u, int, int wr, int wc, int fr, int fq) const {
#pragma unroll
        for (int ai = 0; ai < 2; ++ai)
#pragma unroll
            for (int m = 0; m < 4; ++m) {
                const int row = ai * 128 + wr * 64 + m * 16 + fr;
                f32x4 v0, v1;
#pragma unroll
                for (int r = 0; r < 4; ++r) { v0[r] = siluf_(acc[ai][0][m][0][r]) * acc[ai][1][m][0][r]; v1[r] = siluf_(acc[ai][0][m][1][r]) * acc[ai][1][m][1][r]; }
                const uint2 a = pack4(v0), c = pack4(v1);
                *(uint4*)(scr + row * 256 + u.pn * 128 + wc * 32 + 8 * fq) = make_uint4(a.x, a.y, c.x, c.y);
            }
        return false;
    }
};
struct ProvDown {
    const char* scr; const char* w2t;
    __device__ __forceinline__ void offsets(unsigned (&va)[2][2], unsigned (&vb)[2][2], const int (&sR)[2], const int (&sC)[2]) const {
#pragma unroll
        for (int h = 0; h < 2; ++h)
#pragma unroll
            for (int p = 0; p < 2; ++p) { va[h][p] = (unsigned)(((h * 128 + sR[p]) * 256 + sC[p]) * 2); vb[h][p] = (unsigned)(((h * 128 + (sR[p] & ~31) + pg8::perm32(sR[p] & 31)) * 256 + sC[p]) * 2); }
    }
    __device__ __forceinline__ bool get(int i, pg8::Unit& u, pg8::Ops& o) const {
        if (i >= 4) return false;
        u.pm = 0; u.pn = i; o.A = scr; o.B = w2t + (size_t)i * 256 * 256 * 2;
        return true;
    }
};
struct EpiDown {
    bf16_t* Y; bf16_t* SHOUT; const int* aid; int rows; bool routed;
    __device__ __forceinline__ bool operator()(f32x4 (&acc)[2][2][4][2], const pg8::Unit& u, int, int wr, int wc, int fr, int fq) const {
#pragma unroll
        for (int ai = 0; ai < 2; ++ai)
#pragma unroll
            for (int m = 0; m < 4; ++m) {
                const int row = ai * 128 + wr * 64 + m * 16 + fr;
                if (row < rows) {
                    const int a = aid[row];
                    bf16_t* dst = (routed ? (Y + (size_t)a * DM) : (SHOUT + (size_t)(a >> 3) * H1LD)) + u.pn * 256 + wc * 32 + 8 * fq;
#pragma unroll
                    for (int bj = 0; bj < 2; ++bj) { const uint2 x = pack4(acc[ai][bj][m][0]), y = pack4(acc[ai][bj][m][1]); *(uint4*)(dst + bj * 128) = make_uint4(x.x, x.y, y.x, y.y); }
                }
            }
        return false;
    }
};
struct ProvRouter {
    const char* hi; const char* lo; const char* whi; const char* wlo; int tile0, tstep;
    __device__ __forceinline__ void offsets(unsigned (&va)[2][2], unsigned (&vb)[2][2], const int (&sR)[2], const int (&sC)[2]) const {
#pragma unroll
        for (int h = 0; h < 2; ++h)
#pragma unroll
            for (int p = 0; p < 2; ++p) { va[h][p] = (unsigned)(((size_t)(h * 128 + sR[p]) * H1LD + sC[p]) * 2); vb[h][p] = (unsigned)(((size_t)(h * 128 + sR[p]) * 1024 + sC[p]) * 2); }
    }
    __device__ __forceinline__ bool get(int i, pg8::Unit& u, pg8::Ops& o) const {
        const int q = i / 3, seg = i - q * 3, ot = tile0 + q * tstep;
        if (ot >= 128) return false;
        u.pm = ot; u.pn = seg;
        o.A = (seg == 1 ? lo : hi) + (size_t)ot * 256 * H1LD * 2; o.B = seg == 0 ? wlo : whi;
        return true;
    }
};
struct EpiRouter {
    float* LOGITS;
    __device__ __forceinline__ bool operator()(f32x4 (&acc)[2][2][4][2], const pg8::Unit& u, int, int wr, int wc, int fr, int fq) const {
        if (u.pn < 2) return true;
#pragma unroll
        for (int ai = 0; ai < 2; ++ai)
#pragma unroll
            for (int m = 0; m < 4; ++m) {
                const size_t tok = (size_t)u.pm * 256 + ai * 128 + wr * 64 + m * 16 + fr;
#pragma unroll
                for (int bj = 0; bj < 2; ++bj)
#pragma unroll
                    for (int n = 0; n < 2; ++n) *(f32x4*)(LOGITS + tok * 256 + bj * 128 + wc * 32 + n * 16 + 4 * fq) = acc[ai][bj][m][n];
            }
        return false;
    }
};
__device__ __forceinline__ void phase5c(const Params& P, char* lds) {
    const int xg = blockIdx.x & 7, rk = blockIdx.x >> 3, G8 = gridDim.x >> 3;
    const bool two = G8 >= 2; const int nr = two ? (G8 >> 1) : G8, ns = two ? G8 - nr : G8;
    const bool conv_first = (rk & 1) != 0;
    if (conv_first) convert_experts(P, lds);
    if (!two || rk < nr) {
        ProvRouter PV; PV.hi = (const char*)P.out; PV.lo = (const char*)(P.ws + WS_Y1); PV.whi = (const char*)(P.ws + WB_WRHI); PV.wlo = (const char*)(P.ws + WB_WRLO);
        PV.tile0 = xg * 16 + rk; PV.tstep = 0;
        EpiRouter E; E.LOGITS = (float*)(P.ws + WS_LOGITS);
        for (int j = rk; j < 16; j += nr) { PV.tile0 = xg * 16 + j; PV.tstep = 128; pg8::gemm_phase((LAS unsigned char*)lds, DM, PV, E); }
    }
    if (!two || rk >= nr) {
        int* aid = (int*)(lds + LDS_ROWS);
        bf16_t* SCR = (bf16_t*)(P.ws + WS_SCR + (size_t)blockIdx.x * 131072);
        const bf16_t* wb = (const bf16_t*)(P.ws + WB_WS1);
        for (int j = two ? rk - nr : rk; j < 16; j += ns) {
            const int t = threadIdx.x;
            __syncthreads();
            if (t < 256) aid[t] = ((xg * 16 + j) * 256 + t) * 8;
            __syncthreads();
            {
                ProvUp PV; PV.h1 = (const char*)P.out; PV.wb = (const char*)wb; PV.aid = aid;
                EpiUp E; E.scr = SCR;
                pg8::gemm_phase((LAS unsigned char*)lds, DM, PV, E);
            }
            asm volatile("s_waitcnt vmcnt(0)" ::: "memory");
            __syncthreads();
            {
                ProvDown PV; PV.scr = (const char*)SCR; PV.w2t = (const char*)(wb + 524288);
                EpiDown E; E.Y = (bf16_t*)(P.ws + WS_Y); E.SHOUT = (bf16_t*)P.out + 1024; E.aid = aid; E.rows = 256; E.routed = false;
                pg8::gemm_phase((LAS unsigned char*)lds, 256, PV, E);
            }
            __syncthreads();
        }
    }
    if (!conv_first) convert_experts(P, lds);
}

__device__ __forceinline__ void phase7(const Params& P, char* lds) {
    const int t0_ = threadIdx.x;
    unsigned* ctl = (unsigned*)(P.ws + WS_CTL);
    int* pre = (int*)(lds + LDS_PRE);
    int* aid = (int*)(lds + LDS_ROWS);
    const int* LIST = (const int*)(P.ws + WS_LIST);
    bf16_t* SCR = (bf16_t*)(P.ws + WS_SCR + (size_t)blockIdx.x * 131072);
    const int xg = blockIdx.x & 7, rk = blockIdx.x >> 3, G8 = gridDim.x >> 3;
    __syncthreads();
    if (t0_ == 0) {
        int s = 0;
        for (int k = 0; k < 32; ++k) { pre[k] = s; s += ((int)ctl[CTL_CNT + (xg + 8 * k) * 16] + 255) >> 8; }
        pre[32] = s;
    }
    __syncthreads();
    const int T = pre[32];
    for (int g = rk; g < T; g += G8) {
        const int t = threadIdx.x;
        const bf16_t* wb; int rows; const bool routed = true;
        {
            int lo = 0, hi = 32;
            while (hi - lo > 1) { const int mid = (lo + hi) >> 1; if (pre[mid] <= g) lo = mid; else hi = mid; }
            const int e = xg + 8 * lo, tile = g - pre[lo], cnt = (int)ctl[CTL_CNT + e * 16];
            rows = cnt - tile * 256; rows = rows < 256 ? rows : 256; rows = __builtin_amdgcn_readfirstlane(rows);
            if (t < 256) aid[t] = LIST[(size_t)e * NTOK + tile * 256 + (t < rows ? t : rows - 1)];
            wb = (const bf16_t*)(P.ws + WS_EXPW) + (size_t)e * 786432;
        }
        __syncthreads();
        {
            ProvUp PV; PV.h1 = (const char*)P.out; PV.wb = (const char*)wb; PV.aid = aid;
            EpiUp E; E.scr = SCR;
            pg8::gemm_phase((LAS unsigned char*)lds, DM, PV, E);
        }
        asm volatile("s_waitcnt vmcnt(0)" ::: "memory");
        __syncthreads();
        {
            ProvDown PV; PV.scr = (const char*)SCR; PV.w2t = (const char*)(wb + 524288);
            EpiDown E; E.Y = (bf16_t*)(P.ws + WS_Y); E.SHOUT = (bf16_t*)P.out + 1024; E.aid = aid; E.rows = rows; E.routed = routed;
            pg8::gemm_phase((LAS unsigned char*)lds, 256, PV, E);
        }
        __syncthreads();
    }
}

__device__ __forceinline__ void phase8(const Params& P) {
    const int t = threadIdx.x, lane = t & 63, w = t >> 6;
    const int gw = blockIdx.x * NWV + w, nw = gridDim.x * NWV;
    const bf16_t* H1 = (const bf16_t*)P.out; const bf16_t* SHOUT = (const bf16_t*)P.out + 1024;
    const bf16_t* Y = (const bf16_t*)(P.ws + WS_Y); const float* EW = (const float*)(P.ws + WS_EW);
    for (int tok = gw; tok < NTOK; tok += nw) {
        float v[4][4];
#pragma unroll
        for (int i = 0; i < 4; ++i) {
            const uint2 h = *(const uint2*)(H1 + (size_t)tok * H1LD + 4 * (lane + 64 * i));
            const uint2 s = *(const uint2*)(SHOUT + (size_t)tok * H1LD + 4 * (lane + 64 * i));
            v[i][0] = ALPHA * bflo(h.x) + bflo(s.x); v[i][1] = ALPHA * bfhi(h.x) + bfhi(s.x);
            v[i][2] = ALPHA * bflo(h.y) + bflo(s.y); v[i][3] = ALPHA * bfhi(h.y) + bfhi(s.y);
        }
#pragma unroll
        for (int k = 0; k < 8; ++k) {
            const float wk = EW[tok * 8 + k];
            const bf16_t* yr = Y + ((size_t)tok * 8 + k) * DM;
#pragma unroll
            for (int i = 0; i < 4; ++i) {
                const uint2 y = *(const uint2*)(yr + 4 * (lane + 64 * i));
                v[i][0] += wk * bflo(y.x); v[i][1] += wk * bfhi(y.x); v[i][2] += wk * bflo(y.y); v[i][3] += wk * bfhi(y.y);
            }
        }
        float s = 0.f;
#pragma unroll
        for (int i = 0; i < 4; ++i) s += v[i][0] + v[i][1] + v[i][2] + v[i][3];
        const float mu = wave_sum(s) * (1.f / DM);
        float q = 0.f;
#pragma unroll
        for (int i = 0; i < 4; ++i)
#pragma unroll
            for (int c = 0; c < 4; ++c) { const float d = v[i][c] - mu; q += d * d; }
        const float rstd = rsqrtf(wave_sum(q) * (1.f / DM) + 1e-5f);
#pragma unroll
        for (int i = 0; i < 4; ++i) {
            const float4 g = ((const float4*)P.ln2_g)[lane + 64 * i], bb = ((const float4*)P.ln2_b)[lane + 64 * i];
            float4 o;
            o.x = (v[i][0] - mu) * rstd * g.x + bb.x; o.y = (v[i][1] - mu) * rstd * g.y + bb.y;
            o.z = (v[i][2] - mu) * rstd * g.z + bb.z; o.w = (v[i][3] - mu) * rstd * g.w + bb.w;
            ((float4*)(P.out + (size_t)tok * DM))[lane + 64 * i] = o;
        }
    }
}

constexpr int N_PHASES = 11;
__global__ void __launch_bounds__(512, 2) fwd_kernel(Params P) {
    extern __shared__ __attribute__((aligned(16))) char lds[];
    const int t = threadIdx.x;
    if (t == 0) *(uint4*)(lds + LDS_BARW) = make_uint4(0u, 0u, 0u, 0u);
    {
        float* LUT = (float*)(lds + LDS_LUT);
        for (int i = t; i < 256 * 8; i += NTHR) {
            const int d = (i >> 3) - 64, h = i & 7;
            float v = NEGBIG;
            if (d >= 0) {
                int bucket = d;
                if (d >= 16) { bucket = 16 + (int)(log2f((float)d * (1.f / 16.f)) * (16.f / 3.f)); bucket = bucket < 31 ? bucket : 31; }
                v = P.rel_bias[bucket * 8 + h] * LOG2E;
            }
            LUT[i] = v;
        }
    }
    __syncthreads();
    XcdBarrier bar = xcd_barrier_post((unsigned*)(P.ws + WS_CTL), (volatile LAS unsigned*)(lds + LDS_BARW));
#ifndef ONLY_PHASE
#define ONLY_PHASE -1
#endif
#ifndef PROBE_DUP
#define PROBE_DUP -1
#endif
#define PHASE(k, call) if ((ONLY_PHASE < 0 || ONLY_PHASE == (k)) && P.ph_lo <= (k) && (k) < P.ph_hi) { call; if ((k) + 1 < P.ph_hi) xcd_barrier(bar); }
#define PHASE_DUP(k, call) if (PROBE_DUP == (k)) { call; xcd_barrier(bar); }
    PHASE(0, phase0(P))
    PHASE_DUP(1, phase1<true>(P, lds))
    PHASE(1, phase1<false>(P, lds))
    PHASE_DUP(2, phase2<1024>(P, lds))
    PHASE(2, phase2<0>(P, lds))
#ifndef P3DUP
#define P3DUP 7
#endif
    PHASE_DUP(3, (phase3<1024, P3DUP>(P, lds)))
    PHASE(3, (phase3<0, 7>(P, lds)))
    PHASE_DUP(4, phase4(P, lds))
    PHASE(4, phase4(P, lds))
    PHASE_DUP(5, phase5a(P, lds))
    PHASE(5, phase5a(P, lds))
#ifndef P6DUP
#define P6DUP 1
#endif
    PHASE_DUP(6, phase5b<P6DUP>(P, lds))
    PHASE(6, phase5b<0>(P, lds))
    PHASE_DUP(7, phase5c(P, lds))
    PHASE(7, phase5c(P, lds))
    PHASE_DUP(8, phase5d<true>(P))
    PHASE(8, phase5d<false>(P))
    PHASE_DUP(9, phase7(P, lds))
    PHASE(9, phase7(P, lds))
    PHASE_DUP(10, phase8(P))
#ifdef PROBE_BAR
    for (int i = 0; i < 16; ++i) xcd_barrier(bar);
#endif
    PHASE(10, phase8(P))
#undef PHASE
}

#ifndef MK_LAUNCHES
#define MK_LAUNCHES 1
#endif

extern "C" void kernel_launch(void* const* d_in, const int* in_sizes, int n_in, void* d_out, int out_size, void* d_ws, size_t ws_size,
                              hipStream_t stream) {
    static int grid = 0;
    if (grid == 0) {
        if (n_in != 31 || in_sizes[0] != NTOK * DM || out_size != NTOK * DM || ws_size < WS_END) {
            fprintf(stderr, "kernel_launch: unexpected shapes (n_in %d, in0 %d, out %d, ws %zu < %zu)\n", n_in, n_in > 0 ? in_sizes[0] : -1, out_size, ws_size, (size_t)WS_END);
            grid = -1; return;
        }
        int dev = 0, cus = 0, per_cu = 0;
        if (hipGetDevice(&dev) != hipSuccess || hipDeviceGetAttribute(&cus, hipDeviceAttributeMultiprocessorCount, dev) != hipSuccess) { grid = -1; return; }
        if (hipFuncSetAttribute((const void*)fwd_kernel, hipFuncAttributeMaxDynamicSharedMemorySize, LDS_BYTES) != hipSuccess) { grid = -1; return; }
        if (hipOccupancyMaxActiveBlocksPerMultiprocessor(&per_cu, (const void*)fwd_kernel, NTHR, LDS_BYTES) != hipSuccess || per_cu < 1) per_cu = 1;
        (void)hipGetLastError();
        grid = cus;
    }
    if (grid < 0) return;
    if (hipMemsetAsync((char*)d_ws + WS_CTL, 0, CTL_BYTES, stream) != hipSuccess) return;
    Params p{};
    const float** pp = (const float**)&p;
    for (int i = 0; i < 31; ++i) pp[i] = (const float*)d_in[i];
    p.out = (float*)d_out; p.ws = (char*)d_ws;
#if MK_LAUNCHES == 1
    p.ph_lo = 0; p.ph_hi = N_PHASES;
    hipLaunchKernelGGL(fwd_kernel, dim3(grid), dim3(NTHR), LDS_BYTES, stream, p);
#else
    for (int k = 0; k < N_PHASES; ++k) { p.ph_lo = k; p.ph_hi = k + 1; hipLaunchKernelGGL(fwd_kernel, dim3(grid), dim3(NTHR), LDS_BYTES, stream, p); }
#endif
}
```

```cpp
#include <hip/hip_runtime.h>
#include <stdint.h>
#include <stdio.h>

typedef unsigned short bf16_t;
typedef __attribute__((ext_vector_type(8))) short bf16x8;
typedef __attribute__((ext_vector_type(4))) short bf16x4;
typedef __attribute__((ext_vector_type(4))) float f32x4;

constexpr int NTOK = 32768, SEQ = 8192, DM = 1024, DIN = 5944;
constexpr int C_QNSA = 0, C_KVNSA = 512, C_GNSA = 1280, C_CQ = 1304, C_CKV = 2072, C_KROPE = 2328, C_QMEM = 2360, C_GMERGE = 2872;
constexpr float ALPHA = 1.189207115002721f;
constexpr float LOG2E = 1.4426950408889634f;
constexpr float NEGBIG = -1e30f;

constexpr size_t MBY = 1ull << 20;
constexpr size_t WS_CTL = 0;
constexpr size_t CTL_BYTES = 65536;
constexpr int CTL_Q = 4096;
constexpr int CTL_CNT = 8192;
constexpr size_t WS_COS = 1 * MBY, WS_SIN = WS_COS + 512 * 1024;
constexpr size_t WS_KC = 2 * MBY, WS_VTC = WS_KC + 512 * 1024;
constexpr size_t WS_KMEM = 3 * MBY, WS_VTMEM = 4 * MBY, WS_MEMB = 5 * MBY, WS_EID = 7 * MBY, WS_EW = 8 * MBY;
constexpr size_t WS_A = 16 * MBY;
constexpr size_t WS_PROJ = WS_A, WS_QM = WS_A + 372 * MBY, WS_KM = WS_A + 420 * MBY, WS_VTM = WS_A + 468 * MBY;
constexpr size_t WS_Y1 = WS_A, WS_Y = WS_A;
constexpr size_t WS_B = WS_A + 512 * MBY;
constexpr size_t WS_H0 = WS_B;
constexpr int NEA = 117;
constexpr size_t WS_EXPA = WS_B + 272 * MBY + MBY / 2, WS_EXPB = WS_B;
static_assert(WS_EXPA + (size_t)NEA * 1572864 <= WS_B + 448 * MBY && (size_t)(256 - NEA) * 1572864 <= 208 * MBY + MBY / 2, "expert weight pieces");
__device__ __forceinline__ const unsigned short* expw_ptr(const char* ws, int e) {
    return (const unsigned short*)(ws + (e < NEA ? WS_EXPA + (size_t)e * 1572864 : WS_EXPB + (size_t)(e - NEA) * 1572864));
}
constexpr size_t WS_ONSA = WS_B + 64 * MBY, WS_OMLA = WS_B + 96 * MBY, WS_OMEM = WS_B + 128 * MBY;
constexpr size_t WS_LOGITS = WS_A + 128 * MBY, WS_LIST = WS_B + 208 * MBY + MBY / 2;
constexpr size_t WS_MERGED = WS_B + 160 * MBY;
constexpr size_t WS_KCS = WS_B + 224 * MBY, WS_VCS = WS_KCS + 8 * MBY, WS_KSLC = WS_KCS + 16 * MBY, WS_KWIN = WS_KCS + 24 * MBY,
                 WS_VTSLC = WS_KCS + 32 * MBY, WS_VTWIN = WS_KCS + 40 * MBY;
constexpr size_t WS_SCR = WS_B + 416 * MBY;
constexpr size_t WS_SCR2 = WS_B + 240 * MBY + MBY / 2;
constexpr size_t WS_WB = WS_B + 448 * MBY;
constexpr size_t WB_WIN = WS_WB, WB_WUQ = WB_WIN + 12582912, WB_WUKV = WB_WUQ + 1179648, WB_WMEM = WB_WUKV + 524288, WB_WBR = WB_WMEM + 2097152,
                 WB_WOUT = WB_WBR + 3145728, WB_WRHI = WB_WOUT + 2097152, WB_WRLO = WB_WRHI + 524288, WB_WS1 = WB_WRLO + 524288, WB_WS3 = WB_WS1 + 524288,
                 WB_WS2 = WB_WS3 + 524288, WB_WCK1 = WB_WS2 + 524288, WB_WCV1 = WB_WCK1 + 1048576, WB_WCK2 = WB_WCV1 + 1048576, WB_WCV2 = WB_WCK2 + 65536,
                 WB_POSP = WB_WCV2 + 65536  , WB_END = WB_POSP + 32768;
static_assert(WB_END <= WS_WB + 32 * MBY, "bf16 weight region");
constexpr size_t WS_END = WS_B + 480 * MBY;
constexpr int H1LD = 2048;

struct Params {
    const float *x, *mem, *ln0_g, *ln0_b, *rel_bias, *w_in, *cmp_pos_k, *cmp_pos_v, *cmp_k_w1, *cmp_k_w2, *cmp_v_w1, *cmp_v_w2,
        *mla_q_norm, *mla_w_uq, *mla_kv_norm, *mla_w_ukv, *mem_w_kv, *w_branch, *w_out, *ln1_g, *ln1_b, *router_w, *router_b,
        *exp_w1, *exp_w3, *exp_w2, *sh_w1, *sh_w3, *sh_w2, *ln2_g, *ln2_b;
    float* out;
    char* ws;
    int ph_lo, ph_hi;
};

#define XB_TMO      128
#define XB_XCNT(j)  (256  + 64 * (j))
#define XB_XSUB(j)  (1280 + 64 * (j))
#define XB_XGEN(j)  (2304 + 64 * (j))
#define XB_TOP      3328
#define XB_TOPGEN   3392
#define XCD_BAR_WORDS 3456
#define XB_SPIN_CAP (1u << 18)
#define LAS __attribute__((address_space(3)))

__device__ __forceinline__ unsigned xb_ld(unsigned* p)              { return __hip_atomic_load(p, __ATOMIC_RELAXED, __HIP_MEMORY_SCOPE_AGENT); }
__device__ __forceinline__ unsigned xb_add(unsigned* p, unsigned v) { return __hip_atomic_fetch_add(p, v, __ATOMIC_RELAXED, __HIP_MEMORY_SCOPE_AGENT); }
__device__ __forceinline__ unsigned xb_xcc_id() { return (unsigned)__builtin_amdgcn_s_getreg((3 << 11) | 20) & 0xFu; }
#define XB_SPIN(cond, bar) do { unsigned _sp = 0; while (cond) { __builtin_amdgcn_s_sleep(1); \
    if ((++_sp & 255u) == 0u) { if (xb_ld(&(bar)[XB_TMO])) break; if (_sp > XB_SPIN_CAP) { atomicAdd(&(bar)[XB_TMO], 1u); break; } } } } while (0)

struct XcdBarrier { unsigned* bar; unsigned x; volatile LAS unsigned* st; };

__device__ __forceinline__ XcdBarrier xcd_barrier_post(unsigned* bar, volatile LAS unsigned* st) {
    XcdBarrier b; b.bar = bar; b.x = xb_xcc_id(); b.st = st;
    if (threadIdx.x == 0) (void)xb_add(&bar[XB_XCNT(b.x)], 1u);
    return b;
}
__device__ __forceinline__ void xcd_barrier_complete(unsigned* bar, unsigned x, unsigned& nloc, unsigned& nx) {
    const unsigned G = gridDim.x * gridDim.y * gridDim.z;
    unsigned sum, cnt, mine, sp = 0u;
    for (;;) {
        sum = 0u; cnt = 0u; mine = 0u;
#pragma unroll
        for (unsigned j = 0; j < 16; ++j) { const unsigned c = xb_ld(&bar[XB_XCNT(j)]); sum += c; cnt += (c > 0u) ? 1u : 0u; mine = (j == x) ? c : mine; }
        if (sum == G) break;
        __builtin_amdgcn_s_sleep(1);
        if ((++sp & 255u) == 0u) { if (xb_ld(&bar[XB_TMO])) break; if (sp > XB_SPIN_CAP) { atomicAdd(&bar[XB_TMO], 1u); break; } }
    }
    nloc = mine > 0u ? mine : 1u; nx = cnt > 0u ? cnt : 1u;
}
__device__ __forceinline__ void xcd_barrier(const XcdBarrier& b) {
    asm volatile("s_waitcnt vmcnt(0)" ::: "memory");
    __syncthreads();
    if (threadIdx.x == 0) {
        unsigned* bar = b.bar;
        __builtin_amdgcn_s_waitcnt(0);
        unsigned nloc = b.st[0], nx = b.st[1];
        if (nloc == 0u) { xcd_barrier_complete(bar, b.x, nloc, nx); b.st[0] = nloc; b.st[1] = nx; }
        const unsigned old = xb_add(&bar[XB_XSUB(b.x)], 1u);
        const unsigned gen = old / nloc;
        if (old + 1u == (gen + 1u) * nloc) {
            __builtin_amdgcn_fence(__ATOMIC_RELEASE, "agent");
            asm volatile("s_waitcnt vmcnt(0)" ::: "memory");
            const unsigned og = xb_add(&bar[XB_TOP], 1u);
            const unsigned tg = og / nx;
            if (og + 1u == (tg + 1u) * nx) xb_add(&bar[XB_TOPGEN], 1u);
            else XB_SPIN(xb_ld(&bar[XB_TOPGEN]) == tg, bar);
            __builtin_amdgcn_fence(__ATOMIC_ACQUIRE, "agent");
            xb_add(&bar[XB_XGEN(b.x)], 1u);
            asm volatile("s_waitcnt vmcnt(0)" ::: "memory");
        } else {
            XB_SPIN(xb_ld(&bar[XB_XGEN(b.x)]) == gen, bar);
            __builtin_amdgcn_fence(__ATOMIC_ACQUIRE, "agent");
            asm volatile("s_waitcnt vmcnt(0)" ::: "memory");
        }
    }
    __syncthreads();
}

__device__ __forceinline__ float bf2f(bf16_t v) { return __uint_as_float(((uint32_t)v) << 16); }
__device__ __forceinline__ float bflo(uint32_t v) { return __uint_as_float(v << 16); }
__device__ __forceinline__ float bfhi(uint32_t v) { return __uint_as_float(v & 0xffff0000u); }
__device__ __forceinline__ uint32_t pack2(float a, float b) {
    typedef __attribute__((ext_vector_type(2))) __bf16 bf2_t; typedef __attribute__((ext_vector_type(2))) float f2_t;
    f2_t v = {a, b}; bf2_t r = __builtin_convertvector(v, bf2_t); return __builtin_bit_cast(uint32_t, r);
}
__device__ __forceinline__ bf16_t f2bf(float a) { return (bf16_t)(pack2(a, 0.f) & 0xffffu); }
__device__ __forceinline__ uint2 pack4(f32x4 v) { return make_uint2(pack2(v[0], v[1]), pack2(v[2], v[3])); }
__device__ __forceinline__ float fexp2(float x) { return __builtin_amdgcn_exp2f(x); }
__device__ __forceinline__ float frcp(float x) { return __builtin_amdgcn_rcpf(x); }
__device__ __forceinline__ float sigmoidf_(float x) { return frcp(1.f + fexp2(-x * LOG2E)); }
__device__ __forceinline__ float siluf_(float x) { return x * frcp(1.f + fexp2(-x * LOG2E)); }
__device__ __forceinline__ float geluf_(float x) {
    const float u = 0.7978845608028654f * (x + 0.044715f * x * x * x);
    const float t = 1.f - 2.f * frcp(1.f + fexp2(2.f * u * LOG2E));
    return 0.5f * x * (1.f + t);
}
__device__ __forceinline__ float wave_sum(float v) {
    v += __uint_as_float(__builtin_amdgcn_update_dpp(0u, __float_as_uint(v), 0xB1, 0xF, 0xF, true));
    v += __uint_as_float(__builtin_amdgcn_update_dpp(0u, __float_as_uint(v), 0x4E, 0xF, 0xF, true));
    v += __uint_as_float(__builtin_amdgcn_update_dpp(0u, __float_as_uint(v), 0x141, 0xF, 0xF, true));
    v += __uint_as_float(__builtin_amdgcn_update_dpp(0u, __float_as_uint(v), 0x140, 0xF, 0xF, true));
    auto r = __builtin_amdgcn_permlane16_swap(__float_as_uint(v), __float_as_uint(v), false, false);
    v = __uint_as_float(r[0]) + __uint_as_float(r[1]);
    auto q = __builtin_amdgcn_permlane32_swap(__float_as_uint(v), __float_as_uint(v), false, false);
    return __uint_as_float(q[0]) + __uint_as_float(q[1]);
}
__device__ __forceinline__ float wave_max(float v) {
    v = fmaxf(v, __uint_as_float(__builtin_amdgcn_update_dpp(0u, __float_as_uint(v), 0xB1, 0xF, 0xF, true)));
    v = fmaxf(v, __uint_as_float(__builtin_amdgcn_update_dpp(0u, __float_as_uint(v), 0x4E, 0xF, 0xF, true)));
    v = fmaxf(v, __uint_as_float(__builtin_amdgcn_update_dpp(0u, __float_as_uint(v), 0x141, 0xF, 0xF, true)));
    v = fmaxf(v, __uint_as_float(__builtin_amdgcn_update_dpp(0u, __float_as_uint(v), 0x140, 0xF, 0xF, true)));
    auto r = __builtin_amdgcn_permlane16_swap(__float_as_uint(v), __float_as_uint(v), false, false);
    v = fmaxf(__uint_as_float(r[0]), __uint_as_float(r[1]));
    auto q = __builtin_amdgcn_permlane32_swap(__float_as_uint(v), __float_as_uint(v), false, false);
    return fmaxf(__uint_as_float(q[0]), __uint_as_float(q[1]));
}
__device__ __forceinline__ float quad_max(float x) {
    auto r = __builtin_amdgcn_permlane16_swap(__float_as_uint(x), __float_as_uint(x), false, false);
    x = fmaxf(__uint_as_float(r[0]), __uint_as_float(r[1]));
    auto q = __builtin_amdgcn_permlane32_swap(__float_as_uint(x), __float_as_uint(x), false, false);
    return fmaxf(__uint_as_float(q[0]), __uint_as_float(q[1]));
}
__device__ __forceinline__ float quad_min(float x) {
    auto r = __builtin_amdgcn_permlane16_swap(__float_as_uint(x), __float_as_uint(x), false, false);
    x = fminf(__uint_as_float(r[0]), __uint_as_float(r[1]));
    auto q = __builtin_amdgcn_permlane32_swap(__float_as_uint(x), __float_as_uint(x), false, false);
    return fminf(__uint_as_float(q[0]), __uint_as_float(q[1]));
}
__device__ __forceinline__ float quad_sum(float x) {
    auto r = __builtin_amdgcn_permlane16_swap(__float_as_uint(x), __float_as_uint(x), false, false);
    x = __uint_as_float(r[0]) + __uint_as_float(r[1]);
    auto q = __builtin_amdgcn_permlane32_swap(__float_as_uint(x), __float_as_uint(x), false, false);
    return __uint_as_float(q[0]) + __uint_as_float(q[1]);
}
__device__ __forceinline__ float quad4_sum(float x) {
    x += __uint_as_float(__builtin_amdgcn_update_dpp(0u, __float_as_uint(x), 0xB1, 0xF, 0xF, true));
    x += __uint_as_float(__builtin_amdgcn_update_dpp(0u, __float_as_uint(x), 0x4E, 0xF, 0xF, true));
    return x;
}
__device__ __forceinline__ float max16(const f32x4 (&s)[4]) {
    const float a = fmaxf(fmaxf(s[0][0], s[0][1]), fmaxf(s[0][2], s[0][3])), b = fmaxf(fmaxf(s[1][0], s[1][1]), fmaxf(s[1][2], s[1][3]));
    const float c = fmaxf(fmaxf(s[2][0], s[2][1]), fmaxf(s[2][2], s[2][3])), d = fmaxf(fmaxf(s[3][0], s[3][1]), fmaxf(s[3][2], s[3][3]));
    return fmaxf(fmaxf(a, b), fmaxf(c, d));
}
__device__ __forceinline__ float sum16(const f32x4 (&s)[4]) {
    const f32x4 v = (s[0] + s[1]) + (s[2] + s[3]);
    return (v[0] + v[1]) + (v[2] + v[3]);
}
__device__ __forceinline__ void lds_fadd(float* p, float v) {
    asm volatile("ds_add_f32 %0, %1" :: "v"((unsigned)(size_t)(LAS float*)p), "v"(v) : "memory");
}
__device__ __forceinline__ f32x4 mfma16(bf16x8 a, bf16x8 b, f32x4 c) { return __builtin_amdgcn_mfma_f32_16x16x32_bf16(a, b, c, 0, 0, 0); }

constexpr int NTHR = 512, NWV = 8;
constexpr int LDS_BYTES = 163840;
constexpr int LDS_MISC = 147456;
constexpr int LDS_LUT = LDS_MISC;
constexpr int LDS_SEL = LDS_MISC + 8192;
constexpr int LDS_WOR = LDS_SEL + 1024;
constexpr int LDS_TL = LDS_WOR + 128;
constexpr int LDS_ITEM = LDS_TL + 256;
constexpr int LDS_ROWS = LDS_ITEM + 64;
constexpr int LDS_PRE = LDS_ROWS + 2048;
constexpr int LDS_KSC = LDS_PRE + 256;
constexpr int LDS_BARW = 163824;
static_assert(LDS_KSC + 1024 <= LDS_BARW, "LDS map");

__device__ __forceinline__ int queue_pop(unsigned* head, char* lds) {
    __syncthreads();
    if (threadIdx.x == 0) *(volatile int*)(lds + LDS_ITEM) = (int)atomicAdd(head, 1u);
    __syncthreads();
    return __builtin_amdgcn_readfirstlane(*(volatile int*)(lds + LDS_ITEM));
}

__device__ __forceinline__ int swz(int row, int chunk) { return (row << 7) + (((chunk ^ (row >> 1) ^ ((row >> 4) & 1)) & 7) << 4); }
constexpr int TILE_B = 16384;

struct GemmA { const char* base; unsigned off[4]; };

constexpr int STAGE_B = 49152, STAGE_BOFF = 32768;
__device__ __forceinline__ int gl_row(int i, int t) { return 8 * ((t >> 6) + 8 * i) + ((t & 63) >> 3); }
__device__ __forceinline__ int gl_chunk(int row, int t) { return ((t & 7) ^ (row >> 1) ^ ((row >> 4) & 1)) & 7; }
__device__ __forceinline__ int perm32_(int rho) { const int n = rho >> 4, i = rho & 15; return 8 * (i >> 2) + 4 * n + (i & 3); }
template <int NP, bool PERM = false>
__device__ __forceinline__ GemmA make_op(const bf16_t* base, long ld, int r0, int rmax) {
    GemmA a; const int t = threadIdx.x;
    a.base = (const char*)base;
#pragma unroll
    for (int i = 0; i < NP; ++i) { const int lr_ = gl_row(i, t); int r = r0 + (PERM ? ((lr_ & ~31) + perm32_(lr_ & 31)) : lr_); r = r < rmax ? r : rmax - 1; a.off[i] = (unsigned)(((size_t)r * ld + gl_chunk(lr_, t) * 8) * 2); }
    return a;
}
__device__ __forceinline__ void gemm_mainloop_g(char* lds, const GemmA& A, const GemmA& B, int nk, f32x4 (&acc)[4][4]) {
    int t = threadIdx.x; asm volatile("" : "+v"(t));
    const int lane = t & 63, w = t >> 6, wm = w >> 1, wn = w & 1;
    const int lr = lane & 15, lq = lane >> 4;
    const int wu = __builtin_amdgcn_readfirstlane(w);
    const int xr = (lr >> 1) & 7;
    unsigned ardA[2][2], ardB[2][2];
#pragma unroll
    for (int kk = 0; kk < 2; ++kk)
#pragma unroll
        for (int par = 0; par < 2; ++par) {
            const int ch = ((kk * 4 + lq) ^ xr ^ par) & 7;
            ardA[kk][par] = (unsigned)((wm * 64 + par * 16 + lr) * 128 + ch * 16);
            ardB[kk][par] = (unsigned)(STAGE_BOFF + (wn * 64 + par * 16 + lr) * 128 + ch * 16);
        }
    const char* abase = A.base; const char* bbase = B.base;
    LAS char* ldsl = (LAS char*)lds;
#define GI_(so_) { \
        _Pragma("unroll") for (int i = 0; i < 4; ++i) \
            __builtin_amdgcn_global_load_lds((const unsigned*)(abase + A.off[i]), (LAS unsigned*)(ldsl + (so_) + (wu + 8 * i) * 1024), 16, 0, 0); \
        _Pragma("unroll") for (int i = 0; i < 2; ++i) \
            __builtin_amdgcn_global_load_lds((const unsigned*)(bbase + B.off[i]), (LAS unsigned*)(ldsl + (so_) + STAGE_BOFF + (wu + 8 * i) * 1024), 16, 0, 0); \
        abase += 128; bbase += 128; }
    __syncthreads();
    GI_(0);
    if (nk > 1) GI_(STAGE_B);
    int cso = 0, lso = 2 * STAGE_B;
#pragma unroll 1
    for (int kt = 0; kt < nk; ++kt) {
        if (kt + 1 < nk) asm volatile("s_waitcnt vmcnt(6)" ::: "memory");
        else asm volatile("s_waitcnt vmcnt(0)" ::: "memory");
        __builtin_amdgcn_s_barrier();
        if (kt + 2 < nk) GI_(lso);
#pragma unroll
        for (int kk = 0; kk < 2; ++kk) {
            bf16x8 af[4], bfr[4];
#pragma unroll
            for (int i = 0; i < 4; ++i) af[i] = *(const bf16x8*)(lds + cso + ardA[kk][i & 1] + (i >> 1) * 4096);
#pragma unroll
            for (int j = 0; j < 4; ++j) bfr[j] = *(const bf16x8*)(lds + cso + ardB[kk][j & 1] + (j >> 1) * 4096);
#pragma unroll
            for (int i = 0; i < 4; ++i)
#pragma unroll
                for (int j = 0; j < 4; ++j) acc[i][j] = mfma16(bfr[j], af[i], acc[i][j]);
        }
        cso = (cso == 2 * STAGE_B) ? 0 : cso + STAGE_B;
        lso = (lso == 2 * STAGE_B) ? 0 : lso + STAGE_B;
    }
    __syncthreads();
#undef GI_
}

template <bool SWAPW1 = false>
__device__ __forceinline__ void gemm_mainloop_c(char* lds, const GemmA& A, const GemmA& B, int nk, f32x4 (&acc)[4][4], int& ring, bool primed, bool chain, const GemmA& An, const GemmA& Bn) {
    int t = threadIdx.x; asm volatile("" : "+v"(t));
    const int lane = t & 63, w = t >> 6, wm = w >> 1, wn = w & 1;
    const int lr = lane & 15, lq = lane >> 4;
    const int wu = __builtin_amdgcn_readfirstlane(w);
    const int xr = (lr >> 1) & 7;
    unsigned ardA[2][2], ardB[2][2];
#pragma unroll
    for (int kk = 0; kk < 2; ++kk)
#pragma unroll
        for (int par = 0; par < 2; ++par) {
            const int ch = ((kk * 4 + lq) ^ xr ^ par) & 7;
            ardA[kk][par] = (unsigned)((wm * 64 + par * 16 + lr) * 128 + ch * 16);
            ardB[kk][par] = (unsigned)(STAGE_BOFF + (wn * 64 + par * 16 + lr) * 128 + ch * 16);
        }
    const char* abase = A.base; const char* bbase = B.base;
    const char* anb = An.base; const char* bnb = Bn.base;
    LAS char* ldsl = (LAS char*)lds;
#define GI_(so_) { \
        _Pragma("unroll") for (int i = 0; i < 4; ++i) \
            __builtin_amdgcn_global_load_lds((const unsigned*)(abase + A.off[i]), (LAS unsigned*)(ldsl + (so_) + (wu + 8 * i) * 1024), 16, 0, 0); \
        _Pragma("unroll") for (int i = 0; i < 2; ++i) \
            __builtin_amdgcn_global_load_lds((const unsigned*)(bbase + B.off[i]), (LAS unsigned*)(ldsl + (so_) + STAGE_BOFF + (wu + 8 * i) * 1024), 16, 0, 0); \
        abase += 128; bbase += 128; }
#define GIN_(so_) { \
        _Pragma("unroll") for (int i = 0; i < 4; ++i) \
            __builtin_amdgcn_global_load_lds((const unsigned*)(anb + An.off[i]), (LAS unsigned*)(ldsl + (so_) + (wu + 8 * i) * 1024), 16, 0, 0); \
        _Pragma("unroll") for (int i = 0; i < 2; ++i) \
            __builtin_amdgcn_global_load_lds((const unsigned*)(bnb + Bn.off[i]), (LAS unsigned*)(ldsl + (so_) + STAGE_BOFF + (wu + 8 * i) * 1024), 16, 0, 0); \
        anb += 128; bnb += 128; }
    int cso = ring, lso = (ring == 0) ? 2 * STAGE_B : ring - STAGE_B;
    if (!primed) {
        __syncthreads();
        GI_(cso);
        { const int s1 = (cso == 2 * STAGE_B) ? 0 : cso + STAGE_B; GI_(s1); }
    } else { abase += 256; bbase += 256; }
#pragma unroll 1
    for (int kt = 0; kt < nk; ++kt) {
        if (kt + 1 < nk || chain) asm volatile("s_waitcnt vmcnt(6)" ::: "memory");
        else asm volatile("s_waitcnt vmcnt(0)" ::: "memory");
        __builtin_amdgcn_s_barrier();
        if (kt + 2 < nk) GI_(lso) else if (chain) GIN_(lso)
#pragma unroll
        for (int kk = 0; kk < 2; ++kk) {
            bf16x8 af[4], bfr[4];
#pragma unroll
            for (int i = 0; i < 4; ++i) af[i] = *(const bf16x8*)(lds + cso + ardA[kk][i & 1] + (i >> 1) * 4096);
#pragma unroll
            for (int j = 0; j < 4; ++j) bfr[j] = *(const bf16x8*)(lds + cso + ardB[kk][j & 1] + (j >> 1) * 4096);
            if (SWAPW1 && wn == 1) {
#pragma unroll
                for (int i = 0; i < 4; ++i)
#pragma unroll
                    for (int j = 0; j < 4; ++j) acc[i][j] = mfma16(af[i], bfr[j], acc[i][j]);
            } else {
#pragma unroll
                for (int i = 0; i < 4; ++i)
#pragma unroll
                    for (int j = 0; j < 4; ++j) acc[i][j] = mfma16(bfr[j], af[i], acc[i][j]);
            }
        }
        cso = (cso == 2 * STAGE_B) ? 0 : cso + STAGE_B;
        lso = (lso == 2 * STAGE_B) ? 0 : lso + STAGE_B;
    }
    ring = cso;
    if (!chain) __syncthreads();
#undef GI_
#undef GIN_
}

template <bool LO>
__device__ __forceinline__ void conv_wT(const float* src, int K, int N, bf16_t* dst, int ldd, const float* gain) {
    const int t = threadIdx.x & 255, kg = t >> 5, n4 = t & 31;
    const int ntn = (N + 127) >> 7, ntiles = (K >> 6) * ntn;
    for (int tile = blockIdx.x * 2 + (threadIdx.x >> 8); tile < ntiles; tile += gridDim.x * 2) {
        const int k0 = (tile / ntn) * 64 + kg * 8, n = (tile % ntn) * 128 + n4 * 4;
        if (n < N) {
            float4 r[8];
#pragma unroll
            for (int kk = 0; kk < 8; ++kk) r[kk] = *(const float4*)(src + (size_t)(k0 + kk) * N + n);
            if (gain) {
#pragma unroll
                for (int kk = 0; kk < 8; ++kk) { const float g = gain[k0 + kk]; r[kk].x *= g; r[kk].y *= g; r[kk].z *= g; r[kk].w *= g; }
            }
#pragma unroll
            for (int c = 0; c < 4; ++c) {
                float v[8];
#pragma unroll
                for (int kk = 0; kk < 8; ++kk) { float f = (c == 0) ? r[kk].x : (c == 1) ? r[kk].y : (c == 2) ? r[kk].z : r[kk].w; if (LO) f = f - bf2f(f2bf(f)); v[kk] = f; }
                *(uint4*)(dst + (size_t)(n + c) * ldd + k0) = make_uint4(pack2(v[0], v[1]), pack2(v[2], v[3]), pack2(v[4], v[5]), pack2(v[6], v[7]));
            }
        }
    }
}

__device__ __forceinline__ void zero_acc(f32x4 (&acc)[4][4]) {
#pragma unroll
    for (int i = 0; i < 4; ++i)
#pragma unroll
        for (int j = 0; j < 4; ++j) acc[i][j] = (f32x4){0.f, 0.f, 0.f, 0.f};
}

namespace pg8 {
constexpr int BM = 256, BK = 64, HALF = 128, HTB = HALF * BK * 2, STAGE_BYTES = 8 * HTB;
__device__ __forceinline__ int lds_byte(int r, int c) { const int st = (r >> 4) * 2 + (c >> 5), rr = r & 15, cc = c & 31, ob = rr * 64 + cc * 2; return st * 1024 + (ob ^ (((ob >> 9) & 1) << 5)); }
__device__ __forceinline__ void stage_rc(int b, int& R, int& C) { const int st = b / 1024, sb = b % 1024, swz_ = sb ^ (((sb >> 9) & 1) << 5); R = (st >> 1) * 16 + swz_ / 64; C = (st & 1) * 32 + (swz_ % 64) / 2; }
__device__ __forceinline__ int perm32(int rho) { const int n = rho >> 4, i = rho & 15; return 8 * (i >> 2) + 4 * n + (i & 3); }
struct Unit { int pm, pn; };
struct Ops { const char* A; const char* B; };
template <class Prov, class Epi>
__device__ __forceinline__ void gemm_phase(LAS unsigned char* lds, const int K, Prov& PV, const Epi& E) {
    int tid = threadIdx.x; asm volatile("" : "+v"(tid));
    const int wid = __builtin_amdgcn_readfirstlane(tid >> 6), lane = tid & 63, wr = wid >> 2, wc = wid & 3, fr = lane & 15, fq = lane >> 4;
    int nt = K / BK; asm volatile("" : "+s"(nt));
    int sR[2], sC[2];
#pragma unroll
    for (int i = 0; i < 2; ++i) stage_rc(tid * 16 + i * 8192, sR[i], sC[i]);
    const size_t kstep = (size_t)(BK * 2);
    const unsigned ldsw = (unsigned)wid * 1024u;
    const int aoff = lds_byte(wr * 64 + fr, fq * 8), boff = lds_byte(wc * 32 + fr, fq * 8);
#define PG8_SA(b, h) (((b) * 2 + (h)) * HTB)
#define PG8_SB(b, h) ((4 + (b) * 2 + (h)) * HTB)
#define PG8_STAGE(bufoff, gbase, voff) do { _Pragma("unroll") for (int _i = 0; _i < 2; ++_i) \
        __builtin_amdgcn_global_load_lds((const unsigned*)((const char*)(gbase) + (voff)[_i]), (LAS unsigned*)(lds + (bufoff) + ldsw + _i * 8192), 16, 0, 0); } while (0)
#define PG8_LDA(dst, b, h) do { _Pragma("unroll") for (int m = 0; m < 4; ++m) _Pragma("unroll") for (int k = 0; k < 2; ++k) dst[m][k] = *(const LAS bf16x8*)(lds + PG8_SA(b, h) + aoff + m * 2048 + k * 1024); } while (0)
#define PG8_LDB(dst, b, h) do { _Pragma("unroll") for (int n = 0; n < 2; ++n) _Pragma("unroll") for (int k = 0; k < 2; ++k) dst[n][k] = *(const LAS bf16x8*)(lds + PG8_SB(b, h) + boff + n * 2048 + k * 1024); } while (0)
#define PG8_MMA(ai, bj, At, Bt) do { __builtin_amdgcn_s_setprio(1); _Pragma("unroll") for (int m = 0; m < 4; ++m) _Pragma("unroll") for (int n = 0; n < 2; ++n) _Pragma("unroll") for (int k = 0; k < 2; ++k) \
        acc[ai][bj][m][n] = __builtin_amdgcn_mfma_f32_16x16x32_bf16(Bt[n][k], At[m][k], acc[ai][bj][m][n], 0, 0, 0); __builtin_amdgcn_s_setprio(0); } while (0)
#define PG8_WAIT_V(n) asm volatile("s_waitcnt vmcnt(" #n ")" ::: "memory")
#define PG8_WAIT_L(n) asm volatile("s_waitcnt lgkmcnt(" #n ")" ::: "memory")
#define PG8_BAR __builtin_amdgcn_s_barrier()
#define PG8_SCHED __builtin_amdgcn_sched_barrier(0)
    Unit cur, nxt; Ops oc, on; int ui = 0;
    unsigned va[2][2], vb[2][2];
    PV.offsets(va, vb, sR, sC);
    if (!PV.get(0, cur, oc)) return;
    f32x4 acc[2][2][4][2];
#pragma unroll
    for (int a = 0; a < 2; ++a)
#pragma unroll
        for (int b = 0; b < 2; ++b)
#pragma unroll
            for (int m = 0; m < 4; ++m)
#pragma unroll
                for (int n = 0; n < 2; ++n) acc[a][b][m][n] = (f32x4){0.f, 0.f, 0.f, 0.f};
    bf16x8 At[4][2], B0[2][2], B1[2][2];
    PG8_STAGE(PG8_SB(0, 0), oc.B, vb[0]); PG8_STAGE(PG8_SA(0, 0), oc.A, va[0]); PG8_STAGE(PG8_SB(0, 1), oc.B, vb[1]); PG8_STAGE(PG8_SA(0, 1), oc.A, va[1]);
    if (wr == 1) PG8_BAR;
    PG8_WAIT_V(4); PG8_BAR;
    PG8_STAGE(PG8_SB(1, 0), oc.B + kstep, vb[0]); PG8_STAGE(PG8_SA(1, 0), oc.A + kstep, va[0]); PG8_STAGE(PG8_SB(1, 1), oc.B + kstep, vb[1]);
    PG8_WAIT_V(6); PG8_BAR;
    for (;;) {
        const bool has_next = PV.get(ui + 1, nxt, on);
        if (!has_next) on = oc;
#pragma unroll 1
        for (int t = 0; t < nt; t += 2) {
            const bool last = (t == nt - 2);
            const char* a1 = oc.A + (size_t)(t + 1) * kstep;
            const char* a2 = last ? on.A : oc.A + (size_t)(t + 2) * kstep; const char* b2 = last ? on.B : oc.B + (size_t)(t + 2) * kstep;
            const char* a3 = a2 + kstep; const char* b3 = b2 + kstep;
            PG8_LDB(B0, 0, 0); PG8_SCHED; PG8_LDA(At, 0, 0); PG8_STAGE(PG8_SA(1, 1), a1, va[1]);
            PG8_WAIT_L(8); PG8_BAR; PG8_WAIT_L(0); PG8_MMA(0, 0, At, B0); PG8_BAR; PG8_SCHED;
            PG8_LDB(B1, 0, 1); PG8_STAGE(PG8_SB(0, 0), b2, vb[0]);
            PG8_BAR; PG8_WAIT_L(0); PG8_MMA(0, 1, At, B1); PG8_BAR;
            PG8_LDA(At, 0, 1); PG8_STAGE(PG8_SA(0, 0), a2, va[0]);
            PG8_BAR; PG8_WAIT_L(0); PG8_MMA(1, 0, At, B0); PG8_BAR; PG8_SCHED;
            PG8_STAGE(PG8_SB(0, 1), b2, vb[1]);
            PG8_WAIT_V(6); PG8_BAR; PG8_MMA(1, 1, At, B1); PG8_BAR;
            PG8_LDB(B0, 1, 0); PG8_SCHED; PG8_LDA(At, 1, 0); PG8_STAGE(PG8_SA(0, 1), a2, va[1]);
            PG8_WAIT_L(8); PG8_BAR; PG8_WAIT_L(0); PG8_MMA(0, 0, At, B0); PG8_BAR; PG8_SCHED;
            PG8_LDB(B1, 1, 1); PG8_STAGE(PG8_SB(1, 0), b3, vb[0]);
            PG8_BAR; PG8_WAIT_L(0); PG8_MMA(0, 1, At, B1); PG8_BAR;
            PG8_LDA(At, 1, 1); PG8_STAGE(PG8_SA(1, 0), a3, va[0]);
            PG8_BAR; PG8_WAIT_L(0); PG8_MMA(1, 0, At, B0); PG8_BAR; PG8_SCHED;
            PG8_STAGE(PG8_SB(1, 1), b3, vb[1]);
            PG8_WAIT_V(6); PG8_BAR; PG8_MMA(1, 1, At, B1); PG8_BAR;
        }
        bool keep;
        { int tz = threadIdx.x; asm volatile("" : "+v"(tz));
          keep = E(acc, cur, ui, wr, wc, tz & 15, (tz >> 4) & 3); }
        if (!has_next) break;
        if (!keep)
#pragma unroll
        for (int a = 0; a < 2; ++a)
#pragma unroll
            for (int b = 0; b < 2; ++b)
#pragma unroll
                for (int m = 0; m < 4; ++m)
#pragma unroll
                    for (int n = 0; n < 2; ++n) acc[a][b][m][n] = (f32x4){0.f, 0.f, 0.f, 0.f};
        cur = nxt; oc = on; ++ui;
    }
    PG8_WAIT_V(0);
    if (wr == 0) PG8_BAR;
    PG8_BAR;
#undef PG8_SA
#undef PG8_SB
#undef PG8_STAGE
#undef PG8_LDA
#undef PG8_LDB
#undef PG8_MMA
#undef PG8_WAIT_V
#undef PG8_WAIT_L
#undef PG8_BAR
#undef PG8_SCHED
}
struct StaticOrder {
    int nM, nN, nwg, G, c;
    __device__ void init(int M, int N, int G_, int c_) { nM = M / BM; nN = N / BM; nwg = nM * nN; G = G_; c = c_; }
    __device__ bool next(int i, Unit& u) const {
        const long L = (long)i * G + c; if (L >= nwg) return false;
        int wgid = (int)L; { const int q = nwg / 8, r = nwg % 8, xcd = wgid % 8, off = wgid / 8; wgid = (xcd < r ? xcd * (q + 1) : r * (q + 1) + (xcd - r) * q) + off; }
        const int nig = 8 * nN, gid = wgid / nig, fm = gid * 8, gsz = (nM - fm) < 8 ? (nM - fm) : 8;
        u.pm = fm + ((wgid % nig) % gsz); u.pn = (wgid % nig) / gsz; return true;
    }
};
struct DenseProv {
    StaticOrder S; const bf16_t* A; const bf16_t* Bt; long lda, ldb; bool perm;
    __device__ __forceinline__ void offsets(unsigned (&va)[2][2], unsigned (&vb)[2][2], const int (&sR)[2], const int (&sC)[2]) const {
#pragma unroll
        for (int h = 0; h < 2; ++h)
#pragma unroll
            for (int p = 0; p < 2; ++p) { const int rb = perm ? ((sR[p] & ~31) + perm32(sR[p] & 31)) : sR[p];
                va[h][p] = (unsigned)(((size_t)(h * HALF + sR[p]) * lda + sC[p]) * 2); vb[h][p] = (unsigned)(((size_t)(h * HALF + rb) * ldb + sC[p]) * 2); }
    }
    __device__ __forceinline__ bool get(int i, Unit& u, Ops& o) const {
        if (!S.next(i, u)) return false;
        o.A = (const char*)(A + (size_t)u.pm * BM * lda); o.B = (const char*)(Bt + (size_t)u.pn * BM * ldb);
        return true;
    }
};
}

__device__ __forceinline__ void phase0(const Params& P) {
    const int t = threadIdx.x, lane = t & 63, w = t >> 6;
    const int gw = blockIdx.x * NWV + w, nw = gridDim.x * NWV;
    bf16_t* H0 = (bf16_t*)(P.ws + WS_H0);
    for (int row0 = gw; row0 < NTOK; row0 += 2 * nw) {
        const int row1 = row0 + nw; const bool has1 = row1 < NTOK;
        const float4* xr0 = (const float4*)(P.x + (size_t)row0 * DM); const float4* xr1 = (const float4*)(P.x + (size_t)(has1 ? row1 : row0) * DM);
        float4 v[2][4]; float s0 = 0.f, s1 = 0.f;
#pragma unroll
        for (int i = 0; i < 4; ++i) { v[0][i] = xr0[lane + 64 * i]; v[1][i] = xr1[lane + 64 * i]; }
#pragma unroll
        for (int i = 0; i < 4; ++i) { s0 += v[0][i].x + v[0][i].y + v[0][i].z + v[0][i].w; s1 += v[1][i].x + v[1][i].y + v[1][i].z + v[1][i].w; }
        const float mu0 = wave_sum(s0) * (1.f / DM), mu1 = wave_sum(s1) * (1.f / DM);
        float q0 = 0.f, q1 = 0.f;
#pragma unroll
        for (int i = 0; i < 4; ++i) {
            { float a = v[0][i].x - mu0, b = v[0][i].y - mu0, c = v[0][i].z - mu0, d = v[0][i].w - mu0; q0 += a * a + b * b + c * c + d * d; }
            { float a = v[1][i].x - mu1, b = v[1][i].y - mu1, c = v[1][i].z - mu1, d = v[1][i].w - mu1; q1 += a * a + b * b + c * c + d * d; }
        }
        const float rstd0 = rsqrtf(wave_sum(q0) * (1.f / DM) + 1e-5f), rstd1 = rsqrtf(wave_sum(q1) * (1.f / DM) + 1e-5f);
#pragma unroll
        for (int i = 0; i < 4; ++i) {
            const float4 g = ((const float4*)P.ln0_g)[lane + 64 * i], bb = ((const float4*)P.ln0_b)[lane + 64 * i];
            *(uint2*)(H0 + (size_t)row0 * DM + 4 * (lane + 64 * i)) =
                make_uint2(pack2((v[0][i].x - mu0) * rstd0 * g.x + bb.x, (v[0][i].y - mu0) * rstd0 * g.y + bb.y), pack2((v[0][i].z - mu0) * rstd0 * g.z + bb.z, (v[0][i].w - mu0) * rstd0 * g.w + bb.w));
            if (has1) *(uint2*)(H0 + (size_t)row1 * DM + 4 * (lane + 64 * i)) =
                make_uint2(pack2((v[1][i].x - mu1) * rstd1 * g.x + bb.x, (v[1][i].y - mu1) * rstd1 * g.y + bb.y), pack2((v[1][i].z - mu1) * rstd1 * g.z + bb.z, (v[1][i].w - mu1) * rstd1 * g.w + bb.w));
        }
    }
    const int gt = blockIdx.x * NTHR + t, nt = gridDim.x * NTHR;
    bf16_t* MEMB = (bf16_t*)(P.ws + WS_MEMB);
    for (int i = gt; i < 4 * 256 * DM / 4; i += nt) {
        const float4 v = ((const float4*)P.mem)[i];
        *(uint2*)(MEMB + (size_t)i * 4) = make_uint2(pack2(v.x, v.y), pack2(v.z, v.w));
    }
    float* COS = (float*)(P.ws + WS_COS); float* SIN = (float*)(P.ws + WS_SIN);
    for (int i = gt; i < SEQ * 16; i += nt) {
        const int pos = i >> 4, j = i & 15;
        const float freq = exp2f(-(float)j * (13.287712379549449f / 16.f));
        const float ang = (float)pos * freq;
        float sn, cs; sincosf(ang, &sn, &cs);
        COS[i] = cs; SIN[i] = sn;
    }
    {
        char* wsb = P.ws;
        const int tt = t & 255, kg = tt >> 5, n4 = tt & 31;
        constexpr int NJ = 17;
        const int jK[NJ]  = {1024, 768, 256, 1024, 512, 512, 512, 1024, 1024, 1024, 1024, 1024, 256, 2048, 2048, 256, 256};
        const int jN[NJ]  = {DIN, 768, 1024, 1024, 1024, 1024, 1024, 1024, 256, 256, 256, 256, 1024, 256, 256, 64, 64};
        int first[NJ + 1]; first[0] = 0;
#pragma unroll
        for (int j = 0; j < NJ; ++j) first[j + 1] = first[j] + (jK[j] >> 6) * ((jN[j] + 127) >> 7);
        for (int g = blockIdx.x * 2 + (t >> 8); g < first[NJ]; g += gridDim.x * 2) {
            int j = 0;
#pragma unroll
            for (int q = 1; q < NJ; ++q) j += (g >= first[q]) ? 1 : 0;
            const float* src; bf16_t* dst; const float* gain = nullptr; bool lo = false; int K, N, ldd, f0;
            switch (j) {
                case 0: src = P.w_in; dst = (bf16_t*)(wsb + WB_WIN); break;
                case 1: src = P.mla_w_uq; dst = (bf16_t*)(wsb + WB_WUQ); gain = P.mla_q_norm; break;
                case 2: src = P.mla_w_ukv; dst = (bf16_t*)(wsb + WB_WUKV); gain = P.mla_kv_norm; break;
                case 3: src = P.mem_w_kv; dst = (bf16_t*)(wsb + WB_WMEM); break;
                case 4: src = P.w_branch; dst = (bf16_t*)(wsb + WB_WBR); break;
                case 5: src = P.w_branch + 512 * 1024; dst = (bf16_t*)(wsb + WB_WBR) + 1024 * 512; break;
                case 6: src = P.w_branch + 2 * 512 * 1024; dst = (bf16_t*)(wsb + WB_WBR) + 2 * 1024 * 512; break;
                case 7: src = P.w_out; dst = (bf16_t*)(wsb + WB_WOUT); break;
                case 8: src = P.router_w; dst = (bf16_t*)(wsb + WB_WRHI); break;
                case 9: src = P.router_w; dst = (bf16_t*)(wsb + WB_WRLO); lo = true; break;
                case 10: src = P.sh_w1; dst = (bf16_t*)(wsb + WB_WS1); break;
                case 11: src = P.sh_w3; dst = (bf16_t*)(wsb + WB_WS3); break;
                case 12: src = P.sh_w2; dst = (bf16_t*)(wsb + WB_WS2); break;
                case 13: src = P.cmp_k_w1; dst = (bf16_t*)(wsb + WB_WCK1); break;
                case 14: src = P.cmp_v_w1; dst = (bf16_t*)(wsb + WB_WCV1); break;
                case 15: src = P.cmp_k_w2; dst = (bf16_t*)(wsb + WB_WCK2); break;
                default: src = P.cmp_v_w2; dst = (bf16_t*)(wsb + WB_WCV2); break;
            }
            K = jK[0]; N = jN[0]; f0 = first[0];
#pragma unroll
            for (int q = 1; q < NJ; ++q) if (j == q) { K = jK[q]; N = jN[q]; f0 = first[q]; }
            ldd = K;
            const int ntn = (N + 127) >> 7, tile = g - f0;
            const int k0 = (tile / ntn) * 64 + kg * 8, n = (tile % ntn) * 128 + n4 * 4;
            if (n < N) {
                float4 r[8];
#pragma unroll
                for (int kk = 0; kk < 8; ++kk) r[kk] = *(const float4*)(src + (size_t)(k0 + kk) * N + n);
                if (gain) {
#pragma unroll
                    for (int kk = 0; kk < 8; ++kk) { const float gg = gain[k0 + kk]; r[kk].x *= gg; r[kk].y *= gg; r[kk].z *= gg; r[kk].w *= gg; }
                }
#pragma unroll
                for (int c = 0; c < 4; ++c) {
                    float v[8];
#pragma unroll
                    for (int kk = 0; kk < 8; ++kk) { float f = (c == 0) ? r[kk].x : (c == 1) ? r[kk].y : (c == 2) ? r[kk].z : r[kk].w; if (lo) f = f - bf2f(f2bf(f)); v[kk] = f; }
                    *(uint4*)(dst + (size_t)(n + c) * ldd + k0) = make_uint4(pack2(v[0], v[1]), pack2(v[2], v[3]), pack2(v[4], v[5]), pack2(v[6], v[7]));
                }
            }
        }
        float* POSP = (float*)(wsb + WB_POSP);
        for (int i = gt; i < 2 * 16 * 256 * 16; i += nt) {
            const int o = i >> 4, part = i & 15, kv = o >> 12, kc = (o >> 8) & 15, c = o & 255;
            const float* pos = kv ? P.cmp_pos_v : P.cmp_pos_k; const float* w1 = kv ? P.cmp_v_w1 : P.cmp_k_w1;
            float a = 0.f;
#pragma unroll
            for (int k8 = 0; k8 < 8; ++k8) { const int k = kc * 128 + part * 8 + k8; a += pos[k] * w1[(size_t)k * 256 + c]; }
            a += __uint_as_float(__builtin_amdgcn_update_dpp(0u, __float_as_uint(a), 0xB1, 0xF, 0xF, true));
            a += __uint_as_float(__builtin_amdgcn_update_dpp(0u, __float_as_uint(a), 0x4E, 0xF, 0xF, true));
            a += __uint_as_float(__builtin_amdgcn_update_dpp(0u, __float_as_uint(a), 0x141, 0xF, 0xF, true));
            a += __uint_as_float(__builtin_amdgcn_update_dpp(0u, __float_as_uint(a), 0x140, 0xF, 0xF, true));
            if (part == 0) POSP[o] = a;
        }
    }
    bf16_t* KC = (bf16_t*)(P.ws + WS_KC); bf16_t* VTC = (bf16_t*)(P.ws + WS_VTC);
    for (int i = gt; i < 8 * 64; i += nt) { const int bg = i >> 6, d = i & 63; KC[((size_t)bg * 512 + 511) * 64 + d] = 0; VTC[((size_t)bg * 64 + d) * 512 + 511] = 0; }
}

__device__ __forceinline__ void proj_store8(const Params& P, int tok, int n0, f32x4 v0, f32x4 v1) {
    if (n0 >= DIN) return;
    const int nt = n0 >> 7;
    if (nt >= 4 && nt < 10) {
        const int j = nt - 4, g = (n0 >> 6) & 1, d = n0 & 63, b = tok >> 13, sq = tok & 8191;
        bf16_t* dstk = (bf16_t*)(P.ws + (j == 0 ? WS_KCS : j == 1 ? WS_VCS : j == 2 ? WS_KSLC : j == 4 ? WS_KWIN : j == 3 ? WS_VTSLC : WS_VTWIN));
        if (j == 3 || j == 5) {
#pragma unroll
            for (int r = 0; r < 4; ++r) { dstk[((size_t)(b * 2 + g) * 64 + d + r) * SEQ + sq] = f2bf(v0[r]); dstk[((size_t)(b * 2 + g) * 64 + d + 4 + r) * SEQ + sq] = f2bf(v1[r]); }
        } else { const uint2 a = pack4(v0), c = pack4(v1); *(uint4*)(dstk + (((size_t)(b * 2 + g) * SEQ + sq) * 64 + d)) = make_uint4(a.x, a.y, c.x, c.y); }
    } else {
        float sc = 1.f;
        if (nt < 4) sc = 0.125f * LOG2E;
        else if (n0 >= C_QMEM && n0 < C_GMERGE) sc = 0.08838834764831845f * LOG2E;
        v0 *= sc; v1 *= sc;
        if (n0 >= C_GMERGE || (n0 >= C_GNSA && n0 < C_CQ)) {
#pragma unroll
            for (int r = 0; r < 4; ++r) { v0[r] = sigmoidf_(v0[r]); v1[r] = sigmoidf_(v1[r]); }
        }
        const uint2 a = pack4(v0), c = pack4(v1);
        *(uint4*)((bf16_t*)(P.ws + WS_PROJ) + (size_t)tok * DIN + n0) = make_uint4(a.x, a.y, c.x, c.y);
    }
}
template <bool LIGHT>
struct EpiProj {
    const Params* P;
    __device__ __forceinline__ bool operator()(f32x4 (&acc)[2][2][4][2], const pg8::Unit& u, int, int wr, int wc, int fr, int fq) const {
#pragma unroll
        for (int ai = 0; ai < 2; ++ai)
#pragma unroll
            for (int m = 0; m < 4; ++m) {
                const int tok = u.pm * 256 + ai * 128 + wr * 64 + m * 16 + fr;
#pragma unroll
                for (int bj = 0; bj < 2; ++bj) {
                    if (!LIGHT) proj_store8(*P, tok, u.pn * 256 + bj * 128 + wc * 32 + 8 * fq, acc[ai][bj][m][0], acc[ai][bj][m][1]);
                    else asm volatile("" :: "v"(acc[ai][bj][m][0][0]), "v"(acc[ai][bj][m][1][3]));
                }
            }
        return false;
    }
};
template <bool LIGHT>
__device__ __forceinline__ void phase1(const Params& P, char* lds) {
    {
        pg8::DenseProv PV; PV.S.init(NTOK, 6144, gridDim.x, blockIdx.x);
        PV.A = (const bf16_t*)(P.ws + WS_H0); PV.Bt = (const bf16_t*)(P.ws + WB_WIN); PV.lda = DM; PV.ldb = DM; PV.perm = true;
        EpiProj<LIGHT> E; E.P = &P;
        pg8::gemm_phase((LAS unsigned char*)lds, DM, PV, E);
    }
}

template <int LEN>
__device__ __forceinline__ void rows_rstd(const bf16_t* base, long ld, int m0, float* dst) {
    const int t = threadIdx.x, row = t >> 1, part = t & 1;
    const uint4* p = (const uint4*)(base + (size_t)(m0 + row) * ld + part * (LEN / 2));
    float ss = 0.f;
#pragma unroll 1
    for (int i0 = 0; i0 < LEN / 16; i0 += 16) {
        uint4 v[16];
#pragma unroll
        for (int i = 0; i < 16; ++i) v[i] = p[i0 + i];
#pragma unroll
        for (int i = 0; i < 16; ++i) {
            float a;
            a = bflo(v[i].x); ss += a * a; a = bfhi(v[i].x); ss += a * a; a = bflo(v[i].y); ss += a * a; a = bfhi(v[i].y); ss += a * a;
            a = bflo(v[i].z); ss += a * a; a = bfhi(v[i].z); ss += a * a; a = bflo(v[i].w); ss += a * a; a = bfhi(v[i].w); ss += a * a;
        }
    }
    ss += __shfl_xor(ss, 1);
    if (part == 0) dst[row] = rsqrtf(ss * (1.f / LEN) + 1e-6f);
}

template <int QOFF>
__device__ __forceinline__ void phase2(const Params& P, char* lds) {
    unsigned* ctl = (unsigned*)(P.ws + WS_CTL);
    bf16_t* PROJ = (bf16_t*)(P.ws + WS_PROJ);
    float* rsc = (float*)(lds + LDS_ROWS + 1024);
    float* gsc = (float*)(lds + LDS_KSC);
    const float* COS = (const float*)(P.ws + WS_COS); const float* SIN = (const float*)(P.ws + WS_SIN);
#define P2_TID int t = threadIdx.x; asm volatile("" : "+v"(t)); const int lane = t & 63, w = t >> 6, wm = w >> 1, wn = w & 1, lr = lane & 15, lq = lane >> 4;
#ifndef P2SEL
#define P2SEL 7
#endif
    if (P2SEL & 1) for (;;) {
        const int it = queue_pop(&ctl[QOFF + CTL_Q + 0], lds);
        if (it >= 32) break;
        P2_TID
        {
            const int kv = it >> 4, mt = it & 15, m0 = mt * 256;
            const bf16_t* SRC = (const bf16_t*)(P.ws + (kv ? WS_VCS : WS_KCS));
            const bf16_t* w1t = (const bf16_t*)(P.ws + (kv ? WB_WCV1 : WB_WCK1)); const bf16_t* w2t = (const bf16_t*)(P.ws + (kv ? WB_WCV2 : WB_WCK2));
            {
                const float* pp = (const float*)(P.ws + WB_POSP) + kv * 4096 + (t & 255);
                float a = 0.f;
#pragma unroll
                for (int kc = 0; kc < 16; ++kc) a += pp[kc * 256];
                if (t < 256) gsc[t] = a;
            }
            __syncthreads();
            bf16_t* HID = (bf16_t*)(P.ws + WS_SCR + (size_t)blockIdx.x * 131072);
            GemmA A;
#pragma unroll
            for (int i = 0; i < 4; ++i) {
                const int lr_ = gl_row(i, t); int r = m0 + lr_; r = r < 4088 ? r : 4087;
                const int b = r / 1022, rem = r - b * 1022, n = rem >> 1, g = rem & 1;
                A.off[i] = (unsigned)((((size_t)(b * 2 + g) * SEQ + 16 * n) * 64 + gl_chunk(lr_, t) * 8) * 2);
            }
            A.base = (const char*)SRC;
            for (int nt = 0; nt < 2; ++nt) {
                f32x4 acc[4][4]; zero_acc(acc);
                GemmA B = make_op<2>(w1t, 2048, nt * 128, 256);
                gemm_mainloop_g(lds, A, B, 2048 / 64, acc);
#pragma unroll
                for (int i = 0; i < 4; ++i)
#pragma unroll
                    for (int j = 0; j < 4; ++j) {
                        f32x4 v = acc[i][j];
                        const f32x4 pb = *(const f32x4*)(gsc + nt * 128 + wn * 64 + j * 16 + 4 * lq);
#pragma unroll
                        for (int r = 0; r < 4; ++r) v[r] = geluf_(v[r] + pb[r]);
                        *(uint2*)(HID + (wm * 64 + i * 16 + lr) * 256 + nt * 128 + wn * 64 + j * 16 + 4 * lq) = pack4(v);
                    }
            }
            asm volatile("s_waitcnt vmcnt(0)" ::: "memory");
            __syncthreads();
            {
                f32x4 acc[4][4]; zero_acc(acc);
                GemmA A2 = make_op<4>(HID, 256, 0, 256);
                GemmA B2 = make_op<2>(w2t, 256, 0, 64);
                gemm_mainloop_g(lds, A2, B2, 256 / 64, acc);
                if (wn == 0) {
                    bf16_t* KC = (bf16_t*)(P.ws + WS_KC); bf16_t* VTC = (bf16_t*)(P.ws + WS_VTC);
#pragma unroll
                    for (int i = 0; i < 4; ++i) {
                        const int r = m0 + wm * 64 + i * 16 + lr;
                        if (r < 4088) {
                            const int b = r / 1022, rem = r - b * 1022, n = rem >> 1, g = rem & 1;
#pragma unroll
                            for (int j = 0; j < 4; ++j) {
                                const int d = j * 16 + 4 * lq;
                                if (!kv) *(uint2*)(KC + ((size_t)(b * 2 + g) * 512 + n) * 64 + d) = pack4(acc[i][j]);
                                else {
#pragma unroll
                                    for (int rr = 0; rr < 4; ++rr) VTC[((size_t)(b * 2 + g) * 64 + d + rr) * 512 + n] = f2bf(acc[i][j][rr]);
                                }
                            }
                        }
                    }
                }
            }
        }
    }
    if (P2SEL & 2) for (;;) {
        const int it = queue_pop(&ctl[QOFF + CTL_Q + 256], lds);
        if (it >= 256) break;
        P2_TID
        {
            const int mt = it >> 1, half = it & 1, m0 = mt * 256;
            rows_rstd<768>(PROJ + C_CQ, DIN, m0, rsc);
            __syncthreads();
            GemmA A = make_op<4>(PROJ + C_CQ, DIN, m0, NTOK);
            bf16_t* QM = (bf16_t*)(P.ws + WS_QM);
            int ring = 0;
#pragma unroll 1
            for (int k3 = 0; k3 < 3; ++k3) {
                const int n0 = (half * 3 + k3) * 128;
                f32x4 acc[4][4]; zero_acc(acc);
                GemmA B = make_op<2>((const bf16_t*)(P.ws + WB_WUQ), 768, n0, 768);
                GemmA Bn = make_op<2>((const bf16_t*)(P.ws + WB_WUQ), 768, n0 + (k3 < 2 ? 128 : 0), 768);
                gemm_mainloop_c(lds, A, B, 768 / 64, acc, ring, k3 > 0, k3 < 2, A, Bn);
                const int c16 = (n0 + wn * 64) >> 4;
                const bool rp0 = (c16 % 6) == 4, rp2 = ((c16 + 2) % 6) == 4;
                int lrz = lr; asm volatile("" : "+v"(lrz));
#pragma unroll
                for (int i = 0; i < 4; ++i) {
                    const int tl = wm * 64 + i * 16 + lrz, tok = m0 + tl, pos = tok & (SEQ - 1);
                    const float sc = rsc[tl] * (0.10206207261596575f * LOG2E);
                    const float4 cs = *(const float4*)(COS + pos * 16 + 4 * lq), sn = *(const float4*)(SIN + pos * 16 + 4 * lq);
                    const float csa[4] = {cs.x, cs.y, cs.z, cs.w}, sna[4] = {sn.x, sn.y, sn.z, sn.w};
#pragma unroll
                    for (int j = 0; j < 4; ++j) acc[i][j] *= sc;
#pragma unroll
                    for (int j = 0; j < 4; j += 2) {
                        if (j == 0 ? rp0 : rp2) {
#pragma unroll
                            for (int r = 0; r < 4; ++r) {
                                const float x1 = acc[i][j][r], x2 = acc[i][j + 1][r];
                                acc[i][j][r] = x1 * csa[r] - x2 * sna[r]; acc[i][j + 1][r] = x2 * csa[r] + x1 * sna[r];
                            }
                        }
                    }
#pragma unroll
                    for (int j = 0; j < 4; ++j) *(uint2*)(QM + (size_t)tok * 768 + n0 + wn * 64 + j * 16 + 4 * lq) = pack4(acc[i][j]);
                }
            }
        }
    }
    if (P2SEL & 4) for (;;) {
        const int it = queue_pop(&ctl[QOFF + CTL_Q + 320], lds);
        if (it >= 128) break;
        P2_TID
        {
            const int mt = it, m0 = mt * 256;
            rows_rstd<256>(PROJ + C_CKV, DIN, m0, rsc);
            __syncthreads();
            GemmA A = make_op<4>(PROJ + C_CKV, DIN, m0, NTOK);
            bf16_t* KM = (bf16_t*)(P.ws + WS_KM); bf16_t* VTM = (bf16_t*)(P.ws + WS_VTM);
            int ring = 0;
#pragma unroll 1
            for (int h = 0; h < 8; ++h) {
                f32x4 acc[4][4]; zero_acc(acc);
                GemmA B = make_op<2>((const bf16_t*)(P.ws + WB_WUKV), 256, h * 128, 1024);
                GemmA Bn = make_op<2>((const bf16_t*)(P.ws + WB_WUKV), 256, (h < 7 ? h + 1 : h) * 128, 1024);
                gemm_mainloop_c<true>(lds, A, B, 256 / 64, acc, ring, h > 0, h < 7, A, Bn);
                if (wn == 0) {
#pragma unroll
                    for (int i = 0; i < 4; ++i) {
                        const int tl = wm * 64 + i * 16 + lr, tok = m0 + tl, b = tok >> 13, s = tok & (SEQ - 1);
                        const float sc = rsc[tl];
#pragma unroll
                        for (int j = 0; j < 4; ++j) *(uint2*)(KM + ((size_t)(b * 8 + h) * SEQ + s) * 96 + j * 16 + 4 * lq) = pack4(acc[i][j] * sc);
                    }
                } else {
#pragma unroll
                    for (int i = 0; i < 4; ++i) {
                        const int tl = wm * 64 + i * 16 + 4 * lq, tok = m0 + tl, b = tok >> 13, s = tok & (SEQ - 1);
                        const f32x4 sc = *(const f32x4*)(rsc + tl);
#pragma unroll
                        for (int j = 0; j < 4; ++j) *(uint2*)(VTM + ((size_t)(b * 8 + h) * 64 + j * 16 + lr) * SEQ + s) = pack4(acc[i][j] * sc);
                    }
                }
            }
        }
    }
    for (;;) {
        const int tile = queue_pop(&ctl[QOFF + CTL_Q + 384], lds);
        if (tile >= 32) break;
        int t = threadIdx.x; asm volatile("" : "+v"(t)); const int lane = t & 63, w = t >> 6, wm = w >> 1, wn = w & 1, lr = lane & 15, lq = lane >> 4;
        f32x4 acc[4][4]; zero_acc(acc);
        {
            const int mt = tile >> 3, nt = tile & 7, m0 = mt * 256, n0 = nt * 128;
            GemmA A = make_op<4>((const bf16_t*)(P.ws + WS_MEMB), DM, m0, 1024);
            GemmA B = make_op<2>((const bf16_t*)(P.ws + WB_WMEM), 1024, n0, 1024);
            gemm_mainloop_g(lds, A, B, DM / 64, acc);
            bf16_t* KMEM = (bf16_t*)(P.ws + WS_KMEM); bf16_t* VTMEM = (bf16_t*)(P.ws + WS_VTMEM);
#pragma unroll
            for (int i = 0; i < 4; ++i) {
                const int row = m0 + wm * 64 + i * 16 + lr, b = row >> 8, m = row & 255;
#pragma unroll
                for (int jj = 0; jj < 4; ++jj) {
                    const int n = n0 + wn * 64 + jj * 16 + 4 * lq;
                    const int two = n >> 9, h = (n >> 7) & 3, d = n & 127;
                    if (two == 0) *(uint2*)(KMEM + (((size_t)(b * 4 + h) * 256 + m) * 128 + d)) = pack4(acc[i][jj]);
                    else {
#pragma unroll
                        for (int r = 0; r < 4; ++r) VTMEM[((size_t)(b * 4 + h) * 128 + d + r) * 256 + m] = f2bf(acc[i][jj][r]);
                    }
                }
            }
        }
    }
    {
        const int t = threadIdx.x;
        bf16_t* KM = (bf16_t*)(P.ws + WS_KM);
        const int gt = blockIdx.x * NTHR + t, nt = gridDim.x * NTHR;
        for (int i = gt; i < NTOK * 16; i += nt) {
            const int tok = i >> 4, j = i & 15, b = tok >> 13, s = tok & (SEQ - 1);
            const float x1 = bf2f(PROJ[(size_t)tok * DIN + C_KROPE + j]), x2 = bf2f(PROJ[(size_t)tok * DIN + C_KROPE + 16 + j]);
            const float cs = COS[s * 16 + j], sn = SIN[s * 16 + j];
            const bf16_t o1 = f2bf(x1 * cs - x2 * sn), o2 = f2bf(x2 * cs + x1 * sn);
#pragma unroll
            for (int h = 0; h < 8; ++h) {
                bf16_t* kr = KM + ((size_t)(b * 8 + h) * SEQ + s) * 96 + 64;
                kr[j] = o1; kr[16 + j] = o2;
            }
        }
    }
}

__device__ __forceinline__ int offk(int sub, int key, int c) { return sub * 4096 + key * 64 + (((c ^ (-(key >> 2))) & 3) << 4); }
__device__ __forceinline__ int offv(int dv, int ch) { return dv * 128 + (((ch ^ (dv >> 1)) & 7) << 4); }

template <int DK, int DV, bool NEEDV, class KP, class VP, class TL, class FN>
__device__ __forceinline__ void kv_loop(char* lds, int n, KP kp, VP vp, TL tl, FN fn) {
    if (n <= 0) return;
    int t = threadIdx.x; asm volatile("" : "+v"(t));
    const int lane = t & 63, wu = __builtin_amdgcn_readfirstlane(t >> 6);
    constexpr int KPN = DK / 8, VPN = DV / 8, KPT = (KPN + 7) / 8, VPT = (VPN + 7) / 8;
    constexpr int KB = DK * 128, VB = DV * 128;
    LAS char* ldsl = (LAS char*)lds;
#define KVI_(tile, buf) { \
        _Pragma("unroll") for (int i = 0; i < KPT; ++i) { const int p_ = wu + 8 * i, key_ = 16 * (p_ & 3) + (lane >> 2), c_ = ((lane & 3) ^ (-(key_ >> 2))) & 3; \
            if (p_ < KPN) __builtin_amdgcn_global_load_lds((const unsigned*)(kp(tile, key_) + (p_ >> 2) * 32 + c_ * 8), (LAS unsigned*)(ldsl + (buf) * KB + p_ * 1024), 16, 0, 0); } \
        if (NEEDV) { _Pragma("unroll") for (int i = 0; i < VPT; ++i) { const int p_ = wu + 8 * i, dv_ = 8 * p_ + (lane >> 3), ch_ = ((lane & 7) ^ (dv_ >> 1)) & 7; \
            if (p_ < VPN) __builtin_amdgcn_global_load_lds((const unsigned*)(vp(tile, dv_) + ch_ * 8), (LAS unsigned*)(ldsl + 2 * KB + (buf) * VB + p_ * 1024), 16, 0, 0); } } }
    __syncthreads();
    { const int t0 = tl(0); KVI_(t0, 0); }
    asm volatile("s_waitcnt vmcnt(0)" ::: "memory");
    __syncthreads();
#pragma unroll 1
    for (int i = 0; i < n; ++i) {
        const int cur = i & 1, tile = tl(i);
        if (i + 1 < n) { const int tn = tl(i + 1); if (cur) KVI_(tn, 0) else KVI_(tn, 1) }
        fn(tile, (const char*)(lds + cur * KB), (const char*)(lds + 2 * KB + cur * VB));
        asm volatile("s_waitcnt vmcnt(0)" ::: "memory");
        __syncthreads();
    }
#undef KVI_
}

template <int DK, int DV, class KP, class VP, class TL, class FN>
__device__ __forceinline__ void kv_loop2(char* lds, int n, KP kp, VP vp, TL tl, FN fn) {
    if (n <= 0) return;
    int t = threadIdx.x; asm volatile("" : "+v"(t));
    const int lane = t & 63, wu = __builtin_amdgcn_readfirstlane(t >> 6);
    constexpr int KPN = DK / 8, VPN = DV / 8, KPT = (KPN + 7) / 8, VPT = (VPN + 7) / 8;
    constexpr int KB = DK * 128, VB = DV * 128, TB = KB + VB, SB = 2 * TB;
    LAS char* ldsl = (LAS char*)lds;
#define KVI2_(tile, off_) { \
        _Pragma("unroll") for (int i = 0; i < KPT; ++i) { const int p_ = wu + 8 * i, key_ = 16 * (p_ & 3) + (lane >> 2), c_ = ((lane & 3) ^ (-(key_ >> 2))) & 3; \
            if (p_ < KPN) __builtin_amdgcn_global_load_lds((const unsigned*)(kp(tile, key_) + (p_ >> 2) * 32 + c_ * 8), (LAS unsigned*)(ldsl + (off_) + p_ * 1024), 16, 0, 0); } \
        _Pragma("unroll") for (int i = 0; i < VPT; ++i) { const int p_ = wu + 8 * i, dv_ = 8 * p_ + (lane >> 3), ch_ = ((lane & 7) ^ (dv_ >> 1)) & 7; \
            if (p_ < VPN) __builtin_amdgcn_global_load_lds((const unsigned*)(vp(tile, dv_) + ch_ * 8), (LAS unsigned*)(ldsl + (off_) + KB + p_ * 1024), 16, 0, 0); } }
    const int np = (n + 1) >> 1;
    __syncthreads();
    { const int ta = tl(0), tb = tl(n > 1 ? 1 : 0); KVI2_(ta, 0); KVI2_(tb, TB); }
    asm volatile("s_waitcnt vmcnt(0)" ::: "memory");
    __syncthreads();
#pragma unroll 1
    for (int i = 0; i < np; ++i) {
        const int cur = i & 1;
        if (i + 1 < np) { const int ia = 2 * i + 2, ib = (2 * i + 3 < n) ? 2 * i + 3 : ia; const int ta = tl(ia), tb = tl(ib);
            if (cur) { KVI2_(ta, 0); KVI2_(tb, TB); } else { KVI2_(ta, SB); KVI2_(tb, SB + TB); } }
        const char* base = lds + cur * SB;
        const bool hasB = 2 * i + 1 < n;
        fn(tl(2 * i), base, base + KB, tl(hasB ? 2 * i + 1 : 2 * i), base + TB, base + TB + KB, hasB);
        asm volatile("s_waitcnt vmcnt(0)" ::: "memory");
        __syncthreads();
    }
#undef KVI2_
}

template <int DK, int NST>
__device__ __forceinline__ void qk_tile(const char* Kb, const bf16x8 (&qf)[NST][DK / 32], f32x4 (&s)[NST][4], int lane) {
    const int lr = lane & 15, lq = lane >> 4;
#pragma unroll
    for (int kt = 0; kt < 4; ++kt) {
#pragma unroll
        for (int st = 0; st < NST; ++st) s[st][kt] = (f32x4){0.f, 0.f, 0.f, 0.f};
#pragma unroll
        for (int ks = 0; ks < DK / 32; ++ks) {
            const bf16x8 kf = *(const bf16x8*)(Kb + offk(ks, kt * 16 + lr, lq));
#pragma unroll
            for (int st = 0; st < NST; ++st) s[st][kt] = mfma16(kf, qf[st][ks], s[st][kt]);
        }
    }
}
template <int DV, int NST>
__device__ __forceinline__ void pv_tile(const char* Vb, const f32x4 (&p)[NST][4], f32x4 (&O)[NST][DV / 16], int lane) {
    const int lr = lane & 15, lq = lane >> 4;
#pragma unroll
    for (int h2 = 0; h2 < 2; ++h2) {
        bf16x8 pf[NST];
#pragma unroll
        for (int st = 0; st < NST; ++st) {
            const uint2 a = pack4(p[st][2 * h2]), b = pack4(p[st][2 * h2 + 1]);
            const uint4 u = make_uint4(a.x, a.y, b.x, b.y);
            pf[st] = __builtin_bit_cast(bf16x8, u);
        }
#pragma unroll
        for (int dvt = 0; dvt < DV / 16; ++dvt) {
            const int dv = dvt * 16 + lr;
            const bf16x4 v0 = *(const bf16x4*)(Vb + offv(dv, 4 * h2 + (lq >> 1)) + (lq & 1) * 8);
            const bf16x4 v1 = *(const bf16x4*)(Vb + offv(dv, 4 * h2 + 2 + (lq >> 1)) + (lq & 1) * 8);
            const bf16x8 vf = __builtin_shufflevector(v0, v1, 0, 1, 2, 3, 4, 5, 6, 7);
#pragma unroll
            for (int st = 0; st < NST; ++st) O[st][dvt] = mfma16(vf, pf[st], O[st][dvt]);
        }
    }
}
constexpr float RESCALE_AT = 1099511627776.f, RESCALE_BY = 1.f / 1099511627776.f;
template <int DV, int NST>
__device__ __forceinline__ void softmax_online(f32x4 (&s)[NST][4], float (&c)[NST], float (&l)[NST], f32x4 (&O)[NST][DV / 16]) {
    bool scaled = false, big = false;
#pragma unroll
    for (int st = 0; st < NST; ++st) scaled = scaled || (c[st] != 1.f);
#pragma unroll
    for (int st = 0; st < NST; ++st)
#pragma unroll
        for (int kt = 0; kt < 4; ++kt)
#pragma unroll
            for (int r = 0; r < 4; ++r) s[st][kt][r] = fexp2(s[st][kt][r]);
    if (__any(scaled)) {
#pragma unroll
        for (int st = 0; st < NST; ++st)
#pragma unroll
            for (int kt = 0; kt < 4; ++kt) s[st][kt] *= c[st];
    }
#pragma unroll
    for (int st = 0; st < NST; ++st) { l[st] += sum16(s[st]); big = big || (l[st] > RESCALE_AT); }
    if (__any(big)) {
#pragma unroll
        for (int st = 0; st < NST; ++st) {
            const float f = l[st] > RESCALE_AT ? RESCALE_BY : 1.f;
            const float g = quad_min(f);
            l[st] *= g; c[st] *= g;
#pragma unroll
            for (int kt = 0; kt < 4; ++kt) s[st][kt] *= g;
#pragma unroll
            for (int dvt = 0; dvt < DV / 16; ++dvt) O[st][dvt] *= g;
        }
    }
}
__device__ __forceinline__ float quad_lsum(float l) { return quad_sum(l); }

__device__ __forceinline__ void mla_item(const Params& P, char* lds, int b, int h, int qblk) {
    int t = threadIdx.x; asm volatile("" : "+v"(t));
    const int lane = t & 63, w = t >> 6, lr = lane & 15, lq = lane >> 4;
    const bf16_t* QM = (const bf16_t*)(P.ws + WS_QM);
    const bf16_t* KM = (const bf16_t*)(P.ws + WS_KM) + (size_t)(b * 8 + h) * SEQ * 96;
    const bf16_t* VTM = (const bf16_t*)(P.ws + WS_VTM) + (size_t)(b * 8 + h) * 64 * SEQ;
    const int wq0 = qblk * 256 + w * 32;
    bf16x8 qf[2][3];
#pragma unroll
    for (int st = 0; st < 2; ++st)
#pragma unroll
        for (int ks = 0; ks < 3; ++ks) qf[st][ks] = *(const bf16x8*)(QM + (size_t)(b * SEQ + wq0 + st * 16 + lr) * 768 + h * 96 + ks * 32 + lq * 8);
    float m[2] = {1.f, 1.f}, l[2] = {0.f, 0.f};
    f32x4 O[2][4];
#pragma unroll
    for (int st = 0; st < 2; ++st)
#pragma unroll
        for (int d = 0; d < 4; ++d) O[st][d] = (f32x4){0.f, 0.f, 0.f, 0.f};
    auto mla_tile = [&](int tile, const char* Kb, const char* Vb) __attribute__((always_inline)) {
        if (tile * 64 > wq0 + 31) return;
        f32x4 s[2][4];
        qk_tile<96, 2>(Kb, qf, s, lane);
        if (tile * 64 + 63 > wq0) {
#pragma unroll
            for (int st = 0; st < 2; ++st)
#pragma unroll
                for (int kt = 0; kt < 4; ++kt)
#pragma unroll
                    for (int r = 0; r < 4; ++r)
                        if (tile * 64 + kt * 16 + 4 * lq + r > wq0 + st * 16 + lr) s[st][kt][r] = NEGBIG;
        }
        softmax_online<64, 2>(s, m, l, O);
        pv_tile<64, 2>(Vb, s, O, lane);
    };
    kv_loop2<96, 64>(lds, 4 * qblk + 4,
        [&](int tile, int key) __attribute__((always_inline)) { return KM + (size_t)(tile * 64 + key) * 96; },
        [&](int tile, int dv) __attribute__((always_inline)) { return VTM + (size_t)dv * SEQ + tile * 64; },
        [&](int i) __attribute__((always_inline)) { return i; },
        [&](int ta, const char* Ka, const char* Va, int tb, const char* Kb, const char* Vb, bool hasB) __attribute__((always_inline)) {
            mla_tile(ta, Ka, Va);
            if (hasB) mla_tile(tb, Kb, Vb);
        });
    bf16_t* OM = (bf16_t*)(P.ws + WS_OMLA);
#pragma unroll
    for (int st = 0; st < 2; ++st) {
        const float inv = 1.f / quad_lsum(l[st]);
        const size_t tok = (size_t)b * SEQ + wq0 + st * 16 + lr;
#pragma unroll
        for (int d = 0; d < 4; ++d) *(uint2*)(OM + tok * 512 + h * 64 + d * 16 + 4 * lq) = pack4(O[st][d] * inv);
    }
}

__device__ __forceinline__ void mem_item(const Params& P, char* lds, int b, int h, int qblk) {
    int t = threadIdx.x; asm volatile("" : "+v"(t));
    const int lane = t & 63, w = t >> 6, lr = lane & 15, lq = lane >> 4;
    const bf16_t* PROJ = (const bf16_t*)(P.ws + WS_PROJ);
    const bf16_t* KMEM = (const bf16_t*)(P.ws + WS_KMEM) + (size_t)(b * 4 + h) * 256 * 128;
    const bf16_t* VTMEM = (const bf16_t*)(P.ws + WS_VTMEM) + (size_t)(b * 4 + h) * 128 * 256;
    const size_t tok = (size_t)b * SEQ + qblk * 128 + w * 16 + lr;
    bf16x8 qf[1][4];
#pragma unroll
    for (int ks = 0; ks < 4; ++ks) qf[0][ks] = *(const bf16x8*)(PROJ + tok * DIN + C_QMEM + h * 128 + ks * 32 + lq * 8);
    float m[1] = {1.f}, l[1] = {0.f};
    f32x4 O[1][8];
#pragma unroll
    for (int d = 0; d < 8; ++d) O[0][d] = (f32x4){0.f, 0.f, 0.f, 0.f};
    kv_loop<128, 128, true>(lds, 4,
        [&](int tile, int key) __attribute__((always_inline)) { return KMEM + (size_t)(tile * 64 + key) * 128; },
        [&](int tile, int dv) __attribute__((always_inline)) { return VTMEM + (size_t)dv * 256 + tile * 64; },
        [&](int i) __attribute__((always_inline)) { return i; },
        [&](int tile, const char* Kb, const char* Vb) __attribute__((always_inline)) {
            f32x4 s[1][4];
            qk_tile<128, 1>(Kb, qf, s, lane);
            softmax_online<128, 1>(s, m, l, O);
            pv_tile<128, 1>(Vb, s, O, lane);
        });
    bf16_t* OM = (bf16_t*)(P.ws + WS_OMEM);
    const float inv = 1.f / quad_lsum(l[0]);
#pragma unroll
    for (int d = 0; d < 8; ++d) *(uint2*)(OM + tok * 512 + h * 128 + d * 16 + 4 * lq) = pack4(O[0][d] * inv);
}

__device__ __forceinline__ void softmax_stats(const f32x4 (&s)[2][4], float (&c)[2], float (&l)[2]) {
#pragma unroll
    for (int st = 0; st < 2; ++st) {
        f32x4 e[4];
#pragma unroll
        for (int kt = 0; kt < 4; ++kt)
#pragma unroll
            for (int r = 0; r < 4; ++r) e[kt][r] = fexp2(s[st][kt][r]);
        l[st] += sum16(e) * c[st];
        const float g = quad_min(l[st] > RESCALE_AT ? RESCALE_BY : 1.f);
        l[st] *= g; c[st] *= g;
    }
}

template <int NMASK>
__device__ __forceinline__ void nsa_item(const Params& P, char* lds, int b, int g, int q0) {
    int t = threadIdx.x; asm volatile("" : "+v"(t));
    const int lane = t & 63, w = t >> 6, lr = lane & 15, lq = lane >> 4;
    const int hg = g * 4 + (lr & 3);
    const bf16_t* PROJ = (const bf16_t*)(P.ws + WS_PROJ);
    const size_t bg = (size_t)(b * 2 + g);
    const bf16_t* KC = (const bf16_t*)(P.ws + WS_KC) + bg * 512 * 64;
    const bf16_t* VTC = (const bf16_t*)(P.ws + WS_VTC) + bg * 64 * 512;
    const bf16_t* KSLC = (const bf16_t*)(P.ws + WS_KSLC) + bg * SEQ * 64;
    const bf16_t* VTSLC = (const bf16_t*)(P.ws + WS_VTSLC) + bg * 64 * SEQ;
    const bf16_t* KWIN = (const bf16_t*)(P.ws + WS_KWIN) + bg * SEQ * 64;
    const bf16_t* VTWIN = (const bf16_t*)(P.ws + WS_VTWIN) + bg * 64 * SEQ;
    float* imp = (float*)(lds + 65536);
    const float* LUT = (const float*)(lds + LDS_LUT) + 64 * 8;
    unsigned* SEL = (unsigned*)(lds + LDS_SEL);
    unsigned* WOR = (unsigned*)(lds + LDS_WOR);
    unsigned char* TL = (unsigned char*)(lds + LDS_TL);
    int* TLN = (int*)(lds + LDS_TL + 128);
    int tpos[2];
    tpos[0] = q0 + 8 * w + (lr >> 2); tpos[1] = tpos[0] + 4;
    bf16x8 qf[2][2];
#pragma unroll
    for (int st = 0; st < 2; ++st)
#pragma unroll
        for (int ks = 0; ks < 2; ++ks) qf[st][ks] = *(const bf16x8*)(PROJ + (size_t)(b * SEQ + tpos[st]) * DIN + C_QNSA + hg * 64 + ks * 32 + lq * 8);
    auto gate = [&](int st, int k) __attribute__((always_inline)) { return bf2f(PROJ[(size_t)(b * SEQ + tpos[st]) * DIN + C_GNSA + hg * 3 + k]); };
    f32x4 OT[2][4];
#pragma unroll
    for (int i = 0; i < 16; ++i) imp[(8 * w) * 128 + i * 64 + lane] = 0.f;

    const float bfar = LUT[128 * 8 + hg];
    const int ntc = (((q0 + 32) >> 4) >> 6) + 1;
    float m[2] = {1.f, 1.f}, l[2] = {0.f, 0.f};
    auto cmp_mask = [&](int tile, f32x4 (&s)[2][4]) __attribute__((always_inline)) {
#pragma unroll
        for (int st = 0; st < 2; ++st)
#pragma unroll
            for (int kt = 0; kt < 4; ++kt)
#pragma unroll
                for (int r = 0; r < 4; ++r) {
                    const int n = tile * 64 + kt * 16 + 4 * lq + r;
                    const int dist = tpos[st] - (16 * n + 31);
                    const int di = dist < -1 ? -1 : (dist < 128 ? dist : 128);
                    s[st][kt][r] += LUT[di * 8 + hg];
                }
    };
    kv_loop<64, 64, false>(lds, ntc,
        [&](int tile, int key) __attribute__((always_inline)) { return KC + (size_t)(tile * 64 + key) * 64; },
        [&](int tile, int dv) __attribute__((always_inline)) { return VTC; },
        [&](int i) __attribute__((always_inline)) { return i; },
        [&](int tile, const char* Kb, const char* Vb) __attribute__((always_inline)) {
            f32x4 s[2][4];
            const bool farc = q0 + 8 * w - (16 * (tile * 64 + 63) + 31) >= 128;
            qk_tile<64, 2>(Kb, qf, s, lane);
            if (farc) {
#pragma unroll
                for (int st = 0; st < 2; ++st)
#pragma unroll
                    for (int kt = 0; kt < 4; ++kt) s[st][kt] += bfar;
            } else cmp_mask(tile, s);
            softmax_stats(s, m, l);
        });
    float invl[2];
#pragma unroll
    for (int st = 0; st < 2; ++st) { const float lt = quad_lsum(l[st]); invl[st] = lt > 0.f ? m[st] / lt : 0.f; }
#pragma unroll
    for (int st = 0; st < 2; ++st)
#pragma unroll
        for (int d = 0; d < 4; ++d) OT[st][d] = (f32x4){0.f, 0.f, 0.f, 0.f};
    kv_loop<64, 64, true>(lds, ntc,
        [&](int tile, int key) __attribute__((always_inline)) { return KC + (size_t)(tile * 64 + key) * 64; },
        [&](int tile, int dv) __attribute__((always_inline)) { return VTC + (size_t)dv * 512 + tile * 64; },
        [&](int i) __attribute__((always_inline)) { return i; },
        [&](int tile, const char* Kb, const char* Vb) __attribute__((always_inline)) {
            f32x4 s[2][4];
            const bool farc = q0 + 8 * w - (16 * (tile * 64 + 63) + 31) >= 128;
            qk_tile<64, 2>(Kb, qf, s, lane);
            if (farc) {
#pragma unroll
                for (int st = 0; st < 2; ++st)
#pragma unroll
                    for (int kt = 0; kt < 4; ++kt) s[st][kt] += bfar;
            } else cmp_mask(tile, s);
#pragma unroll
            for (int st = 0; st < 2; ++st)
#pragma unroll
                for (int kt = 0; kt < 4; ++kt) {
#pragma unroll
                    for (int r = 0; r < 4; ++r) {
                        s[st][kt][r] = fexp2(s[st][kt][r]) * invl[st];
                    }
                    float ps = (s[st][kt][0] + s[st][kt][1]) + (s[st][kt][2] + s[st][kt][3]);
                    float pc = s[st][kt][3];
                    ps = quad4_sum(ps);
                    pc = quad4_sum(pc);
                    const int j = tile * 16 + kt * 4 + lq;
                    float* row = imp + (8 * w + 4 * st + (lr >> 2)) * 128;
                    if ((lr & 3) == 0) lds_fadd(&row[j], ps);
                    if ((lr & 3) == 0 && j + 1 < 128) lds_fadd(&row[j + 1], pc);
                }
            pv_tile<64, 2>(Vb, s, OT, lane);
        });
#pragma unroll
    for (int st = 0; st < 2; ++st) {
        const float g0 = gate(st, 0);
#pragma unroll
        for (int d = 0; d < 4; ++d) OT[st][d] *= g0;
    }

    {
        unsigned wo0 = 0, wo1 = 0, wo2 = 0, wo3 = 0;
        for (int qi = 0; qi < 8; ++qi) {
            const int tq = q0 + 8 * w + qi, cur = tq >> 6;
            const float v0 = imp[(8 * w + qi) * 128 + lane], v1 = imp[(8 * w + qi) * 128 + 64 + lane];
            const int j0 = lane, j1 = lane + 64;
            bool s0 = (j0 == 0) || (j0 == cur) || (j0 + 1 == cur);
            bool s1 = (j1 == cur) || (j1 + 1 == cur);
            const bool c0 = (j0 >= 1) && (j0 + 2 <= cur), c1 = (j1 + 2 <= cur);
            if (cur - 2 <= 13) { s0 = s0 || c0; s1 = s1 || c1; }
            else {
                const unsigned k0 = c0 ? __float_as_uint(v0) + 1u : 0u, k1 = c1 ? __float_as_uint(v1) + 1u : 0u;
                unsigned T = 0u;
                for (int bit = 30; bit >= 0; --bit) {
                    const unsigned cand = T | (1u << bit);
                    const int cnt = __popcll(__ballot(k0 >= cand)) + __popcll(__ballot(k1 >= cand));
                    if (cnt >= 13) { T = cand; if (cnt == 13) break; }
                }
                const unsigned long long gt0 = __ballot(k0 > T), gt1 = __ballot(k1 > T);
                unsigned long long eq0 = __ballot(k0 == T), eq1 = __ballot(k1 == T);
                int need = 13 - (__popcll(gt0) + __popcll(gt1));
                unsigned long long tk0 = 0ull, tk1 = 0ull;
                while (need > 0 && eq0) { const unsigned long long lowb = eq0 & (0ull - eq0); tk0 |= lowb; eq0 ^= lowb; --need; }
                while (need > 0 && eq1) { const unsigned long long lowb = eq1 & (0ull - eq1); tk1 |= lowb; eq1 ^= lowb; --need; }
                s0 = s0 || ((gt0 | tk0) >> lane) & 1ull;
                s1 = s1 || ((gt1 | tk1) >> lane) & 1ull;
            }
            const unsigned long long b0 = __ballot(s0), b1 = __ballot(s1);
            if (lane == 0) {
                SEL[(8 * w + qi) * 4 + 0] = (unsigned)b0; SEL[(8 * w + qi) * 4 + 1] = (unsigned)(b0 >> 32);
                SEL[(8 * w + qi) * 4 + 2] = (unsigned)b1; SEL[(8 * w + qi) * 4 + 3] = (unsigned)(b1 >> 32);
            }
            wo0 |= (unsigned)b0; wo1 |= (unsigned)(b0 >> 32); wo2 |= (unsigned)b1; wo3 |= (unsigned)(b1 >> 32);
        }
        if (lane == 0) { WOR[w * 4 + 0] = wo0; WOR[w * 4 + 1] = wo1; WOR[w * 4 + 2] = wo2; WOR[w * 4 + 3] = wo3; }
    }
    __syncthreads();
    if (w == 0) {
        unsigned o0 = 0u, o1 = 0u, o2 = 0u, o3 = 0u;
#pragma unroll
        for (int ww = 0; ww < NWV; ++ww) { o0 |= WOR[ww * 4 + 0]; o1 |= WOR[ww * 4 + 1]; o2 |= WOR[ww * 4 + 2]; o3 |= WOR[ww * 4 + 3]; }
        const bool n0 = ((lane < 32 ? o0 : o1) >> (lane & 31)) & 1u, n1 = ((lane < 32 ? o2 : o3) >> (lane & 31)) & 1u;
        const unsigned long long m0 = __ballot(n0), m1 = __ballot(n1);
        const unsigned long long below = (1ull << lane) - 1ull;
        const int c0 = __popcll(m0);
        if (n0) TL[__popcll(m0 & below)] = (unsigned char)lane;
        if (n1) TL[c0 + __popcll(m1 & below)] = (unsigned char)(64 + lane);
        if (lane == 0) *TLN = c0 + __popcll(m1);
    }
    __syncthreads();
    const int nts = *TLN;
    f32x4* ST = (f32x4*)(lds + 65536);
#pragma unroll
    for (int k = 0; k < 8; ++k) ST[k * NTHR + t] = OT[k >> 2][k & 3];

    if (NMASK & 2)
    {
        f32x4 Oa[1][4], Ob[1][4];
#pragma unroll
        for (int d = 0; d < 4; ++d) { Oa[0][d] = (f32x4){0.f, 0.f, 0.f, 0.f}; Ob[0][d] = (f32x4){0.f, 0.f, 0.f, 0.f}; }
        float ca[1] = {1.f}, cb[1] = {1.f}, la[1] = {0.f}, lb[1] = {0.f};
        bf16x8 qfa[1][2], qfb[1][2];
#pragma unroll
        for (int ks = 0; ks < 2; ++ks) { qfa[0][ks] = qf[0][ks]; qfb[0][ks] = qf[1][ks]; }
        auto proc = [&](int tile, const char* Kb, const char* Vb, const bf16x8 (&q1)[1][2], f32x4 (&O1)[1][4], float (&c1)[1], float (&l1)[1], bool on, int tp) __attribute__((always_inline)) {
            f32x4 s[1][4];
            qk_tile<64, 1>(Kb, q1, s, lane);
            const bool far = tile * 64 + 63 + 128 <= q0 + 8 * w;
            if (far) {
                const float ab = on ? bfar : NEGBIG;
#pragma unroll
                for (int kt = 0; kt < 4; ++kt) s[0][kt] += ab;
            } else {
                int D = tp - (tile * 64 + 4 * lq); D = D < 191 ? D : 191; D = on ? D : -1;
                const float* lp = LUT + (D - 63) * 8 + hg;
#pragma unroll
                for (int kt = 0; kt < 4; ++kt)
#pragma unroll
                    for (int r = 0; r < 4; ++r) s[0][kt][r] += lp[(63 - (kt * 16 + r)) * 8];
            }
            softmax_online<64, 1>(s, c1, l1, O1);
            pv_tile<64, 1>(Vb, s, O1, lane);
        };
        auto s_tile = [&](int tile, const char* Kb, const char* Vb) __attribute__((always_inline)) {
            const unsigned wv = WOR[w * 4 + (tile >> 5)];
            if (!((wv >> (tile & 31)) & 1u)) return;
            const bool on0 = (SEL[(8 * w + (lr >> 2)) * 4 + (tile >> 5)] >> (tile & 31)) & 1u;
            const bool on1 = (SEL[(8 * w + 4 + (lr >> 2)) * 4 + (tile >> 5)] >> (tile & 31)) & 1u;
            if (__any(on0)) proc(tile, Kb, Vb, qfa, Oa, ca, la, on0, tpos[0]);
            if (__any(on1)) proc(tile, Kb, Vb, qfb, Ob, cb, lb, on1, tpos[1]);
        };
        kv_loop2<64, 64>(lds, nts,
            [&](int tile, int key) __attribute__((always_inline)) { return KSLC + (size_t)(tile * 64 + key) * 64; },
            [&](int tile, int dv) __attribute__((always_inline)) { return VTSLC + (size_t)dv * SEQ + tile * 64; },
            [&](int i) __attribute__((always_inline)) { return (int)TL[i]; },
            [&](int ta, const char* Ka, const char* Va, int tb, const char* Kb, const char* Vb, bool hasB) __attribute__((always_inline)) {
                s_tile(ta, Ka, Va);
                if (hasB) s_tile(tb, Kb, Vb);
            });
        {
            const float lt = quad_lsum(la[0]);
            const float f = lt > 0.f ? gate(0, 1) / lt : 0.f;
#pragma unroll
            for (int d = 0; d < 4; ++d) ST[d * NTHR + t] += Oa[0][d] * f;
        }
        {
            const float lt = quad_lsum(lb[0]);
            const float f = lt > 0.f ? gate(1, 1) / lt : 0.f;
#pragma unroll
            for (int d = 0; d < 4; ++d) ST[(4 + d) * NTHR + t] += Ob[0][d] * f;
        }
    }
    if (NMASK & 4) {
        f32x4 O[2][4];
#pragma unroll
        for (int st = 0; st < 2; ++st)
#pragma unroll
            for (int d = 0; d < 4; ++d) O[st][d] = (f32x4){0.f, 0.f, 0.f, 0.f};
        m[0] = 1.f; m[1] = 1.f; l[0] = 0.f; l[1] = 0.f;
        const int tw0 = (q0 - 511 > 0 ? q0 - 511 : 0) >> 6, tw1 = (q0 + 63) >> 6;
        kv_loop<64, 64, true>(lds, tw1 - tw0 + 1,
            [&](int tile, int key) __attribute__((always_inline)) { return KWIN + (size_t)(tile * 64 + key) * 64; },
            [&](int tile, int dv) __attribute__((always_inline)) { return VTWIN + (size_t)dv * SEQ + tile * 64; },
            [&](int i) __attribute__((always_inline)) { return tw0 + i; },
            [&](int tile, const char* Kb, const char* Vb) __attribute__((always_inline)) {
                f32x4 s[2][4];
                const bool mid = q0 + 8 * w - (tile * 64 + 63) >= 128 && q0 + 8 * w + 7 - tile * 64 < 512;
                qk_tile<64, 2>(Kb, qf, s, lane);
                if (mid) {
#pragma unroll
                    for (int st = 0; st < 2; ++st)
#pragma unroll
                        for (int kt = 0; kt < 4; ++kt) s[st][kt] += bfar;
                } else if (q0 + 8 * w - (tile * 64 + 63) < 128) {
#pragma unroll
                    for (int st = 0; st < 2; ++st) {
                        int D = tpos[st] - (tile * 64 + 4 * lq); D = D < 191 ? D : 191;
                        const float* lp = LUT + (D - 63) * 8 + hg;
#pragma unroll
                        for (int kt = 0; kt < 4; ++kt)
#pragma unroll
                            for (int r = 0; r < 4; ++r) s[st][kt][r] += lp[(63 - (kt * 16 + r)) * 8];
                    }
                } else {
#pragma unroll
                    for (int st = 0; st < 2; ++st)
#pragma unroll
                        for (int kt = 0; kt < 4; ++kt)
#pragma unroll
                            for (int r = 0; r < 4; ++r) {
                                const int dist = tpos[st] - (tile * 64 + kt * 16 + 4 * lq + r);
                                s[st][kt][r] = dist < 512 ? s[st][kt][r] + bfar : NEGBIG;
                            }
                }
                softmax_online<64, 2>(s, m, l, O);
                pv_tile<64, 2>(Vb, s, O, lane);
            });
#pragma unroll
        for (int st = 0; st < 2; ++st) {
            const float lt = quad_lsum(l[st]);
            const float f = lt > 0.f ? gate(st, 2) / lt : 0.f;
            bf16_t* ON = (bf16_t*)(P.ws + WS_ONSA);
#pragma unroll
            for (int d = 0; d < 4; ++d)
                *(uint2*)(ON + (size_t)(b * SEQ + tpos[st]) * 512 + hg * 64 + d * 16 + 4 * lq) = pack4(ST[(st * 4 + d) * NTHR + t] + O[st][d] * f);
        }
    }
}

#ifndef P3SEL
#define P3SEL 7
#endif
#ifndef NSADUP
#define NSADUP 7
#endif
__device__ __forceinline__ void convert_experts(const Params& P, char* lds, int tbeg, int tend, int b0, int st);
constexpr int CONV_CHUNKS3 = NEA * 96 / 4;
template <int QOFF, int SEL>
__device__ __forceinline__ void phase3(const Params& P, char* lds) {
    unsigned* ctl = (unsigned*)(P.ws + WS_CTL);
    unsigned* chead = &ctl[QOFF + CTL_Q + 448];
#define P3_QUEUE(head_, n_, call_) { int it = queue_pop(head_, lds); while (it < (n_)) { \
        unsigned nx_ = 0u, cx_ = 0u; if (threadIdx.x == 0) { nx_ = atomicAdd(head_, 1u); cx_ = atomicAdd(chead, 1u); } \
        call_; \
        __syncthreads(); if (threadIdx.x == 0) { *(volatile int*)(lds + LDS_ITEM) = (int)nx_; *(volatile int*)(lds + LDS_ITEM + 4) = (int)cx_; } __syncthreads(); \
        it = __builtin_amdgcn_readfirstlane(*(volatile int*)(lds + LDS_ITEM)); \
        { const int cc_ = __builtin_amdgcn_readfirstlane(*(volatile int*)(lds + LDS_ITEM + 4)); if (cc_ < CONV_CHUNKS3) convert_experts(P, lds, cc_ * 4, cc_ * 4 + 4, 0, 1); } } }
    if (SEL & 1) P3_QUEUE(&ctl[QOFF + CTL_Q + 64], 1024, mla_item(P, lds, (it & 31) >> 3, it & 7, 31 - (it >> 5)))
    if (SEL & 2) P3_QUEUE(&ctl[QOFF + CTL_Q + 128], 1024, (nsa_item<(QOFF == 0 ? 7 : NSADUP)>(P, lds, (it & 7) >> 1, it & 1, (127 - (it >> 3)) * 64)))
    if (SEL & 4) P3_QUEUE(&ctl[QOFF + CTL_Q + 192], 1024, mem_item(P, lds, it >> 8, (it >> 6) & 3, it & 63))
#undef P3_QUEUE
    for (;;) { const int cc = queue_pop(chead, lds); if (cc >= CONV_CHUNKS3) break; convert_experts(P, lds, cc * 4, cc * 4 + 4, 0, 1); }
}

__device__ __forceinline__ void phase4(const Params& P, char* lds) {
    const bf16_t* PROJ = (const bf16_t*)(P.ws + WS_PROJ);
    bf16_t* MERGED = (bf16_t*)(P.ws + WS_MERGED);
    int ring = 0; bool primed = false;
    auto tile_mn = [&](int tile, int& m0, int& n0) __attribute__((always_inline)) {
        const int bb = tile & 255, rnd = tile >> 8, xg = bb & 7, rr = bb >> 3;
        const int mt = (xg + 8 * rnd) * 4 + (rr & 3), nt = rr >> 2; m0 = mt * 256; n0 = nt * 128;
    };
    for (int tile = blockIdx.x; tile < 1024; tile += gridDim.x) {
        int t = threadIdx.x; asm volatile("" : "+v"(t)); const int lane = t & 63, w = t >> 6, wm = w >> 1, wn = w & 1, lr = lane & 15, lq = lane >> 4;
        int m0, n0; tile_mn(tile, m0, n0);
        const bool last_tile = tile + (int)gridDim.x >= 1024;
        f32x4 tot[4][4]; zero_acc(tot);
#pragma unroll 1
        for (int br = 0; br < 3; ++br) {
            f32x4 acc[4][4]; zero_acc(acc);
            GemmA A = make_op<4>((const bf16_t*)(P.ws + WS_ONSA + (size_t)br * 32 * MBY), 512, m0, NTOK);
            GemmA B = make_op<2, true>((const bf16_t*)(P.ws + WB_WBR) + (size_t)br * 1024 * 512, 512, n0, 1024);
            const bool chain = !(br == 2 && last_tile);
            int m1 = m0, n1 = n0; const int br1 = br == 2 ? 0 : br + 1;
            if (br == 2 && !last_tile) tile_mn(tile + gridDim.x, m1, n1);
            GemmA An = make_op<4>((const bf16_t*)(P.ws + WS_ONSA + (size_t)br1 * 32 * MBY), 512, m1, NTOK);
            GemmA Bn = make_op<2, true>((const bf16_t*)(P.ws + WB_WBR) + (size_t)br1 * 1024 * 512, 512, n1, 1024);
            gemm_mainloop_c(lds, A, B, 512 / 64, acc, ring, primed, chain, An, Bn);
            primed = chain;
#pragma unroll
            for (int i = 0; i < 4; ++i) {
                const size_t tok = m0 + wm * 64 + i * 16 + lr;
#pragma unroll
                for (int jp = 0; jp < 2; ++jp) {
                    const int n = n0 + wn * 64 + jp * 32 + 8 * lq;
                    const uint4 gv = *(const uint4*)(PROJ + tok * DIN + C_GMERGE + br * 1024 + n);
                    tot[i][2 * jp][0] += bflo(gv.x) * acc[i][2 * jp][0]; tot[i][2 * jp][1] += bfhi(gv.x) * acc[i][2 * jp][1];
                    tot[i][2 * jp][2] += bflo(gv.y) * acc[i][2 * jp][2]; tot[i][2 * jp][3] += bfhi(gv.y) * acc[i][2 * jp][3];
                    tot[i][2 * jp + 1][0] += bflo(gv.z) * acc[i][2 * jp + 1][0]; tot[i][2 * jp + 1][1] += bfhi(gv.z) * acc[i][2 * jp + 1][1];
                    tot[i][2 * jp + 1][2] += bflo(gv.w) * acc[i][2 * jp + 1][2]; tot[i][2 * jp + 1][3] += bfhi(gv.w) * acc[i][2 * jp + 1][3];
                }
            }
        }
#pragma unroll
        for (int i = 0; i < 4; ++i) {
            const size_t tok = m0 + wm * 64 + i * 16 + lr;
#pragma unroll
            for (int jp = 0; jp < 2; ++jp) { const uint2 x = pack4(tot[i][2 * jp]), y = pack4(tot[i][2 * jp + 1]); *(uint4*)(MERGED + tok * DM + n0 + wn * 64 + jp * 32 + 8 * lq) = make_uint4(x.x, x.y, y.x, y.y); }
        }
    }
}

struct EpiY1 {
    const bf16_t* H0; bf16_t* Y1;
    __device__ __forceinline__ bool operator()(f32x4 (&acc)[2][2][4][2], const pg8::Unit& u, int, int wr, int wc, int fr, int fq) const {
#pragma unroll
        for (int ai = 0; ai < 2; ++ai)
#pragma unroll
            for (int m = 0; m < 4; ++m) {
                const size_t tok = (size_t)u.pm * 256 + ai * 128 + wr * 64 + m * 16 + fr;
#pragma unroll
                for (int bj = 0; bj < 2; ++bj) {
                    const int col = u.pn * 256 + bj * 128 + wc * 32 + 8 * fq;
                    const uint4 hv = *(const uint4*)(H0 + tok * DM + col);
                    f32x4 v0 = acc[ai][bj][m][0], v1 = acc[ai][bj][m][1];
                    v0[0] += ALPHA * bflo(hv.x); v0[1] += ALPHA * bfhi(hv.x); v0[2] += ALPHA * bflo(hv.y); v0[3] += ALPHA * bfhi(hv.y);
                    v1[0] += ALPHA * bflo(hv.z); v1[1] += ALPHA * bfhi(hv.z); v1[2] += ALPHA * bflo(hv.w); v1[3] += ALPHA * bfhi(hv.w);
                    const uint2 a = pack4(v0), c = pack4(v1);
                    *(uint4*)(Y1 + tok * H1LD + col) = make_uint4(a.x, a.y, c.x, c.y);
                }
            }
        return false;
    }
};
__device__ __forceinline__ void phase5a(const Params& P, char* lds) {
    pg8::DenseProv PV; PV.S.init(NTOK, DM, gridDim.x, blockIdx.x);
    PV.A = (const bf16_t*)(P.ws + WS_MERGED); PV.Bt = (const bf16_t*)(P.ws + WB_WOUT); PV.lda = DM; PV.ldb = DM; PV.perm = true;
    EpiY1 E; E.H0 = (const bf16_t*)(P.ws + WS_H0); E.Y1 = (bf16_t*)(P.ws + WS_Y1);
    pg8::gemm_phase((LAS unsigned char*)lds, DM, PV, E);
}

template <int MODE>
__device__ __forceinline__ void phase5b(const Params& P, char* lds) {
    const int t = threadIdx.x, lane = t & 63, w = t >> 6;
    const int gw = blockIdx.x * NWV + w, nw = gridDim.x * NWV;
    bf16_t* H1 = (bf16_t*)P.out; bf16_t* H1LO = (bf16_t*)(P.ws + WS_Y1);
    if (MODE == 0) for (int row0 = gw; row0 < NTOK; row0 += 2 * nw) {
        const int row1 = row0 + nw; const bool has1 = row1 < NTOK;
        const bf16_t* yb = (const bf16_t*)(P.ws + WS_Y1);
        uint4 raw[2][2];
#pragma unroll
        for (int u = 0; u < 2; ++u)
#pragma unroll
            for (int i = 0; i < 2; ++i) raw[u][i] = *(const uint4*)(yb + (size_t)((u && has1) ? row1 : row0) * H1LD + i * 512 + 8 * lane);
        float v[2][16]; float s[2] = {0.f, 0.f};
#pragma unroll
        for (int u = 0; u < 2; ++u)
#pragma unroll
            for (int i = 0; i < 2; ++i) {
                v[u][8 * i + 0] = bflo(raw[u][i].x); v[u][8 * i + 1] = bfhi(raw[u][i].x); v[u][8 * i + 2] = bflo(raw[u][i].y); v[u][8 * i + 3] = bfhi(raw[u][i].y);
                v[u][8 * i + 4] = bflo(raw[u][i].z); v[u][8 * i + 5] = bfhi(raw[u][i].z); v[u][8 * i + 6] = bflo(raw[u][i].w); v[u][8 * i + 7] = bfhi(raw[u][i].w);
            }
#pragma unroll
        for (int u = 0; u < 2; ++u)
#pragma unroll
            for (int k = 0; k < 16; ++k) s[u] += v[u][k];
        const float mu[2] = {wave_sum(s[0]) * (1.f / DM), wave_sum(s[1]) * (1.f / DM)};
        float q[2] = {0.f, 0.f};
#pragma unroll
        for (int u = 0; u < 2; ++u)
#pragma unroll
            for (int k = 0; k < 16; ++k) { const float d = v[u][k] - mu[u]; q[u] += d * d; }
        const float rstd[2] = {rsqrtf(wave_sum(q[0]) * (1.f / DM) + 1e-5f), rsqrtf(wave_sum(q[1]) * (1.f / DM) + 1e-5f)};
#pragma unroll
        for (int i = 0; i < 2; ++i) {
            const float4 g0 = ((const float4*)P.ln1_g)[i * 128 + 2 * lane], g1 = ((const float4*)P.ln1_g)[i * 128 + 2 * lane + 1];
            const float4 b0 = ((const float4*)P.ln1_b)[i * 128 + 2 * lane], b1 = ((const float4*)P.ln1_b)[i * 128 + 2 * lane + 1];
            const float gg[8] = {g0.x, g0.y, g0.z, g0.w, g1.x, g1.y, g1.z, g1.w}, bb[8] = {b0.x, b0.y, b0.z, b0.w, b1.x, b1.y, b1.z, b1.w};
#pragma unroll
            for (int u = 0; u < 2; ++u) {
                const int row = u ? row1 : row0;
                float h[8];
#pragma unroll
                for (int k = 0; k < 8; ++k) h[k] = (v[u][8 * i + k] - mu[u]) * rstd[u] * gg[k] + bb[k];
                const uint4 hi = make_uint4(pack2(h[0], h[1]), pack2(h[2], h[3]), pack2(h[4], h[5]), pack2(h[6], h[7]));
                const uint4 lo = make_uint4(pack2(h[0] - bflo(hi.x), h[1] - bfhi(hi.x)), pack2(h[2] - bflo(hi.y), h[3] - bfhi(hi.y)),
                                            pack2(h[4] - bflo(hi.z), h[5] - bfhi(hi.z)), pack2(h[6] - bflo(hi.w), h[7] - bfhi(hi.w)));
                if (u == 0 || has1) {
                    *(uint4*)(H1 + (size_t)row * H1LD + i * 512 + 8 * lane) = hi;
                    *(uint4*)(H1LO + (size_t)row * H1LD + i * 512 + 8 * lane) = lo;
                }
            }
        }
    }
}

#ifndef CONV_SPLIT
#define CONV_SPLIT 18432
#endif
__device__ __forceinline__ void convert_experts(const Params& P, char* lds, int tbeg, int tend, int b0, int st) {
    const int t = threadIdx.x;
    const int tt = t & 255, sub = t >> 8, kg = tt >> 5, n4 = tt & 31;
    char* tb = lds + sub * 16384;
    const int NT_ = tend, step = st * 2;
    __syncthreads();
    for (int tile0 = tbeg + b0 * 2; tile0 < NT_; tile0 += 2 * step) {
        float4 r[2][8]; const float* srcs[2]; bf16_t* dsts[2]; int lddv[2], kt0v[2], nt0v[2]; bool hasv[2];
#pragma unroll
        for (int q = 0; q < 2; ++q) {
            const int tile_ = tile0 + q * step + sub; hasv[q] = tile_ < NT_;
            const int tile = hasv[q] ? tile_ : tile0 + sub;
            const int mat = tile >> 5, loc = tile & 31, e = mat / 3, which = mat - e * 3;
            srcs[q] = (which == 0 ? P.exp_w1 : which == 1 ? P.exp_w3 : P.exp_w2) + (size_t)e * 262144;
            dsts[q] = (bf16_t*)expw_ptr(P.ws, e) + which * 262144;
            const int N = which == 2 ? 1024 : 256; lddv[q] = which == 2 ? 256 : 1024;
            kt0v[q] = (which == 2 ? (loc >> 3) : (loc >> 1)) * 64; nt0v[q] = (which == 2 ? (loc & 7) : (loc & 1)) * 128;
            const int k0 = kt0v[q] + kg * 8, n = nt0v[q] + n4 * 4;
#pragma unroll
            for (int kk = 0; kk < 8; ++kk) r[q][kk] = *(const float4*)(srcs[q] + (size_t)(k0 + kk) * N + n);
        }
#pragma unroll
        for (int q = 0; q < 2; ++q) {
#pragma unroll
            for (int c = 0; c < 4; ++c) {
                float v[8];
#pragma unroll
                for (int kk = 0; kk < 8; ++kk) v[kk] = (c == 0) ? r[q][kk].x : (c == 1) ? r[q][kk].y : (c == 2) ? r[q][kk].z : r[q][kk].w;
                *(uint4*)(tb + swz(4 * n4 + c, kg)) = make_uint4(pack2(v[0], v[1]), pack2(v[2], v[3]), pack2(v[4], v[5]), pack2(v[6], v[7]));
            }
            __syncthreads();
            if (hasv[q]) {
#pragma unroll
                for (int i = 0; i < 4; ++i) {
                    const int row = (tt >> 3) + 32 * i, ch = tt & 7;
                    *(uint4*)(dsts[q] + (size_t)(nt0v[q] + row) * lddv[q] + kt0v[q] + ch * 8) = *(const uint4*)(tb + swz(row, ch));
                }
            }
            __syncthreads();
        }
    }
}

__device__ __forceinline__ unsigned long long ord_key(float v, int e) {
    unsigned u = __float_as_uint(v); u = (u & 0x80000000u) ? ~u : (u | 0x80000000u);
    return ((unsigned long long)u << 8) | (unsigned)(255 - e);
}
template <bool NOWRITE>
__device__ __forceinline__ void phase5d(const Params& P, char* lds) {
    const bool conv_first5 = ((blockIdx.x >> 3) & 1) != 0;
    if (!NOWRITE && conv_first5) convert_experts(P, lds, CONV_SPLIT, 768 * 32, blockIdx.x, gridDim.x);
    const int t = threadIdx.x, lane = t & 63, w = t >> 6;
    const int gw = blockIdx.x * NWV + w, nw = gridDim.x * NWV;
    const float* LOGITS = (const float*)(P.ws + WS_LOGITS);
    unsigned* ctl = (unsigned*)(P.ws + WS_CTL);
    int* EID = (int*)(P.ws + WS_EID); float* EW = (float*)(P.ws + WS_EW); int* LIST = (int*)(P.ws + WS_LIST);
    const float4 rb = ((const float4*)P.router_b)[lane];
    float4 lgn = ((const float4*)(LOGITS + (size_t)(gw < NTOK ? gw : 0) * 256))[lane];
    for (int tok = gw; tok < NTOK; tok += nw) {
        const float4 lg = lgn;
        { const int tn = tok + nw < NTOK ? tok + nw : tok; lgn = ((const float4*)(LOGITS + (size_t)tn * 256))[lane]; }
        float s[4] = {sigmoidf_(lg.x), sigmoidf_(lg.y), sigmoidf_(lg.z), sigmoidf_(lg.w)};
        float sb[4] = {s[0] + rb.x, s[1] + rb.y, s[2] + rb.z, s[3] + rb.w};
        float a = fmaxf(sb[0], sb[1]), bq = fminf(sb[0], sb[1]);
        { const float a2 = fmaxf(sb[2], sb[3]), b2 = fminf(sb[2], sb[3]); const float na = fmaxf(a, a2); bq = fmaxf(fminf(a, a2), fmaxf(bq, b2)); a = na; }
#define DPPF_(x, ctrl) __uint_as_float(__builtin_amdgcn_update_dpp(0u, __float_as_uint(x), ctrl, 0xF, 0xF, true))
        { const float a2 = DPPF_(a, 0xB1), b2 = DPPF_(bq, 0xB1); const float na = fmaxf(a, a2); bq = fmaxf(fminf(a, a2), fmaxf(bq, b2)); a = na; }
        { const float a2 = DPPF_(a, 0x4E), b2 = DPPF_(bq, 0x4E); const float na = fmaxf(a, a2); bq = fmaxf(fminf(a, a2), fmaxf(bq, b2)); a = na; }
        { const float a2 = DPPF_(a, 0x141), b2 = DPPF_(bq, 0x141); const float na = fmaxf(a, a2); bq = fmaxf(fminf(a, a2), fmaxf(bq, b2)); a = na; }
#undef DPPF_
        const float gs = a + bq; const int grp = lane >> 3;
        int rank = 0;
#pragma unroll
        for (int g2 = 0; g2 < 8; ++g2) { const float o = __uint_as_float(__builtin_amdgcn_readlane(__float_as_uint(gs), g2 * 8)); rank += (o > gs || (o == gs && g2 < grp)) ? 1 : 0; }
        const bool gsel = rank < 4;
        float v[4];
#pragma unroll
        for (int i = 0; i < 4; ++i) v[i] = gsel ? sb[i] : -3.0e38f;
        int my_e = 0; float my_s = 0.f, wsum = 0.f;
        for (int r = 0; r < 8; ++r) {
            float bv = v[0]; int bi = 0;
#pragma unroll
            for (int i = 1; i < 4; ++i) if (v[i] > bv) { bv = v[i]; bi = i; }
            const float wm = wave_max(bv);
            const int wl = __builtin_amdgcn_readfirstlane(__ffsll((long long)__ballot(bv == wm)) - 1);
            const int wi = __builtin_amdgcn_readlane(bi, wl);
            const float mine = bi == 0 ? s[0] : bi == 1 ? s[1] : bi == 2 ? s[2] : s[3];
            const float sv = __uint_as_float(__builtin_amdgcn_readlane(__float_as_uint(mine), wl));
            if (lane == wl) { if (bi == 0) v[0] = -3.0e38f; else if (bi == 1) v[1] = -3.0e38f; else if (bi == 2) v[2] = -3.0e38f; else v[3] = -3.0e38f; }
            wsum += sv;
            if (lane == r) { my_e = wl * 4 + wi; my_s = sv; }
        }
        if (NOWRITE) { asm volatile("" :: "v"(my_e), "v"(my_s), "v"(wsum)); }
        else if (lane < 8) {
            const float wv = my_s / wsum * 2.5f;
            EID[tok * 8 + lane] = my_e; EW[tok * 8 + lane] = wv;
            const unsigned pos = atomicAdd(&ctl[CTL_CNT + my_e * 16], 1u);
            LIST[(size_t)my_e * NTOK + pos] = tok * 8 + lane;
        }
    }
    if (!NOWRITE && !conv_first5) convert_experts(P, lds, CONV_SPLIT, 768 * 32, blockIdx.x, gridDim.x);
}

struct ProvUp {
    const char* h1; const char* wb; const int* aid;
    __device__ __forceinline__ void offsets(unsigned (&va)[2][2], unsigned (&vb)[2][2], const int (&sR)[2], const int (&sC)[2]) const {
#pragma unroll
        for (int h = 0; h < 2; ++h)
#pragma unroll
            for (int p = 0; p < 2; ++p) {
                va[h][p] = (unsigned)(((size_t)(aid[h * 128 + sR[p]] >> 3) * H1LD + sC[p]) * 2);
                vb[h][p] = (unsigned)(((size_t)h * 262144 + (size_t)((sR[p] & ~31) + pg8::perm32(sR[p] & 31)) * 1024 + sC[p]) * 2);
            }
    }
    __device__ __forceinline__ bool get(int i, pg8::Unit& u, pg8::Ops& o) const {
        if (i >= 2) return false;
        u.pm = 0; u.pn = i; o.A = h1; o.B = wb + (size_t)i * 128 * 1024 * 2;
        return true;
    }
};
struct EpiUp {
    bf16_t* scr;
    __device__ __forceinline__ bool operator()(f32x4 (&acc)[2][2][4][2], const pg8::Unit& u, int, int wr, int wc, int fr, int fq) const {
#pragma unroll
        for (int ai = 0; ai < 2; ++ai)
#pragma unroll
            for (int m = 0; m < 4; ++m) {
                const int row = ai * 128 + wr * 64 + m * 16 + fr;
                f32x4 v0, v1;
#pragma unroll
                for (int r = 0; r < 4; ++r) { v0[r] = siluf_(acc[ai][0][m][0][r]) * acc[ai][1][m][0][r]; v1[r] = siluf_(acc[ai][0][m][1][r]) * acc[ai][1][m][1][r]; }
                const uint2 a = pack4(v0), c = pack4(v1);
                *(uint4*)(scr + row * 256 + u.pn * 128 + wc * 32 + 8 * fq) = make_uint4(a.x, a.y, c.x, c.y);
            }
        return false;
    }
};
struct ProvDown {
    const char* scr; const char* w2t;
    __device__ __forceinline__ void offsets(unsigned (&va)[2][2], unsigned (&vb)[2][2], const int (&sR)[2], const int (&sC)[2]) const {
#pragma unroll
        for (int h = 0; h < 2; ++h)
#pragma unroll
            for (int p = 0; p < 2; ++p) { va[h][p] = (unsigned)(((h * 128 + sR[p]) * 256 + sC[p]) * 2); vb[h][p] = (unsigned)(((h * 128 + (sR[p] & ~31) + pg8::perm32(sR[p] & 31)) * 256 + sC[p]) * 2); }
    }
    __device__ __forceinline__ bool get(int i, pg8::Unit& u, pg8::Ops& o) const {
        if (i >= 4) return false;
        u.pm = 0; u.pn = i; o.A = scr; o.B = w2t + (size_t)i * 256 * 256 * 2;
        return true;
    }
};
struct EpiDown {
    bf16_t* Y; bf16_t* SHOUT; const int* aid; int rows; bool routed;
    __device__ __forceinline__ bool operator()(f32x4 (&acc)[2][2][4][2], const pg8::Unit& u, int, int wr, int wc, int fr, int fq) const {
#pragma unroll
        for (int ai = 0; ai < 2; ++ai)
#pragma unroll
            for (int m = 0; m < 4; ++m) {
                const int row = ai * 128 + wr * 64 + m * 16 + fr;
                if (row < rows) {
                    const int a = aid[row];
                    bf16_t* dst = (routed ? (Y + (size_t)a * DM) : (SHOUT + (size_t)(a >> 3) * H1LD)) + u.pn * 256 + wc * 32 + 8 * fq;
#pragma unroll
                    for (int bj = 0; bj < 2; ++bj) { const uint2 x = pack4(acc[ai][bj][m][0]), y = pack4(acc[ai][bj][m][1]); *(uint4*)(dst + bj * 128) = make_uint4(x.x, x.y, y.x, y.y); }
                }
            }
        return false;
    }
};
struct ProvRouter {
    const char* hi; const char* lo; const char* whi; const char* wlo; int tile0, tstep;
    __device__ __forceinline__ void offsets(unsigned (&va)[2][2], unsigned (&vb)[2][2], const int (&sR)[2], const int (&sC)[2]) const {
#pragma unroll
        for (int h = 0; h < 2; ++h)
#pragma unroll
            for (int p = 0; p < 2; ++p) { va[h][p] = (unsigned)(((size_t)(h * 128 + sR[p]) * H1LD + sC[p]) * 2); vb[h][p] = (unsigned)(((size_t)(h * 128 + sR[p]) * 1024 + sC[p]) * 2); }
    }
    __device__ __forceinline__ bool get(int i, pg8::Unit& u, pg8::Ops& o) const {
        const int q = i / 3, seg = i - q * 3, ot = tile0 + q * tstep;
        if (ot >= 128) return false;
        u.pm = ot; u.pn = seg;
        o.A = (seg == 1 ? lo : hi) + (size_t)ot * 256 * H1LD * 2; o.B = seg == 0 ? wlo : whi;
        return true;
    }
};
struct EpiRouter {
    float* LOGITS;
    __device__ __forceinline__ bool operator()(f32x4 (&acc)[2][2][4][2], const pg8::Unit& u, int, int wr, int wc, int fr, int fq) const {
        if (u.pn < 2) return true;
#pragma unroll
        for (int ai = 0; ai < 2; ++ai)
#pragma unroll
            for (int m = 0; m < 4; ++m) {
                const size_t tok = (size_t)u.pm * 256 + ai * 128 + wr * 64 + m * 16 + fr;
#pragma unroll
                for (int bj = 0; bj < 2; ++bj)
#pragma unroll
                    for (int n = 0; n < 2; ++n) *(f32x4*)(LOGITS + tok * 256 + bj * 128 + wc * 32 + n * 16 + 4 * fq) = acc[ai][bj][m][n];
            }
        return false;
    }
};
__device__ __forceinline__ void phase5c(const Params& P, char* lds) {
    const int xg = blockIdx.x & 7, rk = blockIdx.x >> 3, G8 = gridDim.x >> 3;
    const bool two = G8 >= 2; const int nr = two ? (G8 >> 1) : G8, ns = two ? G8 - nr : G8;
    const bool conv_first = (rk & 1) != 0;
    if (conv_first) convert_experts(P, lds, NEA * 96, CONV_SPLIT, blockIdx.x, gridDim.x);
    if (!two || rk < nr) {
        ProvRouter PV; PV.hi = (const char*)P.out; PV.lo = (const char*)(P.ws + WS_Y1); PV.whi = (const char*)(P.ws + WB_WRHI); PV.wlo = (const char*)(P.ws + WB_WRLO);
        PV.tile0 = xg * 16 + rk; PV.tstep = 0;
        EpiRouter E; E.LOGITS = (float*)(P.ws + WS_LOGITS);
        for (int j = rk; j < 16; j += nr) { PV.tile0 = xg * 16 + j; PV.tstep = 128; pg8::gemm_phase((LAS unsigned char*)lds, DM, PV, E); }
    }
    if (!two || rk >= nr) {
        int* aid = (int*)(lds + LDS_ROWS);
        bf16_t* SCR = (bf16_t*)(P.ws + WS_SCR2 + (size_t)blockIdx.x * 131072);
        const bf16_t* wb = (const bf16_t*)(P.ws + WB_WS1);
        for (int j = two ? rk - nr : rk; j < 16; j += ns) {
            const int t = threadIdx.x;
            __syncthreads();
            if (t < 256) aid[t] = ((xg * 16 + j) * 256 + t) * 8;
            __syncthreads();
            {
                ProvUp PV; PV.h1 = (const char*)P.out; PV.wb = (const char*)wb; PV.aid = aid;
                EpiUp E; E.scr = SCR;
                pg8::gemm_phase((LAS unsigned char*)lds, DM, PV, E);
            }
            asm volatile("s_waitcnt vmcnt(0)" ::: "memory");
            __syncthreads();
            {
                ProvDown PV; PV.scr = (const char*)SCR; PV.w2t = (const char*)(wb + 524288);
                EpiDown E; E.Y = (bf16_t*)(P.ws + WS_Y); E.SHOUT = (bf16_t*)P.out + 1024; E.aid = aid; E.rows = 256; E.routed = false;
                pg8::gemm_phase((LAS unsigned char*)lds, 256, PV, E);
            }
            __syncthreads();
        }
    }
    if (!conv_first) convert_experts(P, lds, NEA * 96, CONV_SPLIT, blockIdx.x, gridDim.x);
}

__device__ __forceinline__ void phase7(const Params& P, char* lds) {
    const int t0_ = threadIdx.x;
    unsigned* ctl = (unsigned*)(P.ws + WS_CTL);
    int* pre = (int*)(lds + LDS_PRE);
    int* aid = (int*)(lds + LDS_ROWS);
    const int* LIST = (const int*)(P.ws + WS_LIST);
    bf16_t* SCR = (bf16_t*)(P.ws + WS_SCR2 + (size_t)blockIdx.x * 131072);
    const int xg = blockIdx.x & 7, rk = blockIdx.x >> 3, G8 = gridDim.x >> 3;
    __syncthreads();
    if (t0_ == 0) {
        int s = 0;
        for (int k = 0; k < 32; ++k) { pre[k] = s; s += ((int)ctl[CTL_CNT + (xg + 8 * k) * 16] + 255) >> 8; }
        pre[32] = s;
    }
    __syncthreads();
    const int T = pre[32];
    for (int g = rk; g < T; g += G8) {
        const int t = threadIdx.x;
        const bf16_t* wb; int rows; const bool routed = true;
        {
            int lo = 0, hi = 32;
            while (hi - lo > 1) { const int mid = (lo + hi) >> 1; if (pre[mid] <= g) lo = mid; else hi = mid; }
            const int e = xg + 8 * lo, tile = g - pre[lo], cnt = (int)ctl[CTL_CNT + e * 16];
            rows = cnt - tile * 256; rows = rows < 256 ? rows : 256; rows = __builtin_amdgcn_readfirstlane(rows);
            if (t < 256) aid[t] = LIST[(size_t)e * NTOK + tile * 256 + (t < rows ? t : rows - 1)];
            wb = (const bf16_t*)expw_ptr(P.ws, e);
        }
        __syncthreads();
        {
            ProvUp PV; PV.h1 = (const char*)P.out; PV.wb = (const char*)wb; PV.aid = aid;
            EpiUp E; E.scr = SCR;
            pg8::gemm_phase((LAS unsigned char*)lds, DM, PV, E);
        }
        asm volatile("s_waitcnt vmcnt(0)" ::: "memory");
        __syncthreads();
        {
            ProvDown PV; PV.scr = (const char*)SCR; PV.w2t = (const char*)(wb + 524288);
            EpiDown E; E.Y = (bf16_t*)(P.ws + WS_Y); E.SHOUT = (bf16_t*)P.out + 1024; E.aid = aid; E.rows = rows; E.routed = routed;
            pg8::gemm_phase((LAS unsigned char*)lds, 256, PV, E);
        }
        __syncthreads();
    }
}

__device__ __forceinline__ void phase8(const Params& P) {
    const int t = threadIdx.x, lane = t & 63, w = t >> 6;
    const int gw = blockIdx.x * NWV + w, nw = gridDim.x * NWV;
    const bf16_t* H1 = (const bf16_t*)P.out; const bf16_t* SHOUT = (const bf16_t*)P.out + 1024;
    const bf16_t* Y = (const bf16_t*)(P.ws + WS_Y); const float* EW = (const float*)(P.ws + WS_EW);
    for (int tok = gw; tok < NTOK; tok += nw) {
        float v[4][4];
#pragma unroll
        for (int i = 0; i < 4; ++i) {
            const uint2 h = *(const uint2*)(H1 + (size_t)tok * H1LD + 4 * (lane + 64 * i));
            const uint2 s = *(const uint2*)(SHOUT + (size_t)tok * H1LD + 4 * (lane + 64 * i));
            v[i][0] = ALPHA * bflo(h.x) + bflo(s.x); v[i][1] = ALPHA * bfhi(h.x) + bfhi(s.x);
            v[i][2] = ALPHA * bflo(h.y) + bflo(s.y); v[i][3] = ALPHA * bfhi(h.y) + bfhi(s.y);
        }
#pragma unroll
        for (int k = 0; k < 8; ++k) {
            const float wk = EW[tok * 8 + k];
            const bf16_t* yr = Y + ((size_t)tok * 8 + k) * DM;
#pragma unroll
            for (int i = 0; i < 4; ++i) {
                const uint2 y = *(const uint2*)(yr + 4 * (lane + 64 * i));
                v[i][0] += wk * bflo(y.x); v[i][1] += wk * bfhi(y.x); v[i][2] += wk * bflo(y.y); v[i][3] += wk * bfhi(y.y);
            }
        }
        float s = 0.f;
#pragma unroll
        for (int i = 0; i < 4; ++i) s += v[i][0] + v[i][1] + v[i][2] + v[i][3];
        const float mu = wave_sum(s) * (1.f / DM);
        float q = 0.f;
#pragma unroll
        for (int i = 0; i < 4; ++i)
#pragma unroll
            for (int c = 0; c < 4; ++c) { const float d = v[i][c] - mu; q += d * d; }
        const float rstd = rsqrtf(wave_sum(q) * (1.f / DM) + 1e-5f);
#pragma unroll
        for (int i = 0; i < 4; ++i) {
            const float4 g = ((const float4*)P.ln2_g)[lane + 64 * i], bb = ((const float4*)P.ln2_b)[lane + 64 * i];
            float4 o;
            o.x = (v[i][0] - mu) * rstd * g.x + bb.x; o.y = (v[i][1] - mu) * rstd * g.y + bb.y;
            o.z = (v[i][2] - mu) * rstd * g.z + bb.z; o.w = (v[i][3] - mu) * rstd * g.w + bb.w;
            ((float4*)(P.out + (size_t)tok * DM))[lane + 64 * i] = o;
        }
    }
}

constexpr int N_PHASES = 11;
__global__ void __launch_bounds__(512, 2) fwd_kernel(Params P) {
    extern __shared__ __attribute__((aligned(16))) char lds[];
    const int t = threadIdx.x;
    if (t == 0) *(uint4*)(lds + LDS_BARW) = make_uint4(0u, 0u, 0u, 0u);
    {
        float* LUT = (float*)(lds + LDS_LUT);
        for (int i = t; i < 256 * 8; i += NTHR) {
            const int d = (i >> 3) - 64, h = i & 7;
            float v = NEGBIG;
            if (d >= 0) {
                int bucket = d;
                if (d >= 16) { bucket = 16 + (int)(log2f((float)d * (1.f / 16.f)) * (16.f / 3.f)); bucket = bucket < 31 ? bucket : 31; }
                v = P.rel_bias[bucket * 8 + h] * LOG2E;
            }
            LUT[i] = v;
        }
    }
    __syncthreads();
    XcdBarrier bar = xcd_barrier_post((unsigned*)(P.ws + WS_CTL), (volatile LAS unsigned*)(lds + LDS_BARW));
#ifndef ONLY_PHASE
#define ONLY_PHASE -1
#endif
#ifndef PROBE_DUP
#define PROBE_DUP -1
#endif
#define PHASE(k, call) if ((ONLY_PHASE < 0 || ONLY_PHASE == (k)) && P.ph_lo <= (k) && (k) < P.ph_hi) { call; if ((k) + 1 < P.ph_hi) xcd_barrier(bar); }
#define PHASE_DUP(k, call) if (PROBE_DUP == (k)) { call; xcd_barrier(bar); }
    PHASE(0, phase0(P))
    PHASE_DUP(1, phase1<true>(P, lds))
    PHASE(1, phase1<false>(P, lds))
    PHASE_DUP(2, phase2<1024>(P, lds))
    PHASE(2, phase2<0>(P, lds))
#ifndef P3DUP
#define P3DUP 7
#endif
    PHASE_DUP(3, (phase3<1024, P3DUP>(P, lds)))
    PHASE(3, (phase3<0, 7>(P, lds)))
    PHASE_DUP(4, phase4(P, lds))
    PHASE(4, phase4(P, lds))
    PHASE_DUP(5, phase5a(P, lds))
    PHASE(5, phase5a(P, lds))
#ifndef P6DUP
#define P6DUP 1
#endif
    PHASE_DUP(6, phase5b<P6DUP>(P, lds))
    PHASE(6, phase5b<0>(P, lds))
    PHASE_DUP(7, phase5c(P, lds))
    PHASE(7, phase5c(P, lds))
    PHASE_DUP(8, phase5d<true>(P, lds))
    PHASE(8, phase5d<false>(P, lds))
    PHASE_DUP(9, phase7(P, lds))
    PHASE(9, phase7(P, lds))
    PHASE_DUP(10, phase8(P))
#ifdef PROBE_BAR
    for (int i = 0; i < 16; ++i) xcd_barrier(bar);
#endif
    PHASE(10, phase8(P))
#undef PHASE
}

#ifndef MK_LAUNCHES
#define MK_LAUNCHES 1
#endif

extern "C" void kernel_launch(void* const* d_in, const int* in_sizes, int n_in, void* d_out, int out_size, void* d_ws, size_t ws_size,
                              hipStream_t stream) {
    static int grid = 0;
    if (grid == 0) {
        if (n_in != 31 || in_sizes[0] != NTOK * DM || out_size != NTOK * DM || ws_size < WS_END) {
            fprintf(stderr, "kernel_launch: unexpected shapes (n_in %d, in0 %d, out %d, ws %zu < %zu)\n", n_in, n_in > 0 ? in_sizes[0] : -1, out_size, ws_size, (size_t)WS_END);
            grid = -1; return;
        }
        int dev = 0, cus = 0, per_cu = 0;
        if (hipGetDevice(&dev) != hipSuccess || hipDeviceGetAttribute(&cus, hipDeviceAttributeMultiprocessorCount, dev) != hipSuccess) { grid = -1; return; }
        if (hipFuncSetAttribute((const void*)fwd_kernel, hipFuncAttributeMaxDynamicSharedMemorySize, LDS_BYTES) != hipSuccess) { grid = -1; return; }
        if (hipOccupancyMaxActiveBlocksPerMultiprocessor(&per_cu, (const void*)fwd_kernel, NTHR, LDS_BYTES) != hipSuccess || per_cu < 1) per_cu = 1;
        (void)hipGetLastError();
        grid = cus;
    }
    if (grid < 0) return;
    if (hipMemsetAsync((char*)d_ws + WS_CTL, 0, CTL_BYTES, stream) != hipSuccess) return;
    Params p{};
    const float** pp = (const float**)&p;
    for (int i = 0; i < 31; ++i) pp[i] = (const float*)d_in[i];
    p.out = (float*)d_out; p.ws = (char*)d_ws;
#if MK_LAUNCHES == 1
    p.ph_lo = 0; p.ph_hi = N_PHASES;
    hipLaunchKernelGGL(fwd_kernel, dim3(grid), dim3(NTHR), LDS_BYTES, stream, p);
#else
    for (int k = 0; k < N_PHASES; ++k) { p.ph_lo = k; p.ph_hi = k + 1; hipLaunchKernelGGL(fwd_kernel, dim3(grid), dim3(NTHR), LDS_BYTES, stream, p); }
#endif
}
```

```cpp
#include <hip/hip_runtime.h>
#include <stdint.h>
#include <stdio.h>

typedef unsigned short bf16_t;
typedef __attribute__((ext_vector_type(8))) short bf16x8;
typedef __attribute__((ext_vector_type(4))) short bf16x4;
typedef __attribute__((ext_vector_type(4))) float f32x4;

constexpr int NTOK = 32768, SEQ = 8192, DM = 1024, DIN = 5944;
constexpr int C_QNSA = 0, C_KVNSA = 512, C_GNSA = 1280, C_CQ = 1304, C_CKV = 2072, C_KROPE = 2328, C_QMEM = 2360, C_GMERGE = 2872;
constexpr float ALPHA = 1.189207115002721f;
constexpr float LOG2E = 1.4426950408889634f;
constexpr float NEGBIG = -1e30f;

constexpr size_t MBY = 1ull << 20;
constexpr size_t WS_CTL = 0;
constexpr size_t CTL_BYTES = 65536;
constexpr int CTL_Q = 4096;
constexpr int CTL_CNT = 8192;
constexpr size_t WS_COS = 1 * MBY, WS_SIN = WS_COS + 512 * 1024;
constexpr size_t WS_KC = 2 * MBY, WS_VTC = WS_KC + 512 * 1024;
constexpr size_t WS_KMEM = 3 * MBY, WS_VTMEM = 4 * MBY, WS_MEMB = 5 * MBY, WS_EID = 7 * MBY, WS_EW = 8 * MBY;
constexpr size_t WS_A = 16 * MBY;
constexpr size_t WS_PROJ = WS_A, WS_QM = WS_A + 372 * MBY, WS_KM = WS_A + 420 * MBY, WS_VTM = WS_A + 468 * MBY;
constexpr size_t WS_Y1 = WS_A, WS_Y = WS_A;
constexpr size_t WS_B = WS_A + 512 * MBY;
constexpr size_t WS_H0 = WS_B;
constexpr int NEA = 117;
constexpr size_t WS_EXPA = WS_B + 272 * MBY + MBY / 2, WS_EXPB = WS_B;
static_assert(WS_EXPA + (size_t)NEA * 1572864 <= WS_B + 448 * MBY && (size_t)(256 - NEA) * 1572864 <= 208 * MBY + MBY / 2, "expert weight pieces");
__device__ __forceinline__ const unsigned short* expw_ptr(const char* ws, int e) {
    return (const unsigned short*)(ws + (e < NEA ? WS_EXPA + (size_t)e * 1572864 : WS_EXPB + (size_t)(e - NEA) * 1572864));
}
constexpr size_t WS_ONSA = WS_B + 64 * MBY, WS_OMLA = WS_B + 96 * MBY, WS_OMEM = WS_B + 128 * MBY;
constexpr size_t WS_LOGITS = WS_A + 128 * MBY, WS_LIST = WS_B + 208 * MBY + MBY / 2;
constexpr size_t WS_MERGED = WS_B + 160 * MBY;
constexpr size_t WS_KCS = WS_B + 224 * MBY, WS_VCS = WS_KCS + 8 * MBY, WS_KSLC = WS_KCS + 16 * MBY, WS_KWIN = WS_KCS + 24 * MBY,
                 WS_VTSLC = WS_KCS + 32 * MBY, WS_VTWIN = WS_KCS + 40 * MBY;
constexpr size_t WS_SCR = WS_B + 416 * MBY;
constexpr size_t WS_SCR2 = WS_B + 240 * MBY + MBY / 2;
constexpr size_t WS_WB = WS_B + 448 * MBY;
constexpr size_t WB_WIN = WS_WB, WB_WUQ = WB_WIN + 12582912, WB_WUKV = WB_WUQ + 1179648, WB_WMEM = WB_WUKV + 524288, WB_WBR = WB_WMEM + 2097152,
                 WB_WOUT = WB_WBR + 3145728, WB_WRHI = WB_WOUT + 2097152, WB_WRLO = WB_WRHI + 524288, WB_WS1 = WB_WRLO + 524288, WB_WS3 = WB_WS1 + 524288,
                 WB_WS2 = WB_WS3 + 524288, WB_WCK1 = WB_WS2 + 524288, WB_WCV1 = WB_WCK1 + 1048576, WB_WCK2 = WB_WCV1 + 1048576, WB_WCV2 = WB_WCK2 + 65536,
                 WB_POSP = WB_WCV2 + 65536  , WB_END = WB_POSP + 32768;
static_assert(WB_END <= WS_WB + 32 * MBY, "bf16 weight region");
constexpr size_t WS_END = WS_B + 480 * MBY;
constexpr int H1LD = 2048;

struct Params {
    const float *x, *mem, *ln0_g, *ln0_b, *rel_bias, *w_in, *cmp_pos_k, *cmp_pos_v, *cmp_k_w1, *cmp_k_w2, *cmp_v_w1, *cmp_v_w2,
        *mla_q_norm, *mla_w_uq, *mla_kv_norm, *mla_w_ukv, *mem_w_kv, *w_branch, *w_out, *ln1_g, *ln1_b, *router_w, *router_b,
        *exp_w1, *exp_w3, *exp_w2, *sh_w1, *sh_w3, *sh_w2, *ln2_g, *ln2_b;
    float* out;
    char* ws;
    int ph_lo, ph_hi;
};

#define XB_TMO      128
#define XB_XCNT(j)  (256  + 64 * (j))
#define XB_XSUB(j)  (1280 + 64 * (j))
#define XB_XGEN(j)  (2304 + 64 * (j))
#define XB_TOP      3328
#define XB_TOPGEN   3392
#define XCD_BAR_WORDS 3456
#define XB_SPIN_CAP (1u << 18)
#define LAS __attribute__((address_space(3)))

__device__ __forceinline__ unsigned xb_ld(unsigned* p)              { return __hip_atomic_load(p, __ATOMIC_RELAXED, __HIP_MEMORY_SCOPE_AGENT); }
__device__ __forceinline__ unsigned xb_add(unsigned* p, unsigned v) { return __hip_atomic_fetch_add(p, v, __ATOMIC_RELAXED, __HIP_MEMORY_SCOPE_AGENT); }
__device__ __forceinline__ unsigned xb_xcc_id() { return (unsigned)__builtin_amdgcn_s_getreg((3 << 11) | 20) & 0xFu; }
#define XB_SPIN(cond, bar) do { unsigned _sp = 0; while (cond) { __builtin_amdgcn_s_sleep(1); \
    if ((++_sp & 255u) == 0u) { if (xb_ld(&(bar)[XB_TMO])) break; if (_sp > XB_SPIN_CAP) { atomicAdd(&(bar)[XB_TMO], 1u); break; } } } } while (0)

struct XcdBarrier { unsigned* bar; unsigned x; volatile LAS unsigned* st; };

__device__ __forceinline__ XcdBarrier xcd_barrier_post(unsigned* bar, volatile LAS unsigned* st) {
    XcdBarrier b; b.bar = bar; b.x = xb_xcc_id(); b.st = st;
    if (threadIdx.x == 0) (void)xb_add(&bar[XB_XCNT(b.x)], 1u);
    return b;
}
__device__ __forceinline__ void xcd_barrier_complete(unsigned* bar, unsigned x, unsigned& nloc, unsigned& nx) {
    const unsigned G = gridDim.x * gridDim.y * gridDim.z;
    unsigned sum, cnt, mine, sp = 0u;
    for (;;) {
        sum = 0u; cnt = 0u; mine = 0u;
#pragma unroll
        for (unsigned j = 0; j < 16; ++j) { const unsigned c = xb_ld(&bar[XB_XCNT(j)]); sum += c; cnt += (c > 0u) ? 1u : 0u; mine = (j == x) ? c : mine; }
        if (sum == G) break;
        __builtin_amdgcn_s_sleep(1);
        if ((++sp & 255u) == 0u) { if (xb_ld(&bar[XB_TMO])) break; if (sp > XB_SPIN_CAP) { atomicAdd(&bar[XB_TMO], 1u); break; } }
    }
    nloc = mine > 0u ? mine : 1u; nx = cnt > 0u ? cnt : 1u;
}
__device__ __forceinline__ void xcd_barrier(const XcdBarrier& b) {
    asm volatile("s_waitcnt vmcnt(0)" ::: "memory");
    __syncthreads();
    if (threadIdx.x == 0) {
        unsigned* bar = b.bar;
        __builtin_amdgcn_s_waitcnt(0);
        unsigned nloc = b.st[0], nx = b.st[1];
        if (nloc == 0u) { xcd_barrier_complete(bar, b.x, nloc, nx); b.st[0] = nloc; b.st[1] = nx; }
        const unsigned old = xb_add(&bar[XB_XSUB(b.x)], 1u);
        const unsigned gen = old / nloc;
        if (old + 1u == (gen + 1u) * nloc) {
            __builtin_amdgcn_fence(__ATOMIC_RELEASE, "agent");
            asm volatile("s_waitcnt vmcnt(0)" ::: "memory");
            const unsigned og = xb_add(&bar[XB_TOP], 1u);
            const unsigned tg = og / nx;
            if (og + 1u == (tg + 1u) * nx) xb_add(&bar[XB_TOPGEN], 1u);
            else XB_SPIN(xb_ld(&bar[XB_TOPGEN]) == tg, bar);
            __builtin_amdgcn_fence(__ATOMIC_ACQUIRE, "agent");
            xb_add(&bar[XB_XGEN(b.x)], 1u);
            asm volatile("s_waitcnt vmcnt(0)" ::: "memory");
        } else {
            XB_SPIN(xb_ld(&bar[XB_XGEN(b.x)]) == gen, bar);
            __builtin_amdgcn_fence(__ATOMIC_ACQUIRE, "agent");
            asm volatile("s_waitcnt vmcnt(0)" ::: "memory");
        }
    }
    __syncthreads();
}

__device__ __forceinline__ float bf2f(bf16_t v) { return __uint_as_float(((uint32_t)v) << 16); }
__device__ __forceinline__ float bflo(uint32_t v) { return __uint_as_float(v << 16); }
__device__ __forceinline__ float bfhi(uint32_t v) { return __uint_as_float(v & 0xffff0000u); }
__device__ __forceinline__ uint32_t pack2(float a, float b) {
    typedef __attribute__((ext_vector_type(2))) __bf16 bf2_t; typedef __attribute__((ext_vector_type(2))) float f2_t;
    f2_t v = {a, b}; bf2_t r = __builtin_convertvector(v, bf2_t); return __builtin_bit_cast(uint32_t, r);
}
__device__ __forceinline__ bf16_t f2bf(float a) { return (bf16_t)(pack2(a, 0.f) & 0xffffu); }
__device__ __forceinline__ uint2 pack4(f32x4 v) { return make_uint2(pack2(v[0], v[1]), pack2(v[2], v[3])); }
__device__ __forceinline__ float fexp2(float x) { return __builtin_amdgcn_exp2f(x); }
__device__ __forceinline__ float frcp(float x) { return __builtin_amdgcn_rcpf(x); }
__device__ __forceinline__ float sigmoidf_(float x) { return frcp(1.f + fexp2(-x * LOG2E)); }
__device__ __forceinline__ float siluf_(float x) { return x * frcp(1.f + fexp2(-x * LOG2E)); }
__device__ __forceinline__ float geluf_(float x) {
    const float u = 0.7978845608028654f * (x + 0.044715f * x * x * x);
    const float t = 1.f - 2.f * frcp(1.f + fexp2(2.f * u * LOG2E));
    return 0.5f * x * (1.f + t);
}
__device__ __forceinline__ float wave_sum(float v) {
    v += __uint_as_float(__builtin_amdgcn_update_dpp(0u, __float_as_uint(v), 0xB1, 0xF, 0xF, true));
    v += __uint_as_float(__builtin_amdgcn_update_dpp(0u, __float_as_uint(v), 0x4E, 0xF, 0xF, true));
    v += __uint_as_float(__builtin_amdgcn_update_dpp(0u, __float_as_uint(v), 0x141, 0xF, 0xF, true));
    v += __uint_as_float(__builtin_amdgcn_update_dpp(0u, __float_as_uint(v), 0x140, 0xF, 0xF, true));
    auto r = __builtin_amdgcn_permlane16_swap(__float_as_uint(v), __float_as_uint(v), false, false);
    v = __uint_as_float(r[0]) + __uint_as_float(r[1]);
    auto q = __builtin_amdgcn_permlane32_swap(__float_as_uint(v), __float_as_uint(v), false, false);
    return __uint_as_float(q[0]) + __uint_as_float(q[1]);
}
__device__ __forceinline__ float wave_max(float v) {
    v = fmaxf(v, __uint_as_float(__builtin_amdgcn_update_dpp(0u, __float_as_uint(v), 0xB1, 0xF, 0xF, true)));
    v = fmaxf(v, __uint_as_float(__builtin_amdgcn_update_dpp(0u, __float_as_uint(v), 0x4E, 0xF, 0xF, true)));
    v = fmaxf(v, __uint_as_float(__builtin_amdgcn_update_dpp(0u, __float_as_uint(v), 0x141, 0xF, 0xF, true)));
    v = fmaxf(v, __uint_as_float(__builtin_amdgcn_update_dpp(0u, __float_as_uint(v), 0x140, 0xF, 0xF, true)));
    auto r = __builtin_amdgcn_permlane16_swap(__float_as_uint(v), __float_as_uint(v), false, false);
    v = fmaxf(__uint_as_float(r[0]), __uint_as_float(r[1]));
    auto q = __builtin_amdgcn_permlane32_swap(__float_as_uint(v), __float_as_uint(v), false, false);
    return fmaxf(__uint_as_float(q[0]), __uint_as_float(q[1]));
}
__device__ __forceinline__ float quad_max(float x) {
    auto r = __builtin_amdgcn_permlane16_swap(__float_as_uint(x), __float_as_uint(x), false, false);
    x = fmaxf(__uint_as_float(r[0]), __uint_as_float(r[1]));
    auto q = __builtin_amdgcn_permlane32_swap(__float_as_uint(x), __float_as_uint(x), false, false);
    return fmaxf(__uint_as_float(q[0]), __uint_as_float(q[1]));
}
__device__ __forceinline__ float quad_min(float x) {
    auto r = __builtin_amdgcn_permlane16_swap(__float_as_uint(x), __float_as_uint(x), false, false);
    x = fminf(__uint_as_float(r[0]), __uint_as_float(r[1]));
    auto q = __builtin_amdgcn_permlane32_swap(__float_as_uint(x), __float_as_uint(x), false, false);
    return fminf(__uint_as_float(q[0]), __uint_as_float(q[1]));
}
__device__ __forceinline__ float quad_sum(float x) {
    auto r = __builtin_amdgcn_permlane16_swap(__float_as_uint(x), __float_as_uint(x), false, false);
    x = __uint_as_float(r[0]) + __uint_as_float(r[1]);
    auto q = __builtin_amdgcn_permlane32_swap(__float_as_uint(x), __float_as_uint(x), false, false);
    return __uint_as_float(q[0]) + __uint_as_float(q[1]);
}
__device__ __forceinline__ float quad4_sum(float x) {
    x += __uint_as_float(__builtin_amdgcn_update_dpp(0u, __float_as_uint(x), 0xB1, 0xF, 0xF, true));
    x += __uint_as_float(__builtin_amdgcn_update_dpp(0u, __float_as_uint(x), 0x4E, 0xF, 0xF, true));
    return x;
}
__device__ __forceinline__ float max16(const f32x4 (&s)[4]) {
    const float a = fmaxf(fmaxf(s[0][0], s[0][1]), fmaxf(s[0][2], s[0][3])), b = fmaxf(fmaxf(s[1][0], s[1][1]), fmaxf(s[1][2], s[1][3]));
    const float c = fmaxf(fmaxf(s[2][0], s[2][1]), fmaxf(s[2][2], s[2][3])), d = fmaxf(fmaxf(s[3][0], s[3][1]), fmaxf(s[3][2], s[3][3]));
    return fmaxf(fmaxf(a, b), fmaxf(c, d));
}
__device__ __forceinline__ float sum16(const f32x4 (&s)[4]) {
    const f32x4 v = (s[0] + s[1]) + (s[2] + s[3]);
    return (v[0] + v[1]) + (v[2] + v[3]);
}
__device__ __forceinline__ void lds_fadd(float* p, float v) {
    asm volatile("ds_add_f32 %0, %1" :: "v"((unsigned)(size_t)(LAS float*)p), "v"(v) : "memory");
}
__device__ __forceinline__ f32x4 mfma16(bf16x8 a, bf16x8 b, f32x4 c) { return __builtin_amdgcn_mfma_f32_16x16x32_bf16(a, b, c, 0, 0, 0); }

constexpr int NTHR = 512, NWV = 8;
constexpr int LDS_BYTES = 163840;
constexpr int LDS_MISC = 147456;
constexpr int LDS_LUT = LDS_MISC;
constexpr int LDS_SEL = LDS_MISC + 8192;
constexpr int LDS_WOR = LDS_SEL + 1024;
constexpr int LDS_TL = LDS_WOR + 128;
constexpr int LDS_ITEM = LDS_TL + 256;
constexpr int LDS_ROWS = LDS_ITEM + 64;
constexpr int LDS_PRE = LDS_ROWS + 2048;
constexpr int LDS_KSC = LDS_PRE + 256;
constexpr int LDS_BARW = 163824;
static_assert(LDS_KSC + 1024 <= LDS_BARW, "LDS map");

__device__ __forceinline__ int queue_pop(unsigned* head, char* lds) {
    __syncthreads();
    if (threadIdx.x == 0) *(volatile int*)(lds + LDS_ITEM) = (int)atomicAdd(head, 1u);
    __syncthreads();
    return __builtin_amdgcn_readfirstlane(*(volatile int*)(lds + LDS_ITEM));
}

__device__ __forceinline__ int swz(int row, int chunk) { return (row << 7) + (((chunk ^ (row >> 1) ^ ((row >> 4) & 1)) & 7) << 4); }
constexpr int TILE_B = 16384;

struct GemmA { const char* base; unsigned off[4]; };

constexpr int STAGE_B = 49152, STAGE_BOFF = 32768;
__device__ __forceinline__ int gl_row(int i, int t) { return 8 * ((t >> 6) + 8 * i) + ((t & 63) >> 3); }
__device__ __forceinline__ int gl_chunk(int row, int t) { return ((t & 7) ^ (row >> 1) ^ ((row >> 4) & 1)) & 7; }
__device__ __forceinline__ int perm32_(int rho) { const int n = rho >> 4, i = rho & 15; return 8 * (i >> 2) + 4 * n + (i & 3); }
template <int NP, bool PERM = false>
__device__ __forceinline__ GemmA make_op(const bf16_t* base, long ld, int r0, int rmax) {
    GemmA a; const int t = threadIdx.x;
    a.base = (const char*)base;
#pragma unroll
    for (int i = 0; i < NP; ++i) { const int lr_ = gl_row(i, t); int r = r0 + (PERM ? ((lr_ & ~31) + perm32_(lr_ & 31)) : lr_); r = r < rmax ? r : rmax - 1; a.off[i] = (unsigned)(((size_t)r * ld + gl_chunk(lr_, t) * 8) * 2); }
    return a;
}
__device__ __forceinline__ void gemm_mainloop_g(char* lds, const GemmA& A, const GemmA& B, int nk, f32x4 (&acc)[4][4]) {
    int t = threadIdx.x; asm volatile("" : "+v"(t));
    const int lane = t & 63, w = t >> 6, wm = w >> 1, wn = w & 1;
    const int lr = lane & 15, lq = lane >> 4;
    const int wu = __builtin_amdgcn_readfirstlane(w);
    const int xr = (lr >> 1) & 7;
    unsigned ardA[2][2], ardB[2][2];
#pragma unroll
    for (int kk = 0; kk < 2; ++kk)
#pragma unroll
        for (int par = 0; par < 2; ++par) {
            const int ch = ((kk * 4 + lq) ^ xr ^ par) & 7;
            ardA[kk][par] = (unsigned)((wm * 64 + par * 16 + lr) * 128 + ch * 16);
            ardB[kk][par] = (unsigned)(STAGE_BOFF + (wn * 64 + par * 16 + lr) * 128 + ch * 16);
        }
    const char* abase = A.base; const char* bbase = B.base;
    LAS char* ldsl = (LAS char*)lds;
#define GI_(so_) { \
        _Pragma("unroll") for (int i = 0; i < 4; ++i) \
            __builtin_amdgcn_global_load_lds((const unsigned*)(abase + A.off[i]), (LAS unsigned*)(ldsl + (so_) + (wu + 8 * i) * 1024), 16, 0, 0); \
        _Pragma("unroll") for (int i = 0; i < 2; ++i) \
            __builtin_amdgcn_global_load_lds((const unsigned*)(bbase + B.off[i]), (LAS unsigned*)(ldsl + (so_) + STAGE_BOFF + (wu + 8 * i) * 1024), 16, 0, 0); \
        abase += 128; bbase += 128; }
    __syncthreads();
    GI_(0);
    if (nk > 1) GI_(STAGE_B);
    int cso = 0, lso = 2 * STAGE_B;
#pragma unroll 1
    for (int kt = 0; kt < nk; ++kt) {
        if (kt + 1 < nk) asm volatile("s_waitcnt vmcnt(6)" ::: "memory");
        else asm volatile("s_waitcnt vmcnt(0)" ::: "memory");
        __builtin_amdgcn_s_barrier();
        if (kt + 2 < nk) GI_(lso);
#pragma unroll
        for (int kk = 0; kk < 2; ++kk) {
            bf16x8 af[4], bfr[4];
#pragma unroll
            for (int i = 0; i < 4; ++i) af[i] = *(const bf16x8*)(lds + cso + ardA[kk][i & 1] + (i >> 1) * 4096);
#pragma unroll
            for (int j = 0; j < 4; ++j) bfr[j] = *(const bf16x8*)(lds + cso + ardB[kk][j & 1] + (j >> 1) * 4096);
#pragma unroll
            for (int i = 0; i < 4; ++i)
#pragma unroll
                for (int j = 0; j < 4; ++j) acc[i][j] = mfma16(bfr[j], af[i], acc[i][j]);
        }
        cso = (cso == 2 * STAGE_B) ? 0 : cso + STAGE_B;
        lso = (lso == 2 * STAGE_B) ? 0 : lso + STAGE_B;
    }
    __syncthreads();
#undef GI_
}

template <bool SWAPW1 = false>
__device__ __forceinline__ void gemm_mainloop_c(char* lds, const GemmA& A, const GemmA& B, int nk, f32x4 (&acc)[4][4], int& ring, bool primed, bool chain, const GemmA& An, const GemmA& Bn) {
    int t = threadIdx.x; asm volatile("" : "+v"(t));
    const int lane = t & 63, w = t >> 6, wm = w >> 1, wn = w & 1;
    const int lr = lane & 15, lq = lane >> 4;
    const int wu = __builtin_amdgcn_readfirstlane(w);
    const int xr = (lr >> 1) & 7;
    unsigned ardA[2][2], ardB[2][2];
#pragma unroll
    for (int kk = 0; kk < 2; ++kk)
#pragma unroll
        for (int par = 0; par < 2; ++par) {
            const int ch = ((kk * 4 + lq) ^ xr ^ par) & 7;
            ardA[kk][par] = (unsigned)((wm * 64 + par * 16 + lr) * 128 + ch * 16);
            ardB[kk][par] = (unsigned)(STAGE_BOFF + (wn * 64 + par * 16 + lr) * 128 + ch * 16);
        }
    const char* abase = A.base; const char* bbase = B.base;
    const char* anb = An.base; const char* bnb = Bn.base;
    LAS char* ldsl = (LAS char*)lds;
#define GI_(so_) { \
        _Pragma("unroll") for (int i = 0; i < 4; ++i) \
            __builtin_amdgcn_global_load_lds((const unsigned*)(abase + A.off[i]), (LAS unsigned*)(ldsl + (so_) + (wu + 8 * i) * 1024), 16, 0, 0); \
        _Pragma("unroll") for (int i = 0; i < 2; ++i) \
            __builtin_amdgcn_global_load_lds((const unsigned*)(bbase + B.off[i]), (LAS unsigned*)(ldsl + (so_) + STAGE_BOFF + (wu + 8 * i) * 1024), 16, 0, 0); \
        abase += 128; bbase += 128; }
#define GIN_(so_) { \
        _Pragma("unroll") for (int i = 0; i < 4; ++i) \
            __builtin_amdgcn_global_load_lds((const unsigned*)(anb + An.off[i]), (LAS unsigned*)(ldsl + (so_) + (wu + 8 * i) * 1024), 16, 0, 0); \
        _Pragma("unroll") for (int i = 0; i < 2; ++i) \
            __builtin_amdgcn_global_load_lds((const unsigned*)(bnb + Bn.off[i]), (LAS unsigned*)(ldsl + (so_) + STAGE_BOFF + (wu + 8 * i) * 1024), 16, 0, 0); \
        anb += 128; bnb += 128; }
    int cso = ring, lso = (ring == 0) ? 2 * STAGE_B : ring - STAGE_B;
    if (!primed) {
        __syncthreads();
        GI_(cso);
        { const int s1 = (cso == 2 * STAGE_B) ? 0 : cso + STAGE_B; GI_(s1); }
    } else { abase += 256; bbase += 256; }
#pragma unroll 1
    for (int kt = 0; kt < nk; ++kt) {
        if (kt + 1 < nk || chain) asm volatile("s_waitcnt vmcnt(6)" ::: "memory");
        else asm volatile("s_waitcnt vmcnt(0)" ::: "memory");
        __builtin_amdgcn_s_barrier();
        if (kt + 2 < nk) GI_(lso) else if (chain) GIN_(lso)
#pragma unroll
        for (int kk = 0; kk < 2; ++kk) {
            bf16x8 af[4], bfr[4];
#pragma unroll
            for (int i = 0; i < 4; ++i) af[i] = *(const bf16x8*)(lds + cso + ardA[kk][i & 1] + (i >> 1) * 4096);
#pragma unroll
            for (int j = 0; j < 4; ++j) bfr[j] = *(const bf16x8*)(lds + cso + ardB[kk][j & 1] + (j >> 1) * 4096);
            if (SWAPW1 && wn == 1) {
#pragma unroll
                for (int i = 0; i < 4; ++i)
#pragma unroll
                    for (int j = 0; j < 4; ++j) acc[i][j] = mfma16(af[i], bfr[j], acc[i][j]);
            } else {
#pragma unroll
                for (int i = 0; i < 4; ++i)
#pragma unroll
                    for (int j = 0; j < 4; ++j) acc[i][j] = mfma16(bfr[j], af[i], acc[i][j]);
            }
        }
        cso = (cso == 2 * STAGE_B) ? 0 : cso + STAGE_B;
        lso = (lso == 2 * STAGE_B) ? 0 : lso + STAGE_B;
    }
    ring = cso;
    if (!chain) __syncthreads();
#undef GI_
#undef GIN_
}

template <bool LO>
__device__ __forceinline__ void conv_wT(const float* src, int K, int N, bf16_t* dst, int ldd, const float* gain) {
    const int t = threadIdx.x & 255, kg = t >> 5, n4 = t & 31;
    const int ntn = (N + 127) >> 7, ntiles = (K >> 6) * ntn;
    for (int tile = blockIdx.x * 2 + (threadIdx.x >> 8); tile < ntiles; tile += gridDim.x * 2) {
        const int k0 = (tile / ntn) * 64 + kg * 8, n = (tile % ntn) * 128 + n4 * 4;
        if (n < N) {
            float4 r[8];
#pragma unroll
            for (int kk = 0; kk < 8; ++kk) r[kk] = *(const float4*)(src + (size_t)(k0 + kk) * N + n);
            if (gain) {
#pragma unroll
                for (int kk = 0; kk < 8; ++kk) { const float g = gain[k0 + kk]; r[kk].x *= g; r[kk].y *= g; r[kk].z *= g; r[kk].w *= g; }
            }
#pragma unroll
            for (int c = 0; c < 4; ++c) {
                float v[8];
#pragma unroll
                for (int kk = 0; kk < 8; ++kk) { float f = (c == 0) ? r[kk].x : (c == 1) ? r[kk].y : (c == 2) ? r[kk].z : r[kk].w; if (LO) f = f - bf2f(f2bf(f)); v[kk] = f; }
                *(uint4*)(dst + (size_t)(n + c) * ldd + k0) = make_uint4(pack2(v[0], v[1]), pack2(v[2], v[3]), pack2(v[4], v[5]), pack2(v[6], v[7]));
            }
        }
    }
}

__device__ __forceinline__ void zero_acc(f32x4 (&acc)[4][4]) {
#pragma unroll
    for (int i = 0; i < 4; ++i)
#pragma unroll
        for (int j = 0; j < 4; ++j) acc[i][j] = (f32x4){0.f, 0.f, 0.f, 0.f};
}

namespace pg8 {
constexpr int BM = 256, BK = 64, HALF = 128, HTB = HALF * BK * 2, STAGE_BYTES = 8 * HTB;
__device__ __forceinline__ int lds_byte(int r, int c) { const int st = (r >> 4) * 2 + (c >> 5), rr = r & 15, cc = c & 31, ob = rr * 64 + cc * 2; return st * 1024 + (ob ^ (((ob >> 9) & 1) << 5)); }
__device__ __forceinline__ void stage_rc(int b, int& R, int& C) { const int st = b / 1024, sb = b % 1024, swz_ = sb ^ (((sb >> 9) & 1) << 5); R = (st >> 1) * 16 + swz_ / 64; C = (st & 1) * 32 + (swz_ % 64) / 2; }
__device__ __forceinline__ int perm32(int rho) { const int n = rho >> 4, i = rho & 15; return 8 * (i >> 2) + 4 * n + (i & 3); }
struct Unit { int pm, pn; };
struct Ops { const char* A; const char* B; };
template <class Prov, class Epi>
__device__ __forceinline__ void gemm_phase(LAS unsigned char* lds, const int K, Prov& PV, const Epi& E) {
    int tid = threadIdx.x; asm volatile("" : "+v"(tid));
    const int wid = __builtin_amdgcn_readfirstlane(tid >> 6), lane = tid & 63, wr = wid >> 2, wc = wid & 3, fr = lane & 15, fq = lane >> 4;
    int nt = K / BK; asm volatile("" : "+s"(nt));
    int sR[2], sC[2];
#pragma unroll
    for (int i = 0; i < 2; ++i) stage_rc(tid * 16 + i * 8192, sR[i], sC[i]);
    const size_t kstep = (size_t)(BK * 2);
    const unsigned ldsw = (unsigned)wid * 1024u;
    const int aoff = lds_byte(wr * 64 + fr, fq * 8), boff = lds_byte(wc * 32 + fr, fq * 8);
#define PG8_SA(b, h) (((b) * 2 + (h)) * HTB)
#define PG8_SB(b, h) ((4 + (b) * 2 + (h)) * HTB)
#define PG8_STAGE(bufoff, gbase, voff) do { _Pragma("unroll") for (int _i = 0; _i < 2; ++_i) \
        __builtin_amdgcn_global_load_lds((const unsigned*)((const char*)(gbase) + (voff)[_i]), (LAS unsigned*)(lds + (bufoff) + ldsw + _i * 8192), 16, 0, 0); } while (0)
#define PG8_LDA(dst, b, h) do { _Pragma("unroll") for (int m = 0; m < 4; ++m) _Pragma("unroll") for (int k = 0; k < 2; ++k) dst[m][k] = *(const LAS bf16x8*)(lds + PG8_SA(b, h) + aoff + m * 2048 + k * 1024); } while (0)
#define PG8_LDB(dst, b, h) do { _Pragma("unroll") for (int n = 0; n < 2; ++n) _Pragma("unroll") for (int k = 0; k < 2; ++k) dst[n][k] = *(const LAS bf16x8*)(lds + PG8_SB(b, h) + boff + n * 2048 + k * 1024); } while (0)
#define PG8_MMA(ai, bj, At, Bt) do { __builtin_amdgcn_s_setprio(1); _Pragma("unroll") for (int m = 0; m < 4; ++m) _Pragma("unroll") for (int n = 0; n < 2; ++n) _Pragma("unroll") for (int k = 0; k < 2; ++k) \
        acc[ai][bj][m][n] = __builtin_amdgcn_mfma_f32_16x16x32_bf16(Bt[n][k], At[m][k], acc[ai][bj][m][n], 0, 0, 0); __builtin_amdgcn_s_setprio(0); } while (0)
#define PG8_WAIT_V(n) asm volatile("s_waitcnt vmcnt(" #n ")" ::: "memory")
#define PG8_WAIT_L(n) asm volatile("s_waitcnt lgkmcnt(" #n ")" ::: "memory")
#define PG8_BAR __builtin_amdgcn_s_barrier()
#define PG8_SCHED __builtin_amdgcn_sched_barrier(0)
    Unit cur, nxt; Ops oc, on; int ui = 0;
    unsigned va[2][2], vb[2][2];
    PV.offsets(va, vb, sR, sC);
    if (!PV.get(0, cur, oc)) return;
    f32x4 acc[2][2][4][2];
#pragma unroll
    for (int a = 0; a < 2; ++a)
#pragma unroll
        for (int b = 0; b < 2; ++b)
#pragma unroll
            for (int m = 0; m < 4; ++m)
#pragma unroll
                for (int n = 0; n < 2; ++n) acc[a][b][m][n] = (f32x4){0.f, 0.f, 0.f, 0.f};
    bf16x8 At[4][2], B0[2][2], B1[2][2];
    PG8_STAGE(PG8_SB(0, 0), oc.B, vb[0]); PG8_STAGE(PG8_SA(0, 0), oc.A, va[0]); PG8_STAGE(PG8_SB(0, 1), oc.B, vb[1]); PG8_STAGE(PG8_SA(0, 1), oc.A, va[1]);
    if (wr == 1) PG8_BAR;
    PG8_WAIT_V(4); PG8_BAR;
    PG8_STAGE(PG8_SB(1, 0), oc.B + kstep, vb[0]); PG8_STAGE(PG8_SA(1, 0), oc.A + kstep, va[0]); PG8_STAGE(PG8_SB(1, 1), oc.B + kstep, vb[1]);
    PG8_WAIT_V(6); PG8_BAR;
    for (;;) {
        const bool has_next = PV.get(ui + 1, nxt, on);
        if (!has_next) on = oc;
#pragma unroll 1
        for (int t = 0; t < nt; t += 2) {
            const bool last = (t == nt - 2);
            const char* a1 = oc.A + (size_t)(t + 1) * kstep;
            const char* a2 = last ? on.A : oc.A + (size_t)(t + 2) * kstep; const char* b2 = last ? on.B : oc.B + (size_t)(t + 2) * kstep;
            const char* a3 = a2 + kstep; const char* b3 = b2 + kstep;
            PG8_LDB(B0, 0, 0); PG8_SCHED; PG8_LDA(At, 0, 0); PG8_STAGE(PG8_SA(1, 1), a1, va[1]);
            PG8_WAIT_L(8); PG8_BAR; PG8_WAIT_L(0); PG8_MMA(0, 0, At, B0); PG8_BAR; PG8_SCHED;
            PG8_LDB(B1, 0, 1); PG8_STAGE(PG8_SB(0, 0), b2, vb[0]);
            PG8_BAR; PG8_WAIT_L(0); PG8_MMA(0, 1, At, B1); PG8_BAR;
            PG8_LDA(At, 0, 1); PG8_STAGE(PG8_SA(0, 0), a2, va[0]);
            PG8_BAR; PG8_WAIT_L(0); PG8_MMA(1, 0, At, B0); PG8_BAR; PG8_SCHED;
            PG8_STAGE(PG8_SB(0, 1), b2, vb[1]);
            PG8_WAIT_V(6); PG8_BAR; PG8_MMA(1, 1, At, B1); PG8_BAR;
            PG8_LDB(B0, 1, 0); PG8_SCHED; PG8_LDA(At, 1, 0); PG8_STAGE(PG8_SA(0, 1), a2, va[1]);
            PG8_WAIT_L(8); PG8_BAR; PG8_WAIT_L(0); PG8_MMA(0, 0, At, B0); PG8_BAR; PG8_SCHED;
            PG8_LDB(B1, 1, 1); PG8_STAGE(PG8_SB(1, 0), b3, vb[0]);
            PG8_BAR; PG8_WAIT_L(0); PG8_MMA(0, 1, At, B1); PG8_BAR;
            PG8_LDA(At, 1, 1); PG8_STAGE(PG8_SA(1, 0), a3, va[0]);
            PG8_BAR; PG8_WAIT_L(0); PG8_MMA(1, 0, At, B0); PG8_BAR; PG8_SCHED;
            PG8_STAGE(PG8_SB(1, 1), b3, vb[1]);
            PG8_WAIT_V(6); PG8_BAR; PG8_MMA(1, 1, At, B1); PG8_BAR;
        }
        bool keep;
        { int tz = threadIdx.x; asm volatile("" : "+v"(tz));
          keep = E(acc, cur, ui, wr, wc, tz & 15, (tz >> 4) & 3); }
        if (!has_next) break;
        if (!keep)
#pragma unroll
        for (int a = 0; a < 2; ++a)
#pragma unroll
            for (int b = 0; b < 2; ++b)
#pragma unroll
                for (int m = 0; m < 4; ++m)
#pragma unroll
                    for (int n = 0; n < 2; ++n) acc[a][b][m][n] = (f32x4){0.f, 0.f, 0.f, 0.f};
        cur = nxt; oc = on; ++ui;
    }
    PG8_WAIT_V(0);
    if (wr == 0) PG8_BAR;
    PG8_BAR;
#undef PG8_SA
#undef PG8_SB
#undef PG8_STAGE
#undef PG8_LDA
#undef PG8_LDB
#undef PG8_MMA
#undef PG8_WAIT_V
#undef PG8_WAIT_L
#undef PG8_BAR
#undef PG8_SCHED
}
struct StaticOrder {
    int nM, nN, nwg, G, c;
    __device__ void init(int M, int N, int G_, int c_) { nM = M / BM; nN = N / BM; nwg = nM * nN; G = G_; c = c_; }
    __device__ bool next(int i, Unit& u) const {
        const long L = (long)i * G + c; if (L >= nwg) return false;
        int wgid = (int)L; { const int q = nwg / 8, r = nwg % 8, xcd = wgid % 8, off = wgid / 8; wgid = (xcd < r ? xcd * (q + 1) : r * (q + 1) + (xcd - r) * q) + off; }
        const int nig = 8 * nN, gid = wgid / nig, fm = gid * 8, gsz = (nM - fm) < 8 ? (nM - fm) : 8;
        u.pm = fm + ((wgid % nig) % gsz); u.pn = (wgid % nig) / gsz; return true;
    }
};
struct DenseProv {
    StaticOrder S; const bf16_t* A; const bf16_t* Bt; long lda, ldb; bool perm;
    __device__ __forceinline__ void offsets(unsigned (&va)[2][2], unsigned (&vb)[2][2], const int (&sR)[2], const int (&sC)[2]) const {
#pragma unroll
        for (int h = 0; h < 2; ++h)
#pragma unroll
            for (int p = 0; p < 2; ++p) { const int rb = perm ? ((sR[p] & ~31) + perm32(sR[p] & 31)) : sR[p];
                va[h][p] = (unsigned)(((size_t)(h * HALF + sR[p]) * lda + sC[p]) * 2); vb[h][p] = (unsigned)(((size_t)(h * HALF + rb) * ldb + sC[p]) * 2); }
    }
    __device__ __forceinline__ bool get(int i, Unit& u, Ops& o) const {
        if (!S.next(i, u)) return false;
        o.A = (const char*)(A + (size_t)u.pm * BM * lda); o.B = (const char*)(Bt + (size_t)u.pn * BM * ldb);
        return true;
    }
};
}

__device__ __forceinline__ void phase0(const Params& P) {
    const int t = threadIdx.x, lane = t & 63, w = t >> 6;
    const int gw = blockIdx.x * NWV + w, nw = gridDim.x * NWV;
    bf16_t* H0 = (bf16_t*)(P.ws + WS_H0);
    for (int row0 = gw; row0 < NTOK; row0 += 2 * nw) {
        const int row1 = row0 + nw; const bool has1 = row1 < NTOK;
        const float4* xr0 = (const float4*)(P.x + (size_t)row0 * DM); const float4* xr1 = (const float4*)(P.x + (size_t)(has1 ? row1 : row0) * DM);
        float4 v[2][4]; float s0 = 0.f, s1 = 0.f;
#pragma unroll
        for (int i = 0; i < 4; ++i) { v[0][i] = xr0[lane + 64 * i]; v[1][i] = xr1[lane + 64 * i]; }
#pragma unroll
        for (int i = 0; i < 4; ++i) { s0 += v[0][i].x + v[0][i].y + v[0][i].z + v[0][i].w; s1 += v[1][i].x + v[1][i].y + v[1][i].z + v[1][i].w; }
        const float mu0 = wave_sum(s0) * (1.f / DM), mu1 = wave_sum(s1) * (1.f / DM);
        float q0 = 0.f, q1 = 0.f;
#pragma unroll
        for (int i = 0; i < 4; ++i) {
            { float a = v[0][i].x - mu0, b = v[0][i].y - mu0, c = v[0][i].z - mu0, d = v[0][i].w - mu0; q0 += a * a + b * b + c * c + d * d; }
            { float a = v[1][i].x - mu1, b = v[1][i].y - mu1, c = v[1][i].z - mu1, d = v[1][i].w - mu1; q1 += a * a + b * b + c * c + d * d; }
        }
        const float rstd0 = rsqrtf(wave_sum(q0) * (1.f / DM) + 1e-5f), rstd1 = rsqrtf(wave_sum(q1) * (1.f / DM) + 1e-5f);
#pragma unroll
        for (int i = 0; i < 4; ++i) {
            const float4 g = ((const float4*)P.ln0_g)[lane + 64 * i], bb = ((const float4*)P.ln0_b)[lane + 64 * i];
            *(uint2*)(H0 + (size_t)row0 * DM + 4 * (lane + 64 * i)) =
                make_uint2(pack2((v[0][i].x - mu0) * rstd0 * g.x + bb.x, (v[0][i].y - mu0) * rstd0 * g.y + bb.y), pack2((v[0][i].z - mu0) * rstd0 * g.z + bb.z, (v[0][i].w - mu0) * rstd0 * g.w + bb.w));
            if (has1) *(uint2*)(H0 + (size_t)row1 * DM + 4 * (lane + 64 * i)) =
                make_uint2(pack2((v[1][i].x - mu1) * rstd1 * g.x + bb.x, (v[1][i].y - mu1) * rstd1 * g.y + bb.y), pack2((v[1][i].z - mu1) * rstd1 * g.z + bb.z, (v[1][i].w - mu1) * rstd1 * g.w + bb.w));
        }
    }
    const int gt = blockIdx.x * NTHR + t, nt = gridDim.x * NTHR;
    bf16_t* MEMB = (bf16_t*)(P.ws + WS_MEMB);
    for (int i = gt; i < 4 * 256 * DM / 4; i += nt) {
        const float4 v = ((const float4*)P.mem)[i];
        *(uint2*)(MEMB + (size_t)i * 4) = make_uint2(pack2(v.x, v.y), pack2(v.z, v.w));
    }
    float* COS = (float*)(P.ws + WS_COS); float* SIN = (float*)(P.ws + WS_SIN);
    for (int i = gt; i < SEQ * 16; i += nt) {
        const int pos = i >> 4, j = i & 15;
        const float freq = exp2f(-(float)j * (13.287712379549449f / 16.f));
        const float ang = (float)pos * freq;
        float sn, cs; sincosf(ang, &sn, &cs);
        COS[i] = cs; SIN[i] = sn;
    }
    {
        char* wsb = P.ws;
        const int tt = t & 255, kg = tt >> 5, n4 = tt & 31;
        constexpr int NJ = 17;
        const int jK[NJ]  = {1024, 768, 256, 1024, 512, 512, 512, 1024, 1024, 1024, 1024, 1024, 256, 2048, 2048, 256, 256};
        const int jN[NJ]  = {DIN, 768, 1024, 1024, 1024, 1024, 1024, 1024, 256, 256, 256, 256, 1024, 256, 256, 64, 64};
        int first[NJ + 1]; first[0] = 0;
#pragma unroll
        for (int j = 0; j < NJ; ++j) first[j + 1] = first[j] + (jK[j] >> 6) * ((jN[j] + 127) >> 7);
        for (int g = blockIdx.x * 2 + (t >> 8); g < first[NJ]; g += gridDim.x * 2) {
            int j = 0;
#pragma unroll
            for (int q = 1; q < NJ; ++q) j += (g >= first[q]) ? 1 : 0;
            const float* src; bf16_t* dst; const float* gain = nullptr; bool lo = false; int K, N, ldd, f0;
            switch (j) {
                case 0: src = P.w_in; dst = (bf16_t*)(wsb + WB_WIN); break;
                case 1: src = P.mla_w_uq; dst = (bf16_t*)(wsb + WB_WUQ); gain = P.mla_q_norm; break;
                case 2: src = P.mla_w_ukv; dst = (bf16_t*)(wsb + WB_WUKV); gain = P.mla_kv_norm; break;
                case 3: src = P.mem_w_kv; dst = (bf16_t*)(wsb + WB_WMEM); break;
                case 4: src = P.w_branch; dst = (bf16_t*)(wsb + WB_WBR); break;
                case 5: src = P.w_branch + 512 * 1024; dst = (bf16_t*)(wsb + WB_WBR) + 1024 * 512; break;
                case 6: src = P.w_branch + 2 * 512 * 1024; dst = (bf16_t*)(wsb + WB_WBR) + 2 * 1024 * 512; break;
                case 7: src = P.w_out; dst = (bf16_t*)(wsb + WB_WOUT); break;
                case 8: src = P.router_w; dst = (bf16_t*)(wsb + WB_WRHI); break;
                case 9: src = P.router_w; dst = (bf16_t*)(wsb + WB_WRLO); lo = true; break;
                case 10: src = P.sh_w1; dst = (bf16_t*)(wsb + WB_WS1); break;
                case 11: src = P.sh_w3; dst = (bf16_t*)(wsb + WB_WS3); break;
                case 12: src = P.sh_w2; dst = (bf16_t*)(wsb + WB_WS2); break;
                case 13: src = P.cmp_k_w1; dst = (bf16_t*)(wsb + WB_WCK1); break;
                case 14: src = P.cmp_v_w1; dst = (bf16_t*)(wsb + WB_WCV1); break;
                case 15: src = P.cmp_k_w2; dst = (bf16_t*)(wsb + WB_WCK2); break;
                default: src = P.cmp_v_w2; dst = (bf16_t*)(wsb + WB_WCV2); break;
            }
            K = jK[0]; N = jN[0]; f0 = first[0];
#pragma unroll
            for (int q = 1; q < NJ; ++q) if (j == q) { K = jK[q]; N = jN[q]; f0 = first[q]; }
            ldd = K;
            const int ntn = (N + 127) >> 7, tile = g - f0;
            const int k0 = (tile / ntn) * 64 + kg * 8, n = (tile % ntn) * 128 + n4 * 4;
            if (n < N) {
                float4 r[8];
#pragma unroll
                for (int kk = 0; kk < 8; ++kk) r[kk] = *(const float4*)(src + (size_t)(k0 + kk) * N + n);
                if (gain) {
#pragma unroll
                    for (int kk = 0; kk < 8; ++kk) { const float gg = gain[k0 + kk]; r[kk].x *= gg; r[kk].y *= gg; r[kk].z *= gg; r[kk].w *= gg; }
                }
#pragma unroll
                for (int c = 0; c < 4; ++c) {
                    float v[8];
#pragma unroll
                    for (int kk = 0; kk < 8; ++kk) { float f = (c == 0) ? r[kk].x : (c == 1) ? r[kk].y : (c == 2) ? r[kk].z : r[kk].w; if (lo) f = f - bf2f(f2bf(f)); v[kk] = f; }
                    *(uint4*)(dst + (size_t)(n + c) * ldd + k0) = make_uint4(pack2(v[0], v[1]), pack2(v[2], v[3]), pack2(v[4], v[5]), pack2(v[6], v[7]));
                }
            }
        }
        float* POSP = (float*)(wsb + WB_POSP);
        for (int i = gt; i < 2 * 16 * 256 * 16; i += nt) {
            const int o = i >> 4, part = i & 15, kv = o >> 12, kc = (o >> 8) & 15, c = o & 255;
            const float* pos = kv ? P.cmp_pos_v : P.cmp_pos_k; const float* w1 = kv ? P.cmp_v_w1 : P.cmp_k_w1;
            float a = 0.f;
#pragma unroll
            for (int k8 = 0; k8 < 8; ++k8) { const int k = kc * 128 + part * 8 + k8; a += pos[k] * w1[(size_t)k * 256 + c]; }
            a += __uint_as_float(__builtin_amdgcn_update_dpp(0u, __float_as_uint(a), 0xB1, 0xF, 0xF, true));
            a += __uint_as_float(__builtin_amdgcn_update_dpp(0u, __float_as_uint(a), 0x4E, 0xF, 0xF, true));
            a += __uint_as_float(__builtin_amdgcn_update_dpp(0u, __float_as_uint(a), 0x141, 0xF, 0xF, true));
            a += __uint_as_float(__builtin_amdgcn_update_dpp(0u, __float_as_uint(a), 0x140, 0xF, 0xF, true));
            if (part == 0) POSP[o] = a;
        }
    }
    bf16_t* KC = (bf16_t*)(P.ws + WS_KC); bf16_t* VTC = (bf16_t*)(P.ws + WS_VTC);
    for (int i = gt; i < 8 * 64; i += nt) { const int bg = i >> 6, d = i & 63; KC[((size_t)bg * 512 + 511) * 64 + d] = 0; VTC[((size_t)bg * 64 + d) * 512 + 511] = 0; }
}

__device__ __forceinline__ void proj_store8(const Params& P, int tok, int n0, f32x4 v0, f32x4 v1) {
    if (n0 >= DIN) return;
    const int nt = n0 >> 7;
    if (nt >= 4 && nt < 10) {
        const int j = nt - 4, g = (n0 >> 6) & 1, d = n0 & 63, b = tok >> 13, sq = tok & 8191;
        bf16_t* dstk = (bf16_t*)(P.ws + (j == 0 ? WS_KCS : j == 1 ? WS_VCS : j == 2 ? WS_KSLC : j == 4 ? WS_KWIN : j == 3 ? WS_VTSLC : WS_VTWIN));
        if (j == 3 || j == 5) {
#pragma unroll
            for (int r = 0; r < 4; ++r) { dstk[((size_t)(b * 2 + g) * 64 + d + r) * SEQ + sq] = f2bf(v0[r]); dstk[((size_t)(b * 2 + g) * 64 + d + 4 + r) * SEQ + sq] = f2bf(v1[r]); }
        } else { const uint2 a = pack4(v0), c = pack4(v1); *(uint4*)(dstk + (((size_t)(b * 2 + g) * SEQ + sq) * 64 + d)) = make_uint4(a.x, a.y, c.x, c.y); }
    } else {
        float sc = 1.f;
        if (nt < 4) sc = 0.125f * LOG2E;
        else if (n0 >= C_QMEM && n0 < C_GMERGE) sc = 0.08838834764831845f * LOG2E;
        v0 *= sc; v1 *= sc;
        if (n0 >= C_GMERGE || (n0 >= C_GNSA && n0 < C_CQ)) {
#pragma unroll
            for (int r = 0; r < 4; ++r) { v0[r] = sigmoidf_(v0[r]); v1[r] = sigmoidf_(v1[r]); }
        }
        const uint2 a = pack4(v0), c = pack4(v1);
        *(uint4*)((bf16_t*)(P.ws + WS_PROJ) + (size_t)tok * DIN + n0) = make_uint4(a.x, a.y, c.x, c.y);
    }
}
template <bool LIGHT>
struct EpiProj {
    const Params* P;
    __device__ __forceinline__ bool operator()(f32x4 (&acc)[2][2][4][2], const pg8::Unit& u, int, int wr, int wc, int fr, int fq) const {
#pragma unroll
        for (int ai = 0; ai < 2; ++ai)
#pragma unroll
            for (int m = 0; m < 4; ++m) {
                const int tok = u.pm * 256 + ai * 128 + wr * 64 + m * 16 + fr;
#pragma unroll
                for (int bj = 0; bj < 2; ++bj) {
                    if (!LIGHT) proj_store8(*P, tok, u.pn * 256 + bj * 128 + wc * 32 + 8 * fq, acc[ai][bj][m][0], acc[ai][bj][m][1]);
                    else asm volatile("" :: "v"(acc[ai][bj][m][0][0]), "v"(acc[ai][bj][m][1][3]));
                }
            }
        return false;
    }
};
template <bool LIGHT>
__device__ __forceinline__ void phase1(const Params& P, char* lds) {
    {
        pg8::DenseProv PV; PV.S.init(NTOK, 6144, gridDim.x, blockIdx.x);
        PV.A = (const bf16_t*)(P.ws + WS_H0); PV.Bt = (const bf16_t*)(P.ws + WB_WIN); PV.lda = DM; PV.ldb = DM; PV.perm = true;
        EpiProj<LIGHT> E; E.P = &P;
        pg8::gemm_phase((LAS unsigned char*)lds, DM, PV, E);
    }
}

template <int LEN>
__device__ __forceinline__ void rows_rstd(const bf16_t* base, long ld, int m0, float* dst) {
    const int t = threadIdx.x, row = t >> 1, part = t & 1;
    const uint4* p = (const uint4*)(base + (size_t)(m0 + row) * ld + part * (LEN / 2));
    float ss = 0.f;
#pragma unroll 1
    for (int i0 = 0; i0 < LEN / 16; i0 += 16) {
        uint4 v[16];
#pragma unroll
        for (int i = 0; i < 16; ++i) v[i] = p[i0 + i];
#pragma unroll
        for (int i = 0; i < 16; ++i) {
            float a;
            a = bflo(v[i].x); ss += a * a; a = bfhi(v[i].x); ss += a * a; a = bflo(v[i].y); ss += a * a; a = bfhi(v[i].y); ss += a * a;
            a = bflo(v[i].z); ss += a * a; a = bfhi(v[i].z); ss += a * a; a = bflo(v[i].w); ss += a * a; a = bfhi(v[i].w); ss += a * a;
        }
    }
    ss += __shfl_xor(ss, 1);
    if (part == 0) dst[row] = rsqrtf(ss * (1.f / LEN) + 1e-6f);
}

template <int QOFF>
__device__ __forceinline__ void phase2(const Params& P, char* lds) {
    unsigned* ctl = (unsigned*)(P.ws + WS_CTL);
    bf16_t* PROJ = (bf16_t*)(P.ws + WS_PROJ);
    float* rsc = (float*)(lds + LDS_ROWS + 1024);
    float* gsc = (float*)(lds + LDS_KSC);
    const float* COS = (const float*)(P.ws + WS_COS); const float* SIN = (const float*)(P.ws + WS_SIN);
#define P2_TID int t = threadIdx.x; asm volatile("" : "+v"(t)); const int lane = t & 63, w = t >> 6, wm = w >> 1, wn = w & 1, lr = lane & 15, lq = lane >> 4;
#ifndef P2SEL
#define P2SEL 7
#endif
    if (P2SEL & 1) for (;;) {
        const int it = queue_pop(&ctl[QOFF + CTL_Q + 0], lds);
        if (it >= 32) break;
        P2_TID
        {
            const int kv = it >> 4, mt = it & 15, m0 = mt * 256;
            const bf16_t* SRC = (const bf16_t*)(P.ws + (kv ? WS_VCS : WS_KCS));
            const bf16_t* w1t = (const bf16_t*)(P.ws + (kv ? WB_WCV1 : WB_WCK1)); const bf16_t* w2t = (const bf16_t*)(P.ws + (kv ? WB_WCV2 : WB_WCK2));
            {
                const float* pp = (const float*)(P.ws + WB_POSP) + kv * 4096 + (t & 255);
                float a = 0.f;
#pragma unroll
                for (int kc = 0; kc < 16; ++kc) a += pp[kc * 256];
                if (t < 256) gsc[t] = a;
            }
            __syncthreads();
            bf16_t* HID = (bf16_t*)(P.ws + WS_SCR + (size_t)blockIdx.x * 131072);
            GemmA A;
#pragma unroll
            for (int i = 0; i < 4; ++i) {
                const int lr_ = gl_row(i, t); int r = m0 + lr_; r = r < 4088 ? r : 4087;
                const int b = r / 1022, rem = r - b * 1022, n = rem >> 1, g = rem & 1;
                A.off[i] = (unsigned)((((size_t)(b * 2 + g) * SEQ + 16 * n) * 64 + gl_chunk(lr_, t) * 8) * 2);
            }
            A.base = (const char*)SRC;
            for (int nt = 0; nt < 2; ++nt) {
                f32x4 acc[4][4]; zero_acc(acc);
                GemmA B = make_op<2>(w1t, 2048, nt * 128, 256);
                gemm_mainloop_g(lds, A, B, 2048 / 64, acc);
#pragma unroll
                for (int i = 0; i < 4; ++i)
#pragma unroll
                    for (int j = 0; j < 4; ++j) {
                        f32x4 v = acc[i][j];
                        const f32x4 pb = *(const f32x4*)(gsc + nt * 128 + wn * 64 + j * 16 + 4 * lq);
#pragma unroll
                        for (int r = 0; r < 4; ++r) v[r] = geluf_(v[r] + pb[r]);
                        *(uint2*)(HID + (wm * 64 + i * 16 + lr) * 256 + nt * 128 + wn * 64 + j * 16 + 4 * lq) = pack4(v);
                    }
            }
            asm volatile("s_waitcnt vmcnt(0)" ::: "memory");
            __syncthreads();
            {
                f32x4 acc[4][4]; zero_acc(acc);
                GemmA A2 = make_op<4>(HID, 256, 0, 256);
                GemmA B2 = make_op<2>(w2t, 256, 0, 64);
                gemm_mainloop_g(lds, A2, B2, 256 / 64, acc);
                if (wn == 0) {
                    bf16_t* KC = (bf16_t*)(P.ws + WS_KC); bf16_t* VTC = (bf16_t*)(P.ws + WS_VTC);
#pragma unroll
                    for (int i = 0; i < 4; ++i) {
                        const int r = m0 + wm * 64 + i * 16 + lr;
                        if (r < 4088) {
                            const int b = r / 1022, rem = r - b * 1022, n = rem >> 1, g = rem & 1;
#pragma unroll
                            for (int j = 0; j < 4; ++j) {
                                const int d = j * 16 + 4 * lq;
                                if (!kv) *(uint2*)(KC + ((size_t)(b * 2 + g) * 512 + n) * 64 + d) = pack4(acc[i][j]);
                                else {
#pragma unroll
                                    for (int rr = 0; rr < 4; ++rr) VTC[((size_t)(b * 2 + g) * 64 + d + rr) * 512 + n] = f2bf(acc[i][j][rr]);
                                }
                            }
                        }
                    }
                }
            }
        }
    }
    if (P2SEL & 2) for (;;) {
        const int it = queue_pop(&ctl[QOFF + CTL_Q + 256], lds);
        if (it >= 256) break;
        P2_TID
        {
            const int mt = it >> 1, half = it & 1, m0 = mt * 256;
            rows_rstd<768>(PROJ + C_CQ, DIN, m0, rsc);
            __syncthreads();
            GemmA A = make_op<4>(PROJ + C_CQ, DIN, m0, NTOK);
            bf16_t* QM = (bf16_t*)(P.ws + WS_QM);
            int ring = 0;
#pragma unroll 1
            for (int k3 = 0; k3 < 3; ++k3) {
                const int n0 = (half * 3 + k3) * 128;
                f32x4 acc[4][4]; zero_acc(acc);
                GemmA B = make_op<2>((const bf16_t*)(P.ws + WB_WUQ), 768, n0, 768);
                GemmA Bn = make_op<2>((const bf16_t*)(P.ws + WB_WUQ), 768, n0 + (k3 < 2 ? 128 : 0), 768);
                gemm_mainloop_c(lds, A, B, 768 / 64, acc, ring, k3 > 0, k3 < 2, A, Bn);
                const int c16 = (n0 + wn * 64) >> 4;
                const bool rp0 = (c16 % 6) == 4, rp2 = ((c16 + 2) % 6) == 4;
                int lrz = lr; asm volatile("" : "+v"(lrz));
#pragma unroll
                for (int i = 0; i < 4; ++i) {
                    const int tl = wm * 64 + i * 16 + lrz, tok = m0 + tl, pos = tok & (SEQ - 1);
                    const float sc = rsc[tl] * (0.10206207261596575f * LOG2E);
                    const float4 cs = *(const float4*)(COS + pos * 16 + 4 * lq), sn = *(const float4*)(SIN + pos * 16 + 4 * lq);
                    const float csa[4] = {cs.x, cs.y, cs.z, cs.w}, sna[4] = {sn.x, sn.y, sn.z, sn.w};
#pragma unroll
                    for (int j = 0; j < 4; ++j) acc[i][j] *= sc;
#pragma unroll
                    for (int j = 0; j < 4; j += 2) {
                        if (j == 0 ? rp0 : rp2) {
#pragma unroll
                            for (int r = 0; r < 4; ++r) {
                                const float x1 = acc[i][j][r], x2 = acc[i][j + 1][r];
                                acc[i][j][r] = x1 * csa[r] - x2 * sna[r]; acc[i][j + 1][r] = x2 * csa[r] + x1 * sna[r];
                            }
                        }
                    }
#pragma unroll
                    for (int j = 0; j < 4; ++j) *(uint2*)(QM + (size_t)tok * 768 + n0 + wn * 64 + j * 16 + 4 * lq) = pack4(acc[i][j]);
                }
            }
        }
    }
    if (P2SEL & 4) for (;;) {
        const int it = queue_pop(&ctl[QOFF + CTL_Q + 320], lds);
        if (it >= 128) break;
        P2_TID
        {
            const int mt = it, m0 = mt * 256;
            rows_rstd<256>(PROJ + C_CKV, DIN, m0, rsc);
            __syncthreads();
            GemmA A = make_op<4>(PROJ + C_CKV, DIN, m0, NTOK);
            bf16_t* KM = (bf16_t*)(P.ws + WS_KM); bf16_t* VTM = (bf16_t*)(P.ws + WS_VTM);
            int ring = 0;
#pragma unroll 1
            for (int h = 0; h < 8; ++h) {
                f32x4 acc[4][4]; zero_acc(acc);
                GemmA B = make_op<2>((const bf16_t*)(P.ws + WB_WUKV), 256, h * 128, 1024);
                GemmA Bn = make_op<2>((const bf16_t*)(P.ws + WB_WUKV), 256, (h < 7 ? h + 1 : h) * 128, 1024);
                gemm_mainloop_c<true>(lds, A, B, 256 / 64, acc, ring, h > 0, h < 7, A, Bn);
                if (wn == 0) {
#pragma unroll
                    for (int i = 0; i < 4; ++i) {
                        const int tl = wm * 64 + i * 16 + lr, tok = m0 + tl, b = tok >> 13, s = tok & (SEQ - 1);
                        const float sc = rsc[tl];
#pragma unroll
                        for (int j = 0; j < 4; ++j) *(uint2*)(KM + ((size_t)(b * 8 + h) * SEQ + s) * 96 + j * 16 + 4 * lq) = pack4(acc[i][j] * sc);
                    }
                } else {
#pragma unroll
                    for (int i = 0; i < 4; ++i) {
                        const int tl = wm * 64 + i * 16 + 4 * lq, tok = m0 + tl, b = tok >> 13, s = tok & (SEQ - 1);
                        const f32x4 sc = *(const f32x4*)(rsc + tl);
#pragma unroll
                        for (int j = 0; j < 4; ++j) *(uint2*)(VTM + ((size_t)(b * 8 + h) * 64 + j * 16 + lr) * SEQ + s) = pack4(acc[i][j] * sc);
                    }
                }
            }
        }
    }
    for (;;) {
        const int tile = queue_pop(&ctl[QOFF + CTL_Q + 384], lds);
        if (tile >= 32) break;
        int t = threadIdx.x; asm volatile("" : "+v"(t)); const int lane = t & 63, w = t >> 6, wm = w >> 1, wn = w & 1, lr = lane & 15, lq = lane >> 4;
        f32x4 acc[4][4]; zero_acc(acc);
        {
            const int mt = tile >> 3, nt = tile & 7, m0 = mt * 256, n0 = nt * 128;
            GemmA A = make_op<4>((const bf16_t*)(P.ws + WS_MEMB), DM, m0, 1024);
            GemmA B = make_op<2>((const bf16_t*)(P.ws + WB_WMEM), 1024, n0, 1024);
            gemm_mainloop_g(lds, A, B, DM / 64, acc);
            bf16_t* KMEM = (bf16_t*)(P.ws + WS_KMEM); bf16_t* VTMEM = (bf16_t*)(P.ws + WS_VTMEM);
#pragma unroll
            for (int i = 0; i < 4; ++i) {
                const int row = m0 + wm * 64 + i * 16 + lr, b = row >> 8, m = row & 255;
#pragma unroll
                for (int jj = 0; jj < 4; ++jj) {
                    const int n = n0 + wn * 64 + jj * 16 + 4 * lq;
                    const int two = n >> 9, h = (n >> 7) & 3, d = n & 127;
                    if (two == 0) *(uint2*)(KMEM + (((size_t)(b * 4 + h) * 256 + m) * 128 + d)) = pack4(acc[i][jj]);
                    else {
#pragma unroll
                        for (int r = 0; r < 4; ++r) VTMEM[((size_t)(b * 4 + h) * 128 + d + r) * 256 + m] = f2bf(acc[i][jj][r]);
                    }
                }
            }
        }
    }
    {
        const int t = threadIdx.x;
        bf16_t* KM = (bf16_t*)(P.ws + WS_KM);
        const int gt = blockIdx.x * NTHR + t, nt = gridDim.x * NTHR;
        for (int i = gt; i < NTOK * 16; i += nt) {
            const int tok = i >> 4, j = i & 15, b = tok >> 13, s = tok & (SEQ - 1);
            const float x1 = bf2f(PROJ[(size_t)tok * DIN + C_KROPE + j]), x2 = bf2f(PROJ[(size_t)tok * DIN + C_KROPE + 16 + j]);
            const float cs = COS[s * 16 + j], sn = SIN[s * 16 + j];
            const bf16_t o1 = f2bf(x1 * cs - x2 * sn), o2 = f2bf(x2 * cs + x1 * sn);
#pragma unroll
            for (int h = 0; h < 8; ++h) {
                bf16_t* kr = KM + ((size_t)(b * 8 + h) * SEQ + s) * 96 + 64;
                kr[j] = o1; kr[16 + j] = o2;
            }
        }
    }
}

__device__ __forceinline__ int offk(int sub, int key, int c) { return sub * 4096 + key * 64 + (((c ^ (-(key >> 2))) & 3) << 4); }
__device__ __forceinline__ int offv(int dv, int ch) { return dv * 128 + (((ch ^ (dv >> 1)) & 7) << 4); }

template <int DK, int DV, bool NEEDV, class KP, class VP, class TL, class FN>
__device__ __forceinline__ void kv_loop(char* lds, int n, KP kp, VP vp, TL tl, FN fn) {
    if (n <= 0) return;
    int t = threadIdx.x; asm volatile("" : "+v"(t));
    const int lane = t & 63, wu = __builtin_amdgcn_readfirstlane(t >> 6);
    constexpr int KPN = DK / 8, VPN = DV / 8, KPT = (KPN + 7) / 8, VPT = (VPN + 7) / 8;
    constexpr int KB = DK * 128, VB = DV * 128;
    LAS char* ldsl = (LAS char*)lds;
#define KVI_(tile, buf) { \
        _Pragma("unroll") for (int i = 0; i < KPT; ++i) { const int p_ = wu + 8 * i, key_ = 16 * (p_ & 3) + (lane >> 2), c_ = ((lane & 3) ^ (-(key_ >> 2))) & 3; \
            if (p_ < KPN) __builtin_amdgcn_global_load_lds((const unsigned*)(kp(tile, key_) + (p_ >> 2) * 32 + c_ * 8), (LAS unsigned*)(ldsl + (buf) * KB + p_ * 1024), 16, 0, 0); } \
        if (NEEDV) { _Pragma("unroll") for (int i = 0; i < VPT; ++i) { const int p_ = wu + 8 * i, dv_ = 8 * p_ + (lane >> 3), ch_ = ((lane & 7) ^ (dv_ >> 1)) & 7; \
            if (p_ < VPN) __builtin_amdgcn_global_load_lds((const unsigned*)(vp(tile, dv_) + ch_ * 8), (LAS unsigned*)(ldsl + 2 * KB + (buf) * VB + p_ * 1024), 16, 0, 0); } } }
    __syncthreads();
    { const int t0 = tl(0); KVI_(t0, 0); }
    asm volatile("s_waitcnt vmcnt(0)" ::: "memory");
    __syncthreads();
#pragma unroll 1
    for (int i = 0; i < n; ++i) {
        const int cur = i & 1, tile = tl(i);
        if (i + 1 < n) { const int tn = tl(i + 1); if (cur) KVI_(tn, 0) else KVI_(tn, 1) }
        fn(tile, (const char*)(lds + cur * KB), (const char*)(lds + 2 * KB + cur * VB));
        asm volatile("s_waitcnt vmcnt(0)" ::: "memory");
        __syncthreads();
    }
#undef KVI_
}

template <int DK, int DV, class KP, class VP, class TL, class FN>
__device__ __forceinline__ void kv_loop2(char* lds, int n, KP kp, VP vp, TL tl, FN fn) {
    if (n <= 0) return;
    int t = threadIdx.x; asm volatile("" : "+v"(t));
    const int lane = t & 63, wu = __builtin_amdgcn_readfirstlane(t >> 6);
    constexpr int KPN = DK / 8, VPN = DV / 8, KPT = (KPN + 7) / 8, VPT = (VPN + 7) / 8;
    constexpr int KB = DK * 128, VB = DV * 128, TB = KB + VB, SB = 2 * TB;
    LAS char* ldsl = (LAS char*)lds;
#define KVI2_(tile, off_) { \
        _Pragma("unroll") for (int i = 0; i < KPT; ++i) { const int p_ = wu + 8 * i, key_ = 16 * (p_ & 3) + (lane >> 2), c_ = ((lane & 3) ^ (-(key_ >> 2))) & 3; \
            if (p_ < KPN) __builtin_amdgcn_global_load_lds((const unsigned*)(kp(tile, key_) + (p_ >> 2) * 32 + c_ * 8), (LAS unsigned*)(ldsl + (off_) + p_ * 1024), 16, 0, 0); } \
        _Pragma("unroll") for (int i = 0; i < VPT; ++i) { const int p_ = wu + 8 * i, dv_ = 8 * p_ + (lane >> 3), ch_ = ((lane & 7) ^ (dv_ >> 1)) & 7; \
            if (p_ < VPN) __builtin_amdgcn_global_load_lds((const unsigned*)(vp(tile, dv_) + ch_ * 8), (LAS unsigned*)(ldsl + (off_) + KB + p_ * 1024), 16, 0, 0); } }
    const int np = (n + 1) >> 1;
    __syncthreads();
    { const int ta = tl(0), tb = tl(n > 1 ? 1 : 0); KVI2_(ta, 0); KVI2_(tb, TB); }
    asm volatile("s_waitcnt vmcnt(0)" ::: "memory");
    __syncthreads();
#pragma unroll 1
    for (int i = 0; i < np; ++i) {
        const int cur = i & 1;
        if (i + 1 < np) { const int ia = 2 * i + 2, ib = (2 * i + 3 < n) ? 2 * i + 3 : ia; const int ta = tl(ia), tb = tl(ib);
            if (cur) { KVI2_(ta, 0); KVI2_(tb, TB); } else { KVI2_(ta, SB); KVI2_(tb, SB + TB); } }
        const char* base = lds + cur * SB;
        const bool hasB = 2 * i + 1 < n;
        fn(tl(2 * i), base, base + KB, tl(hasB ? 2 * i + 1 : 2 * i), base + TB, base + TB + KB, hasB);
        asm volatile("s_waitcnt vmcnt(0)" ::: "memory");
        __syncthreads();
    }
#undef KVI2_
}

template <int DK, int NST>
__device__ __forceinline__ void qk_tile(const char* Kb, const bf16x8 (&qf)[NST][DK / 32], f32x4 (&s)[NST][4], int lane) {
    const int lr = lane & 15, lq = lane >> 4;
#pragma unroll
    for (int kt = 0; kt < 4; ++kt) {
#pragma unroll
        for (int st = 0; st < NST; ++st) s[st][kt] = (f32x4){0.f, 0.f, 0.f, 0.f};
#pragma unroll
        for (int ks = 0; ks < DK / 32; ++ks) {
            const bf16x8 kf = *(const bf16x8*)(Kb + offk(ks, kt * 16 + lr, lq));
#pragma unroll
            for (int st = 0; st < NST; ++st) s[st][kt] = mfma16(kf, qf[st][ks], s[st][kt]);
        }
    }
}
template <int DV, int NST>
__device__ __forceinline__ void pv_tile(const char* Vb, const f32x4 (&p)[NST][4], f32x4 (&O)[NST][DV / 16], int lane) {
    const int lr = lane & 15, lq = lane >> 4;
#pragma unroll
    for (int h2 = 0; h2 < 2; ++h2) {
        bf16x8 pf[NST];
#pragma unroll
        for (int st = 0; st < NST; ++st) {
            const uint2 a = pack4(p[st][2 * h2]), b = pack4(p[st][2 * h2 + 1]);
            const uint4 u = make_uint4(a.x, a.y, b.x, b.y);
            pf[st] = __builtin_bit_cast(bf16x8, u);
        }
#pragma unroll
        for (int dvt = 0; dvt < DV / 16; ++dvt) {
            const int dv = dvt * 16 + lr;
            const bf16x4 v0 = *(const bf16x4*)(Vb + offv(dv, 4 * h2 + (lq >> 1)) + (lq & 1) * 8);
            const bf16x4 v1 = *(const bf16x4*)(Vb + offv(dv, 4 * h2 + 2 + (lq >> 1)) + (lq & 1) * 8);
            const bf16x8 vf = __builtin_shufflevector(v0, v1, 0, 1, 2, 3, 4, 5, 6, 7);
#pragma unroll
            for (int st = 0; st < NST; ++st) O[st][dvt] = mfma16(vf, pf[st], O[st][dvt]);
        }
    }
}
constexpr float RESCALE_AT = 1099511627776.f, RESCALE_BY = 1.f / 1099511627776.f;
template <int DV, int NST>
__device__ __forceinline__ void softmax_online(f32x4 (&s)[NST][4], float (&c)[NST], float (&l)[NST], f32x4 (&O)[NST][DV / 16]) {
    bool scaled = false, big = false;
#pragma unroll
    for (int st = 0; st < NST; ++st) scaled = scaled || (c[st] != 1.f);
#pragma unroll
    for (int st = 0; st < NST; ++st)
#pragma unroll
        for (int kt = 0; kt < 4; ++kt)
#pragma unroll
            for (int r = 0; r < 4; ++r) s[st][kt][r] = fexp2(s[st][kt][r]);
    if (__any(scaled)) {
#pragma unroll
        for (int st = 0; st < NST; ++st)
#pragma unroll
            for (int kt = 0; kt < 4; ++kt) s[st][kt] *= c[st];
    }
#pragma unroll
    for (int st = 0; st < NST; ++st) { l[st] += sum16(s[st]); big = big || (l[st] > RESCALE_AT); }
    if (__any(big)) {
#pragma unroll
        for (int st = 0; st < NST; ++st) {
            const float f = l[st] > RESCALE_AT ? RESCALE_BY : 1.f;
            const float g = quad_min(f);
            l[st] *= g; c[st] *= g;
#pragma unroll
            for (int kt = 0; kt < 4; ++kt) s[st][kt] *= g;
#pragma unroll
            for (int dvt = 0; dvt < DV / 16; ++dvt) O[st][dvt] *= g;
        }
    }
}
__device__ __forceinline__ float quad_lsum(float l) { return quad_sum(l); }

template <int NP>
__device__ __forceinline__ void store_row16(bf16_t* row, const uint2 (&pk)[2 * NP], int lq) {
#pragma unroll
    for (int p2 = 0; p2 < NP; ++p2) {
        auto sx = __builtin_amdgcn_permlane16_swap(pk[2 * p2].x, pk[2 * p2 + 1].x, false, false);
        auto sy = __builtin_amdgcn_permlane16_swap(pk[2 * p2].y, pk[2 * p2 + 1].y, false, false);
        *(uint4*)(row + 16 * (2 * p2 + (lq & 1)) + 8 * (lq >> 1)) = make_uint4(sx[0], sy[0], sx[1], sy[1]);
    }
}
__device__ __forceinline__ void mla_item(const Params& P, char* lds, int b, int h, int qblk) {
    int t = threadIdx.x; asm volatile("" : "+v"(t));
    const int lane = t & 63, w = t >> 6, lr = lane & 15, lq = lane >> 4;
    const bf16_t* QM = (const bf16_t*)(P.ws + WS_QM);
    const bf16_t* KM = (const bf16_t*)(P.ws + WS_KM) + (size_t)(b * 8 + h) * SEQ * 96;
    const bf16_t* VTM = (const bf16_t*)(P.ws + WS_VTM) + (size_t)(b * 8 + h) * 64 * SEQ;
    const int wq0 = qblk * 256 + w * 32;
    bf16x8 qf[2][3];
#pragma unroll
    for (int st = 0; st < 2; ++st)
#pragma unroll
        for (int ks = 0; ks < 3; ++ks) qf[st][ks] = *(const bf16x8*)(QM + (size_t)(b * SEQ + wq0 + st * 16 + lr) * 768 + h * 96 + ks * 32 + lq * 8);
    float m[2] = {1.f, 1.f}, l[2] = {0.f, 0.f};
    f32x4 O[2][4];
#pragma unroll
    for (int st = 0; st < 2; ++st)
#pragma unroll
        for (int d = 0; d < 4; ++d) O[st][d] = (f32x4){0.f, 0.f, 0.f, 0.f};
    auto mla_tile = [&](int tile, const char* Kb, const char* Vb) __attribute__((always_inline)) {
        if (tile * 64 > wq0 + 31) return;
        f32x4 s[2][4];
        qk_tile<96, 2>(Kb, qf, s, lane);
        if (tile * 64 + 63 > wq0) {
#pragma unroll
            for (int st = 0; st < 2; ++st)
#pragma unroll
                for (int kt = 0; kt < 4; ++kt)
#pragma unroll
                    for (int r = 0; r < 4; ++r)
                        if (tile * 64 + kt * 16 + 4 * lq + r > wq0 + st * 16 + lr) s[st][kt][r] = NEGBIG;
        }
        softmax_online<64, 2>(s, m, l, O);
        pv_tile<64, 2>(Vb, s, O, lane);
    };
    kv_loop2<96, 64>(lds, 4 * qblk + 4,
        [&](int tile, int key) __attribute__((always_inline)) { return KM + (size_t)(tile * 64 + key) * 96; },
        [&](int tile, int dv) __attribute__((always_inline)) { return VTM + (size_t)dv * SEQ + tile * 64; },
        [&](int i) __attribute__((always_inline)) { return i; },
        [&](int ta, const char* Ka, const char* Va, int tb, const char* Kb, const char* Vb, bool hasB) __attribute__((always_inline)) {
            mla_tile(ta, Ka, Va);
            if (hasB) mla_tile(tb, Kb, Vb);
        });
    bf16_t* OM = (bf16_t*)(P.ws + WS_OMLA);
#pragma unroll
    for (int st = 0; st < 2; ++st) {
        const float inv = 1.f / quad_lsum(l[st]);
        const size_t tok = (size_t)b * SEQ + wq0 + st * 16 + lr;
        uint2 pk[4];
#pragma unroll
        for (int d = 0; d < 4; ++d) pk[d] = pack4(O[st][d] * inv);
        store_row16<2>(OM + tok * 512 + h * 64, pk, lq);
    }
}

__device__ __forceinline__ void mem_item(const Params& P, char* lds, int b, int h, int qblk) {
    int t = threadIdx.x; asm volatile("" : "+v"(t));
    const int lane = t & 63, w = t >> 6, lr = lane & 15, lq = lane >> 4;
    const bf16_t* PROJ = (const bf16_t*)(P.ws + WS_PROJ);
    const bf16_t* KMEM = (const bf16_t*)(P.ws + WS_KMEM) + (size_t)(b * 4 + h) * 256 * 128;
    const bf16_t* VTMEM = (const bf16_t*)(P.ws + WS_VTMEM) + (size_t)(b * 4 + h) * 128 * 256;
    const size_t tok = (size_t)b * SEQ + qblk * 128 + w * 16 + lr;
    bf16x8 qf[1][4];
#pragma unroll
    for (int ks = 0; ks < 4; ++ks) qf[0][ks] = *(const bf16x8*)(PROJ + tok * DIN + C_QMEM + h * 128 + ks * 32 + lq * 8);
    float m[1] = {1.f}, l[1] = {0.f};
    f32x4 O[1][8];
#pragma unroll
    for (int d = 0; d < 8; ++d) O[0][d] = (f32x4){0.f, 0.f, 0.f, 0.f};
    kv_loop<128, 128, true>(lds, 4,
        [&](int tile, int key) __attribute__((always_inline)) { return KMEM + (size_t)(tile * 64 + key) * 128; },
        [&](int tile, int dv) __attribute__((always_inline)) { return VTMEM + (size_t)dv * 256 + tile * 64; },
        [&](int i) __attribute__((always_inline)) { return i; },
        [&](int tile, const char* Kb, const char* Vb) __attribute__((always_inline)) {
            f32x4 s[1][4];
            qk_tile<128, 1>(Kb, qf, s, lane);
            softmax_online<128, 1>(s, m, l, O);
            pv_tile<128, 1>(Vb, s, O, lane);
        });
    bf16_t* OM = (bf16_t*)(P.ws + WS_OMEM);
    const float inv = 1.f / quad_lsum(l[0]);
    uint2 pk[8];
#pragma unroll
    for (int d = 0; d < 8; ++d) pk[d] = pack4(O[0][d] * inv);
    store_row16<4>(OM + tok * 512 + h * 128, pk, lq);
}

__device__ __forceinline__ void softmax_stats(const f32x4 (&s)[2][4], float (&c)[2], float (&l)[2]) {
#pragma unroll
    for (int st = 0; st < 2; ++st) {
        f32x4 e[4];
#pragma unroll
        for (int kt = 0; kt < 4; ++kt)
#pragma unroll
            for (int r = 0; r < 4; ++r) e[kt][r] = fexp2(s[st][kt][r]);
        l[st] += sum16(e) * c[st];
        const float g = quad_min(l[st] > RESCALE_AT ? RESCALE_BY : 1.f);
        l[st] *= g; c[st] *= g;
    }
}

template <int NMASK>
__device__ __forceinline__ void nsa_item(const Params& P, char* lds, int b, int g, int q0) {
    int t = threadIdx.x; asm volatile("" : "+v"(t));
    const int lane = t & 63, w = t >> 6, lr = lane & 15, lq = lane >> 4;
    const int hg = g * 4 + (lr & 3);
    const bf16_t* PROJ = (const bf16_t*)(P.ws + WS_PROJ);
    const size_t bg = (size_t)(b * 2 + g);
    const bf16_t* KC = (const bf16_t*)(P.ws + WS_KC) + bg * 512 * 64;
    const bf16_t* VTC = (const bf16_t*)(P.ws + WS_VTC) + bg * 64 * 512;
    const bf16_t* KSLC = (const bf16_t*)(P.ws + WS_KSLC) + bg * SEQ * 64;
    const bf16_t* VTSLC = (const bf16_t*)(P.ws + WS_VTSLC) + bg * 64 * SEQ;
    const bf16_t* KWIN = (const bf16_t*)(P.ws + WS_KWIN) + bg * SEQ * 64;
    const bf16_t* VTWIN = (const bf16_t*)(P.ws + WS_VTWIN) + bg * 64 * SEQ;
    float* imp = (float*)(lds + 65536);
    const float* LUT = (const float*)(lds + LDS_LUT) + 64 * 8;
    unsigned* SEL = (unsigned*)(lds + LDS_SEL);
    unsigned* WOR = (unsigned*)(lds + LDS_WOR);
    unsigned char* TL = (unsigned char*)(lds + LDS_TL);
    int* TLN = (int*)(lds + LDS_TL + 128);
    int tpos[2];
    tpos[0] = q0 + 8 * w + (lr >> 2); tpos[1] = tpos[0] + 4;
    bf16x8 qf[2][2];
#pragma unroll
    for (int st = 0; st < 2; ++st)
#pragma unroll
        for (int ks = 0; ks < 2; ++ks) qf[st][ks] = *(const bf16x8*)(PROJ + (size_t)(b * SEQ + tpos[st]) * DIN + C_QNSA + hg * 64 + ks * 32 + lq * 8);
    auto gate = [&](int st, int k) __attribute__((always_inline)) { return bf2f(PROJ[(size_t)(b * SEQ + tpos[st]) * DIN + C_GNSA + hg * 3 + k]); };
    f32x4 OT[2][4];
#pragma unroll
    for (int i = 0; i < 16; ++i) imp[(8 * w) * 128 + i * 64 + lane] = 0.f;

    const float bfar = LUT[128 * 8 + hg];
    const int ntc = (((q0 + 32) >> 4) >> 6) + 1;
    float m[2] = {1.f, 1.f}, l[2] = {0.f, 0.f};
    auto cmp_mask = [&](int tile, f32x4 (&s)[2][4]) __attribute__((always_inline)) {
#pragma unroll
        for (int st = 0; st < 2; ++st)
#pragma unroll
            for (int kt = 0; kt < 4; ++kt)
#pragma unroll
                for (int r = 0; r < 4; ++r) {
                    const int n = tile * 64 + kt * 16 + 4 * lq + r;
                    const int dist = tpos[st] - (16 * n + 31);
                    const int di = dist < -1 ? -1 : (dist < 128 ? dist : 128);
                    s[st][kt][r] += LUT[di * 8 + hg];
                }
    };
    kv_loop<64, 64, false>(lds, ntc,
        [&](int tile, int key) __attribute__((always_inline)) { return KC + (size_t)(tile * 64 + key) * 64; },
        [&](int tile, int dv) __attribute__((always_inline)) { return VTC; },
        [&](int i) __attribute__((always_inline)) { return i; },
        [&](int tile, const char* Kb, const char* Vb) __attribute__((always_inline)) {
            f32x4 s[2][4];
            const bool farc = q0 + 8 * w - (16 * (tile * 64 + 63) + 31) >= 128;
            qk_tile<64, 2>(Kb, qf, s, lane);
            if (farc) {
#pragma unroll
                for (int st = 0; st < 2; ++st)
#pragma unroll
                    for (int kt = 0; kt < 4; ++kt) s[st][kt] += bfar;
            } else cmp_mask(tile, s);
            softmax_stats(s, m, l);
        });
    float invl[2];
#pragma unroll
    for (int st = 0; st < 2; ++st) { const float lt = quad_lsum(l[st]); invl[st] = lt > 0.f ? m[st] / lt : 0.f; }
#pragma unroll
    for (int st = 0; st < 2; ++st)
#pragma unroll
        for (int d = 0; d < 4; ++d) OT[st][d] = (f32x4){0.f, 0.f, 0.f, 0.f};
    kv_loop<64, 64, true>(lds, ntc,
        [&](int tile, int key) __attribute__((always_inline)) { return KC + (size_t)(tile * 64 + key) * 64; },
        [&](int tile, int dv) __attribute__((always_inline)) { return VTC + (size_t)dv * 512 + tile * 64; },
        [&](int i) __attribute__((always_inline)) { return i; },
        [&](int tile, const char* Kb, const char* Vb) __attribute__((always_inline)) {
            f32x4 s[2][4];
            const bool farc = q0 + 8 * w - (16 * (tile * 64 + 63) + 31) >= 128;
            qk_tile<64, 2>(Kb, qf, s, lane);
            if (farc) {
#pragma unroll
                for (int st = 0; st < 2; ++st)
#pragma unroll
                    for (int kt = 0; kt < 4; ++kt) s[st][kt] += bfar;
            } else cmp_mask(tile, s);
#pragma unroll
            for (int st = 0; st < 2; ++st)
#pragma unroll
                for (int kt = 0; kt < 4; ++kt) {
#pragma unroll
                    for (int r = 0; r < 4; ++r) {
                        s[st][kt][r] = fexp2(s[st][kt][r]) * invl[st];
                    }
                    float ps = (s[st][kt][0] + s[st][kt][1]) + (s[st][kt][2] + s[st][kt][3]);
                    float pc = s[st][kt][3];
                    ps = quad4_sum(ps);
                    pc = quad4_sum(pc);
                    const int j = tile * 16 + kt * 4 + lq;
                    float* row = imp + (8 * w + 4 * st + (lr >> 2)) * 128;
                    if ((lr & 3) == 0) lds_fadd(&row[j], ps);
                    if ((lr & 3) == 0 && j + 1 < 128) lds_fadd(&row[j + 1], pc);
                }
            pv_tile<64, 2>(Vb, s, OT, lane);
        });
#pragma unroll
    for (int st = 0; st < 2; ++st) {
        const float g0 = gate(st, 0);
#pragma unroll
        for (int d = 0; d < 4; ++d) OT[st][d] *= g0;
    }

    {
        unsigned wo0 = 0, wo1 = 0, wo2 = 0, wo3 = 0;
        for (int qi = 0; qi < 8; ++qi) {
            const int tq = q0 + 8 * w + qi, cur = tq >> 6;
            const float v0 = imp[(8 * w + qi) * 128 + lane], v1 = imp[(8 * w + qi) * 128 + 64 + lane];
            const int j0 = lane, j1 = lane + 64;
            bool s0 = (j0 == 0) || (j0 == cur) || (j0 + 1 == cur);
            bool s1 = (j1 == cur) || (j1 + 1 == cur);
            const bool c0 = (j0 >= 1) && (j0 + 2 <= cur), c1 = (j1 + 2 <= cur);
            if (cur - 2 <= 13) { s0 = s0 || c0; s1 = s1 || c1; }
            else {
                const unsigned k0 = c0 ? __float_as_uint(v0) + 1u : 0u, k1 = c1 ? __float_as_uint(v1) + 1u : 0u;
                unsigned T = 0u;
                for (int bit = 30; bit >= 0; --bit) {
                    const unsigned cand = T | (1u << bit);
                    const int cnt = __popcll(__ballot(k0 >= cand)) + __popcll(__ballot(k1 >= cand));
                    if (cnt >= 13) { T = cand; if (cnt == 13) break; }
                }
                const unsigned long long gt0 = __ballot(k0 > T), gt1 = __ballot(k1 > T);
                unsigned long long eq0 = __ballot(k0 == T), eq1 = __ballot(k1 == T);
                int need = 13 - (__popcll(gt0) + __popcll(gt1));
                unsigned long long tk0 = 0ull, tk1 = 0ull;
                while (need > 0 && eq0) { const unsigned long long lowb = eq0 & (0ull - eq0); tk0 |= lowb; eq0 ^= lowb; --need; }
                while (need > 0 && eq1) { const unsigned long long lowb = eq1 & (0ull - eq1); tk1 |= lowb; eq1 ^= lowb; --need; }
                s0 = s0 || ((gt0 | tk0) >> lane) & 1ull;
                s1 = s1 || ((gt1 | tk1) >> lane) & 1ull;
            }
            const unsigned long long b0 = __ballot(s0), b1 = __ballot(s1);
            if (lane == 0) {
                SEL[(8 * w + qi) * 4 + 0] = (unsigned)b0; SEL[(8 * w + qi) * 4 + 1] = (unsigned)(b0 >> 32);
                SEL[(8 * w + qi) * 4 + 2] = (unsigned)b1; SEL[(8 * w + qi) * 4 + 3] = (unsigned)(b1 >> 32);
            }
            wo0 |= (unsigned)b0; wo1 |= (unsigned)(b0 >> 32); wo2 |= (unsigned)b1; wo3 |= (unsigned)(b1 >> 32);
        }
        if (lane == 0) { WOR[w * 4 + 0] = wo0; WOR[w * 4 + 1] = wo1; WOR[w * 4 + 2] = wo2; WOR[w * 4 + 3] = wo3; }
    }
    __syncthreads();
    if (w == 0) {
        unsigned o0 = 0u, o1 = 0u, o2 = 0u, o3 = 0u;
#pragma unroll
        for (int ww = 0; ww < NWV; ++ww) { o0 |= WOR[ww * 4 + 0]; o1 |= WOR[ww * 4 + 1]; o2 |= WOR[ww * 4 + 2]; o3 |= WOR[ww * 4 + 3]; }
        const bool n0 = ((lane < 32 ? o0 : o1) >> (lane & 31)) & 1u, n1 = ((lane < 32 ? o2 : o3) >> (lane & 31)) & 1u;
        const unsigned long long m0 = __ballot(n0), m1 = __ballot(n1);
        const unsigned long long below = (1ull << lane) - 1ull;
        const int c0 = __popcll(m0);
        if (n0) TL[__popcll(m0 & below)] = (unsigned char)lane;
        if (n1) TL[c0 + __popcll(m1 & below)] = (unsigned char)(64 + lane);
        if (lane == 0) *TLN = c0 + __popcll(m1);
    }
    __syncthreads();
    const int nts = *TLN;
    f32x4* ST = (f32x4*)(lds + 65536);
#pragma unroll
    for (int k = 0; k < 8; ++k) ST[k * NTHR + t] = OT[k >> 2][k & 3];

    if (NMASK & 2)
    {
        f32x4 Oa[1][4], Ob[1][4];
#pragma unroll
        for (int d = 0; d < 4; ++d) { Oa[0][d] = (f32x4){0.f, 0.f, 0.f, 0.f}; Ob[0][d] = (f32x4){0.f, 0.f, 0.f, 0.f}; }
        float ca[1] = {1.f}, cb[1] = {1.f}, la[1] = {0.f}, lb[1] = {0.f};
        bf16x8 qfa[1][2], qfb[1][2];
#pragma unroll
        for (int ks = 0; ks < 2; ++ks) { qfa[0][ks] = qf[0][ks]; qfb[0][ks] = qf[1][ks]; }
        auto proc = [&](int tile, const char* Kb, const char* Vb, const bf16x8 (&q1)[1][2], f32x4 (&O1)[1][4], float (&c1)[1], float (&l1)[1], bool on, int tp) __attribute__((always_inline)) {
            f32x4 s[1][4];
            qk_tile<64, 1>(Kb, q1, s, lane);
            const bool far = tile * 64 + 63 + 128 <= q0 + 8 * w;
            if (far) {
                const float ab = on ? bfar : NEGBIG;
#pragma unroll
                for (int kt = 0; kt < 4; ++kt) s[0][kt] += ab;
            } else {
                int D = tp - (tile * 64 + 4 * lq); D = D < 191 ? D : 191; D = on ? D : -1;
                const float* lp = LUT + (D - 63) * 8 + hg;
#pragma unroll
                for (int kt = 0; kt < 4; ++kt)
#pragma unroll
                    for (int r = 0; r < 4; ++r) s[0][kt][r] += lp[(63 - (kt * 16 + r)) * 8];
            }
            softmax_online<64, 1>(s, c1, l1, O1);
            pv_tile<64, 1>(Vb, s, O1, lane);
        };
        auto s_tile = [&](int tile, const char* Kb, const char* Vb) __attribute__((always_inline)) {
            const unsigned wv = WOR[w * 4 + (tile >> 5)];
            if (!((wv >> (tile & 31)) & 1u)) return;
            const bool on0 = (SEL[(8 * w + (lr >> 2)) * 4 + (tile >> 5)] >> (tile & 31)) & 1u;
            const bool on1 = (SEL[(8 * w + 4 + (lr >> 2)) * 4 + (tile >> 5)] >> (tile & 31)) & 1u;
            if (__any(on0)) proc(tile, Kb, Vb, qfa, Oa, ca, la, on0, tpos[0]);
            if (__any(on1)) proc(tile, Kb, Vb, qfb, Ob, cb, lb, on1, tpos[1]);
        };
        kv_loop2<64, 64>(lds, nts,
            [&](int tile, int key) __attribute__((always_inline)) { return KSLC + (size_t)(tile * 64 + key) * 64; },
            [&](int tile, int dv) __attribute__((always_inline)) { return VTSLC + (size_t)dv * SEQ + tile * 64; },
            [&](int i) __attribute__((always_inline)) { return (int)TL[i]; },
            [&](int ta, const char* Ka, const char* Va, int tb, const char* Kb, const char* Vb, bool hasB) __attribute__((always_inline)) {
                s_tile(ta, Ka, Va);
                if (hasB) s_tile(tb, Kb, Vb);
            });
        {
            const float lt = quad_lsum(la[0]);
            const float f = lt > 0.f ? gate(0, 1) / lt : 0.f;
#pragma unroll
            for (int d = 0; d < 4; ++d) ST[d * NTHR + t] += Oa[0][d] * f;
        }
        {
            const float lt = quad_lsum(lb[0]);
            const float f = lt > 0.f ? gate(1, 1) / lt : 0.f;
#pragma unroll
            for (int d = 0; d < 4; ++d) ST[(4 + d) * NTHR + t] += Ob[0][d] * f;
        }
    }
    if (NMASK & 4) {
        f32x4 O[2][4];
#pragma unroll
        for (int st = 0; st < 2; ++st)
#pragma unroll
            for (int d = 0; d < 4; ++d) O[st][d] = (f32x4){0.f, 0.f, 0.f, 0.f};
        m[0] = 1.f; m[1] = 1.f; l[0] = 0.f; l[1] = 0.f;
        const int tw0 = (q0 - 511 > 0 ? q0 - 511 : 0) >> 6, tw1 = (q0 + 63) >> 6;
        kv_loop<64, 64, true>(lds, tw1 - tw0 + 1,
            [&](int tile, int key) __attribute__((always_inline)) { return KWIN + (size_t)(tile * 64 + key) * 64; },
            [&](int tile, int dv) __attribute__((always_inline)) { return VTWIN + (size_t)dv * SEQ + tile * 64; },
            [&](int i) __attribute__((always_inline)) { return tw0 + i; },
            [&](int tile, const char* Kb, const char* Vb) __attribute__((always_inline)) {
                f32x4 s[2][4];
                const bool mid = q0 + 8 * w - (tile * 64 + 63) >= 128 && q0 + 8 * w + 7 - tile * 64 < 512;
                qk_tile<64, 2>(Kb, qf, s, lane);
                if (mid) {
#pragma unroll
                    for (int st = 0; st < 2; ++st)
#pragma unroll
                        for (int kt = 0; kt < 4; ++kt) s[st][kt] += bfar;
                } else if (q0 + 8 * w - (tile * 64 + 63) < 128) {
#pragma unroll
                    for (int st = 0; st < 2; ++st) {
                        int D = tpos[st] - (tile * 64 + 4 * lq); D = D < 191 ? D : 191;
                        const float* lp = LUT + (D - 63) * 8 + hg;
#pragma unroll
                        for (int kt = 0; kt < 4; ++kt)
#pragma unroll
                            for (int r = 0; r < 4; ++r) s[st][kt][r] += lp[(63 - (kt * 16 + r)) * 8];
                    }
                } else {
#pragma unroll
                    for (int st = 0; st < 2; ++st)
#pragma unroll
                        for (int kt = 0; kt < 4; ++kt)
#pragma unroll
                            for (int r = 0; r < 4; ++r) {
                                const int dist = tpos[st] - (tile * 64 + kt * 16 + 4 * lq + r);
                                s[st][kt][r] = dist < 512 ? s[st][kt][r] + bfar : NEGBIG;
                            }
                }
                softmax_online<64, 2>(s, m, l, O);
                pv_tile<64, 2>(Vb, s, O, lane);
            });
#pragma unroll
        for (int st = 0; st < 2; ++st) {
            const float lt = quad_lsum(l[st]);
            const float f = lt > 0.f ? gate(st, 2) / lt : 0.f;
            bf16_t* ON = (bf16_t*)(P.ws + WS_ONSA);
            uint2 pk[4];
#pragma unroll
            for (int d = 0; d < 4; ++d) pk[d] = pack4(ST[(st * 4 + d) * NTHR + t] + O[st][d] * f);
            store_row16<2>(ON + (size_t)(b * SEQ + tpos[st]) * 512 + hg * 64, pk, lq);
        }
    }
}

#ifndef P3SEL
#define P3SEL 7
#endif
#ifndef NSADUP
#define NSADUP 7
#endif
__device__ __forceinline__ void convert_experts(const Params& P, char* lds, int tbeg, int tend, int b0, int st);
constexpr int CONV_CHUNKS3 = NEA * 96 / 4;
template <int QOFF, int SEL>
__device__ __forceinline__ void phase3(const Params& P, char* lds) {
    unsigned* ctl = (unsigned*)(P.ws + WS_CTL);
    unsigned* chead = &ctl[QOFF + CTL_Q + 448];
#define P3_QUEUE(head_, n_, call_) { int it = queue_pop(head_, lds); while (it < (n_)) { \
        unsigned nx_ = 0u, cx_ = 0u; if (threadIdx.x == 0) { nx_ = atomicAdd(head_, 1u); cx_ = atomicAdd(chead, 1u); } \
        call_; \
        __syncthreads(); if (threadIdx.x == 0) { *(volatile int*)(lds + LDS_ITEM) = (int)nx_; *(volatile int*)(lds + LDS_ITEM + 4) = (int)cx_; } __syncthreads(); \
        it = __builtin_amdgcn_readfirstlane(*(volatile int*)(lds + LDS_ITEM)); \
        { const int cc_ = __builtin_amdgcn_readfirstlane(*(volatile int*)(lds + LDS_ITEM + 4)); if (cc_ < CONV_CHUNKS3) convert_experts(P, lds, cc_ * 4, cc_ * 4 + 4, 0, 1); } } }
    if (SEL & 1) P3_QUEUE(&ctl[QOFF + CTL_Q + 64], 1024, mla_item(P, lds, (it & 31) >> 3, it & 7, 31 - (it >> 5)))
    if (SEL & 2) P3_QUEUE(&ctl[QOFF + CTL_Q + 128], 1024, (nsa_item<(QOFF == 0 ? 7 : NSADUP)>(P, lds, (it & 7) >> 1, it & 1, (127 - (it >> 3)) * 64)))
    if (SEL & 4) P3_QUEUE(&ctl[QOFF + CTL_Q + 192], 1024, mem_item(P, lds, it >> 8, (it >> 6) & 3, it & 63))
#undef P3_QUEUE
    for (;;) { const int cc = queue_pop(chead, lds); if (cc >= CONV_CHUNKS3) break; convert_experts(P, lds, cc * 4, cc * 4 + 4, 0, 1); }
}

__device__ __forceinline__ void phase4(const Params& P, char* lds) {
    const bf16_t* PROJ = (const bf16_t*)(P.ws + WS_PROJ);
    bf16_t* MERGED = (bf16_t*)(P.ws + WS_MERGED);
    int ring = 0; bool primed = false;
    auto tile_mn = [&](int tile, int& m0, int& n0) __attribute__((always_inline)) {
        const int bb = tile & 255, rnd = tile >> 8, xg = bb & 7, rr = bb >> 3;
        const int mt = (xg + 8 * rnd) * 4 + (rr & 3), nt = rr >> 2; m0 = mt * 256; n0 = nt * 128;
    };
    for (int tile = blockIdx.x; tile < 1024; tile += gridDim.x) {
        int t = threadIdx.x; asm volatile("" : "+v"(t)); const int lane = t & 63, w = t >> 6, wm = w >> 1, wn = w & 1, lr = lane & 15, lq = lane >> 4;
        int m0, n0; tile_mn(tile, m0, n0);
        const bool last_tile = tile + (int)gridDim.x >= 1024;
        f32x4 tot[4][4]; zero_acc(tot);
#pragma unroll 1
        for (int br = 0; br < 3; ++br) {
            f32x4 acc[4][4]; zero_acc(acc);
            GemmA A = make_op<4>((const bf16_t*)(P.ws + WS_ONSA + (size_t)br * 32 * MBY), 512, m0, NTOK);
            GemmA B = make_op<2, true>((const bf16_t*)(P.ws + WB_WBR) + (size_t)br * 1024 * 512, 512, n0, 1024);
            const bool chain = !(br == 2 && last_tile);
            int m1 = m0, n1 = n0; const int br1 = br == 2 ? 0 : br + 1;
            if (br == 2 && !last_tile) tile_mn(tile + gridDim.x, m1, n1);
            GemmA An = make_op<4>((const bf16_t*)(P.ws + WS_ONSA + (size_t)br1 * 32 * MBY), 512, m1, NTOK);
            GemmA Bn = make_op<2, true>((const bf16_t*)(P.ws + WB_WBR) + (size_t)br1 * 1024 * 512, 512, n1, 1024);
            gemm_mainloop_c(lds, A, B, 512 / 64, acc, ring, primed, chain, An, Bn);
            primed = chain;
#pragma unroll
            for (int i = 0; i < 4; ++i) {
                const size_t tok = m0 + wm * 64 + i * 16 + lr;
#pragma unroll
                for (int jp = 0; jp < 2; ++jp) {
                    const int n = n0 + wn * 64 + jp * 32 + 8 * lq;
                    const uint4 gv = *(const uint4*)(PROJ + tok * DIN + C_GMERGE + br * 1024 + n);
                    tot[i][2 * jp][0] += bflo(gv.x) * acc[i][2 * jp][0]; tot[i][2 * jp][1] += bfhi(gv.x) * acc[i][2 * jp][1];
                    tot[i][2 * jp][2] += bflo(gv.y) * acc[i][2 * jp][2]; tot[i][2 * jp][3] += bfhi(gv.y) * acc[i][2 * jp][3];
                    tot[i][2 * jp + 1][0] += bflo(gv.z) * acc[i][2 * jp + 1][0]; tot[i][2 * jp + 1][1] += bfhi(gv.z) * acc[i][2 * jp + 1][1];
                    tot[i][2 * jp + 1][2] += bflo(gv.w) * acc[i][2 * jp + 1][2]; tot[i][2 * jp + 1][3] += bfhi(gv.w) * acc[i][2 * jp + 1][3];
                }
            }
        }
#pragma unroll
        for (int i = 0; i < 4; ++i) {
            const size_t tok = m0 + wm * 64 + i * 16 + lr;
#pragma unroll
            for (int jp = 0; jp < 2; ++jp) { const uint2 x = pack4(tot[i][2 * jp]), y = pack4(tot[i][2 * jp + 1]); *(uint4*)(MERGED + tok * DM + n0 + wn * 64 + jp * 32 + 8 * lq) = make_uint4(x.x, x.y, y.x, y.y); }
        }
    }
}

struct EpiY1 {
    const bf16_t* H0; bf16_t* Y1;
    __device__ __forceinline__ bool operator()(f32x4 (&acc)[2][2][4][2], const pg8::Unit& u, int, int wr, int wc, int fr, int fq) const {
#pragma unroll
        for (int ai = 0; ai < 2; ++ai)
#pragma unroll
            for (int m = 0; m < 4; ++m) {
                const size_t tok = (size_t)u.pm * 256 + ai * 128 + wr * 64 + m * 16 + fr;
#pragma unroll
                for (int bj = 0; bj < 2; ++bj) {
                    const int col = u.pn * 256 + bj * 128 + wc * 32 + 8 * fq;
                    const uint4 hv = *(const uint4*)(H0 + tok * DM + col);
                    f32x4 v0 = acc[ai][bj][m][0], v1 = acc[ai][bj][m][1];
                    v0[0] += ALPHA * bflo(hv.x); v0[1] += ALPHA * bfhi(hv.x); v0[2] += ALPHA * bflo(hv.y); v0[3] += ALPHA * bfhi(hv.y);
                    v1[0] += ALPHA * bflo(hv.z); v1[1] += ALPHA * bfhi(hv.z); v1[2] += ALPHA * bflo(hv.w); v1[3] += ALPHA * bfhi(hv.w);
                    const uint2 a = pack4(v0), c = pack4(v1);
                    *(uint4*)(Y1 + tok * H1LD + col) = make_uint4(a.x, a.y, c.x, c.y);
                }
            }
        return false;
    }
};
__device__ __forceinline__ void phase5a(const Params& P, char* lds) {
    pg8::DenseProv PV; PV.S.init(NTOK, DM, gridDim.x, blockIdx.x);
    PV.A = (const bf16_t*)(P.ws + WS_MERGED); PV.Bt = (const bf16_t*)(P.ws + WB_WOUT); PV.lda = DM; PV.ldb = DM; PV.perm = true;
    EpiY1 E; E.H0 = (const bf16_t*)(P.ws + WS_H0); E.Y1 = (bf16_t*)(P.ws + WS_Y1);
    pg8::gemm_phase((LAS unsigned char*)lds, DM, PV, E);
}

template <int MODE>
__device__ __forceinline__ void phase5b(const Params& P, char* lds) {
    const int t = threadIdx.x, lane = t & 63, w = t >> 6;
    const int gw = blockIdx.x * NWV + w, nw = gridDim.x * NWV;
    bf16_t* H1 = (bf16_t*)P.out; bf16_t* H1LO = (bf16_t*)(P.ws + WS_Y1);
    if (MODE == 0) for (int row0 = gw; row0 < NTOK; row0 += 2 * nw) {
        const int row1 = row0 + nw; const bool has1 = row1 < NTOK;
        const bf16_t* yb = (const bf16_t*)(P.ws + WS_Y1);
        uint4 raw[2][2];
#pragma unroll
        for (int u = 0; u < 2; ++u)
#pragma unroll
            for (int i = 0; i < 2; ++i) raw[u][i] = *(const uint4*)(yb + (size_t)((u && has1) ? row1 : row0) * H1LD + i * 512 + 8 * lane);
        float v[2][16]; float s[2] = {0.f, 0.f};
#pragma unroll
        for (int u = 0; u < 2; ++u)
#pragma unroll
            for (int i = 0; i < 2; ++i) {
                v[u][8 * i + 0] = bflo(raw[u][i].x); v[u][8 * i + 1] = bfhi(raw[u][i].x); v[u][8 * i + 2] = bflo(raw[u][i].y); v[u][8 * i + 3] = bfhi(raw[u][i].y);
                v[u][8 * i + 4] = bflo(raw[u][i].z); v[u][8 * i + 5] = bfhi(raw[u][i].z); v[u][8 * i + 6] = bflo(raw[u][i].w); v[u][8 * i + 7] = bfhi(raw[u][i].w);
            }
#pragma unroll
        for (int u = 0; u < 2; ++u)
#pragma unroll
            for (int k = 0; k < 16; ++k) s[u] += v[u][k];
        const float mu[2] = {wave_sum(s[0]) * (1.f / DM), wave_sum(s[1]) * (1.f / DM)};
        float q[2] = {0.f, 0.f};
#pragma unroll
        for (int u = 0; u < 2; ++u)
#pragma unroll
            for (int k = 0; k < 16; ++k) { const float d = v[u][k] - mu[u]; q[u] += d * d; }
        const float rstd[2] = {rsqrtf(wave_sum(q[0]) * (1.f / DM) + 1e-5f), rsqrtf(wave_sum(q[1]) * (1.f / DM) + 1e-5f)};
#pragma unroll
        for (int i = 0; i < 2; ++i) {
            const float4 g0 = ((const float4*)P.ln1_g)[i * 128 + 2 * lane], g1 = ((const float4*)P.ln1_g)[i * 128 + 2 * lane + 1];
            const float4 b0 = ((const float4*)P.ln1_b)[i * 128 + 2 * lane], b1 = ((const float4*)P.ln1_b)[i * 128 + 2 * lane + 1];
            const float gg[8] = {g0.x, g0.y, g0.z, g0.w, g1.x, g1.y, g1.z, g1.w}, bb[8] = {b0.x, b0.y, b0.z, b0.w, b1.x, b1.y, b1.z, b1.w};
#pragma unroll
            for (int u = 0; u < 2; ++u) {
                const int row = u ? row1 : row0;
                float h[8];
#pragma unroll
                for (int k = 0; k < 8; ++k) h[k] = (v[u][8 * i + k] - mu[u]) * rstd[u] * gg[k] + bb[k];
                const uint4 hi = make_uint4(pack2(h[0], h[1]), pack2(h[2], h[3]), pack2(h[4], h[5]), pack2(h[6], h[7]));
                const uint4 lo = make_uint4(pack2(h[0] - bflo(hi.x), h[1] - bfhi(hi.x)), pack2(h[2] - bflo(hi.y), h[3] - bfhi(hi.y)),
                                            pack2(h[4] - bflo(hi.z), h[5] - bfhi(hi.z)), pack2(h[6] - bflo(hi.w), h[7] - bfhi(hi.w)));
                if (u == 0 || has1) {
                    *(uint4*)(H1 + (size_t)row * H1LD + i * 512 + 8 * lane) = hi;
                    *(uint4*)(H1LO + (size_t)row * H1LD + i * 512 + 8 * lane) = lo;
                }
            }
        }
    }
}

#ifndef CONV_SPLIT
#define CONV_SPLIT 18432
#endif
__device__ __forceinline__ void convert_experts(const Params& P, char* lds, int tbeg, int tend, int b0, int st) {
    const int t = threadIdx.x;
    const int tt = t & 255, sub = t >> 8, kg = tt >> 5, n4 = tt & 31;
    char* tb = lds + sub * 16384;
    const int NT_ = tend, step = st * 2;
    __syncthreads();
    for (int tile0 = tbeg + b0 * 2; tile0 < NT_; tile0 += 2 * step) {
        float4 r[2][8]; const float* srcs[2]; bf16_t* dsts[2]; int lddv[2], kt0v[2], nt0v[2]; bool hasv[2];
#pragma unroll
        for (int q = 0; q < 2; ++q) {
            const int tile_ = tile0 + q * step + sub; hasv[q] = tile_ < NT_;
            const int tile = hasv[q] ? tile_ : tile0 + sub;
            const int mat = tile >> 5, loc = tile & 31, e = mat / 3, which = mat - e * 3;
            srcs[q] = (which == 0 ? P.exp_w1 : which == 1 ? P.exp_w3 : P.exp_w2) + (size_t)e * 262144;
            dsts[q] = (bf16_t*)expw_ptr(P.ws, e) + which * 262144;
            const int N = which == 2 ? 1024 : 256; lddv[q] = which == 2 ? 256 : 1024;
            kt0v[q] = (which == 2 ? (loc >> 3) : (loc >> 1)) * 64; nt0v[q] = (which == 2 ? (loc & 7) : (loc & 1)) * 128;
            const int k0 = kt0v[q] + kg * 8, n = nt0v[q] + n4 * 4;
#pragma unroll
            for (int kk = 0; kk < 8; ++kk) r[q][kk] = *(const float4*)(srcs[q] + (size_t)(k0 + kk) * N + n);
        }
#pragma unroll
        for (int q = 0; q < 2; ++q) {
#pragma unroll
            for (int c = 0; c < 4; ++c) {
                float v[8];
#pragma unroll
                for (int kk = 0; kk < 8; ++kk) v[kk] = (c == 0) ? r[q][kk].x : (c == 1) ? r[q][kk].y : (c == 2) ? r[q][kk].z : r[q][kk].w;
                *(uint4*)(tb + swz(4 * n4 + c, kg)) = make_uint4(pack2(v[0], v[1]), pack2(v[2], v[3]), pack2(v[4], v[5]), pack2(v[6], v[7]));
            }
            __syncthreads();
            if (hasv[q]) {
#pragma unroll
                for (int i = 0; i < 4; ++i) {
                    const int row = (tt >> 3) + 32 * i, ch = tt & 7;
                    *(uint4*)(dsts[q] + (size_t)(nt0v[q] + row) * lddv[q] + kt0v[q] + ch * 8) = *(const uint4*)(tb + swz(row, ch));
                }
            }
            __syncthreads();
        }
    }
}

__device__ __forceinline__ unsigned long long ord_key(float v, int e) {
    unsigned u = __float_as_uint(v); u = (u & 0x80000000u) ? ~u : (u | 0x80000000u);
    return ((unsigned long long)u << 8) | (unsigned)(255 - e);
}
template <bool NOWRITE>
__device__ __forceinline__ void phase5d(const Params& P, char* lds) {
    const bool conv_first5 = ((blockIdx.x >> 3) & 1) != 0;
    if (!NOWRITE && conv_first5) convert_experts(P, lds, CONV_SPLIT, 768 * 32, blockIdx.x, gridDim.x);
    const int t = threadIdx.x, lane = t & 63, w = t >> 6;
    const int gw = blockIdx.x * NWV + w, nw = gridDim.x * NWV;
    const float* LOGITS = (const float*)(P.ws + WS_LOGITS);
    unsigned* ctl = (unsigned*)(P.ws + WS_CTL);
    int* EID = (int*)(P.ws + WS_EID); float* EW = (float*)(P.ws + WS_EW); int* LIST = (int*)(P.ws + WS_LIST);
    const float4 rb = ((const float4*)P.router_b)[lane];
    float4 lgn = ((const float4*)(LOGITS + (size_t)(gw < NTOK ? gw : 0) * 256))[lane];
    for (int tok = gw; tok < NTOK; tok += nw) {
        const float4 lg = lgn;
        { const int tn = tok + nw < NTOK ? tok + nw : tok; lgn = ((const float4*)(LOGITS + (size_t)tn * 256))[lane]; }
        float s[4] = {sigmoidf_(lg.x), sigmoidf_(lg.y), sigmoidf_(lg.z), sigmoidf_(lg.w)};
        float sb[4] = {s[0] + rb.x, s[1] + rb.y, s[2] + rb.z, s[3] + rb.w};
        float a = fmaxf(sb[0], sb[1]), bq = fminf(sb[0], sb[1]);
        { const float a2 = fmaxf(sb[2], sb[3]), b2 = fminf(sb[2], sb[3]); const float na = fmaxf(a, a2); bq = fmaxf(fminf(a, a2), fmaxf(bq, b2)); a = na; }
#define DPPF_(x, ctrl) __uint_as_float(__builtin_amdgcn_update_dpp(0u, __float_as_uint(x), ctrl, 0xF, 0xF, true))
        { const float a2 = DPPF_(a, 0xB1), b2 = DPPF_(bq, 0xB1); const float na = fmaxf(a, a2); bq = fmaxf(fminf(a, a2), fmaxf(bq, b2)); a = na; }
        { const float a2 = DPPF_(a, 0x4E), b2 = DPPF_(bq, 0x4E); const float na = fmaxf(a, a2); bq = fmaxf(fminf(a, a2), fmaxf(bq, b2)); a = na; }
        { const float a2 = DPPF_(a, 0x141), b2 = DPPF_(bq, 0x141); const float na = fmaxf(a, a2); bq = fmaxf(fminf(a, a2), fmaxf(bq, b2)); a = na; }
#undef DPPF_
        const float gs = a + bq; const int grp = lane >> 3;
        int rank = 0;
#pragma unroll
        for (int g2 = 0; g2 < 8; ++g2) { const float o = __uint_as_float(__builtin_amdgcn_readlane(__float_as_uint(gs), g2 * 8)); rank += (o > gs || (o == gs && g2 < grp)) ? 1 : 0; }
        const bool gsel = rank < 4;
        float v[4];
#pragma unroll
        for (int i = 0; i < 4; ++i) v[i] = gsel ? sb[i] : -3.0e38f;
        int my_e = 0; float my_s = 0.f, wsum = 0.f;
        for (int r = 0; r < 8; ++r) {
            float bv = v[0]; int bi = 0;
#pragma unroll
            for (int i = 1; i < 4; ++i) if (v[i] > bv) { bv = v[i]; bi = i; }
            const float wm = wave_max(bv);
            const int wl = __builtin_amdgcn_readfirstlane(__ffsll((long long)__ballot(bv == wm)) - 1);
            const int wi = __builtin_amdgcn_readlane(bi, wl);
            const float mine = bi == 0 ? s[0] : bi == 1 ? s[1] : bi == 2 ? s[2] : s[3];
            const float sv = __uint_as_float(__builtin_amdgcn_readlane(__float_as_uint(mine), wl));
            if (lane == wl) { if (bi == 0) v[0] = -3.0e38f; else if (bi == 1) v[1] = -3.0e38f; else if (bi == 2) v[2] = -3.0e38f; else v[3] = -3.0e38f; }
            wsum += sv;
            if (lane == r) { my_e = wl * 4 + wi; my_s = sv; }
        }
        if (NOWRITE) { asm volatile("" :: "v"(my_e), "v"(my_s), "v"(wsum)); }
        else if (lane < 8) {
            const float wv = my_s / wsum * 2.5f;
            EID[tok * 8 + lane] = my_e; EW[tok * 8 + lane] = wv;
            const unsigned pos = atomicAdd(&ctl[CTL_CNT + my_e * 16], 1u);
            LIST[(size_t)my_e * NTOK + pos] = tok * 8 + lane;
        }
    }
    if (!NOWRITE && !conv_first5) convert_experts(P, lds, CONV_SPLIT, 768 * 32, blockIdx.x, gridDim.x);
}

struct ProvUp {
    const char* h1; const char* wb; const int* aid;
    __device__ __forceinline__ void offsets(unsigned (&va)[2][2], unsigned (&vb)[2][2], const int (&sR)[2], const int (&sC)[2]) const {
#pragma unroll
        for (int h = 0; h < 2; ++h)
#pragma unroll
            for (int p = 0; p < 2; ++p) {
                va[h][p] = (unsigned)(((size_t)(aid[h * 128 + sR[p]] >> 3) * H1LD + sC[p]) * 2);
                vb[h][p] = (unsigned)(((size_t)h * 262144 + (size_t)((sR[p] & ~31) + pg8::perm32(sR[p] & 31)) * 1024 + sC[p]) * 2);
            }
    }
    __device__ __forceinline__ bool get(int i, pg8::Unit& u, pg8::Ops& o) const {
        if (i >= 2) return false;
        u.pm = 0; u.pn = i; o.A = h1; o.B = wb + (size_t)i * 128 * 1024 * 2;
        return true;
    }
};
struct EpiUp {
    bf16_t* scr;
    __device__ __forceinline__ bool operator()(f32x4 (&acc)[2][2][4][2], const pg8::Unit& u, int, int wr, int wc, int fr, int fq) const {
#pragma unroll
        for (int ai = 0; ai < 2; ++ai)
#pragma unroll
            for (int m = 0; m < 4; ++m) {
                const int row = ai * 128 + wr * 64 + m * 16 + fr;
                f32x4 v0, v1;
#pragma unroll
                for (int r = 0; r < 4; ++r) { v0[r] = siluf_(acc[ai][0][m][0][r]) * acc[ai][1][m][0][r]; v1[r] = siluf_(acc[ai][0][m][1][r]) * acc[ai][1][m][1][r]; }
                const uint2 a = pack4(v0), c = pack4(v1);
                *(uint4*)(scr + row * 256 + u.pn * 128 + wc * 32 + 8 * fq) = make_uint4(a.x, a.y, c.x, c.y);
            }
        return false;
    }
};
struct ProvDown {
    const char* scr; const char* w2t;
    __device__ __forceinline__ void offsets(unsigned (&va)[2][2], unsigned (&vb)[2][2], const int (&sR)[2], const int (&sC)[2]) const {
#pragma unroll
        for (int h = 0; h < 2; ++h)
#pragma unroll
            for (int p = 0; p < 2; ++p) { va[h][p] = (unsigned)(((h * 128 + sR[p]) * 256 + sC[p]) * 2); vb[h][p] = (unsigned)(((h * 128 + (sR[p] & ~31) + pg8::perm32(sR[p] & 31)) * 256 + sC[p]) * 2); }
    }
    __device__ __forceinline__ bool get(int i, pg8::Unit& u, pg8::Ops& o) const {
        if (i >= 4) return false;
        u.pm = 0; u.pn = i; o.A = scr; o.B = w2t + (size_t)i * 256 * 256 * 2;
        return true;
    }
};
struct EpiDown {
    bf16_t* Y; bf16_t* SHOUT; const int* aid; int rows; bool routed;
    __device__ __forceinline__ bool operator()(f32x4 (&acc)[2][2][4][2], const pg8::Unit& u, int, int wr, int wc, int fr, int fq) const {
#pragma unroll
        for (int ai = 0; ai < 2; ++ai)
#pragma unroll
            for (int m = 0; m < 4; ++m) {
                const int row = ai * 128 + wr * 64 + m * 16 + fr;
                if (row < rows) {
                    const int a = aid[row];
                    bf16_t* dst = (routed ? (Y + (size_t)a * DM) : (SHOUT + (size_t)(a >> 3) * H1LD)) + u.pn * 256 + wc * 32 + 8 * fq;
#pragma unroll
                    for (int bj = 0; bj < 2; ++bj) { const uint2 x = pack4(acc[ai][bj][m][0]), y = pack4(acc[ai][bj][m][1]); *(uint4*)(dst + bj * 128) = make_uint4(x.x, x.y, y.x, y.y); }
                }
            }
        return false;
    }
};
struct ProvRouter {
    const char* hi; const char* lo; const char* whi; const char* wlo; int tile0, tstep;
    __device__ __forceinline__ void offsets(unsigned (&va)[2][2], unsigned (&vb)[2][2], const int (&sR)[2], const int (&sC)[2]) const {
#pragma unroll
        for (int h = 0; h < 2; ++h)
#pragma unroll
            for (int p = 0; p < 2; ++p) { va[h][p] = (unsigned)(((size_t)(h * 128 + sR[p]) * H1LD + sC[p]) * 2); vb[h][p] = (unsigned)(((size_t)(h * 128 + sR[p]) * 1024 + sC[p]) * 2); }
    }
    __device__ __forceinline__ bool get(int i, pg8::Unit& u, pg8::Ops& o) const {
        const int q = i / 3, seg = i - q * 3, ot = tile0 + q * tstep;
        if (ot >= 128) return false;
        u.pm = ot; u.pn = seg;
        o.A = (seg == 1 ? lo : hi) + (size_t)ot * 256 * H1LD * 2; o.B = seg == 0 ? wlo : whi;
        return true;
    }
};
struct EpiRouter {
    float* LOGITS;
    __device__ __forceinline__ bool operator()(f32x4 (&acc)[2][2][4][2], const pg8::Unit& u, int, int wr, int wc, int fr, int fq) const {
        if (u.pn < 2) return true;
#pragma unroll
        for (int ai = 0; ai < 2; ++ai)
#pragma unroll
            for (int m = 0; m < 4; ++m) {
                const size_t tok = (size_t)u.pm * 256 + ai * 128 + wr * 64 + m * 16 + fr;
#pragma unroll
                for (int bj = 0; bj < 2; ++bj)
#pragma unroll
                    for (int n = 0; n < 2; ++n) *(f32x4*)(LOGITS + tok * 256 + bj * 128 + wc * 32 + n * 16 + 4 * fq) = acc[ai][bj][m][n];
            }
        return false;
    }
};
__device__ __forceinline__ void phase5c(const Params& P, char* lds) {
    const int xg = blockIdx.x & 7, rk = blockIdx.x >> 3, G8 = gridDim.x >> 3;
    const bool two = G8 >= 2; const int nr = two ? (G8 >> 1) : G8, ns = two ? G8 - nr : G8;
    const bool conv_first = (rk & 1) != 0;
    if (conv_first) convert_experts(P, lds, NEA * 96, CONV_SPLIT, blockIdx.x, gridDim.x);
    if (!two || rk < nr) {
        ProvRouter PV; PV.hi = (const char*)P.out; PV.lo = (const char*)(P.ws + WS_Y1); PV.whi = (const char*)(P.ws + WB_WRHI); PV.wlo = (const char*)(P.ws + WB_WRLO);
        PV.tile0 = xg * 16 + rk; PV.tstep = 0;
        EpiRouter E; E.LOGITS = (float*)(P.ws + WS_LOGITS);
        for (int j = rk; j < 16; j += nr) { PV.tile0 = xg * 16 + j; PV.tstep = 128; pg8::gemm_phase((LAS unsigned char*)lds, DM, PV, E); }
    }
    if (!two || rk >= nr) {
        int* aid = (int*)(lds + LDS_ROWS);
        bf16_t* SCR = (bf16_t*)(P.ws + WS_SCR2 + (size_t)blockIdx.x * 131072);
        const bf16_t* wb = (const bf16_t*)(P.ws + WB_WS1);
        for (int j = two ? rk - nr : rk; j < 16; j += ns) {
            const int t = threadIdx.x;
            __syncthreads();
            if (t < 256) aid[t] = ((xg * 16 + j) * 256 + t) * 8;
            __syncthreads();
            {
                ProvUp PV; PV.h1 = (const char*)P.out; PV.wb = (const char*)wb; PV.aid = aid;
                EpiUp E; E.scr = SCR;
                pg8::gemm_phase((LAS unsigned char*)lds, DM, PV, E);
            }
            asm volatile("s_waitcnt vmcnt(0)" ::: "memory");
            __syncthreads();
            {
                ProvDown PV; PV.scr = (const char*)SCR; PV.w2t = (const char*)(wb + 524288);
                EpiDown E; E.Y = (bf16_t*)(P.ws + WS_Y); E.SHOUT = (bf16_t*)P.out + 1024; E.aid = aid; E.rows = 256; E.routed = false;
                pg8::gemm_phase((LAS unsigned char*)lds, 256, PV, E);
            }
            __syncthreads();
        }
    }
    if (!conv_first) convert_experts(P, lds, NEA * 96, CONV_SPLIT, blockIdx.x, gridDim.x);
}

__device__ __forceinline__ void phase7(const Params& P, char* lds) {
    const int t0_ = threadIdx.x;
    unsigned* ctl = (unsigned*)(P.ws + WS_CTL);
    int* pre = (int*)(lds + LDS_PRE);
    int* aid = (int*)(lds + LDS_ROWS);
    const int* LIST = (const int*)(P.ws + WS_LIST);
    bf16_t* SCR = (bf16_t*)(P.ws + WS_SCR2 + (size_t)blockIdx.x * 131072);
    const int xg = blockIdx.x & 7, rk = blockIdx.x >> 3, G8 = gridDim.x >> 3;
    __syncthreads();
    if (t0_ == 0) {
        int s = 0;
        for (int k = 0; k < 32; ++k) { pre[k] = s; s += ((int)ctl[CTL_CNT + (xg + 8 * k) * 16] + 255) >> 8; }
        pre[32] = s;
    }
    __syncthreads();
    const int T = pre[32];
    for (int g = rk; g < T; g += G8) {
        const int t = threadIdx.x;
        const bf16_t* wb; int rows; const bool routed = true;
        {
            int lo = 0, hi = 32;
            while (hi - lo > 1) { const int mid = (lo + hi) >> 1; if (pre[mid] <= g) lo = mid; else hi = mid; }
            const int e = xg + 8 * lo, tile = g - pre[lo], cnt = (int)ctl[CTL_CNT + e * 16];
            rows = cnt - tile * 256; rows = rows < 256 ? rows : 256; rows = __builtin_amdgcn_readfirstlane(rows);
            if (t < 256) aid[t] = LIST[(size_t)e * NTOK + tile * 256 + (t < rows ? t : rows - 1)];
            wb = (const bf16_t*)expw_ptr(P.ws, e);
        }
        __syncthreads();
        {
            ProvUp PV; PV.h1 = (const char*)P.out; PV.wb = (const char*)wb; PV.aid = aid;
            EpiUp E; E.scr = SCR;
            pg8::gemm_phase((LAS unsigned char*)lds, DM, PV, E);
        }
        asm volatile("s_waitcnt vmcnt(0)" ::: "memory");
        __syncthreads();
        {
            ProvDown PV; PV.scr = (const char*)SCR; PV.w2t = (const char*)(wb + 524288);
            EpiDown E; E.Y = (bf16_t*)(P.ws + WS_Y); E.SHOUT = (bf16_t*)P.out + 1024; E.aid = aid; E.rows = rows; E.routed = routed;
            pg8::gemm_phase((LAS unsigned char*)lds, 256, PV, E);
        }
        __syncthreads();
    }
}

__device__ __forceinline__ void phase8(const Params& P) {
    const int t = threadIdx.x, lane = t & 63, w = t >> 6;
    const int gw = blockIdx.x * NWV + w, nw = gridDim.x * NWV;
    const bf16_t* H1 = (const bf16_t*)P.out; const bf16_t* SHOUT = (const bf16_t*)P.out + 1024;
    const bf16_t* Y = (const bf16_t*)(P.ws + WS_Y); const float* EW = (const float*)(P.ws + WS_EW);
    for (int tok = gw; tok < NTOK; tok += nw) {
        float v[4][4];
#pragma unroll
        for (int i = 0; i < 4; ++i) {
            const uint2 h = *(const uint2*)(H1 + (size_t)tok * H1LD + 4 * (lane + 64 * i));
            const uint2 s = *(const uint2*)(SHOUT + (size_t)tok * H1LD + 4 * (lane + 64 * i));
            v[i][0] = ALPHA * bflo(h.x) + bflo(s.x); v[i][1] = ALPHA * bfhi(h.x) + bfhi(s.x);
            v[i][2] = ALPHA * bflo(h.y) + bflo(s.y); v[i][3] = ALPHA * bfhi(h.y) + bfhi(s.y);
        }
#pragma unroll
        for (int k = 0; k < 8; ++k) {
            const float wk = EW[tok * 8 + k];
            const bf16_t* yr = Y + ((size_t)tok * 8 + k) * DM;
#pragma unroll
            for (int i = 0; i < 4; ++i) {
                const uint2 y = *(const uint2*)(yr + 4 * (lane + 64 * i));
                v[i][0] += wk * bflo(y.x); v[i][1] += wk * bfhi(y.x); v[i][2] += wk * bflo(y.y); v[i][3] += wk * bfhi(y.y);
            }
        }
        float s = 0.f;
#pragma unroll
        for (int i = 0; i < 4; ++i) s += v[i][0] + v[i][1] + v[i][2] + v[i][3];
        const float mu = wave_sum(s) * (1.f / DM);
        float q = 0.f;
#pragma unroll
        for (int i = 0; i < 4; ++i)
#pragma unroll
            for (int c = 0; c < 4; ++c) { const float d = v[i][c] - mu; q += d * d; }
        const float rstd = rsqrtf(wave_sum(q) * (1.f / DM) + 1e-5f);
#pragma unroll
        for (int i = 0; i < 4; ++i) {
            const float4 g = ((const float4*)P.ln2_g)[lane + 64 * i], bb = ((const float4*)P.ln2_b)[lane + 64 * i];
            float4 o;
            o.x = (v[i][0] - mu) * rstd * g.x + bb.x; o.y = (v[i][1] - mu) * rstd * g.y + bb.y;
            o.z = (v[i][2] - mu) * rstd * g.z + bb.z; o.w = (v[i][3] - mu) * rstd * g.w + bb.w;
            ((float4*)(P.out + (size_t)tok * DM))[lane + 64 * i] = o;
        }
    }
}

constexpr int N_PHASES = 11;
__global__ void __launch_bounds__(512, 2) fwd_kernel(Params P) {
    extern __shared__ __attribute__((aligned(16))) char lds[];
    const int t = threadIdx.x;
    if (t == 0) *(uint4*)(lds + LDS_BARW) = make_uint4(0u, 0u, 0u, 0u);
    {
        float* LUT = (float*)(lds + LDS_LUT);
        for (int i = t; i < 256 * 8; i += NTHR) {
            const int d = (i >> 3) - 64, h = i & 7;
            float v = NEGBIG;
            if (d >= 0) {
                int bucket = d;
                if (d >= 16) { bucket = 16 + (int)(log2f((float)d * (1.f / 16.f)) * (16.f / 3.f)); bucket = bucket < 31 ? bucket : 31; }
                v = P.rel_bias[bucket * 8 + h] * LOG2E;
            }
            LUT[i] = v;
        }
    }
    __syncthreads();
    XcdBarrier bar = xcd_barrier_post((unsigned*)(P.ws + WS_CTL), (volatile LAS unsigned*)(lds + LDS_BARW));
#ifndef ONLY_PHASE
#define ONLY_PHASE -1
#endif
#ifndef PROBE_DUP
#define PROBE_DUP -1
#endif
#define PHASE(k, call) if ((ONLY_PHASE < 0 || ONLY_PHASE == (k)) && P.ph_lo <= (k) && (k) < P.ph_hi) { call; if ((k) + 1 < P.ph_hi) xcd_barrier(bar); }
#define PHASE_DUP(k, call) if (PROBE_DUP == (k)) { call; xcd_barrier(bar); }
    PHASE(0, phase0(P))
    PHASE_DUP(1, phase1<true>(P, lds))
    PHASE(1, phase1<false>(P, lds))
    PHASE_DUP(2, phase2<1024>(P, lds))
    PHASE(2, phase2<0>(P, lds))
#ifndef P3DUP
#define P3DUP 7
#endif
    PHASE_DUP(3, (phase3<1024, P3DUP>(P, lds)))
    PHASE(3, (phase3<0, 7>(P, lds)))
    PHASE_DUP(4, phase4(P, lds))
    PHASE(4, phase4(P, lds))
    PHASE_DUP(5, phase5a(P, lds))
    PHASE(5, phase5a(P, lds))
#ifndef P6DUP
#define P6DUP 1
#endif
    PHASE_DUP(6, phase5b<P6DUP>(P, lds))
    PHASE(6, phase5b<0>(P, lds))
    PHASE_DUP(7, phase5c(P, lds))
    PHASE(7, phase5c(P, lds))
    PHASE_DUP(8, phase5d<true>(P, lds))
    PHASE(8, phase5d<false>(P, lds))
    PHASE_DUP(9, phase7(P, lds))
    PHASE(9, phase7(P, lds))
    PHASE_DUP(10, phase8(P))
#ifdef PROBE_BAR
    for (int i = 0; i < 16; ++i) xcd_barrier(bar);
#endif
    PHASE(10, phase8(P))
#undef PHASE
}

#ifndef MK_LAUNCHES
#define MK_LAUNCHES 1
#endif

extern "C" void kernel_launch(void* const* d_in, const int* in_sizes, int n_in, void* d_out, int out_size, void* d_ws, size_t ws_size,
                              hipStream_t stream) {
    static int grid = 0;
    if (grid == 0) {
        if (n_in != 31 || in_sizes[0] != NTOK * DM || out_size != NTOK * DM || ws_size < WS_END) {
            fprintf(stderr, "kernel_launch: unexpected shapes (n_in %d, in0 %d, out %d, ws %zu < %zu)\n", n_in, n_in > 0 ? in_sizes[0] : -1, out_size, ws_size, (size_t)WS_END);
            grid = -1; return;
        }
        int dev = 0, cus = 0, per_cu = 0;
        if (hipGetDevice(&dev) != hipSuccess || hipDeviceGetAttribute(&cus, hipDeviceAttributeMultiprocessorCount, dev) != hipSuccess) { grid = -1; return; }
        if (hipFuncSetAttribute((const void*)fwd_kernel, hipFuncAttributeMaxDynamicSharedMemorySize, LDS_BYTES) != hipSuccess) { grid = -1; return; }
        if (hipOccupancyMaxActiveBlocksPerMultiprocessor(&per_cu, (const void*)fwd_kernel, NTHR, LDS_BYTES) != hipSuccess || per_cu < 1) per_cu = 1;
        (void)hipGetLastError();
        grid = cus;
    }
    if (grid < 0) return;
    if (hipMemsetAsync((char*)d_ws + WS_CTL, 0, CTL_BYTES, stream) != hipSuccess) return;
    Params p{};
    const float** pp = (const float**)&p;
    for (int i = 0; i < 31; ++i) pp[i] = (const float*)d_in[i];
    p.out = (float*)d_out; p.ws = (char*)d_ws;
#if MK_LAUNCHES == 1
    p.ph_lo = 0; p.ph_hi = N_PHASES;
    hipLaunchKernelGGL(fwd_kernel, dim3(grid), dim3(NTHR), LDS_BYTES, stream, p);
#else
    for (int k = 0; k < N_PHASES; ++k) { p.ph_lo = k; p.ph_hi = k + 1; hipLaunchKernelGGL(fwd_kernel, dim3(grid), dim3(NTHR), LDS_BYTES, stream, p); }
#endif
}
```

```cpp
#include <hip/hip_runtime.h>
#include <stdint.h>
#include <stdio.h>

typedef unsigned short bf16_t;
typedef __attribute__((ext_vector_type(8))) short bf16x8;
typedef __attribute__((ext_vector_type(4))) short bf16x4;
typedef __attribute__((ext_vector_type(4))) float f32x4;

constexpr int NTOK = 32768, SEQ = 8192, DM = 1024, DIN = 5944;
constexpr int C_QNSA = 0, C_KVNSA = 512, C_GNSA = 1280, C_CQ = 1304, C_CKV = 2072, C_KROPE = 2328, C_QMEM = 2360, C_GMERGE = 2872;
constexpr float ALPHA = 1.189207115002721f;
constexpr float LOG2E = 1.4426950408889634f;
constexpr float NEGBIG = -1e30f;

constexpr size_t MBY = 1ull << 20;
constexpr size_t WS_CTL = 0;
constexpr size_t CTL_BYTES = 65536;
constexpr int CTL_Q = 4096;
constexpr int CTL_CNT = 8192;
constexpr size_t WS_COS = 1 * MBY, WS_SIN = WS_COS + 512 * 1024;
constexpr size_t WS_KC = 2 * MBY, WS_VTC = WS_KC + 512 * 1024;
constexpr size_t WS_KMEM = 3 * MBY, WS_VTMEM = 4 * MBY, WS_MEMB = 5 * MBY, WS_EID = 7 * MBY, WS_EW = 8 * MBY;
constexpr size_t WS_A = 16 * MBY;
constexpr size_t WS_PROJ = WS_A, WS_QM = WS_A + 372 * MBY, WS_KM = WS_A + 420 * MBY, WS_VTM = WS_A + 468 * MBY;
constexpr size_t WS_Y1 = WS_A, WS_Y = WS_A;
constexpr size_t WS_B = WS_A + 512 * MBY;
constexpr size_t WS_H0 = WS_B;
constexpr int NEA = 117;
constexpr size_t WS_EXPA = WS_B + 272 * MBY + MBY / 2, WS_EXPB = WS_B;
static_assert(WS_EXPA + (size_t)NEA * 1572864 <= WS_B + 448 * MBY && (size_t)(256 - NEA) * 1572864 <= 208 * MBY + MBY / 2, "expert weight pieces");
__device__ __forceinline__ const unsigned short* expw_ptr(const char* ws, int e) {
    return (const unsigned short*)(ws + (e < NEA ? WS_EXPA + (size_t)e * 1572864 : WS_EXPB + (size_t)(e - NEA) * 1572864));
}
constexpr size_t WS_ONSA = WS_B + 64 * MBY, WS_OMLA = WS_B + 96 * MBY, WS_OMEM = WS_B + 128 * MBY;
constexpr size_t WS_LOGITS = WS_A + 128 * MBY, WS_LIST = WS_B + 208 * MBY + MBY / 2;
constexpr size_t WS_MERGED = WS_B + 160 * MBY;
constexpr size_t WS_KCS = WS_B + 224 * MBY, WS_VCS = WS_KCS + 8 * MBY, WS_KSLC = WS_KCS + 16 * MBY, WS_KWIN = WS_KCS + 24 * MBY,
                 WS_VTSLC = WS_KCS + 32 * MBY, WS_VTWIN = WS_KCS + 40 * MBY;
constexpr size_t WS_SCR = WS_B + 416 * MBY;
constexpr size_t WS_SCR2 = WS_B + 240 * MBY + MBY / 2;
constexpr size_t WS_WB = WS_B + 448 * MBY;
constexpr size_t WB_WIN = WS_WB, WB_WUQ = WB_WIN + 12582912, WB_WUKV = WB_WUQ + 1179648, WB_WMEM = WB_WUKV + 524288, WB_WBR = WB_WMEM + 2097152,
                 WB_WOUT = WB_WBR + 3145728, WB_WRHI = WB_WOUT + 2097152, WB_WRLO = WB_WRHI + 524288, WB_WS1 = WB_WRLO + 524288, WB_WS3 = WB_WS1 + 524288,
                 WB_WS2 = WB_WS3 + 524288, WB_WCK1 = WB_WS2 + 524288, WB_WCV1 = WB_WCK1 + 1048576, WB_WCK2 = WB_WCV1 + 1048576, WB_WCV2 = WB_WCK2 + 65536,
                 WB_POSP = WB_WCV2 + 65536  , WB_END = WB_POSP + 32768;
static_assert(WB_END <= WS_WB + 32 * MBY, "bf16 weight region");
constexpr size_t WS_END = WS_B + 480 * MBY;
constexpr int H1LD = 2048;

struct Params {
    const float *x, *mem, *ln0_g, *ln0_b, *rel_bias, *w_in, *cmp_pos_k, *cmp_pos_v, *cmp_k_w1, *cmp_k_w2, *cmp_v_w1, *cmp_v_w2,
        *mla_q_norm, *mla_w_uq, *mla_kv_norm, *mla_w_ukv, *mem_w_kv, *w_branch, *w_out, *ln1_g, *ln1_b, *router_w, *router_b,
        *exp_w1, *exp_w3, *exp_w2, *sh_w1, *sh_w3, *sh_w2, *ln2_g, *ln2_b;
    float* out;
    char* ws;
    int ph_lo, ph_hi;
};

#define XB_TMO      128
#define XB_XCNT(j)  (256  + 64 * (j))
#define XB_XSUB(j)  (1280 + 64 * (j))
#define XB_XGEN(j)  (2304 + 64 * (j))
#define XB_TOP      3328
#define XB_TOPGEN   3392
#define XCD_BAR_WORDS 3456
#define XB_SPIN_CAP (1u << 18)
#define LAS __attribute__((address_space(3)))

__device__ __forceinline__ unsigned xb_ld(unsigned* p)              { return __hip_atomic_load(p, __ATOMIC_RELAXED, __HIP_MEMORY_SCOPE_AGENT); }
__device__ __forceinline__ unsigned xb_add(unsigned* p, unsigned v) { return __hip_atomic_fetch_add(p, v, __ATOMIC_RELAXED, __HIP_MEMORY_SCOPE_AGENT); }
__device__ __forceinline__ unsigned xb_xcc_id() { return (unsigned)__builtin_amdgcn_s_getreg((3 << 11) | 20) & 0xFu; }
#define XB_SPIN(cond, bar) do { unsigned _sp = 0; while (cond) { __builtin_amdgcn_s_sleep(1); \
    if ((++_sp & 255u) == 0u) { if (xb_ld(&(bar)[XB_TMO])) break; if (_sp > XB_SPIN_CAP) { atomicAdd(&(bar)[XB_TMO], 1u); break; } } } } while (0)

struct XcdBarrier { unsigned* bar; unsigned x; volatile LAS unsigned* st; };

__device__ __forceinline__ XcdBarrier xcd_barrier_post(unsigned* bar, volatile LAS unsigned* st) {
    XcdBarrier b; b.bar = bar; b.x = xb_xcc_id(); b.st = st;
    if (threadIdx.x == 0) (void)xb_add(&bar[XB_XCNT(b.x)], 1u);
    return b;
}
__device__ __forceinline__ void xcd_barrier_complete(unsigned* bar, unsigned x, unsigned& nloc, unsigned& nx) {
    const unsigned G = gridDim.x * gridDim.y * gridDim.z;
    unsigned sum, cnt, mine, sp = 0u;
    for (;;) {
        sum = 0u; cnt = 0u; mine = 0u;
#pragma unroll
        for (unsigned j = 0; j < 16; ++j) { const unsigned c = xb_ld(&bar[XB_XCNT(j)]); sum += c; cnt += (c > 0u) ? 1u : 0u; mine = (j == x) ? c : mine; }
        if (sum == G) break;
        __builtin_amdgcn_s_sleep(1);
        if ((++sp & 255u) == 0u) { if (xb_ld(&bar[XB_TMO])) break; if (sp > XB_SPIN_CAP) { atomicAdd(&bar[XB_TMO], 1u); break; } }
    }
    nloc = mine > 0u ? mine : 1u; nx = cnt > 0u ? cnt : 1u;
}
__device__ __forceinline__ void xcd_barrier(const XcdBarrier& b) {
    asm volatile("s_waitcnt vmcnt(0)" ::: "memory");
    __syncthreads();
    if (threadIdx.x == 0) {
        unsigned* bar = b.bar;
        __builtin_amdgcn_s_waitcnt(0);
        unsigned nloc = b.st[0], nx = b.st[1];
        if (nloc == 0u) { xcd_barrier_complete(bar, b.x, nloc, nx); b.st[0] = nloc; b.st[1] = nx; }
        const unsigned old = xb_add(&bar[XB_XSUB(b.x)], 1u);
        const unsigned gen = old / nloc;
        if (old + 1u == (gen + 1u) * nloc) {
            __builtin_amdgcn_fence(__ATOMIC_RELEASE, "agent");
            asm volatile("s_waitcnt vmcnt(0)" ::: "memory");
            const unsigned og = xb_add(&bar[XB_TOP], 1u);
            const unsigned tg = og / nx;
            if (og + 1u == (tg + 1u) * nx) xb_add(&bar[XB_TOPGEN], 1u);
            else XB_SPIN(xb_ld(&bar[XB_TOPGEN]) == tg, bar);
            __builtin_amdgcn_fence(__ATOMIC_ACQUIRE, "agent");
            xb_add(&bar[XB_XGEN(b.x)], 1u);
            asm volatile("s_waitcnt vmcnt(0)" ::: "memory");
        } else {
            XB_SPIN(xb_ld(&bar[XB_XGEN(b.x)]) == gen, bar);
            __builtin_amdgcn_fence(__ATOMIC_ACQUIRE, "agent");
            asm volatile("s_waitcnt vmcnt(0)" ::: "memory");
        }
    }
    __syncthreads();
}

__device__ __forceinline__ float bf2f(bf16_t v) { return __uint_as_float(((uint32_t)v) << 16); }
__device__ __forceinline__ float bflo(uint32_t v) { return __uint_as_float(v << 16); }
__device__ __forceinline__ float bfhi(uint32_t v) { return __uint_as_float(v & 0xffff0000u); }
__device__ __forceinline__ uint32_t pack2(float a, float b) {
    typedef __attribute__((ext_vector_type(2))) __bf16 bf2_t; typedef __attribute__((ext_vector_type(2))) float f2_t;
    f2_t v = {a, b}; bf2_t r = __builtin_convertvector(v, bf2_t); return __builtin_bit_cast(uint32_t, r);
}
__device__ __forceinline__ bf16_t f2bf(float a) { return (bf16_t)(pack2(a, 0.f) & 0xffffu); }
__device__ __forceinline__ uint2 pack4(f32x4 v) { return make_uint2(pack2(v[0], v[1]), pack2(v[2], v[3])); }
__device__ __forceinline__ float fexp2(float x) { return __builtin_amdgcn_exp2f(x); }
__device__ __forceinline__ float frcp(float x) { return __builtin_amdgcn_rcpf(x); }
__device__ __forceinline__ float sigmoidf_(float x) { return frcp(1.f + fexp2(-x * LOG2E)); }
__device__ __forceinline__ float siluf_(float x) { return x * frcp(1.f + fexp2(-x * LOG2E)); }
__device__ __forceinline__ float geluf_(float x) {
    const float u = 0.7978845608028654f * (x + 0.044715f * x * x * x);
    const float t = 1.f - 2.f * frcp(1.f + fexp2(2.f * u * LOG2E));
    return 0.5f * x * (1.f + t);
}
__device__ __forceinline__ float wave_sum(float v) {
    v += __uint_as_float(__builtin_amdgcn_update_dpp(0u, __float_as_uint(v), 0xB1, 0xF, 0xF, true));
    v += __uint_as_float(__builtin_amdgcn_update_dpp(0u, __float_as_uint(v), 0x4E, 0xF, 0xF, true));
    v += __uint_as_float(__builtin_amdgcn_update_dpp(0u, __float_as_uint(v), 0x141, 0xF, 0xF, true));
    v += __uint_as_float(__builtin_amdgcn_update_dpp(0u, __float_as_uint(v), 0x140, 0xF, 0xF, true));
    auto r = __builtin_amdgcn_permlane16_swap(__float_as_uint(v), __float_as_uint(v), false, false);
    v = __uint_as_float(r[0]) + __uint_as_float(r[1]);
    auto q = __builtin_amdgcn_permlane32_swap(__float_as_uint(v), __float_as_uint(v), false, false);
    return __uint_as_float(q[0]) + __uint_as_float(q[1]);
}
__device__ __forceinline__ float wave_max(float v) {
    v = fmaxf(v, __uint_as_float(__builtin_amdgcn_update_dpp(0u, __float_as_uint(v), 0xB1, 0xF, 0xF, true)));
    v = fmaxf(v, __uint_as_float(__builtin_amdgcn_update_dpp(0u, __float_as_uint(v), 0x4E, 0xF, 0xF, true)));
    v = fmaxf(v, __uint_as_float(__builtin_amdgcn_update_dpp(0u, __float_as_uint(v), 0x141, 0xF, 0xF, true)));
    v = fmaxf(v, __uint_as_float(__builtin_amdgcn_update_dpp(0u, __float_as_uint(v), 0x140, 0xF, 0xF, true)));
    auto r = __builtin_amdgcn_permlane16_swap(__float_as_uint(v), __float_as_uint(v), false, false);
    v = fmaxf(__uint_as_float(r[0]), __uint_as_float(r[1]));
    auto q = __builtin_amdgcn_permlane32_swap(__float_as_uint(v), __float_as_uint(v), false, false);
    return fmaxf(__uint_as_float(q[0]), __uint_as_float(q[1]));
}
__device__ __forceinline__ float quad_max(float x) {
    auto r = __builtin_amdgcn_permlane16_swap(__float_as_uint(x), __float_as_uint(x), false, false);
    x = fmaxf(__uint_as_float(r[0]), __uint_as_float(r[1]));
    auto q = __builtin_amdgcn_permlane32_swap(__float_as_uint(x), __float_as_uint(x), false, false);
    return fmaxf(__uint_as_float(q[0]), __uint_as_float(q[1]));
}
__device__ __forceinline__ float quad_min(float x) {
    auto r = __builtin_amdgcn_permlane16_swap(__float_as_uint(x), __float_as_uint(x), false, false);
    x = fminf(__uint_as_float(r[0]), __uint_as_float(r[1]));
    auto q = __builtin_amdgcn_permlane32_swap(__float_as_uint(x), __float_as_uint(x), false, false);
    return fminf(__uint_as_float(q[0]), __uint_as_float(q[1]));
}
__device__ __forceinline__ float quad_sum(float x) {
    auto r = __builtin_amdgcn_permlane16_swap(__float_as_uint(x), __float_as_uint(x), false, false);
    x = __uint_as_float(r[0]) + __uint_as_float(r[1]);
    auto q = __builtin_amdgcn_permlane32_swap(__float_as_uint(x), __float_as_uint(x), false, false);
    return __uint_as_float(q[0]) + __uint_as_float(q[1]);
}
__device__ __forceinline__ float quad4_sum(float x) {
    x += __uint_as_float(__builtin_amdgcn_update_dpp(0u, __float_as_uint(x), 0xB1, 0xF, 0xF, true));
    x += __uint_as_float(__builtin_amdgcn_update_dpp(0u, __float_as_uint(x), 0x4E, 0xF, 0xF, true));
    return x;
}
__device__ __forceinline__ float max16(const f32x4 (&s)[4]) {
    const float a = fmaxf(fmaxf(s[0][0], s[0][1]), fmaxf(s[0][2], s[0][3])), b = fmaxf(fmaxf(s[1][0], s[1][1]), fmaxf(s[1][2], s[1][3]));
    const float c = fmaxf(fmaxf(s[2][0], s[2][1]), fmaxf(s[2][2], s[2][3])), d = fmaxf(fmaxf(s[3][0], s[3][1]), fmaxf(s[3][2], s[3][3]));
    return fmaxf(fmaxf(a, b), fmaxf(c, d));
}
__device__ __forceinline__ float sum16(const f32x4 (&s)[4]) {
    const f32x4 v = (s[0] + s[1]) + (s[2] + s[3]);
    return (v[0] + v[1]) + (v[2] + v[3]);
}
__device__ __forceinline__ void lds_fadd(float* p, float v) {
    asm volatile("ds_add_f32 %0, %1" :: "v"((unsigned)(size_t)(LAS float*)p), "v"(v) : "memory");
}
__device__ __forceinline__ f32x4 mfma16(bf16x8 a, bf16x8 b, f32x4 c) { return __builtin_amdgcn_mfma_f32_16x16x32_bf16(a, b, c, 0, 0, 0); }

constexpr int NTHR = 512, NWV = 8;
constexpr int LDS_BYTES = 163840;
constexpr int LDS_MISC = 147456;
constexpr int LDS_LUT = LDS_MISC;
constexpr int LDS_SEL = LDS_MISC + 8192;
constexpr int LDS_WOR = LDS_SEL + 1024;
constexpr int LDS_TL = LDS_WOR + 128;
constexpr int LDS_ITEM = LDS_TL + 256;
constexpr int LDS_ROWS = LDS_ITEM + 64;
constexpr int LDS_PRE = LDS_ROWS + 2048;
constexpr int LDS_KSC = LDS_PRE + 256;
constexpr int LDS_BARW = 163824;
static_assert(LDS_KSC + 1024 <= LDS_BARW, "LDS map");

__device__ __forceinline__ int queue_pop(unsigned* head, char* lds) {
    __syncthreads();
    if (threadIdx.x == 0) *(volatile int*)(lds + LDS_ITEM) = (int)atomicAdd(head, 1u);
    __syncthreads();
    return __builtin_amdgcn_readfirstlane(*(volatile int*)(lds + LDS_ITEM));
}

__device__ __forceinline__ int swz(int row, int chunk) { return (row << 7) + (((chunk ^ (row >> 1) ^ ((row >> 4) & 1)) & 7) << 4); }
constexpr int TILE_B = 16384;

struct GemmA { const char* base; unsigned off[4]; };

constexpr int STAGE_B = 49152, STAGE_BOFF = 32768;
__device__ __forceinline__ int gl_row(int i, int t) { return 8 * ((t >> 6) + 8 * i) + ((t & 63) >> 3); }
__device__ __forceinline__ int gl_chunk(int row, int t) { return ((t & 7) ^ (row >> 1) ^ ((row >> 4) & 1)) & 7; }
__device__ __forceinline__ int perm32_(int rho) { const int n = rho >> 4, i = rho & 15; return 8 * (i >> 2) + 4 * n + (i & 3); }
template <int NP, bool PERM = false>
__device__ __forceinline__ GemmA make_op(const bf16_t* base, long ld, int r0, int rmax) {
    GemmA a; const int t = threadIdx.x;
    a.base = (const char*)base;
#pragma unroll
    for (int i = 0; i < NP; ++i) { const int lr_ = gl_row(i, t); int r = r0 + (PERM ? ((lr_ & ~31) + perm32_(lr_ & 31)) : lr_); r = r < rmax ? r : rmax - 1; a.off[i] = (unsigned)(((size_t)r * ld + gl_chunk(lr_, t) * 8) * 2); }
    return a;
}
__device__ __forceinline__ void gemm_mainloop_g(char* lds, const GemmA& A, const GemmA& B, int nk, f32x4 (&acc)[4][4]) {
    int t = threadIdx.x; asm volatile("" : "+v"(t));
    const int lane = t & 63, w = t >> 6, wm = w >> 1, wn = w & 1;
    const int lr = lane & 15, lq = lane >> 4;
    const int wu = __builtin_amdgcn_readfirstlane(w);
    const int xr = (lr >> 1) & 7;
    unsigned ardA[2][2], ardB[2][2];
#pragma unroll
    for (int kk = 0; kk < 2; ++kk)
#pragma unroll
        for (int par = 0; par < 2; ++par) {
            const int ch = ((kk * 4 + lq) ^ xr ^ par) & 7;
            ardA[kk][par] = (unsigned)((wm * 64 + par * 16 + lr) * 128 + ch * 16);
            ardB[kk][par] = (unsigned)(STAGE_BOFF + (wn * 64 + par * 16 + lr) * 128 + ch * 16);
        }
    const char* abase = A.base; const char* bbase = B.base;
    LAS char* ldsl = (LAS char*)lds;
#define GI_(so_) { \
        _Pragma("unroll") for (int i = 0; i < 4; ++i) \
            __builtin_amdgcn_global_load_lds((const unsigned*)(abase + A.off[i]), (LAS unsigned*)(ldsl + (so_) + (wu + 8 * i) * 1024), 16, 0, 0); \
        _Pragma("unroll") for (int i = 0; i < 2; ++i) \
            __builtin_amdgcn_global_load_lds((const unsigned*)(bbase + B.off[i]), (LAS unsigned*)(ldsl + (so_) + STAGE_BOFF + (wu + 8 * i) * 1024), 16, 0, 0); \
        abase += 128; bbase += 128; }
    __syncthreads();
    GI_(0);
    if (nk > 1) GI_(STAGE_B);
    int cso = 0, lso = 2 * STAGE_B;
#pragma unroll 1
    for (int kt = 0; kt < nk; ++kt) {
        if (kt + 1 < nk) asm volatile("s_waitcnt vmcnt(6)" ::: "memory");
        else asm volatile("s_waitcnt vmcnt(0)" ::: "memory");
        __builtin_amdgcn_s_barrier();
        if (kt + 2 < nk) GI_(lso);
#pragma unroll
        for (int kk = 0; kk < 2; ++kk) {
            bf16x8 af[4], bfr[4];
#pragma unroll
            for (int i = 0; i < 4; ++i) af[i] = *(const bf16x8*)(lds + cso + ardA[kk][i & 1] + (i >> 1) * 4096);
#pragma unroll
            for (int j = 0; j < 4; ++j) bfr[j] = *(const bf16x8*)(lds + cso + ardB[kk][j & 1] + (j >> 1) * 4096);
#pragma unroll
            for (int i = 0; i < 4; ++i)
#pragma unroll
                for (int j = 0; j < 4; ++j) acc[i][j] = mfma16(bfr[j], af[i], acc[i][j]);
        }
        cso = (cso == 2 * STAGE_B) ? 0 : cso + STAGE_B;
        lso = (lso == 2 * STAGE_B) ? 0 : lso + STAGE_B;
    }
    __syncthreads();
#undef GI_
}

template <bool SWAPW1 = false>
__device__ __forceinline__ void gemm_mainloop_c(char* lds, const GemmA& A, const GemmA& B, int nk, f32x4 (&acc)[4][4], int& ring, bool primed, bool chain, const GemmA& An, const GemmA& Bn) {
    int t = threadIdx.x; asm volatile("" : "+v"(t));
    const int lane = t & 63, w = t >> 6, wm = w >> 1, wn = w & 1;
    const int lr = lane & 15, lq = lane >> 4;
    const int wu = __builtin_amdgcn_readfirstlane(w);
    const int xr = (lr >> 1) & 7;
    unsigned ardA[2][2], ardB[2][2];
#pragma unroll
    for (int kk = 0; kk < 2; ++kk)
#pragma unroll
        for (int par = 0; par < 2; ++par) {
            const int ch = ((kk * 4 + lq) ^ xr ^ par) & 7;
            ardA[kk][par] = (unsigned)((wm * 64 + par * 16 + lr) * 128 + ch * 16);
            ardB[kk][par] = (unsigned)(STAGE_BOFF + (wn * 64 + par * 16 + lr) * 128 + ch * 16);
        }
    const char* abase = A.base; const char* bbase = B.base;
    const char* anb = An.base; const char* bnb = Bn.base;
    LAS char* ldsl = (LAS char*)lds;
#define GI_(so_) { \
        _Pragma("unroll") for (int i = 0; i < 4; ++i) \
            __builtin_amdgcn_global_load_lds((const unsigned*)(abase + A.off[i]), (LAS unsigned*)(ldsl + (so_) + (wu + 8 * i) * 1024), 16, 0, 0); \
        _Pragma("unroll") for (int i = 0; i < 2; ++i) \
            __builtin_amdgcn_global_load_lds((const unsigned*)(bbase + B.off[i]), (LAS unsigned*)(ldsl + (so_) + STAGE_BOFF + (wu + 8 * i) * 1024), 16, 0, 0); \
        abase += 128; bbase += 128; }
#define GIN_(so_) { \
        _Pragma("unroll") for (int i = 0; i < 4; ++i) \
            __builtin_amdgcn_global_load_lds((const unsigned*)(anb + An.off[i]), (LAS unsigned*)(ldsl + (so_) + (wu + 8 * i) * 1024), 16, 0, 0); \
        _Pragma("unroll") for (int i = 0; i < 2; ++i) \
            __builtin_amdgcn_global_load_lds((const unsigned*)(bnb + Bn.off[i]), (LAS unsigned*)(ldsl + (so_) + STAGE_BOFF + (wu + 8 * i) * 1024), 16, 0, 0); \
        anb += 128; bnb += 128; }
    int cso = ring, lso = (ring == 0) ? 2 * STAGE_B : ring - STAGE_B;
    if (!primed) {
        __syncthreads();
        GI_(cso);
        { const int s1 = (cso == 2 * STAGE_B) ? 0 : cso + STAGE_B; GI_(s1); }
    } else { abase += 256; bbase += 256; }
#pragma unroll 1
    for (int kt = 0; kt < nk; ++kt) {
        if (kt + 1 < nk || chain) asm volatile("s_waitcnt vmcnt(6)" ::: "memory");
        else asm volatile("s_waitcnt vmcnt(0)" ::: "memory");
        __builtin_amdgcn_s_barrier();
        if (kt + 2 < nk) GI_(lso) else if (chain) GIN_(lso)
#pragma unroll
        for (int kk = 0; kk < 2; ++kk) {
            bf16x8 af[4], bfr[4];
#pragma unroll
            for (int i = 0; i < 4; ++i) af[i] = *(const bf16x8*)(lds + cso + ardA[kk][i & 1] + (i >> 1) * 4096);
#pragma unroll
            for (int j = 0; j < 4; ++j) bfr[j] = *(const bf16x8*)(lds + cso + ardB[kk][j & 1] + (j >> 1) * 4096);
            if (SWAPW1 && wn == 1) {
#pragma unroll
                for (int i = 0; i < 4; ++i)
#pragma unroll
                    for (int j = 0; j < 4; ++j) acc[i][j] = mfma16(af[i], bfr[j], acc[i][j]);
            } else {
#pragma unroll
                for (int i = 0; i < 4; ++i)
#pragma unroll
                    for (int j = 0; j < 4; ++j) acc[i][j] = mfma16(bfr[j], af[i], acc[i][j]);
            }
        }
        cso = (cso == 2 * STAGE_B) ? 0 : cso + STAGE_B;
        lso = (lso == 2 * STAGE_B) ? 0 : lso + STAGE_B;
    }
    ring = cso;
    if (!chain) __syncthreads();
#undef GI_
#undef GIN_
}

template <bool LO>
__device__ __forceinline__ void conv_wT(const float* src, int K, int N, bf16_t* dst, int ldd, const float* gain) {
    const int t = threadIdx.x & 255, kg = t >> 5, n4 = t & 31;
    const int ntn = (N + 127) >> 7, ntiles = (K >> 6) * ntn;
    for (int tile = blockIdx.x * 2 + (threadIdx.x >> 8); tile < ntiles; tile += gridDim.x * 2) {
        const int k0 = (tile / ntn) * 64 + kg * 8, n = (tile % ntn) * 128 + n4 * 4;
        if (n < N) {
            float4 r[8];
#pragma unroll
            for (int kk = 0; kk < 8; ++kk) r[kk] = *(const float4*)(src + (size_t)(k0 + kk) * N + n);
            if (gain) {
#pragma unroll
                for (int kk = 0; kk < 8; ++kk) { const float g = gain[k0 + kk]; r[kk].x *= g; r[kk].y *= g; r[kk].z *= g; r[kk].w *= g; }
            }
#pragma unroll
            for (int c = 0; c < 4; ++c) {
                float v[8];
#pragma unroll
                for (int kk = 0; kk < 8; ++kk) { float f = (c == 0) ? r[kk].x : (c == 1) ? r[kk].y : (c == 2) ? r[kk].z : r[kk].w; if (LO) f = f - bf2f(f2bf(f)); v[kk] = f; }
                *(uint4*)(dst + (size_t)(n + c) * ldd + k0) = make_uint4(pack2(v[0], v[1]), pack2(v[2], v[3]), pack2(v[4], v[5]), pack2(v[6], v[7]));
            }
        }
    }
}

__device__ __forceinline__ void zero_acc(f32x4 (&acc)[4][4]) {
#pragma unroll
    for (int i = 0; i < 4; ++i)
#pragma unroll
        for (int j = 0; j < 4; ++j) acc[i][j] = (f32x4){0.f, 0.f, 0.f, 0.f};
}

namespace pg8 {
constexpr int BM = 256, BK = 64, HALF = 128, HTB = HALF * BK * 2, STAGE_BYTES = 8 * HTB;
__device__ __forceinline__ int lds_byte(int r, int c) { const int st = (r >> 4) * 2 + (c >> 5), rr = r & 15, cc = c & 31, ob = rr * 64 + cc * 2; return st * 1024 + (ob ^ (((ob >> 9) & 1) << 5)); }
__device__ __forceinline__ void stage_rc(int b, int& R, int& C) { const int st = b / 1024, sb = b % 1024, swz_ = sb ^ (((sb >> 9) & 1) << 5); R = (st >> 1) * 16 + swz_ / 64; C = (st & 1) * 32 + (swz_ % 64) / 2; }
__device__ __forceinline__ int perm32(int rho) { const int n = rho >> 4, i = rho & 15; return 8 * (i >> 2) + 4 * n + (i & 3); }
struct Unit { int pm, pn; };
struct Ops { const char* A; const char* B; };
template <class Prov, class Epi>
__device__ __forceinline__ void gemm_phase(LAS unsigned char* lds, const int K, Prov& PV, const Epi& E) {
    int tid = threadIdx.x; asm volatile("" : "+v"(tid));
    const int wid = __builtin_amdgcn_readfirstlane(tid >> 6), lane = tid & 63, wr = wid >> 2, wc = wid & 3, fr = lane & 15, fq = lane >> 4;
    int nt = K / BK; asm volatile("" : "+s"(nt));
    int sR[2], sC[2];
#pragma unroll
    for (int i = 0; i < 2; ++i) stage_rc(tid * 16 + i * 8192, sR[i], sC[i]);
    const size_t kstep = (size_t)(BK * 2);
    const unsigned ldsw = (unsigned)wid * 1024u;
    const int aoff = lds_byte(wr * 64 + fr, fq * 8), boff = lds_byte(wc * 32 + fr, fq * 8);
#define PG8_SA(b, h) (((b) * 2 + (h)) * HTB)
#define PG8_SB(b, h) ((4 + (b) * 2 + (h)) * HTB)
#define PG8_STAGE(bufoff, gbase, voff) do { _Pragma("unroll") for (int _i = 0; _i < 2; ++_i) \
        __builtin_amdgcn_global_load_lds((const unsigned*)((const char*)(gbase) + (voff)[_i]), (LAS unsigned*)(lds + (bufoff) + ldsw + _i * 8192), 16, 0, 0); } while (0)
#define PG8_LDA(dst, b, h) do { _Pragma("unroll") for (int m = 0; m < 4; ++m) _Pragma("unroll") for (int k = 0; k < 2; ++k) dst[m][k] = *(const LAS bf16x8*)(lds + PG8_SA(b, h) + aoff + m * 2048 + k * 1024); } while (0)
#define PG8_LDB(dst, b, h) do { _Pragma("unroll") for (int n = 0; n < 2; ++n) _Pragma("unroll") for (int k = 0; k < 2; ++k) dst[n][k] = *(const LAS bf16x8*)(lds + PG8_SB(b, h) + boff + n * 2048 + k * 1024); } while (0)
#define PG8_MMA(ai, bj, At, Bt) do { __builtin_amdgcn_s_setprio(1); _Pragma("unroll") for (int m = 0; m < 4; ++m) _Pragma("unroll") for (int n = 0; n < 2; ++n) _Pragma("unroll") for (int k = 0; k < 2; ++k) \
        acc[ai][bj][m][n] = __builtin_amdgcn_mfma_f32_16x16x32_bf16(Bt[n][k], At[m][k], acc[ai][bj][m][n], 0, 0, 0); __builtin_amdgcn_s_setprio(0); } while (0)
#define PG8_WAIT_V(n) asm volatile("s_waitcnt vmcnt(" #n ")" ::: "memory")
#define PG8_WAIT_L(n) asm volatile("s_waitcnt lgkmcnt(" #n ")" ::: "memory")
#define PG8_BAR __builtin_amdgcn_s_barrier()
#define PG8_SCHED __builtin_amdgcn_sched_barrier(0)
    Unit cur, nxt; Ops oc, on; int ui = 0;
    unsigned va[2][2], vb[2][2];
    PV.offsets(va, vb, sR, sC);
    if (!PV.get(0, cur, oc)) return;
    f32x4 acc[2][2][4][2];
#pragma unroll
    for (int a = 0; a < 2; ++a)
#pragma unroll
        for (int b = 0; b < 2; ++b)
#pragma unroll
            for (int m = 0; m < 4; ++m)
#pragma unroll
                for (int n = 0; n < 2; ++n) acc[a][b][m][n] = (f32x4){0.f, 0.f, 0.f, 0.f};
    bf16x8 At[4][2], B0[2][2], B1[2][2];
    PG8_STAGE(PG8_SB(0, 0), oc.B, vb[0]); PG8_STAGE(PG8_SA(0, 0), oc.A, va[0]); PG8_STAGE(PG8_SB(0, 1), oc.B, vb[1]); PG8_STAGE(PG8_SA(0, 1), oc.A, va[1]);
    if (wr == 1) PG8_BAR;
    PG8_WAIT_V(4); PG8_BAR;
    PG8_STAGE(PG8_SB(1, 0), oc.B + kstep, vb[0]); PG8_STAGE(PG8_SA(1, 0), oc.A + kstep, va[0]); PG8_STAGE(PG8_SB(1, 1), oc.B + kstep, vb[1]);
    PG8_WAIT_V(6); PG8_BAR;
    for (;;) {
        const bool has_next = PV.get(ui + 1, nxt, on);
        if (!has_next) on = oc;
#pragma unroll 1
        for (int t = 0; t < nt; t += 2) {
            const bool last = (t == nt - 2);
            const char* a1 = oc.A + (size_t)(t + 1) * kstep;
            const char* a2 = last ? on.A : oc.A + (size_t)(t + 2) * kstep; const char* b2 = last ? on.B : oc.B + (size_t)(t + 2) * kstep;
            const char* a3 = a2 + kstep; const char* b3 = b2 + kstep;
            PG8_LDB(B0, 0, 0); PG8_SCHED; PG8_LDA(At, 0, 0); PG8_STAGE(PG8_SA(1, 1), a1, va[1]);
            PG8_WAIT_L(8); PG8_BAR; PG8_WAIT_L(0); PG8_MMA(0, 0, At, B0); PG8_BAR; PG8_SCHED;
            PG8_LDB(B1, 0, 1); PG8_STAGE(PG8_SB(0, 0), b2, vb[0]);
            PG8_BAR; PG8_WAIT_L(0); PG8_MMA(0, 1, At, B1); PG8_BAR;
            PG8_LDA(At, 0, 1); PG8_STAGE(PG8_SA(0, 0), a2, va[0]);
            PG8_BAR; PG8_WAIT_L(0); PG8_MMA(1, 0, At, B0); PG8_BAR; PG8_SCHED;
            PG8_STAGE(PG8_SB(0, 1), b2, vb[1]);
            PG8_WAIT_V(6); PG8_BAR; PG8_MMA(1, 1, At, B1); PG8_BAR;
            PG8_LDB(B0, 1, 0); PG8_SCHED; PG8_LDA(At, 1, 0); PG8_STAGE(PG8_SA(0, 1), a2, va[1]);
            PG8_WAIT_L(8); PG8_BAR; PG8_WAIT_L(0); PG8_MMA(0, 0, At, B0); PG8_BAR; PG8_SCHED;
            PG8_LDB(B1, 1, 1); PG8_STAGE(PG8_SB(1, 0), b3, vb[0]);
            PG8_BAR; PG8_WAIT_L(0); PG8_MMA(0, 1, At, B1); PG8_BAR;
            PG8_LDA(At, 1, 1); PG8_STAGE(PG8_SA(1, 0), a3, va[0]);
            PG8_BAR; PG8_WAIT_L(0); PG8_MMA(1, 0, At, B0); PG8_BAR; PG8_SCHED;
            PG8_STAGE(PG8_SB(1, 1), b3, vb[1]);
            PG8_WAIT_V(6); PG8_BAR; PG8_MMA(1, 1, At, B1); PG8_BAR;
        }
        bool keep;
        { int tz = threadIdx.x; asm volatile("" : "+v"(tz));
          keep = E(acc, cur, ui, wr, wc, tz & 15, (tz >> 4) & 3); }
        if (!has_next) break;
        if (!keep)
#pragma unroll
        for (int a = 0; a < 2; ++a)
#pragma unroll
            for (int b = 0; b < 2; ++b)
#pragma unroll
                for (int m = 0; m < 4; ++m)
#pragma unroll
                    for (int n = 0; n < 2; ++n) acc[a][b][m][n] = (f32x4){0.f, 0.f, 0.f, 0.f};
        cur = nxt; oc = on; ++ui;
    }
    PG8_WAIT_V(0);
    if (wr == 0) PG8_BAR;
    PG8_BAR;
#undef PG8_SA
#undef PG8_SB
#undef PG8_STAGE
#undef PG8_LDA
#undef PG8_LDB
#undef PG8_MMA
#undef PG8_WAIT_V
#undef PG8_WAIT_L
#undef PG8_BAR
#undef PG8_SCHED
}
struct StaticOrder {
    int nM, nN, nwg, G, c;
    __device__ void init(int M, int N, int G_, int c_) { nM = M / BM; nN = N / BM; nwg = nM * nN; G = G_; c = c_; }
    __device__ bool next(int i, Unit& u) const {
        const long L = (long)i * G + c; if (L >= nwg) return false;
        int wgid = (int)L; { const int q = nwg / 8, r = nwg % 8, xcd = wgid % 8, off = wgid / 8; wgid = (xcd < r ? xcd * (q + 1) : r * (q + 1) + (xcd - r) * q) + off; }
        const int nig = 8 * nN, gid = wgid / nig, fm = gid * 8, gsz = (nM - fm) < 8 ? (nM - fm) : 8;
        u.pm = fm + ((wgid % nig) % gsz); u.pn = (wgid % nig) / gsz; return true;
    }
};
struct DenseProv {
    StaticOrder S; const bf16_t* A; const bf16_t* Bt; long lda, ldb; bool perm;
    __device__ __forceinline__ void offsets(unsigned (&va)[2][2], unsigned (&vb)[2][2], const int (&sR)[2], const int (&sC)[2]) const {
#pragma unroll
        for (int h = 0; h < 2; ++h)
#pragma unroll
            for (int p = 0; p < 2; ++p) { const int rb = perm ? ((sR[p] & ~31) + perm32(sR[p] & 31)) : sR[p];
                va[h][p] = (unsigned)(((size_t)(h * HALF + sR[p]) * lda + sC[p]) * 2); vb[h][p] = (unsigned)(((size_t)(h * HALF + rb) * ldb + sC[p]) * 2); }
    }
    __device__ __forceinline__ bool get(int i, Unit& u, Ops& o) const {
        if (!S.next(i, u)) return false;
        o.A = (const char*)(A + (size_t)u.pm * BM * lda); o.B = (const char*)(Bt + (size_t)u.pn * BM * ldb);
        return true;
    }
};
}

__device__ __forceinline__ void phase0(const Params& P) {
    const int t = threadIdx.x, lane = t & 63, w = t >> 6;
    const int gw = blockIdx.x * NWV + w, nw = gridDim.x * NWV;
    bf16_t* H0 = (bf16_t*)(P.ws + WS_H0);
    for (int row0 = gw; row0 < NTOK; row0 += 2 * nw) {
        const int row1 = row0 + nw; const bool has1 = row1 < NTOK;
        const float* xr[2] = {P.x + (size_t)row0 * DM, P.x + (size_t)(has1 ? row1 : row0) * DM};
        float4 v[2][4];
#pragma unroll
        for (int u = 0; u < 2; ++u)
#pragma unroll
            for (int i = 0; i < 2; ++i) { v[u][2 * i] = *(const float4*)(xr[u] + i * 512 + 8 * lane); v[u][2 * i + 1] = *(const float4*)(xr[u] + i * 512 + 8 * lane + 4); }
        float s_[2] = {0.f, 0.f};
#pragma unroll
        for (int u = 0; u < 2; ++u)
#pragma unroll
            for (int i = 0; i < 4; ++i) s_[u] += v[u][i].x + v[u][i].y + v[u][i].z + v[u][i].w;
        const float mu[2] = {wave_sum(s_[0]) * (1.f / DM), wave_sum(s_[1]) * (1.f / DM)};
        float q_[2] = {0.f, 0.f};
#pragma unroll
        for (int u = 0; u < 2; ++u)
#pragma unroll
            for (int i = 0; i < 4; ++i) { float a = v[u][i].x - mu[u], b = v[u][i].y - mu[u], c = v[u][i].z - mu[u], d = v[u][i].w - mu[u]; q_[u] += a * a + b * b + c * c + d * d; }
        const float rstd[2] = {rsqrtf(wave_sum(q_[0]) * (1.f / DM) + 1e-5f), rsqrtf(wave_sum(q_[1]) * (1.f / DM) + 1e-5f)};
#pragma unroll
        for (int i = 0; i < 2; ++i) {
            const float4 g0 = *(const float4*)(P.ln0_g + i * 512 + 8 * lane), g1 = *(const float4*)(P.ln0_g + i * 512 + 8 * lane + 4);
            const float4 b0 = *(const float4*)(P.ln0_b + i * 512 + 8 * lane), b1 = *(const float4*)(P.ln0_b + i * 512 + 8 * lane + 4);
#pragma unroll
            for (int u = 0; u < 2; ++u) {
                const float4 a = v[u][2 * i], c = v[u][2 * i + 1];
                const uint4 o = make_uint4(pack2((a.x - mu[u]) * rstd[u] * g0.x + b0.x, (a.y - mu[u]) * rstd[u] * g0.y + b0.y), pack2((a.z - mu[u]) * rstd[u] * g0.z + b0.z, (a.w - mu[u]) * rstd[u] * g0.w + b0.w),
                                           pack2((c.x - mu[u]) * rstd[u] * g1.x + b1.x, (c.y - mu[u]) * rstd[u] * g1.y + b1.y), pack2((c.z - mu[u]) * rstd[u] * g1.z + b1.z, (c.w - mu[u]) * rstd[u] * g1.w + b1.w));
                if (u == 0 || has1) *(uint4*)(H0 + (size_t)(u ? row1 : row0) * DM + i * 512 + 8 * lane) = o;
            }
        }
    }
    const int gt = blockIdx.x * NTHR + t, nt = gridDim.x * NTHR;
    bf16_t* MEMB = (bf16_t*)(P.ws + WS_MEMB);
    for (int i = gt; i < 4 * 256 * DM / 4; i += nt) {
        const float4 v = ((const float4*)P.mem)[i];
        *(uint2*)(MEMB + (size_t)i * 4) = make_uint2(pack2(v.x, v.y), pack2(v.z, v.w));
    }
    float* COS = (float*)(P.ws + WS_COS); float* SIN = (float*)(P.ws + WS_SIN);
    for (int i = gt; i < SEQ * 16; i += nt) {
        const int pos = i >> 4, j = i & 15;
        const float freq = exp2f(-(float)j * (13.287712379549449f / 16.f));
        const float ang = (float)pos * freq;
        float sn, cs; sincosf(ang, &sn, &cs);
        COS[i] = cs; SIN[i] = sn;
    }
    {
        char* wsb = P.ws;
        const int tt = t & 255, kg = tt >> 5, n4 = tt & 31;
        constexpr int NJ = 17;
        const int jK[NJ]  = {1024, 768, 256, 1024, 512, 512, 512, 1024, 1024, 1024, 1024, 1024, 256, 2048, 2048, 256, 256};
        const int jN[NJ]  = {DIN, 768, 1024, 1024, 1024, 1024, 1024, 1024, 256, 256, 256, 256, 1024, 256, 256, 64, 64};
        int first[NJ + 1]; first[0] = 0;
#pragma unroll
        for (int j = 0; j < NJ; ++j) first[j + 1] = first[j] + (jK[j] >> 6) * ((jN[j] + 127) >> 7);
        for (int g = blockIdx.x * 2 + (t >> 8); g < first[NJ]; g += gridDim.x * 2) {
            int j = 0;
#pragma unroll
            for (int q = 1; q < NJ; ++q) j += (g >= first[q]) ? 1 : 0;
            const float* src; bf16_t* dst; const float* gain = nullptr; bool lo = false; int K, N, ldd, f0;
            switch (j) {
                case 0: src = P.w_in; dst = (bf16_t*)(wsb + WB_WIN); break;
                case 1: src = P.mla_w_uq; dst = (bf16_t*)(wsb + WB_WUQ); gain = P.mla_q_norm; break;
                case 2: src = P.mla_w_ukv; dst = (bf16_t*)(wsb + WB_WUKV); gain = P.mla_kv_norm; break;
                case 3: src = P.mem_w_kv; dst = (bf16_t*)(wsb + WB_WMEM); break;
                case 4: src = P.w_branch; dst = (bf16_t*)(wsb + WB_WBR); break;
                case 5: src = P.w_branch + 512 * 1024; dst = (bf16_t*)(wsb + WB_WBR) + 1024 * 512; break;
                case 6: src = P.w_branch + 2 * 512 * 1024; dst = (bf16_t*)(wsb + WB_WBR) + 2 * 1024 * 512; break;
                case 7: src = P.w_out; dst = (bf16_t*)(wsb + WB_WOUT); break;
                case 8: src = P.router_w; dst = (bf16_t*)(wsb + WB_WRHI); break;
                case 9: src = P.router_w; dst = (bf16_t*)(wsb + WB_WRLO); lo = true; break;
                case 10: src = P.sh_w1; dst = (bf16_t*)(wsb + WB_WS1); break;
                case 11: src = P.sh_w3; dst = (bf16_t*)(wsb + WB_WS3); break;
                case 12: src = P.sh_w2; dst = (bf16_t*)(wsb + WB_WS2); break;
                case 13: src = P.cmp_k_w1; dst = (bf16_t*)(wsb + WB_WCK1); break;
                case 14: src = P.cmp_v_w1; dst = (bf16_t*)(wsb + WB_WCV1); break;
                case 15: src = P.cmp_k_w2; dst = (bf16_t*)(wsb + WB_WCK2); break;
                default: src = P.cmp_v_w2; dst = (bf16_t*)(wsb + WB_WCV2); break;
            }
            K = jK[0]; N = jN[0]; f0 = first[0];
#pragma unroll
            for (int q = 1; q < NJ; ++q) if (j == q) { K = jK[q]; N = jN[q]; f0 = first[q]; }
            ldd = K;
            const int ntn = (N + 127) >> 7, tile = g - f0;
            const int k0 = (tile / ntn) * 64 + kg * 8, n = (tile % ntn) * 128 + n4 * 4;
            if (n < N) {
                float4 r[8];
#pragma unroll
                for (int kk = 0; kk < 8; ++kk) r[kk] = *(const float4*)(src + (size_t)(k0 + kk) * N + n);
                if (gain) {
#pragma unroll
                    for (int kk = 0; kk < 8; ++kk) { const float gg = gain[k0 + kk]; r[kk].x *= gg; r[kk].y *= gg; r[kk].z *= gg; r[kk].w *= gg; }
                }
#pragma unroll
                for (int c = 0; c < 4; ++c) {
                    float v[8];
#pragma unroll
                    for (int kk = 0; kk < 8; ++kk) { float f = (c == 0) ? r[kk].x : (c == 1) ? r[kk].y : (c == 2) ? r[kk].z : r[kk].w; if (lo) f = f - bf2f(f2bf(f)); v[kk] = f; }
                    *(uint4*)(dst + (size_t)(n + c) * ldd + k0) = make_uint4(pack2(v[0], v[1]), pack2(v[2], v[3]), pack2(v[4], v[5]), pack2(v[6], v[7]));
                }
            }
        }
        float* POSP = (float*)(wsb + WB_POSP);
        for (int i = gt; i < 2 * 16 * 256 * 16; i += nt) {
            const int o = i >> 4, part = i & 15, kv = o >> 12, kc = (o >> 8) & 15, c = o & 255;
            const float* pos = kv ? P.cmp_pos_v : P.cmp_pos_k; const float* w1 = kv ? P.cmp_v_w1 : P.cmp_k_w1;
            float a = 0.f;
#pragma unroll
            for (int k8 = 0; k8 < 8; ++k8) { const int k = kc * 128 + part * 8 + k8; a += pos[k] * w1[(size_t)k * 256 + c]; }
            a += __uint_as_float(__builtin_amdgcn_update_dpp(0u, __float_as_uint(a), 0xB1, 0xF, 0xF, true));
            a += __uint_as_float(__builtin_amdgcn_update_dpp(0u, __float_as_uint(a), 0x4E, 0xF, 0xF, true));
            a += __uint_as_float(__builtin_amdgcn_update_dpp(0u, __float_as_uint(a), 0x141, 0xF, 0xF, true));
            a += __uint_as_float(__builtin_amdgcn_update_dpp(0u, __float_as_uint(a), 0x140, 0xF, 0xF, true));
            if (part == 0) POSP[o] = a;
        }
    }
    bf16_t* KC = (bf16_t*)(P.ws + WS_KC); bf16_t* VTC = (bf16_t*)(P.ws + WS_VTC);
    for (int i = gt; i < 8 * 64; i += nt) { const int bg = i >> 6, d = i & 63; KC[((size_t)bg * 512 + 511) * 64 + d] = 0; VTC[((size_t)bg * 64 + d) * 512 + 511] = 0; }
}

__device__ __forceinline__ void proj_store8(const Params& P, int tok, int n0, f32x4 v0, f32x4 v1) {
    if (n0 >= DIN) return;
    const int nt = n0 >> 7;
    if (nt >= 4 && nt < 10) {
        const int j = nt - 4, g = (n0 >> 6) & 1, d = n0 & 63, b = tok >> 13, sq = tok & 8191;
        bf16_t* dstk = (bf16_t*)(P.ws + (j == 0 ? WS_KCS : j == 1 ? WS_VCS : j == 2 ? WS_KSLC : j == 4 ? WS_KWIN : j == 3 ? WS_VTSLC : WS_VTWIN));
        if (j == 3 || j == 5) {
#pragma unroll
            for (int r = 0; r < 4; ++r) { dstk[((size_t)(b * 2 + g) * 64 + d + r) * SEQ + sq] = f2bf(v0[r]); dstk[((size_t)(b * 2 + g) * 64 + d + 4 + r) * SEQ + sq] = f2bf(v1[r]); }
        } else { const uint2 a = pack4(v0), c = pack4(v1); *(uint4*)(dstk + (((size_t)(b * 2 + g) * SEQ + sq) * 64 + d)) = make_uint4(a.x, a.y, c.x, c.y); }
    } else {
        float sc = 1.f;
        if (nt < 4) sc = 0.125f * LOG2E;
        else if (n0 >= C_QMEM && n0 < C_GMERGE) sc = 0.08838834764831845f * LOG2E;
        v0 *= sc; v1 *= sc;
        if (n0 >= C_GMERGE || (n0 >= C_GNSA && n0 < C_CQ)) {
#pragma unroll
            for (int r = 0; r < 4; ++r) { v0[r] = sigmoidf_(v0[r]); v1[r] = sigmoidf_(v1[r]); }
        }
        const uint2 a = pack4(v0), c = pack4(v1);
        *(uint4*)((bf16_t*)(P.ws + WS_PROJ) + (size_t)tok * DIN + n0) = make_uint4(a.x, a.y, c.x, c.y);
    }
}
template <bool LIGHT>
struct EpiProj {
    const Params* P;
    __device__ __forceinline__ bool operator()(f32x4 (&acc)[2][2][4][2], const pg8::Unit& u, int, int wr, int wc, int fr, int fq) const {
#pragma unroll
        for (int ai = 0; ai < 2; ++ai)
#pragma unroll
            for (int m = 0; m < 4; ++m) {
                const int tok = u.pm * 256 + ai * 128 + wr * 64 + m * 16 + fr;
#pragma unroll
                for (int bj = 0; bj < 2; ++bj) {
                    if (!LIGHT) proj_store8(*P, tok, u.pn * 256 + bj * 128 + wc * 32 + 8 * fq, acc[ai][bj][m][0], acc[ai][bj][m][1]);
                    else asm volatile("" :: "v"(acc[ai][bj][m][0][0]), "v"(acc[ai][bj][m][1][3]));
                }
            }
        return false;
    }
};
template <bool LIGHT>
__device__ __forceinline__ void phase1(const Params& P, char* lds) {
    {
        pg8::DenseProv PV; PV.S.init(NTOK, 6144, gridDim.x, blockIdx.x);
        PV.A = (const bf16_t*)(P.ws + WS_H0); PV.Bt = (const bf16_t*)(P.ws + WB_WIN); PV.lda = DM; PV.ldb = DM; PV.perm = true;
        EpiProj<LIGHT> E; E.P = &P;
        pg8::gemm_phase((LAS unsigned char*)lds, DM, PV, E);
    }
}

template <int NP>
__device__ __forceinline__ void store_row16(bf16_t* row, const uint2 (&pk)[2 * NP], int lq) {
#pragma unroll
    for (int p2 = 0; p2 < NP; ++p2) {
        auto sx = __builtin_amdgcn_permlane16_swap(pk[2 * p2].x, pk[2 * p2 + 1].x, false, false);
        auto sy = __builtin_amdgcn_permlane16_swap(pk[2 * p2].y, pk[2 * p2 + 1].y, false, false);
        *(uint4*)(row + 16 * (2 * p2 + (lq & 1)) + 8 * (lq >> 1)) = make_uint4(sx[0], sy[0], sx[1], sy[1]);
    }
}
template <int LEN>
__device__ __forceinline__ void rows_rstd(const bf16_t* base, long ld, int m0, float* dst) {
    const int t = threadIdx.x, row = t >> 1, part = t & 1;
    const uint4* p = (const uint4*)(base + (size_t)(m0 + row) * ld + part * (LEN / 2));
    float ss = 0.f;
#pragma unroll 1
    for (int i0 = 0; i0 < LEN / 16; i0 += 16) {
        uint4 v[16];
#pragma unroll
        for (int i = 0; i < 16; ++i) v[i] = p[i0 + i];
#pragma unroll
        for (int i = 0; i < 16; ++i) {
            float a;
            a = bflo(v[i].x); ss += a * a; a = bfhi(v[i].x); ss += a * a; a = bflo(v[i].y); ss += a * a; a = bfhi(v[i].y); ss += a * a;
            a = bflo(v[i].z); ss += a * a; a = bfhi(v[i].z); ss += a * a; a = bflo(v[i].w); ss += a * a; a = bfhi(v[i].w); ss += a * a;
        }
    }
    ss += __shfl_xor(ss, 1);
    if (part == 0) dst[row] = rsqrtf(ss * (1.f / LEN) + 1e-6f);
}

template <int QOFF>
__device__ __forceinline__ void phase2(const Params& P, char* lds) {
    unsigned* ctl = (unsigned*)(P.ws + WS_CTL);
    bf16_t* PROJ = (bf16_t*)(P.ws + WS_PROJ);
    float* rsc = (float*)(lds + LDS_ROWS + 1024);
    float* gsc = (float*)(lds + LDS_KSC);
    const float* COS = (const float*)(P.ws + WS_COS); const float* SIN = (const float*)(P.ws + WS_SIN);
#define P2_TID int t = threadIdx.x; asm volatile("" : "+v"(t)); const int lane = t & 63, w = t >> 6, wm = w >> 1, wn = w & 1, lr = lane & 15, lq = lane >> 4;
#ifndef P2SEL
#define P2SEL 7
#endif
    if (P2SEL & 1) for (;;) {
        const int it = queue_pop(&ctl[QOFF + CTL_Q + 0], lds);
        if (it >= 32) break;
        P2_TID
        {
            const int kv = it >> 4, mt = it & 15, m0 = mt * 256;
            const bf16_t* SRC = (const bf16_t*)(P.ws + (kv ? WS_VCS : WS_KCS));
            const bf16_t* w1t = (const bf16_t*)(P.ws + (kv ? WB_WCV1 : WB_WCK1)); const bf16_t* w2t = (const bf16_t*)(P.ws + (kv ? WB_WCV2 : WB_WCK2));
            {
                const float* pp = (const float*)(P.ws + WB_POSP) + kv * 4096 + (t & 255);
                float a = 0.f;
#pragma unroll
                for (int kc = 0; kc < 16; ++kc) a += pp[kc * 256];
                if (t < 256) gsc[t] = a;
            }
            __syncthreads();
            bf16_t* HID = (bf16_t*)(P.ws + WS_SCR + (size_t)blockIdx.x * 131072);
            GemmA A;
#pragma unroll
            for (int i = 0; i < 4; ++i) {
                const int lr_ = gl_row(i, t); int r = m0 + lr_; r = r < 4088 ? r : 4087;
                const int b = r / 1022, rem = r - b * 1022, n = rem >> 1, g = rem & 1;
                A.off[i] = (unsigned)((((size_t)(b * 2 + g) * SEQ + 16 * n) * 64 + gl_chunk(lr_, t) * 8) * 2);
            }
            A.base = (const char*)SRC;
            for (int nt = 0; nt < 2; ++nt) {
                f32x4 acc[4][4]; zero_acc(acc);
                GemmA B = make_op<2>(w1t, 2048, nt * 128, 256);
                gemm_mainloop_g(lds, A, B, 2048 / 64, acc);
#pragma unroll
                for (int i = 0; i < 4; ++i)
                    { uint2 pk[4];
#pragma unroll
                      for (int j = 0; j < 4; ++j) {
                        f32x4 v = acc[i][j];
                        const f32x4 pb = *(const f32x4*)(gsc + nt * 128 + wn * 64 + j * 16 + 4 * lq);
#pragma unroll
                        for (int r = 0; r < 4; ++r) v[r] = geluf_(v[r] + pb[r]);
                        pk[j] = pack4(v);
                      }
                      store_row16<2>(HID + (wm * 64 + i * 16 + lr) * 256 + nt * 128 + wn * 64, pk, lq); }
            }
            asm volatile("s_waitcnt vmcnt(0)" ::: "memory");
            __syncthreads();
            {
                f32x4 acc[4][4]; zero_acc(acc);
                GemmA A2 = make_op<4>(HID, 256, 0, 256);
                GemmA B2 = make_op<2>(w2t, 256, 0, 64);
                gemm_mainloop_g(lds, A2, B2, 256 / 64, acc);
                if (wn == 0) {
                    bf16_t* KC = (bf16_t*)(P.ws + WS_KC); bf16_t* VTC = (bf16_t*)(P.ws + WS_VTC);
#pragma unroll
                    for (int i = 0; i < 4; ++i) {
                        const int r = m0 + wm * 64 + i * 16 + lr;
                        if (r < 4088) {
                            const int b = r / 1022, rem = r - b * 1022, n = rem >> 1, g = rem & 1;
#pragma unroll
                            for (int j = 0; j < 4; ++j) {
                                const int d = j * 16 + 4 * lq;
                                if (!kv) *(uint2*)(KC + ((size_t)(b * 2 + g) * 512 + n) * 64 + d) = pack4(acc[i][j]);
                                else {
#pragma unroll
                                    for (int rr = 0; rr < 4; ++rr) VTC[((size_t)(b * 2 + g) * 64 + d + rr) * 512 + n] = f2bf(acc[i][j][rr]);
                                }
                            }
                        }
                    }
                }
            }
        }
    }
    if (P2SEL & 2) for (;;) {
        const int it = queue_pop(&ctl[QOFF + CTL_Q + 256], lds);
        if (it >= 256) break;
        P2_TID
        {
            const int mt = it >> 1, half = it & 1, m0 = mt * 256;
            rows_rstd<768>(PROJ + C_CQ, DIN, m0, rsc);
            __syncthreads();
            GemmA A = make_op<4>(PROJ + C_CQ, DIN, m0, NTOK);
            bf16_t* QM = (bf16_t*)(P.ws + WS_QM);
            int ring = 0;
#pragma unroll 1
            for (int k3 = 0; k3 < 3; ++k3) {
                const int n0 = (half * 3 + k3) * 128;
                f32x4 acc[4][4]; zero_acc(acc);
                GemmA B = make_op<2>((const bf16_t*)(P.ws + WB_WUQ), 768, n0, 768);
                GemmA Bn = make_op<2>((const bf16_t*)(P.ws + WB_WUQ), 768, n0 + (k3 < 2 ? 128 : 0), 768);
                gemm_mainloop_c(lds, A, B, 768 / 64, acc, ring, k3 > 0, k3 < 2, A, Bn);
                const int c16 = (n0 + wn * 64) >> 4;
                const bool rp0 = (c16 % 6) == 4, rp2 = ((c16 + 2) % 6) == 4;
                int lrz = lr; asm volatile("" : "+v"(lrz));
#pragma unroll
                for (int i = 0; i < 4; ++i) {
                    const int tl = wm * 64 + i * 16 + lrz, tok = m0 + tl, pos = tok & (SEQ - 1);
                    const float sc = rsc[tl] * (0.10206207261596575f * LOG2E);
                    const float4 cs = *(const float4*)(COS + pos * 16 + 4 * lq), sn = *(const float4*)(SIN + pos * 16 + 4 * lq);
                    const float csa[4] = {cs.x, cs.y, cs.z, cs.w}, sna[4] = {sn.x, sn.y, sn.z, sn.w};
#pragma unroll
                    for (int j = 0; j < 4; ++j) acc[i][j] *= sc;
#pragma unroll
                    for (int j = 0; j < 4; j += 2) {
                        if (j == 0 ? rp0 : rp2) {
#pragma unroll
                            for (int r = 0; r < 4; ++r) {
                                const float x1 = acc[i][j][r], x2 = acc[i][j + 1][r];
                                acc[i][j][r] = x1 * csa[r] - x2 * sna[r]; acc[i][j + 1][r] = x2 * csa[r] + x1 * sna[r];
                            }
                        }
                    }
                    { uint2 pk[4];
#pragma unroll
                      for (int j = 0; j < 4; ++j) pk[j] = pack4(acc[i][j]);
                      store_row16<2>(QM + (size_t)tok * 768 + n0 + wn * 64, pk, lq); }
                }
            }
        }
    }
    if (P2SEL & 4) for (;;) {
        const int it = queue_pop(&ctl[QOFF + CTL_Q + 320], lds);
        if (it >= 128) break;
        P2_TID
        {
            const int mt = it, m0 = mt * 256;
            rows_rstd<256>(PROJ + C_CKV, DIN, m0, rsc);
            __syncthreads();
            GemmA A = make_op<4>(PROJ + C_CKV, DIN, m0, NTOK);
            bf16_t* KM = (bf16_t*)(P.ws + WS_KM); bf16_t* VTM = (bf16_t*)(P.ws + WS_VTM);
            int ring = 0;
#pragma unroll 1
            for (int h = 0; h < 8; ++h) {
                f32x4 acc[4][4]; zero_acc(acc);
                GemmA B = make_op<2>((const bf16_t*)(P.ws + WB_WUKV), 256, h * 128, 1024);
                GemmA Bn = make_op<2>((const bf16_t*)(P.ws + WB_WUKV), 256, (h < 7 ? h + 1 : h) * 128, 1024);
                gemm_mainloop_c<true>(lds, A, B, 256 / 64, acc, ring, h > 0, h < 7, A, Bn);
                if (wn == 0) {
#pragma unroll
                    for (int i = 0; i < 4; ++i) {
                        const int tl = wm * 64 + i * 16 + lr, tok = m0 + tl, b = tok >> 13, s = tok & (SEQ - 1);
                        const float sc = rsc[tl];
                        uint2 pk[4];
#pragma unroll
                        for (int j = 0; j < 4; ++j) pk[j] = pack4(acc[i][j] * sc);
                        store_row16<2>(KM + ((size_t)(b * 8 + h) * SEQ + s) * 96, pk, lq);
                    }
                } else {
                    const int tok0 = m0 + wm * 64, b = tok0 >> 13, s0 = tok0 & (SEQ - 1);
                    f32x4 sc[4];
#pragma unroll
                    for (int i = 0; i < 4; ++i) sc[i] = *(const f32x4*)(rsc + wm * 64 + i * 16 + 4 * lq);
#pragma unroll
                    for (int j = 0; j < 4; ++j) {
                        uint2 pk[4];
#pragma unroll
                        for (int i = 0; i < 4; ++i) pk[i] = pack4(acc[i][j] * sc[i]);
                        store_row16<2>(VTM + ((size_t)(b * 8 + h) * 64 + j * 16 + lr) * SEQ + s0, pk, lq);
                    }
                }
            }
        }
    }
    for (;;) {
        const int tile = queue_pop(&ctl[QOFF + CTL_Q + 384], lds);
        if (tile >= 32) break;
        int t = threadIdx.x; asm volatile("" : "+v"(t)); const int lane = t & 63, w = t >> 6, wm = w >> 1, wn = w & 1, lr = lane & 15, lq = lane >> 4;
        f32x4 acc[4][4]; zero_acc(acc);
        {
            const int mt = tile >> 3, nt = tile & 7, m0 = mt * 256, n0 = nt * 128;
            GemmA A = make_op<4>((const bf16_t*)(P.ws + WS_MEMB), DM, m0, 1024);
            GemmA B = make_op<2>((const bf16_t*)(P.ws + WB_WMEM), 1024, n0, 1024);
            gemm_mainloop_g(lds, A, B, DM / 64, acc);
            bf16_t* KMEM = (bf16_t*)(P.ws + WS_KMEM); bf16_t* VTMEM = (bf16_t*)(P.ws + WS_VTMEM);
#pragma unroll
            for (int i = 0; i < 4; ++i) {
                const int row = m0 + wm * 64 + i * 16 + lr, b = row >> 8, m = row & 255;
#pragma unroll
                for (int jj = 0; jj < 4; ++jj) {
                    const int n = n0 + wn * 64 + jj * 16 + 4 * lq;
                    const int two = n >> 9, h = (n >> 7) & 3, d = n & 127;
                    if (two == 0) *(uint2*)(KMEM + (((size_t)(b * 4 + h) * 256 + m) * 128 + d)) = pack4(acc[i][jj]);
                    else {
#pragma unroll
                        for (int r = 0; r < 4; ++r) VTMEM[((size_t)(b * 4 + h) * 128 + d + r) * 256 + m] = f2bf(acc[i][jj][r]);
                    }
                }
            }
        }
    }
    {
        const int t = threadIdx.x;
        bf16_t* KM = (bf16_t*)(P.ws + WS_KM);
        const int gt = blockIdx.x * NTHR + t, nt = gridDim.x * NTHR;
        for (int i = gt; i < NTOK * 4; i += nt) {
            const int tok = i >> 2, c = i & 3, half = c >> 1, j0 = (c & 1) * 8, b = tok >> 13, s = tok & (SEQ - 1);
            const uint4 xa = *(const uint4*)(PROJ + (size_t)tok * DIN + C_KROPE + j0), xb = *(const uint4*)(PROJ + (size_t)tok * DIN + C_KROPE + 16 + j0);
            const float4 c0 = *(const float4*)(COS + s * 16 + j0), c1 = *(const float4*)(COS + s * 16 + j0 + 4);
            const float4 n0 = *(const float4*)(SIN + s * 16 + j0), n1 = *(const float4*)(SIN + s * 16 + j0 + 4);
            const float x1[8] = {bflo(xa.x), bfhi(xa.x), bflo(xa.y), bfhi(xa.y), bflo(xa.z), bfhi(xa.z), bflo(xa.w), bfhi(xa.w)};
            const float x2[8] = {bflo(xb.x), bfhi(xb.x), bflo(xb.y), bfhi(xb.y), bflo(xb.z), bfhi(xb.z), bflo(xb.w), bfhi(xb.w)};
            const float cs[8] = {c0.x, c0.y, c0.z, c0.w, c1.x, c1.y, c1.z, c1.w}, sn[8] = {n0.x, n0.y, n0.z, n0.w, n1.x, n1.y, n1.z, n1.w};
            float o[8];
#pragma unroll
            for (int k = 0; k < 8; ++k) o[k] = half ? (x2[k] * cs[k] + x1[k] * sn[k]) : (x1[k] * cs[k] - x2[k] * sn[k]);
            const uint4 ov = make_uint4(pack2(o[0], o[1]), pack2(o[2], o[3]), pack2(o[4], o[5]), pack2(o[6], o[7]));
#pragma unroll
            for (int h = 0; h < 8; ++h) *(uint4*)(KM + ((size_t)(b * 8 + h) * SEQ + s) * 96 + 64 + half * 16 + j0) = ov;
        }
    }
}

__device__ __forceinline__ int offk(int sub, int key, int c) { return sub * 4096 + key * 64 + (((c ^ (-(key >> 2))) & 3) << 4); }
__device__ __forceinline__ int offv(int dv, int ch) { return dv * 128 + (((ch ^ (dv >> 1)) & 7) << 4); }

template <int DK, int DV, bool NEEDV, class KP, class VP, class TL, class FN>
__device__ __forceinline__ void kv_loop(char* lds, int n, KP kp, VP vp, TL tl, FN fn) {
    if (n <= 0) return;
    int t = threadIdx.x; asm volatile("" : "+v"(t));
    const int lane = t & 63, wu = __builtin_amdgcn_readfirstlane(t >> 6);
    constexpr int KPN = DK / 8, VPN = DV / 8, KPT = (KPN + 7) / 8, VPT = (VPN + 7) / 8;
    constexpr int KB = DK * 128, VB = DV * 128;
    LAS char* ldsl = (LAS char*)lds;
#define KVI_(tile, buf) { \
        _Pragma("unroll") for (int i = 0; i < KPT; ++i) { const int p_ = wu + 8 * i, key_ = 16 * (p_ & 3) + (lane >> 2), c_ = ((lane & 3) ^ (-(key_ >> 2))) & 3; \
            if (p_ < KPN) __builtin_amdgcn_global_load_lds((const unsigned*)(kp(tile, key_) + (p_ >> 2) * 32 + c_ * 8), (LAS unsigned*)(ldsl + (buf) * KB + p_ * 1024), 16, 0, 0); } \
        if (NEEDV) { _Pragma("unroll") for (int i = 0; i < VPT; ++i) { const int p_ = wu + 8 * i, dv_ = 8 * p_ + (lane >> 3), ch_ = ((lane & 7) ^ (dv_ >> 1)) & 7; \
            if (p_ < VPN) __builtin_amdgcn_global_load_lds((const unsigned*)(vp(tile, dv_) + ch_ * 8), (LAS unsigned*)(ldsl + 2 * KB + (buf) * VB + p_ * 1024), 16, 0, 0); } } }
    __syncthreads();
    { const int t0 = tl(0); KVI_(t0, 0); }
    asm volatile("s_waitcnt vmcnt(0)" ::: "memory");
    __syncthreads();
#pragma unroll 1
    for (int i = 0; i < n; ++i) {
        const int cur = i & 1, tile = tl(i);
        if (i + 1 < n) { const int tn = tl(i + 1); if (cur) KVI_(tn, 0) else KVI_(tn, 1) }
        fn(tile, (const char*)(lds + cur * KB), (const char*)(lds + 2 * KB + cur * VB));
        asm volatile("s_waitcnt vmcnt(0)" ::: "memory");
        __syncthreads();
    }
#undef KVI_
}

template <int DK, int DV, class KP, class VP, class TL, class FN>
__device__ __forceinline__ void kv_loop2(char* lds, int n, KP kp, VP vp, TL tl, FN fn) {
    if (n <= 0) return;
    int t = threadIdx.x; asm volatile("" : "+v"(t));
    const int lane = t & 63, wu = __builtin_amdgcn_readfirstlane(t >> 6);
    constexpr int KPN = DK / 8, VPN = DV / 8, KPT = (KPN + 7) / 8, VPT = (VPN + 7) / 8;
    constexpr int KB = DK * 128, VB = DV * 128, TB = KB + VB, SB = 2 * TB;
    LAS char* ldsl = (LAS char*)lds;
#define KVI2_(tile, off_) { \
        _Pragma("unroll") for (int i = 0; i < KPT; ++i) { const int p_ = wu + 8 * i, key_ = 16 * (p_ & 3) + (lane >> 2), c_ = ((lane & 3) ^ (-(key_ >> 2))) & 3; \
            if (p_ < KPN) __builtin_amdgcn_global_load_lds((const unsigned*)(kp(tile, key_) + (p_ >> 2) * 32 + c_ * 8), (LAS unsigned*)(ldsl + (off_) + p_ * 1024), 16, 0, 0); } \
        _Pragma("unroll") for (int i = 0; i < VPT; ++i) { const int p_ = wu + 8 * i, dv_ = 8 * p_ + (lane >> 3), ch_ = ((lane & 7) ^ (dv_ >> 1)) & 7; \
            if (p_ < VPN) __builtin_amdgcn_global_load_lds((const unsigned*)(vp(tile, dv_) + ch_ * 8), (LAS unsigned*)(ldsl + (off_) + KB + p_ * 1024), 16, 0, 0); } }
    const int np = (n + 1) >> 1;
    __syncthreads();
    { const int ta = tl(0), tb = tl(n > 1 ? 1 : 0); KVI2_(ta, 0); KVI2_(tb, TB); }
    asm volatile("s_waitcnt vmcnt(0)" ::: "memory");
    __syncthreads();
#pragma unroll 1
    for (int i = 0; i < np; ++i) {
        const int cur = i & 1;
        if (i + 1 < np) { const int ia = 2 * i + 2, ib = (2 * i + 3 < n) ? 2 * i + 3 : ia; const int ta = tl(ia), tb = tl(ib);
            if (cur) { KVI2_(ta, 0); KVI2_(tb, TB); } else { KVI2_(ta, SB); KVI2_(tb, SB + TB); } }
        const char* base = lds + cur * SB;
        const bool hasB = 2 * i + 1 < n;
        fn(tl(2 * i), base, base + KB, tl(hasB ? 2 * i + 1 : 2 * i), base + TB, base + TB + KB, hasB);
        asm volatile("s_waitcnt vmcnt(0)" ::: "memory");
        __syncthreads();
    }
#undef KVI2_
}

template <int DK, int NST>
__device__ __forceinline__ void qk_tile(const char* Kb, const bf16x8 (&qf)[NST][DK / 32], f32x4 (&s)[NST][4], int lane) {
    const int lr = lane & 15, lq = lane >> 4;
#pragma unroll
    for (int kt = 0; kt < 4; ++kt) {
#pragma unroll
        for (int st = 0; st < NST; ++st) s[st][kt] = (f32x4){0.f, 0.f, 0.f, 0.f};
#pragma unroll
        for (int ks = 0; ks < DK / 32; ++ks) {
            const bf16x8 kf = *(const bf16x8*)(Kb + offk(ks, kt * 16 + lr, lq));
#pragma unroll
            for (int st = 0; st < NST; ++st) s[st][kt] = mfma16(kf, qf[st][ks], s[st][kt]);
        }
    }
}
template <int DV, int NST>
__device__ __forceinline__ void pv_tile(const char* Vb, const f32x4 (&p)[NST][4], f32x4 (&O)[NST][DV / 16], int lane) {
    const int lr = lane & 15, lq = lane >> 4;
#pragma unroll
    for (int h2 = 0; h2 < 2; ++h2) {
        bf16x8 pf[NST];
#pragma unroll
        for (int st = 0; st < NST; ++st) {
            const uint2 a = pack4(p[st][2 * h2]), b = pack4(p[st][2 * h2 + 1]);
            const uint4 u = make_uint4(a.x, a.y, b.x, b.y);
            pf[st] = __builtin_bit_cast(bf16x8, u);
        }
#pragma unroll
        for (int dvt = 0; dvt < DV / 16; ++dvt) {
            const int dv = dvt * 16 + lr;
            const bf16x4 v0 = *(const bf16x4*)(Vb + offv(dv, 4 * h2 + (lq >> 1)) + (lq & 1) * 8);
            const bf16x4 v1 = *(const bf16x4*)(Vb + offv(dv, 4 * h2 + 2 + (lq >> 1)) + (lq & 1) * 8);
            const bf16x8 vf = __builtin_shufflevector(v0, v1, 0, 1, 2, 3, 4, 5, 6, 7);
#pragma unroll
            for (int st = 0; st < NST; ++st) O[st][dvt] = mfma16(vf, pf[st], O[st][dvt]);
        }
    }
}
constexpr float RESCALE_AT = 1099511627776.f, RESCALE_BY = 1.f / 1099511627776.f;
template <int DV, int NST>
__device__ __forceinline__ void softmax_online(f32x4 (&s)[NST][4], float (&c)[NST], float (&l)[NST], f32x4 (&O)[NST][DV / 16]) {
    bool scaled = false, big = false;
#pragma unroll
    for (int st = 0; st < NST; ++st) scaled = scaled || (c[st] != 1.f);
#pragma unroll
    for (int st = 0; st < NST; ++st)
#pragma unroll
        for (int kt = 0; kt < 4; ++kt)
#pragma unroll
            for (int r = 0; r < 4; ++r) s[st][kt][r] = fexp2(s[st][kt][r]);
    if (__any(scaled)) {
#pragma unroll
        for (int st = 0; st < NST; ++st)
#pragma unroll
            for (int kt = 0; kt < 4; ++kt) s[st][kt] *= c[st];
    }
#pragma unroll
    for (int st = 0; st < NST; ++st) { l[st] += sum16(s[st]); big = big || (l[st] > RESCALE_AT); }
    if (__any(big)) {
#pragma unroll
        for (int st = 0; st < NST; ++st) {
            const float f = l[st] > RESCALE_AT ? RESCALE_BY : 1.f;
            const float g = quad_min(f);
            l[st] *= g; c[st] *= g;
#pragma unroll
            for (int kt = 0; kt < 4; ++kt) s[st][kt] *= g;
#pragma unroll
            for (int dvt = 0; dvt < DV / 16; ++dvt) O[st][dvt] *= g;
        }
    }
}
__device__ __forceinline__ float quad_lsum(float l) { return quad_sum(l); }

__device__ __forceinline__ void mla_item(const Params& P, char* lds, int b, int h, int qblk) {
    int t = threadIdx.x; asm volatile("" : "+v"(t));
    const int lane = t & 63, w = t >> 6, lr = lane & 15, lq = lane >> 4;
    const bf16_t* QM = (const bf16_t*)(P.ws + WS_QM);
    const bf16_t* KM = (const bf16_t*)(P.ws + WS_KM) + (size_t)(b * 8 + h) * SEQ * 96;
    const bf16_t* VTM = (const bf16_t*)(P.ws + WS_VTM) + (size_t)(b * 8 + h) * 64 * SEQ;
    const int wq0 = qblk * 256 + w * 32;
    bf16x8 qf[2][3];
#pragma unroll
    for (int st = 0; st < 2; ++st)
#pragma unroll
        for (int ks = 0; ks < 3; ++ks) qf[st][ks] = *(const bf16x8*)(QM + (size_t)(b * SEQ + wq0 + st * 16 + lr) * 768 + h * 96 + ks * 32 + lq * 8);
    float m[2] = {1.f, 1.f}, l[2] = {0.f, 0.f};
    f32x4 O[2][4];
#pragma unroll
    for (int st = 0; st < 2; ++st)
#pragma unroll
        for (int d = 0; d < 4; ++d) O[st][d] = (f32x4){0.f, 0.f, 0.f, 0.f};
    auto mla_tile = [&](int tile, const char* Kb, const char* Vb) __attribute__((always_inline)) {
        if (tile * 64 > wq0 + 31) return;
        f32x4 s[2][4];
        qk_tile<96, 2>(Kb, qf, s, lane);
        if (tile * 64 + 63 > wq0) {
#pragma unroll
            for (int st = 0; st < 2; ++st)
#pragma unroll
                for (int kt = 0; kt < 4; ++kt)
#pragma unroll
                    for (int r = 0; r < 4; ++r)
                        if (tile * 64 + kt * 16 + 4 * lq + r > wq0 + st * 16 + lr) s[st][kt][r] = NEGBIG;
        }
        softmax_online<64, 2>(s, m, l, O);
        pv_tile<64, 2>(Vb, s, O, lane);
    };
    kv_loop2<96, 64>(lds, 4 * qblk + 4,
        [&](int tile, int key) __attribute__((always_inline)) { return KM + (size_t)(tile * 64 + key) * 96; },
        [&](int tile, int dv) __attribute__((always_inline)) { return VTM + (size_t)dv * SEQ + tile * 64; },
        [&](int i) __attribute__((always_inline)) { return i; },
        [&](int ta, const char* Ka, const char* Va, int tb, const char* Kb, const char* Vb, bool hasB) __attribute__((always_inline)) {
            mla_tile(ta, Ka, Va);
            if (hasB) mla_tile(tb, Kb, Vb);
        });
    bf16_t* OM = (bf16_t*)(P.ws + WS_OMLA);
#pragma unroll
    for (int st = 0; st < 2; ++st) {
        const float inv = 1.f / quad_lsum(l[st]);
        const size_t tok = (size_t)b * SEQ + wq0 + st * 16 + lr;
        uint2 pk[4];
#pragma unroll
        for (int d = 0; d < 4; ++d) pk[d] = pack4(O[st][d] * inv);
        store_row16<2>(OM + tok * 512 + h * 64, pk, lq);
    }
}

__device__ __forceinline__ void mem_item(const Params& P, char* lds, int b, int h, int qblk) {
    int t = threadIdx.x; asm volatile("" : "+v"(t));
    const int lane = t & 63, w = t >> 6, lr = lane & 15, lq = lane >> 4;
    const bf16_t* PROJ = (const bf16_t*)(P.ws + WS_PROJ);
    const bf16_t* KMEM = (const bf16_t*)(P.ws + WS_KMEM) + (size_t)(b * 4 + h) * 256 * 128;
    const bf16_t* VTMEM = (const bf16_t*)(P.ws + WS_VTMEM) + (size_t)(b * 4 + h) * 128 * 256;
    const size_t tok = (size_t)b * SEQ + qblk * 128 + w * 16 + lr;
    bf16x8 qf[1][4];
#pragma unroll
    for (int ks = 0; ks < 4; ++ks) qf[0][ks] = *(const bf16x8*)(PROJ + tok * DIN + C_QMEM + h * 128 + ks * 32 + lq * 8);
    float m[1] = {1.f}, l[1] = {0.f};
    f32x4 O[1][8];
#pragma unroll
    for (int d = 0; d < 8; ++d) O[0][d] = (f32x4){0.f, 0.f, 0.f, 0.f};
    kv_loop<128, 128, true>(lds, 4,
        [&](int tile, int key) __attribute__((always_inline)) { return KMEM + (size_t)(tile * 64 + key) * 128; },
        [&](int tile, int dv) __attribute__((always_inline)) { return VTMEM + (size_t)dv * 256 + tile * 64; },
        [&](int i) __attribute__((always_inline)) { return i; },
        [&](int tile, const char* Kb, const char* Vb) __attribute__((always_inline)) {
            f32x4 s[1][4];
            qk_tile<128, 1>(Kb, qf, s, lane);
            softmax_online<128, 1>(s, m, l, O);
            pv_tile<128, 1>(Vb, s, O, lane);
        });
    bf16_t* OM = (bf16_t*)(P.ws + WS_OMEM);
    const float inv = 1.f / quad_lsum(l[0]);
    uint2 pk[8];
#pragma unroll
    for (int d = 0; d < 8; ++d) pk[d] = pack4(O[0][d] * inv);
    store_row16<4>(OM + tok * 512 + h * 128, pk, lq);
}

__device__ __forceinline__ void softmax_stats(const f32x4 (&s)[2][4], float (&c)[2], float (&l)[2]) {
#pragma unroll
    for (int st = 0; st < 2; ++st) {
        f32x4 e[4];
#pragma unroll
        for (int kt = 0; kt < 4; ++kt)
#pragma unroll
            for (int r = 0; r < 4; ++r) e[kt][r] = fexp2(s[st][kt][r]);
        l[st] += sum16(e) * c[st];
        const float g = quad_min(l[st] > RESCALE_AT ? RESCALE_BY : 1.f);
        l[st] *= g; c[st] *= g;
    }
}

template <int NMASK>
__device__ __forceinline__ void nsa_item(const Params& P, char* lds, int b, int g, int q0) {
    int t = threadIdx.x; asm volatile("" : "+v"(t));
    const int lane = t & 63, w = t >> 6, lr = lane & 15, lq = lane >> 4;
    const int hg = g * 4 + (lr & 3);
    const bf16_t* PROJ = (const bf16_t*)(P.ws + WS_PROJ);
    const size_t bg = (size_t)(b * 2 + g);
    const bf16_t* KC = (const bf16_t*)(P.ws + WS_KC) + bg * 512 * 64;
    const bf16_t* VTC = (const bf16_t*)(P.ws + WS_VTC) + bg * 64 * 512;
    const bf16_t* KSLC = (const bf16_t*)(P.ws + WS_KSLC) + bg * SEQ * 64;
    const bf16_t* VTSLC = (const bf16_t*)(P.ws + WS_VTSLC) + bg * 64 * SEQ;
    const bf16_t* KWIN = (const bf16_t*)(P.ws + WS_KWIN) + bg * SEQ * 64;
    const bf16_t* VTWIN = (const bf16_t*)(P.ws + WS_VTWIN) + bg * 64 * SEQ;
    float* imp = (float*)(lds + 65536);
    const float* LUT = (const float*)(lds + LDS_LUT) + 64 * 8;
    unsigned* SEL = (unsigned*)(lds + LDS_SEL);
    unsigned* WOR = (unsigned*)(lds + LDS_WOR);
    unsigned char* TL = (unsigned char*)(lds + LDS_TL);
    int* TLN = (int*)(lds + LDS_TL + 128);
    int tpos[2];
    tpos[0] = q0 + 8 * w + (lr >> 2); tpos[1] = tpos[0] + 4;
    bf16x8 qf[2][2];
#pragma unroll
    for (int st = 0; st < 2; ++st)
#pragma unroll
        for (int ks = 0; ks < 2; ++ks) qf[st][ks] = *(const bf16x8*)(PROJ + (size_t)(b * SEQ + tpos[st]) * DIN + C_QNSA + hg * 64 + ks * 32 + lq * 8);
    auto gate = [&](int st, int k) __attribute__((always_inline)) { return bf2f(PROJ[(size_t)(b * SEQ + tpos[st]) * DIN + C_GNSA + hg * 3 + k]); };
    f32x4 OT[2][4];
#pragma unroll
    for (int i = 0; i < 16; ++i) imp[(8 * w) * 128 + i * 64 + lane] = 0.f;

    const float bfar = LUT[128 * 8 + hg];
    const int ntc = (((q0 + 32) >> 4) >> 6) + 1;
    float m[2] = {1.f, 1.f}, l[2] = {0.f, 0.f};
    auto cmp_mask = [&](int tile, f32x4 (&s)[2][4]) __attribute__((always_inline)) {
#pragma unroll
        for (int st = 0; st < 2; ++st)
#pragma unroll
            for (int kt = 0; kt < 4; ++kt)
#pragma unroll
                for (int r = 0; r < 4; ++r) {
                    const int n = tile * 64 + kt * 16 + 4 * lq + r;
                    const int dist = tpos[st] - (16 * n + 31);
                    const int di = dist < -1 ? -1 : (dist < 128 ? dist : 128);
                    s[st][kt][r] += LUT[di * 8 + hg];
                }
    };
    kv_loop<64, 64, false>(lds, ntc,
        [&](int tile, int key) __attribute__((always_inline)) { return KC + (size_t)(tile * 64 + key) * 64; },
        [&](int tile, int dv) __attribute__((always_inline)) { return VTC; },
        [&](int i) __attribute__((always_inline)) { return i; },
        [&](int tile, const char* Kb, const char* Vb) __attribute__((always_inline)) {
            f32x4 s[2][4];
            const bool farc = q0 + 8 * w - (16 * (tile * 64 + 63) + 31) >= 128;
            qk_tile<64, 2>(Kb, qf, s, lane);
            if (farc) {
#pragma unroll
                for (int st = 0; st < 2; ++st)
#pragma unroll
                    for (int kt = 0; kt < 4; ++kt) s[st][kt] += bfar;
            } else cmp_mask(tile, s);
            softmax_stats(s, m, l);
        });
    float invl[2];
#pragma unroll
    for (int st = 0; st < 2; ++st) { const float lt = quad_lsum(l[st]); invl[st] = lt > 0.f ? m[st] / lt : 0.f; }
#pragma unroll
    for (int st = 0; st < 2; ++st)
#pragma unroll
        for (int d = 0; d < 4; ++d) OT[st][d] = (f32x4){0.f, 0.f, 0.f, 0.f};
    kv_loop<64, 64, true>(lds, ntc,
        [&](int tile, int key) __attribute__((always_inline)) { return KC + (size_t)(tile * 64 + key) * 64; },
        [&](int tile, int dv) __attribute__((always_inline)) { return VTC + (size_t)dv * 512 + tile * 64; },
        [&](int i) __attribute__((always_inline)) { return i; },
        [&](int tile, const char* Kb, const char* Vb) __attribute__((always_inline)) {
            f32x4 s[2][4];
            const bool farc = q0 + 8 * w - (16 * (tile * 64 + 63) + 31) >= 128;
            qk_tile<64, 2>(Kb, qf, s, lane);
            if (farc) {
#pragma unroll
                for (int st = 0; st < 2; ++st)
#pragma unroll
                    for (int kt = 0; kt < 4; ++kt) s[st][kt] += bfar;
            } else cmp_mask(tile, s);
#pragma unroll
            for (int st = 0; st < 2; ++st)
#pragma unroll
                for (int kt = 0; kt < 4; ++kt) {
#pragma unroll
                    for (int r = 0; r < 4; ++r) {
                        s[st][kt][r] = fexp2(s[st][kt][r]) * invl[st];
                    }
                    float ps = (s[st][kt][0] + s[st][kt][1]) + (s[st][kt][2] + s[st][kt][3]);
                    float pc = s[st][kt][3];
                    ps = quad4_sum(ps);
                    pc = quad4_sum(pc);
                    const int j = tile * 16 + kt * 4 + lq;
                    float* row = imp + (8 * w + 4 * st + (lr >> 2)) * 128;
                    if ((lr & 3) == 0) lds_fadd(&row[j], ps);
                    if ((lr & 3) == 0 && j + 1 < 128) lds_fadd(&row[j + 1], pc);
                }
            pv_tile<64, 2>(Vb, s, OT, lane);
        });
#pragma unroll
    for (int st = 0; st < 2; ++st) {
        const float g0 = gate(st, 0);
#pragma unroll
        for (int d = 0; d < 4; ++d) OT[st][d] *= g0;
    }

    {
        unsigned wo0 = 0, wo1 = 0, wo2 = 0, wo3 = 0;
        for (int qi = 0; qi < 8; ++qi) {
            const int tq = q0 + 8 * w + qi, cur = tq >> 6;
            const float v0 = imp[(8 * w + qi) * 128 + lane], v1 = imp[(8 * w + qi) * 128 + 64 + lane];
            const int j0 = lane, j1 = lane + 64;
            bool s0 = (j0 == 0) || (j0 == cur) || (j0 + 1 == cur);
            bool s1 = (j1 == cur) || (j1 + 1 == cur);
            const bool c0 = (j0 >= 1) && (j0 + 2 <= cur), c1 = (j1 + 2 <= cur);
            if (cur - 2 <= 13) { s0 = s0 || c0; s1 = s1 || c1; }
            else {
                const unsigned k0 = c0 ? __float_as_uint(v0) + 1u : 0u, k1 = c1 ? __float_as_uint(v1) + 1u : 0u;
                unsigned T = 0u;
                for (int bit = 30; bit >= 0; --bit) {
                    const unsigned cand = T | (1u << bit);
                    const int cnt = __popcll(__ballot(k0 >= cand)) + __popcll(__ballot(k1 >= cand));
                    if (cnt >= 13) { T = cand; if (cnt == 13) break; }
                }
                const unsigned long long gt0 = __ballot(k0 > T), gt1 = __ballot(k1 > T);
                unsigned long long eq0 = __ballot(k0 == T), eq1 = __ballot(k1 == T);
                int need = 13 - (__popcll(gt0) + __popcll(gt1));
                unsigned long long tk0 = 0ull, tk1 = 0ull;
                while (need > 0 && eq0) { const unsigned long long lowb = eq0 & (0ull - eq0); tk0 |= lowb; eq0 ^= lowb; --need; }
                while (need > 0 && eq1) { const unsigned long long lowb = eq1 & (0ull - eq1); tk1 |= lowb; eq1 ^= lowb; --need; }
                s0 = s0 || ((gt0 | tk0) >> lane) & 1ull;
                s1 = s1 || ((gt1 | tk1) >> lane) & 1ull;
            }
            const unsigned long long b0 = __ballot(s0), b1 = __ballot(s1);
            if (lane == 0) {
                SEL[(8 * w + qi) * 4 + 0] = (unsigned)b0; SEL[(8 * w + qi) * 4 + 1] = (unsigned)(b0 >> 32);
                SEL[(8 * w + qi) * 4 + 2] = (unsigned)b1; SEL[(8 * w + qi) * 4 + 3] = (unsigned)(b1 >> 32);
            }
            wo0 |= (unsigned)b0; wo1 |= (unsigned)(b0 >> 32); wo2 |= (unsigned)b1; wo3 |= (unsigned)(b1 >> 32);
        }
        if (lane == 0) { WOR[w * 4 + 0] = wo0; WOR[w * 4 + 1] = wo1; WOR[w * 4 + 2] = wo2; WOR[w * 4 + 3] = wo3; }
    }
    __syncthreads();
    if (w == 0) {
        unsigned o0 = 0u, o1 = 0u, o2 = 0u, o3 = 0u;
#pragma unroll
        for (int ww = 0; ww < NWV; ++ww) { o0 |= WOR[ww * 4 + 0]; o1 |= WOR[ww * 4 + 1]; o2 |= WOR[ww * 4 + 2]; o3 |= WOR[ww * 4 + 3]; }
        const bool n0 = ((lane < 32 ? o0 : o1) >> (lane & 31)) & 1u, n1 = ((lane < 32 ? o2 : o3) >> (lane & 31)) & 1u;
        const unsigned long long m0 = __ballot(n0), m1 = __ballot(n1);
        const unsigned long long below = (1ull << lane) - 1ull;
        const int c0 = __popcll(m0);
        if (n0) TL[__popcll(m0 & below)] = (unsigned char)lane;
        if (n1) TL[c0 + __popcll(m1 & below)] = (unsigned char)(64 + lane);
        if (lane == 0) *TLN = c0 + __popcll(m1);
    }
    __syncthreads();
    const int nts = *TLN;
    f32x4* ST = (f32x4*)(lds + 65536);
#pragma unroll
    for (int k = 0; k < 8; ++k) ST[k * NTHR + t] = OT[k >> 2][k & 3];

    if (NMASK & 2)
    {
        f32x4 Oa[1][4], Ob[1][4];
#pragma unroll
        for (int d = 0; d < 4; ++d) { Oa[0][d] = (f32x4){0.f, 0.f, 0.f, 0.f}; Ob[0][d] = (f32x4){0.f, 0.f, 0.f, 0.f}; }
        float ca[1] = {1.f}, cb[1] = {1.f}, la[1] = {0.f}, lb[1] = {0.f};
        bf16x8 qfa[1][2], qfb[1][2];
#pragma unroll
        for (int ks = 0; ks < 2; ++ks) { qfa[0][ks] = qf[0][ks]; qfb[0][ks] = qf[1][ks]; }
        auto proc = [&](int tile, const char* Kb, const char* Vb, const bf16x8 (&q1)[1][2], f32x4 (&O1)[1][4], float (&c1)[1], float (&l1)[1], bool on, int tp) __attribute__((always_inline)) {
            f32x4 s[1][4];
            qk_tile<64, 1>(Kb, q1, s, lane);
            const bool far = tile * 64 + 63 + 128 <= q0 + 8 * w;
            if (far) {
                const float ab = on ? bfar : NEGBIG;
#pragma unroll
                for (int kt = 0; kt < 4; ++kt) s[0][kt] += ab;
            } else {
                int D = tp - (tile * 64 + 4 * lq); D = D < 191 ? D : 191; D = on ? D : -1;
                const float* lp = LUT + (D - 63) * 8 + hg;
#pragma unroll
                for (int kt = 0; kt < 4; ++kt)
#pragma unroll
                    for (int r = 0; r < 4; ++r) s[0][kt][r] += lp[(63 - (kt * 16 + r)) * 8];
            }
            softmax_online<64, 1>(s, c1, l1, O1);
            pv_tile<64, 1>(Vb, s, O1, lane);
        };
        auto s_tile = [&](int tile, const char* Kb, const char* Vb) __attribute__((always_inline)) {
            const unsigned wv = WOR[w * 4 + (tile >> 5)];
            if (!((wv >> (tile & 31)) & 1u)) return;
            const bool on0 = (SEL[(8 * w + (lr >> 2)) * 4 + (tile >> 5)] >> (tile & 31)) & 1u;
            const bool on1 = (SEL[(8 * w + 4 + (lr >> 2)) * 4 + (tile >> 5)] >> (tile & 31)) & 1u;
            if (__any(on0)) proc(tile, Kb, Vb, qfa, Oa, ca, la, on0, tpos[0]);
            if (__any(on1)) proc(tile, Kb, Vb, qfb, Ob, cb, lb, on1, tpos[1]);
        };
        kv_loop2<64, 64>(lds, nts,
            [&](int tile, int key) __attribute__((always_inline)) { return KSLC + (size_t)(tile * 64 + key) * 64; },
            [&](int tile, int dv) __attribute__((always_inline)) { return VTSLC + (size_t)dv * SEQ + tile * 64; },
            [&](int i) __attribute__((always_inline)) { return (int)TL[i]; },
            [&](int ta, const char* Ka, const char* Va, int tb, const char* Kb, const char* Vb, bool hasB) __attribute__((always_inline)) {
                s_tile(ta, Ka, Va);
                if (hasB) s_tile(tb, Kb, Vb);
            });
        {
            const float lt = quad_lsum(la[0]);
            const float f = lt > 0.f ? gate(0, 1) / lt : 0.f;
#pragma unroll
            for (int d = 0; d < 4; ++d) ST[d * NTHR + t] += Oa[0][d] * f;
        }
        {
            const float lt = quad_lsum(lb[0]);
            const float f = lt > 0.f ? gate(1, 1) / lt : 0.f;
#pragma unroll
            for (int d = 0; d < 4; ++d) ST[(4 + d) * NTHR + t] += Ob[0][d] * f;
        }
    }
    if (NMASK & 4) {
        f32x4 O[2][4];
#pragma unroll
        for (int st = 0; st < 2; ++st)
#pragma unroll
            for (int d = 0; d < 4; ++d) O[st][d] = (f32x4){0.f, 0.f, 0.f, 0.f};
        m[0] = 1.f; m[1] = 1.f; l[0] = 0.f; l[1] = 0.f;
        const int tw0 = (q0 - 511 > 0 ? q0 - 511 : 0) >> 6, tw1 = (q0 + 63) >> 6;
        kv_loop<64, 64, true>(lds, tw1 - tw0 + 1,
            [&](int tile, int key) __attribute__((always_inline)) { return KWIN + (size_t)(tile * 64 + key) * 64; },
            [&](int tile, int dv) __attribute__((always_inline)) { return VTWIN + (size_t)dv * SEQ + tile * 64; },
            [&](int i) __attribute__((always_inline)) { return tw0 + i; },
            [&](int tile, const char* Kb, const char* Vb) __attribute__((always_inline)) {
                f32x4 s[2][4];
                const bool mid = q0 + 8 * w - (tile * 64 + 63) >= 128 && q0 + 8 * w + 7 - tile * 64 < 512;
                qk_tile<64, 2>(Kb, qf, s, lane);
                if (mid) {
#pragma unroll
                    for (int st = 0; st < 2; ++st)
#pragma unroll
                        for (int kt = 0; kt < 4; ++kt) s[st][kt] += bfar;
                } else if (q0 + 8 * w - (tile * 64 + 63) < 128) {
#pragma unroll
                    for (int st = 0; st < 2; ++st) {
                        int D = tpos[st] - (tile * 64 + 4 * lq); D = D < 191 ? D : 191;
                        const float* lp = LUT + (D - 63) * 8 + hg;
#pragma unroll
                        for (int kt = 0; kt < 4; ++kt)
#pragma unroll
                            for (int r = 0; r < 4; ++r) s[st][kt][r] += lp[(63 - (kt * 16 + r)) * 8];
                    }
                } else {
#pragma unroll
                    for (int st = 0; st < 2; ++st)
#pragma unroll
                        for (int kt = 0; kt < 4; ++kt)
#pragma unroll
                            for (int r = 0; r < 4; ++r) {
                                const int dist = tpos[st] - (tile * 64 + kt * 16 + 4 * lq + r);
                                s[st][kt][r] = dist < 512 ? s[st][kt][r] + bfar : NEGBIG;
                            }
                }
                softmax_online<64, 2>(s, m, l, O);
                pv_tile<64, 2>(Vb, s, O, lane);
            });
#pragma unroll
        for (int st = 0; st < 2; ++st) {
            const float lt = quad_lsum(l[st]);
            const float f = lt > 0.f ? gate(st, 2) / lt : 0.f;
            bf16_t* ON = (bf16_t*)(P.ws + WS_ONSA);
            uint2 pk[4];
#pragma unroll
            for (int d = 0; d < 4; ++d) pk[d] = pack4(ST[(st * 4 + d) * NTHR + t] + O[st][d] * f);
            store_row16<2>(ON + (size_t)(b * SEQ + tpos[st]) * 512 + hg * 64, pk, lq);
        }
    }
}

#ifndef P3SEL
#define P3SEL 7
#endif
#ifndef NSADUP
#define NSADUP 7
#endif
__device__ __forceinline__ void convert_experts(const Params& P, char* lds, int tbeg, int tend, int b0, int st);
constexpr int CONV_CHUNKS3 = NEA * 96 / 4;
template <int QOFF, int SEL>
__device__ __forceinline__ void phase3(const Params& P, char* lds) {
    unsigned* ctl = (unsigned*)(P.ws + WS_CTL);
    unsigned* chead = &ctl[QOFF + CTL_Q + 448];
#define P3_QUEUE(head_, n_, call_) { int it = queue_pop(head_, lds); while (it < (n_)) { \
        unsigned nx_ = 0u, cx_ = 0u; if (threadIdx.x == 0) { nx_ = atomicAdd(head_, 1u); cx_ = atomicAdd(chead, 1u); } \
        call_; \
        __syncthreads(); if (threadIdx.x == 0) { *(volatile int*)(lds + LDS_ITEM) = (int)nx_; *(volatile int*)(lds + LDS_ITEM + 4) = (int)cx_; } __syncthreads(); \
        it = __builtin_amdgcn_readfirstlane(*(volatile int*)(lds + LDS_ITEM)); \
        { const int cc_ = __builtin_amdgcn_readfirstlane(*(volatile int*)(lds + LDS_ITEM + 4)); if (cc_ < CONV_CHUNKS3) convert_experts(P, lds, cc_ * 4, cc_ * 4 + 4, 0, 1); } } }
    if (SEL & 1) P3_QUEUE(&ctl[QOFF + CTL_Q + 64], 1024, mla_item(P, lds, (it & 31) >> 3, it & 7, 31 - (it >> 5)))
    if (SEL & 2) P3_QUEUE(&ctl[QOFF + CTL_Q + 128], 1024, (nsa_item<(QOFF == 0 ? 7 : NSADUP)>(P, lds, (it & 7) >> 1, it & 1, (127 - (it >> 3)) * 64)))
    if (SEL & 4) P3_QUEUE(&ctl[QOFF + CTL_Q + 192], 1024, mem_item(P, lds, it >> 8, (it >> 6) & 3, it & 63))
#undef P3_QUEUE
    for (;;) { const int cc = queue_pop(chead, lds); if (cc >= CONV_CHUNKS3) break; convert_experts(P, lds, cc * 4, cc * 4 + 4, 0, 1); }
}

__device__ __forceinline__ void phase4(const Params& P, char* lds) {
    const bf16_t* PROJ = (const bf16_t*)(P.ws + WS_PROJ);
    bf16_t* MERGED = (bf16_t*)(P.ws + WS_MERGED);
    int ring = 0; bool primed = false;
    auto tile_mn = [&](int tile, int& m0, int& n0) __attribute__((always_inline)) {
        const int bb = tile & 255, rnd = tile >> 8, xg = bb & 7, rr = bb >> 3;
        const int mt = (xg + 8 * rnd) * 4 + (rr & 3), nt = rr >> 2; m0 = mt * 256; n0 = nt * 128;
    };
    for (int tile = blockIdx.x; tile < 1024; tile += gridDim.x) {
        int t = threadIdx.x; asm volatile("" : "+v"(t)); const int lane = t & 63, w = t >> 6, wm = w >> 1, wn = w & 1, lr = lane & 15, lq = lane >> 4;
        int m0, n0; tile_mn(tile, m0, n0);
        const bool last_tile = tile + (int)gridDim.x >= 1024;
        f32x4 tot[4][4]; zero_acc(tot);
#pragma unroll 1
        for (int br = 0; br < 3; ++br) {
            f32x4 acc[4][4]; zero_acc(acc);
            GemmA A = make_op<4>((const bf16_t*)(P.ws + WS_ONSA + (size_t)br * 32 * MBY), 512, m0, NTOK);
            GemmA B = make_op<2, true>((const bf16_t*)(P.ws + WB_WBR) + (size_t)br * 1024 * 512, 512, n0, 1024);
            const bool chain = !(br == 2 && last_tile);
            int m1 = m0, n1 = n0; const int br1 = br == 2 ? 0 : br + 1;
            if (br == 2 && !last_tile) tile_mn(tile + gridDim.x, m1, n1);
            GemmA An = make_op<4>((const bf16_t*)(P.ws + WS_ONSA + (size_t)br1 * 32 * MBY), 512, m1, NTOK);
            GemmA Bn = make_op<2, true>((const bf16_t*)(P.ws + WB_WBR) + (size_t)br1 * 1024 * 512, 512, n1, 1024);
            gemm_mainloop_c(lds, A, B, 512 / 64, acc, ring, primed, chain, An, Bn);
            primed = chain;
#pragma unroll
            for (int i = 0; i < 4; ++i) {
                const size_t tok = m0 + wm * 64 + i * 16 + lr;
#pragma unroll
                for (int jp = 0; jp < 2; ++jp) {
                    const int n = n0 + wn * 64 + jp * 32 + 8 * lq;
                    const uint4 gv = *(const uint4*)(PROJ + tok * DIN + C_GMERGE + br * 1024 + n);
                    tot[i][2 * jp][0] += bflo(gv.x) * acc[i][2 * jp][0]; tot[i][2 * jp][1] += bfhi(gv.x) * acc[i][2 * jp][1];
                    tot[i][2 * jp][2] += bflo(gv.y) * acc[i][2 * jp][2]; tot[i][2 * jp][3] += bfhi(gv.y) * acc[i][2 * jp][3];
                    tot[i][2 * jp + 1][0] += bflo(gv.z) * acc[i][2 * jp + 1][0]; tot[i][2 * jp + 1][1] += bfhi(gv.z) * acc[i][2 * jp + 1][1];
                    tot[i][2 * jp + 1][2] += bflo(gv.w) * acc[i][2 * jp + 1][2]; tot[i][2 * jp + 1][3] += bfhi(gv.w) * acc[i][2 * jp + 1][3];
                }
            }
        }
#pragma unroll
        for (int i = 0; i < 4; ++i) {
            const size_t tok = m0 + wm * 64 + i * 16 + lr;
#pragma unroll
            for (int jp = 0; jp < 2; ++jp) { const uint2 x = pack4(tot[i][2 * jp]), y = pack4(tot[i][2 * jp + 1]); *(uint4*)(MERGED + tok * DM + n0 + wn * 64 + jp * 32 + 8 * lq) = make_uint4(x.x, x.y, y.x, y.y); }
        }
    }
}

struct EpiY1 {
    const bf16_t* H0; bf16_t* Y1;
    __device__ __forceinline__ bool operator()(f32x4 (&acc)[2][2][4][2], const pg8::Unit& u, int, int wr, int wc, int fr, int fq) const {
#pragma unroll
        for (int ai = 0; ai < 2; ++ai)
#pragma unroll
            for (int m = 0; m < 4; ++m) {
                const size_t tok = (size_t)u.pm * 256 + ai * 128 + wr * 64 + m * 16 + fr;
#pragma unroll
                for (int bj = 0; bj < 2; ++bj) {
                    const int col = u.pn * 256 + bj * 128 + wc * 32 + 8 * fq;
                    const uint4 hv = *(const uint4*)(H0 + tok * DM + col);
                    f32x4 v0 = acc[ai][bj][m][0], v1 = acc[ai][bj][m][1];
                    v0[0] += ALPHA * bflo(hv.x); v0[1] += ALPHA * bfhi(hv.x); v0[2] += ALPHA * bflo(hv.y); v0[3] += ALPHA * bfhi(hv.y);
                    v1[0] += ALPHA * bflo(hv.z); v1[1] += ALPHA * bfhi(hv.z); v1[2] += ALPHA * bflo(hv.w); v1[3] += ALPHA * bfhi(hv.w);
                    const uint2 a = pack4(v0), c = pack4(v1);
                    *(uint4*)(Y1 + tok * H1LD + col) = make_uint4(a.x, a.y, c.x, c.y);
                }
            }
        return false;
    }
};
__device__ __forceinline__ void phase5a(const Params& P, char* lds) {
    pg8::DenseProv PV; PV.S.init(NTOK, DM, gridDim.x, blockIdx.x);
    PV.A = (const bf16_t*)(P.ws + WS_MERGED); PV.Bt = (const bf16_t*)(P.ws + WB_WOUT); PV.lda = DM; PV.ldb = DM; PV.perm = true;
    EpiY1 E; E.H0 = (const bf16_t*)(P.ws + WS_H0); E.Y1 = (bf16_t*)(P.ws + WS_Y1);
    pg8::gemm_phase((LAS unsigned char*)lds, DM, PV, E);
}

template <int MODE>
__device__ __forceinline__ void phase5b(const Params& P, char* lds) {
    const int t = threadIdx.x, lane = t & 63, w = t >> 6;
    const int gw = blockIdx.x * NWV + w, nw = gridDim.x * NWV;
    bf16_t* H1 = (bf16_t*)P.out; bf16_t* H1LO = (bf16_t*)(P.ws + WS_Y1);
    if (MODE == 0) for (int row0 = gw; row0 < NTOK; row0 += 2 * nw) {
        const int row1 = row0 + nw; const bool has1 = row1 < NTOK;
        const bf16_t* yb = (const bf16_t*)(P.ws + WS_Y1);
        uint4 raw[2][2];
#pragma unroll
        for (int u = 0; u < 2; ++u)
#pragma unroll
            for (int i = 0; i < 2; ++i) raw[u][i] = *(const uint4*)(yb + (size_t)((u && has1) ? row1 : row0) * H1LD + i * 512 + 8 * lane);
        float v[2][16]; float s[2] = {0.f, 0.f};
#pragma unroll
        for (int u = 0; u < 2; ++u)
#pragma unroll
            for (int i = 0; i < 2; ++i) {
                v[u][8 * i + 0] = bflo(raw[u][i].x); v[u][8 * i + 1] = bfhi(raw[u][i].x); v[u][8 * i + 2] = bflo(raw[u][i].y); v[u][8 * i + 3] = bfhi(raw[u][i].y);
                v[u][8 * i + 4] = bflo(raw[u][i].z); v[u][8 * i + 5] = bfhi(raw[u][i].z); v[u][8 * i + 6] = bflo(raw[u][i].w); v[u][8 * i + 7] = bfhi(raw[u][i].w);
            }
#pragma unroll
        for (int u = 0; u < 2; ++u)
#pragma unroll
            for (int k = 0; k < 16; ++k) s[u] += v[u][k];
        const float mu[2] = {wave_sum(s[0]) * (1.f / DM), wave_sum(s[1]) * (1.f / DM)};
        float q[2] = {0.f, 0.f};
#pragma unroll
        for (int u = 0; u < 2; ++u)
#pragma unroll
            for (int k = 0; k < 16; ++k) { const float d = v[u][k] - mu[u]; q[u] += d * d; }
        const float rstd[2] = {rsqrtf(wave_sum(q[0]) * (1.f / DM) + 1e-5f), rsqrtf(wave_sum(q[1]) * (1.f / DM) + 1e-5f)};
#pragma unroll
        for (int i = 0; i < 2; ++i) {
            const float4 g0 = ((const float4*)P.ln1_g)[i * 128 + 2 * lane], g1 = ((const float4*)P.ln1_g)[i * 128 + 2 * lane + 1];
            const float4 b0 = ((const float4*)P.ln1_b)[i * 128 + 2 * lane], b1 = ((const float4*)P.ln1_b)[i * 128 + 2 * lane + 1];
            const float gg[8] = {g0.x, g0.y, g0.z, g0.w, g1.x, g1.y, g1.z, g1.w}, bb[8] = {b0.x, b0.y, b0.z, b0.w, b1.x, b1.y, b1.z, b1.w};
#pragma unroll
            for (int u = 0; u < 2; ++u) {
                const int row = u ? row1 : row0;
                float h[8];
#pragma unroll
                for (int k = 0; k < 8; ++k) h[k] = (v[u][8 * i + k] - mu[u]) * rstd[u] * gg[k] + bb[k];
                const uint4 hi = make_uint4(pack2(h[0], h[1]), pack2(h[2], h[3]), pack2(h[4], h[5]), pack2(h[6], h[7]));
                const uint4 lo = make_uint4(pack2(h[0] - bflo(hi.x), h[1] - bfhi(hi.x)), pack2(h[2] - bflo(hi.y), h[3] - bfhi(hi.y)),
                                            pack2(h[4] - bflo(hi.z), h[5] - bfhi(hi.z)), pack2(h[6] - bflo(hi.w), h[7] - bfhi(hi.w)));
                if (u == 0 || has1) {
                    *(uint4*)(H1 + (size_t)row * H1LD + i * 512 + 8 * lane) = hi;
                    *(uint4*)(H1LO + (size_t)row * H1LD + i * 512 + 8 * lane) = lo;
                }
            }
        }
    }
}

#ifndef CONV_SPLIT
#define CONV_SPLIT 18432
#endif
__device__ __forceinline__ void convert_experts(const Params& P, char* lds, int tbeg, int tend, int b0, int st) {
    const int t = threadIdx.x;
    const int tt = t & 255, sub = t >> 8, kg = tt >> 5, n4 = tt & 31;
    char* tb = lds + sub * 16384;
    const int NT_ = tend, step = st * 2;
    __syncthreads();
    for (int tile0 = tbeg + b0 * 2; tile0 < NT_; tile0 += 2 * step) {
        float4 r[2][8]; const float* srcs[2]; bf16_t* dsts[2]; int lddv[2], kt0v[2], nt0v[2]; bool hasv[2];
#pragma unroll
        for (int q = 0; q < 2; ++q) {
            const int tile_ = tile0 + q * step + sub; hasv[q] = tile_ < NT_;
            const int tile = hasv[q] ? tile_ : tile0 + sub;
            const int mat = tile >> 5, loc = tile & 31, e = mat / 3, which = mat - e * 3;
            srcs[q] = (which == 0 ? P.exp_w1 : which == 1 ? P.exp_w3 : P.exp_w2) + (size_t)e * 262144;
            dsts[q] = (bf16_t*)expw_ptr(P.ws, e) + which * 262144;
            const int N = which == 2 ? 1024 : 256; lddv[q] = which == 2 ? 256 : 1024;
            kt0v[q] = (which == 2 ? (loc >> 3) : (loc >> 1)) * 64; nt0v[q] = (which == 2 ? (loc & 7) : (loc & 1)) * 128;
            const int k0 = kt0v[q] + kg * 8, n = nt0v[q] + n4 * 4;
#pragma unroll
            for (int kk = 0; kk < 8; ++kk) r[q][kk] = *(const float4*)(srcs[q] + (size_t)(k0 + kk) * N + n);
        }
#pragma unroll
        for (int q = 0; q < 2; ++q) {
#pragma unroll
            for (int c = 0; c < 4; ++c) {
                float v[8];
#pragma unroll
                for (int kk = 0; kk < 8; ++kk) v[kk] = (c == 0) ? r[q][kk].x : (c == 1) ? r[q][kk].y : (c == 2) ? r[q][kk].z : r[q][kk].w;
                *(uint4*)(tb + swz(4 * n4 + c, kg)) = make_uint4(pack2(v[0], v[1]), pack2(v[2], v[3]), pack2(v[4], v[5]), pack2(v[6], v[7]));
            }
            __syncthreads();
            if (hasv[q]) {
#pragma unroll
                for (int i = 0; i < 4; ++i) {
                    const int row = (tt >> 3) + 32 * i, ch = tt & 7;
                    *(uint4*)(dsts[q] + (size_t)(nt0v[q] + row) * lddv[q] + kt0v[q] + ch * 8) = *(const uint4*)(tb + swz(row, ch));
                }
            }
            __syncthreads();
        }
    }
}

__device__ __forceinline__ unsigned long long ord_key(float v, int e) {
    unsigned u = __float_as_uint(v); u = (u & 0x80000000u) ? ~u : (u | 0x80000000u);
    return ((unsigned long long)u << 8) | (unsigned)(255 - e);
}
template <bool NOWRITE>
__device__ __forceinline__ void phase5d(const Params& P, char* lds) {
    const bool conv_first5 = ((blockIdx.x >> 3) & 1) != 0;
    if (!NOWRITE && conv_first5) convert_experts(P, lds, CONV_SPLIT, 768 * 32, blockIdx.x, gridDim.x);
    const int t = threadIdx.x, lane = t & 63, w = t >> 6;
    const int gw = blockIdx.x * NWV + w, nw = gridDim.x * NWV;
    const float* LOGITS = (const float*)(P.ws + WS_LOGITS);
    unsigned* ctl = (unsigned*)(P.ws + WS_CTL);
    int* EID = (int*)(P.ws + WS_EID); float* EW = (float*)(P.ws + WS_EW); int* LIST = (int*)(P.ws + WS_LIST);
    const float4 rb = ((const float4*)P.router_b)[lane];
    float4 lgn = ((const float4*)(LOGITS + (size_t)(gw < NTOK ? gw : 0) * 256))[lane];
    for (int tok = gw; tok < NTOK; tok += nw) {
        const float4 lg = lgn;
        { const int tn = tok + nw < NTOK ? tok + nw : tok; lgn = ((const float4*)(LOGITS + (size_t)tn * 256))[lane]; }
        float s[4] = {sigmoidf_(lg.x), sigmoidf_(lg.y), sigmoidf_(lg.z), sigmoidf_(lg.w)};
        float sb[4] = {s[0] + rb.x, s[1] + rb.y, s[2] + rb.z, s[3] + rb.w};
        float a = fmaxf(sb[0], sb[1]), bq = fminf(sb[0], sb[1]);
        { const float a2 = fmaxf(sb[2], sb[3]), b2 = fminf(sb[2], sb[3]); const float na = fmaxf(a, a2); bq = fmaxf(fminf(a, a2), fmaxf(bq, b2)); a = na; }
#define DPPF_(x, ctrl) __uint_as_float(__builtin_amdgcn_update_dpp(0u, __float_as_uint(x), ctrl, 0xF, 0xF, true))
        { const float a2 = DPPF_(a, 0xB1), b2 = DPPF_(bq, 0xB1); const float na = fmaxf(a, a2); bq = fmaxf(fminf(a, a2), fmaxf(bq, b2)); a = na; }
        { const float a2 = DPPF_(a, 0x4E), b2 = DPPF_(bq, 0x4E); const float na = fmaxf(a, a2); bq = fmaxf(fminf(a, a2), fmaxf(bq, b2)); a = na; }
        { const float a2 = DPPF_(a, 0x141), b2 = DPPF_(bq, 0x141); const float na = fmaxf(a, a2); bq = fmaxf(fminf(a, a2), fmaxf(bq, b2)); a = na; }
#undef DPPF_
        const float gs = a + bq; const int grp = lane >> 3;
        int rank = 0;
#pragma unroll
        for (int g2 = 0; g2 < 8; ++g2) { const float o = __uint_as_float(__builtin_amdgcn_readlane(__float_as_uint(gs), g2 * 8)); rank += (o > gs || (o == gs && g2 < grp)) ? 1 : 0; }
        const bool gsel = rank < 4;
        float v[4];
#pragma unroll
        for (int i = 0; i < 4; ++i) v[i] = gsel ? sb[i] : -3.0e38f;
        int my_e = 0; float my_s = 0.f, wsum = 0.f;
        for (int r = 0; r < 8; ++r) {
            float bv = v[0]; int bi = 0;
#pragma unroll
            for (int i = 1; i < 4; ++i) if (v[i] > bv) { bv = v[i]; bi = i; }
            const float wm = wave_max(bv);
            const int wl = __builtin_amdgcn_readfirstlane(__ffsll((long long)__ballot(bv == wm)) - 1);
            const int wi = __builtin_amdgcn_readlane(bi, wl);
            const float mine = bi == 0 ? s[0] : bi == 1 ? s[1] : bi == 2 ? s[2] : s[3];
            const float sv = __uint_as_float(__builtin_amdgcn_readlane(__float_as_uint(mine), wl));
            if (lane == wl) { if (bi == 0) v[0] = -3.0e38f; else if (bi == 1) v[1] = -3.0e38f; else if (bi == 2) v[2] = -3.0e38f; else v[3] = -3.0e38f; }
            wsum += sv;
            if (lane == r) { my_e = wl * 4 + wi; my_s = sv; }
        }
        if (NOWRITE) { asm volatile("" :: "v"(my_e), "v"(my_s), "v"(wsum)); }
        else if (lane < 8) {
            const float wv = my_s / wsum * 2.5f;
            EID[tok * 8 + lane] = my_e; EW[tok * 8 + lane] = wv;
            const unsigned pos = atomicAdd(&ctl[CTL_CNT + my_e * 16], 1u);
            LIST[(size_t)my_e * NTOK + pos] = tok * 8 + lane;
        }
    }
    if (!NOWRITE && !conv_first5) convert_experts(P, lds, CONV_SPLIT, 768 * 32, blockIdx.x, gridDim.x);
}

struct ProvUp {
    const char* h1; const char* wb; const int* aid;
    __device__ __forceinline__ void offsets(unsigned (&va)[2][2], unsigned (&vb)[2][2], const int (&sR)[2], const int (&sC)[2]) const {
#pragma unroll
        for (int h = 0; h < 2; ++h)
#pragma unroll
            for (int p = 0; p < 2; ++p) {
                va[h][p] = (unsigned)(((size_t)(aid[h * 128 + sR[p]] >> 3) * H1LD + sC[p]) * 2);
                vb[h][p] = (unsigned)(((size_t)h * 262144 + (size_t)((sR[p] & ~31) + pg8::perm32(sR[p] & 31)) * 1024 + sC[p]) * 2);
            }
    }
    __device__ __forceinline__ bool get(int i, pg8::Unit& u, pg8::Ops& o) const {
        if (i >= 2) return false;
        u.pm = 0; u.pn = i; o.A = h1; o.B = wb + (size_t)i * 128 * 1024 * 2;
        return true;
    }
};
struct EpiUp {
    bf16_t* scr;
    __device__ __forceinline__ bool operator()(f32x4 (&acc)[2][2][4][2], const pg8::Unit& u, int, int wr, int wc, int fr, int fq) const {
#pragma unroll
        for (int ai = 0; ai < 2; ++ai)
#pragma unroll
            for (int m = 0; m < 4; ++m) {
                const int row = ai * 128 + wr * 64 + m * 16 + fr;
                f32x4 v0, v1;
#pragma unroll
                for (int r = 0; r < 4; ++r) { v0[r] = siluf_(acc[ai][0][m][0][r]) * acc[ai][1][m][0][r]; v1[r] = siluf_(acc[ai][0][m][1][r]) * acc[ai][1][m][1][r]; }
                const uint2 a = pack4(v0), c = pack4(v1);
                *(uint4*)(scr + row * 256 + u.pn * 128 + wc * 32 + 8 * fq) = make_uint4(a.x, a.y, c.x, c.y);
            }
        return false;
    }
};
struct ProvDown {
    const char* scr; const char* w2t;
    __device__ __forceinline__ void offsets(unsigned (&va)[2][2], unsigned (&vb)[2][2], const int (&sR)[2], const int (&sC)[2]) const {
#pragma unroll
        for (int h = 0; h < 2; ++h)
#pragma unroll
            for (int p = 0; p < 2; ++p) { va[h][p] = (unsigned)(((h * 128 + sR[p]) * 256 + sC[p]) * 2); vb[h][p] = (unsigned)(((h * 128 + (sR[p] & ~31) + pg8::perm32(sR[p] & 31)) * 256 + sC[p]) * 2); }
    }
    __device__ __forceinline__ bool get(int i, pg8::Unit& u, pg8::Ops& o) const {
        if (i >= 4) return false;
        u.pm = 0; u.pn = i; o.A = scr; o.B = w2t + (size_t)i * 256 * 256 * 2;
        return true;
    }
};
struct EpiDown {
    bf16_t* Y; bf16_t* SHOUT; const int* aid; int rows; bool routed;
    __device__ __forceinline__ bool operator()(f32x4 (&acc)[2][2][4][2], const pg8::Unit& u, int, int wr, int wc, int fr, int fq) const {
#pragma unroll
        for (int ai = 0; ai < 2; ++ai)
#pragma unroll
            for (int m = 0; m < 4; ++m) {
                const int row = ai * 128 + wr * 64 + m * 16 + fr;
                if (row < rows) {
                    const int a = aid[row];
                    bf16_t* dst = (routed ? (Y + (size_t)a * DM) : (SHOUT + (size_t)(a >> 3) * H1LD)) + u.pn * 256 + wc * 32 + 8 * fq;
#pragma unroll
                    for (int bj = 0; bj < 2; ++bj) { const uint2 x = pack4(acc[ai][bj][m][0]), y = pack4(acc[ai][bj][m][1]); *(uint4*)(dst + bj * 128) = make_uint4(x.x, x.y, y.x, y.y); }
                }
            }
        return false;
    }
};
struct ProvRouter {
    const char* hi; const char* lo; const char* whi; const char* wlo; int tile0, tstep;
    __device__ __forceinline__ void offsets(unsigned (&va)[2][2], unsigned (&vb)[2][2], const int (&sR)[2], const int (&sC)[2]) const {
#pragma unroll
        for (int h = 0; h < 2; ++h)
#pragma unroll
            for (int p = 0; p < 2; ++p) { va[h][p] = (unsigned)(((size_t)(h * 128 + sR[p]) * H1LD + sC[p]) * 2); vb[h][p] = (unsigned)(((size_t)(h * 128 + sR[p]) * 1024 + sC[p]) * 2); }
    }
    __device__ __forceinline__ bool get(int i, pg8::Unit& u, pg8::Ops& o) const {
        const int q = i / 3, seg = i - q * 3, ot = tile0 + q * tstep;
        if (ot >= 128) return false;
        u.pm = ot; u.pn = seg;
        o.A = (seg == 1 ? lo : hi) + (size_t)ot * 256 * H1LD * 2; o.B = seg == 0 ? wlo : whi;
        return true;
    }
};
struct EpiRouter {
    float* LOGITS;
    __device__ __forceinline__ bool operator()(f32x4 (&acc)[2][2][4][2], const pg8::Unit& u, int, int wr, int wc, int fr, int fq) const {
        if (u.pn < 2) return true;
#pragma unroll
        for (int ai = 0; ai < 2; ++ai)
#pragma unroll
            for (int m = 0; m < 4; ++m) {
                const size_t tok = (size_t)u.pm * 256 + ai * 128 + wr * 64 + m * 16 + fr;
#pragma unroll
                for (int bj = 0; bj < 2; ++bj)
#pragma unroll
                    for (int n = 0; n < 2; ++n) *(f32x4*)(LOGITS + tok * 256 + bj * 128 + wc * 32 + n * 16 + 4 * fq) = acc[ai][bj][m][n];
            }
        return false;
    }
};
__device__ __forceinline__ void phase5c(const Params& P, char* lds) {
    const int xg = blockIdx.x & 7, rk = blockIdx.x >> 3, G8 = gridDim.x >> 3;
    const bool two = G8 >= 2; const int nr = two ? (G8 >> 1) : G8, ns = two ? G8 - nr : G8;
    const bool conv_first = (rk & 1) != 0;
    if (conv_first) convert_experts(P, lds, NEA * 96, CONV_SPLIT, blockIdx.x, gridDim.x);
    if (!two || rk < nr) {
        ProvRouter PV; PV.hi = (const char*)P.out; PV.lo = (const char*)(P.ws + WS_Y1); PV.whi = (const char*)(P.ws + WB_WRHI); PV.wlo = (const char*)(P.ws + WB_WRLO);
        PV.tile0 = xg * 16 + rk; PV.tstep = 0;
        EpiRouter E; E.LOGITS = (float*)(P.ws + WS_LOGITS);
        for (int j = rk; j < 16; j += nr) { PV.tile0 = xg * 16 + j; PV.tstep = 128; pg8::gemm_phase((LAS unsigned char*)lds, DM, PV, E); }
    }
    if (!two || rk >= nr) {
        int* aid = (int*)(lds + LDS_ROWS);
        bf16_t* SCR = (bf16_t*)(P.ws + WS_SCR2 + (size_t)blockIdx.x * 131072);
        const bf16_t* wb = (const bf16_t*)(P.ws + WB_WS1);
        for (int j = two ? rk - nr : rk; j < 16; j += ns) {
            const int t = threadIdx.x;
            __syncthreads();
            if (t < 256) aid[t] = ((xg * 16 + j) * 256 + t) * 8;
            __syncthreads();
            {
                ProvUp PV; PV.h1 = (const char*)P.out; PV.wb = (const char*)wb; PV.aid = aid;
                EpiUp E; E.scr = SCR;
                pg8::gemm_phase((LAS unsigned char*)lds, DM, PV, E);
            }
            asm volatile("s_waitcnt vmcnt(0)" ::: "memory");
            __syncthreads();
            {
                ProvDown PV; PV.scr = (const char*)SCR; PV.w2t = (const char*)(wb + 524288);
                EpiDown E; E.Y = (bf16_t*)(P.ws + WS_Y); E.SHOUT = (bf16_t*)P.out + 1024; E.aid = aid; E.rows = 256; E.routed = false;
                pg8::gemm_phase((LAS unsigned char*)lds, 256, PV, E);
            }
            __syncthreads();
        }
    }
    if (!conv_first) convert_experts(P, lds, NEA * 96, CONV_SPLIT, blockIdx.x, gridDim.x);
}

__device__ __forceinline__ void phase7(const Params& P, char* lds) {
    const int t0_ = threadIdx.x;
    unsigned* ctl = (unsigned*)(P.ws + WS_CTL);
    int* pre = (int*)(lds + LDS_PRE);
    int* aid = (int*)(lds + LDS_ROWS);
    const int* LIST = (const int*)(P.ws + WS_LIST);
    bf16_t* SCR = (bf16_t*)(P.ws + WS_SCR2 + (size_t)blockIdx.x * 131072);
    const int xg = blockIdx.x & 7, rk = blockIdx.x >> 3, G8 = gridDim.x >> 3;
    __syncthreads();
    if (t0_ == 0) {
        int s = 0;
        for (int k = 0; k < 32; ++k) { pre[k] = s; s += ((int)ctl[CTL_CNT + (xg + 8 * k) * 16] + 255) >> 8; }
        pre[32] = s;
    }
    __syncthreads();
    const int T = pre[32];
    for (int g = rk; g < T; g += G8) {
        const int t = threadIdx.x;
        const bf16_t* wb; int rows; const bool routed = true;
        {
            int lo = 0, hi = 32;
            while (hi - lo > 1) { const int mid = (lo + hi) >> 1; if (pre[mid] <= g) lo = mid; else hi = mid; }
            const int e = xg + 8 * lo, tile = g - pre[lo], cnt = (int)ctl[CTL_CNT + e * 16];
            rows = cnt - tile * 256; rows = rows < 256 ? rows : 256; rows = __builtin_amdgcn_readfirstlane(rows);
            if (t < 256) aid[t] = LIST[(size_t)e * NTOK + tile * 256 + (t < rows ? t : rows - 1)];
            wb = (const bf16_t*)expw_ptr(P.ws, e);
        }
        __syncthreads();
        {
            ProvUp PV; PV.h1 = (const char*)P.out; PV.wb = (const char*)wb; PV.aid = aid;
            EpiUp E; E.scr = SCR;
            pg8::gemm_phase((LAS unsigned char*)lds, DM, PV, E);
        }
        asm volatile("s_waitcnt vmcnt(0)" ::: "memory");
        __syncthreads();
        {
            ProvDown PV; PV.scr = (const char*)SCR; PV.w2t = (const char*)(wb + 524288);
            EpiDown E; E.Y = (bf16_t*)(P.ws + WS_Y); E.SHOUT = (bf16_t*)P.out + 1024; E.aid = aid; E.rows = rows; E.routed = routed;
            pg8::gemm_phase((LAS unsigned char*)lds, 256, PV, E);
        }
        __syncthreads();
    }
}

__device__ __forceinline__ void phase8(const Params& P) {
    const int t = threadIdx.x, lane = t & 63, w = t >> 6;
    const int gw = blockIdx.x * NWV + w, nw = gridDim.x * NWV;
    const bf16_t* H1 = (const bf16_t*)P.out; const bf16_t* SHOUT = (const bf16_t*)P.out + 1024;
    const bf16_t* Y = (const bf16_t*)(P.ws + WS_Y); const float* EW = (const float*)(P.ws + WS_EW);
    for (int tok = gw; tok < NTOK; tok += nw) {
        float v[4][4];
#pragma unroll
        for (int i = 0; i < 4; ++i) {
            const uint2 h = *(const uint2*)(H1 + (size_t)tok * H1LD + 4 * (lane + 64 * i));
            const uint2 s = *(const uint2*)(SHOUT + (size_t)tok * H1LD + 4 * (lane + 64 * i));
            v[i][0] = ALPHA * bflo(h.x) + bflo(s.x); v[i][1] = ALPHA * bfhi(h.x) + bfhi(s.x);
            v[i][2] = ALPHA * bflo(h.y) + bflo(s.y); v[i][3] = ALPHA * bfhi(h.y) + bfhi(s.y);
        }
#pragma unroll
        for (int k = 0; k < 8; ++k) {
            const float wk = EW[tok * 8 + k];
            const bf16_t* yr = Y + ((size_t)tok * 8 + k) * DM;
#pragma unroll
            for (int i = 0; i < 4; ++i) {
                const uint2 y = *(const uint2*)(yr + 4 * (lane + 64 * i));
                v[i][0] += wk * bflo(y.x); v[i][1] += wk * bfhi(y.x); v[i][2] += wk * bflo(y.y); v[i][3] += wk * bfhi(y.y);
            }
        }
        float s = 0.f;
#pragma unroll
        for (int i = 0; i < 4; ++i) s += v[i][0] + v[i][1] + v[i][2] + v[i][3];
        const float mu = wave_sum(s) * (1.f / DM);
        float q = 0.f;
#pragma unroll
        for (int i = 0; i < 4; ++i)
#pragma unroll
            for (int c = 0; c < 4; ++c) { const float d = v[i][c] - mu; q += d * d; }
        const float rstd = rsqrtf(wave_sum(q) * (1.f / DM) + 1e-5f);
#pragma unroll
        for (int i = 0; i < 4; ++i) {
            const float4 g = ((const float4*)P.ln2_g)[lane + 64 * i], bb = ((const float4*)P.ln2_b)[lane + 64 * i];
            float4 o;
            o.x = (v[i][0] - mu) * rstd * g.x + bb.x; o.y = (v[i][1] - mu) * rstd * g.y + bb.y;
            o.z = (v[i][2] - mu) * rstd * g.z + bb.z; o.w = (v[i][3] - mu) * rstd * g.w + bb.w;
            ((float4*)(P.out + (size_t)tok * DM))[lane + 64 * i] = o;
        }
    }
}

constexpr int N_PHASES = 11;
__global__ void __launch_bounds__(512, 2) fwd_kernel(Params P) {
    extern __shared__ __attribute__((aligned(16))) char lds[];
    const int t = threadIdx.x;
    if (t == 0) *(uint4*)(lds + LDS_BARW) = make_uint4(0u, 0u, 0u, 0u);
    {
        float* LUT = (float*)(lds + LDS_LUT);
        for (int i = t; i < 256 * 8; i += NTHR) {
            const int d = (i >> 3) - 64, h = i & 7;
            float v = NEGBIG;
            if (d >= 0) {
                int bucket = d;
                if (d >= 16) { bucket = 16 + (int)(log2f((float)d * (1.f / 16.f)) * (16.f / 3.f)); bucket = bucket < 31 ? bucket : 31; }
                v = P.rel_bias[bucket * 8 + h] * LOG2E;
            }
            LUT[i] = v;
        }
    }
    __syncthreads();
    XcdBarrier bar = xcd_barrier_post((unsigned*)(P.ws + WS_CTL), (volatile LAS unsigned*)(lds + LDS_BARW));
#ifndef ONLY_PHASE
#define ONLY_PHASE -1
#endif
#ifndef PROBE_DUP
#define PROBE_DUP -1
#endif
#define PHASE(k, call) if ((ONLY_PHASE < 0 || ONLY_PHASE == (k)) && P.ph_lo <= (k) && (k) < P.ph_hi) { call; if ((k) + 1 < P.ph_hi) xcd_barrier(bar); }
#define PHASE_DUP(k, call) if (PROBE_DUP == (k)) { call; xcd_barrier(bar); }
    PHASE(0, phase0(P))
    PHASE_DUP(1, phase1<true>(P, lds))
    PHASE(1, phase1<false>(P, lds))
    PHASE_DUP(2, phase2<1024>(P, lds))
    PHASE(2, phase2<0>(P, lds))
#ifndef P3DUP
#define P3DUP 7
#endif
    PHASE_DUP(3, (phase3<1024, P3DUP>(P, lds)))
    PHASE(3, (phase3<0, 7>(P, lds)))
    PHASE_DUP(4, phase4(P, lds))
    PHASE(4, phase4(P, lds))
    PHASE_DUP(5, phase5a(P, lds))
    PHASE(5, phase5a(P, lds))
#ifndef P6DUP
#define P6DUP 1
#endif
    PHASE_DUP(6, phase5b<P6DUP>(P, lds))
    PHASE(6, phase5b<0>(P, lds))
    PHASE_DUP(7, phase5c(P, lds))
    PHASE(7, phase5c(P, lds))
    PHASE_DUP(8, phase5d<true>(P, lds))
    PHASE(8, phase5d<false>(P, lds))
    PHASE_DUP(9, phase7(P, lds))
    PHASE(9, phase7(P, lds))
    PHASE_DUP(10, phase8(P))
#ifdef PROBE_BAR
    for (int i = 0; i < 16; ++i) xcd_barrier(bar);
#endif
    PHASE(10, phase8(P))
#undef PHASE
}

#ifndef MK_LAUNCHES
#define MK_LAUNCHES 1
#endif

extern "C" void kernel_launch(void* const* d_in, const int* in_sizes, int n_in, void* d_out, int out_size, void* d_ws, size_t ws_size,
                              hipStream_t stream) {
    static int grid = 0;
    if (grid == 0) {
        if (n_in != 31 || in_sizes[0] != NTOK * DM || out_size != NTOK * DM || ws_size < WS_END) {
            fprintf(stderr, "kernel_launch: unexpected shapes (n_in %d, in0 %d, out %d, ws %zu < %zu)\n", n_in, n_in > 0 ? in_sizes[0] : -1, out_size, ws_size, (size_t)WS_END);
            grid = -1; return;
        }
        int dev = 0, cus = 0, per_cu = 0;
        if (hipGetDevice(&dev) != hipSuccess || hipDeviceGetAttribute(&cus, hipDeviceAttributeMultiprocessorCount, dev) != hipSuccess) { grid = -1; return; }
        if (hipFuncSetAttribute((const void*)fwd_kernel, hipFuncAttributeMaxDynamicSharedMemorySize, LDS_BYTES) != hipSuccess) { grid = -1; return; }
        if (hipOccupancyMaxActiveBlocksPerMultiprocessor(&per_cu, (const void*)fwd_kernel, NTHR, LDS_BYTES) != hipSuccess || per_cu < 1) per_cu = 1;
        (void)hipGetLastError();
        grid = cus;
    }
    if (grid < 0) return;
    if (hipMemsetAsync((char*)d_ws + WS_CTL, 0, CTL_BYTES, stream) != hipSuccess) return;
    Params p{};
    const float** pp = (const float**)&p;
    for (int i = 0; i < 31; ++i) pp[i] = (const float*)d_in[i];
    p.out = (float*)d_out; p.ws = (char*)d_ws;
#if MK_LAUNCHES == 1
    p.ph_lo = 0; p.ph_hi = N_PHASES;
    hipLaunchKernelGGL(fwd_kernel, dim3(grid), dim3(NTHR), LDS_BYTES, stream, p);
#else
    for (int k = 0; k < N_PHASES; ++k) { p.ph_lo = k; p.ph_hi = k + 1; hipLaunchKernelGGL(fwd_kernel, dim3(grid), dim3(NTHR), LDS_BYTES, stream, p); }
#endif
}
```

```cpp
#include <hip/hip_runtime.h>
#include <stdint.h>
#include <stdio.h>

typedef unsigned short bf16_t;
typedef __attribute__((ext_vector_type(8))) short bf16x8;
typedef __attribute__((ext_vector_type(4))) short bf16x4;
typedef __attribute__((ext_vector_type(4))) float f32x4;

constexpr int NTOK = 32768, SEQ = 8192, DM = 1024, DIN = 5944;
constexpr int C_QNSA = 0, C_KVNSA = 512, C_GNSA = 1280, C_CQ = 1304, C_CKV = 2072, C_KROPE = 2328, C_QMEM = 2360, C_GMERGE = 2872;
constexpr float ALPHA = 1.189207115002721f;
constexpr float LOG2E = 1.4426950408889634f;
constexpr float NEGBIG = -1e30f;

constexpr size_t MBY = 1ull << 20;
constexpr size_t WS_CTL = 0;
constexpr size_t CTL_BYTES = 65536;
constexpr int CTL_Q = 4096;
constexpr int CTL_CNT = 8192;
constexpr size_t WS_COS = 1 * MBY, WS_SIN = WS_COS + 512 * 1024;
constexpr size_t WS_KC = 2 * MBY, WS_VTC = WS_KC + 512 * 1024;
constexpr size_t WS_KMEM = 3 * MBY, WS_VTMEM = 4 * MBY, WS_MEMB = 5 * MBY, WS_EID = 7 * MBY, WS_EW = 8 * MBY;
constexpr size_t WS_A = 16 * MBY;
constexpr size_t WS_PROJ = WS_A, WS_QM = WS_A + 372 * MBY, WS_KM = WS_A + 420 * MBY, WS_VTM = WS_A + 468 * MBY;
constexpr size_t WS_Y1 = WS_A, WS_Y = WS_A;
constexpr size_t WS_B = WS_A + 512 * MBY;
constexpr size_t WS_H0 = WS_B;
constexpr int NEA = 117;
constexpr size_t WS_EXPA = WS_B + 272 * MBY + MBY / 2, WS_EXPB = WS_B;
static_assert(WS_EXPA + (size_t)NEA * 1572864 <= WS_B + 448 * MBY && (size_t)(256 - NEA) * 1572864 <= 208 * MBY + MBY / 2, "expert weight pieces");
__device__ __forceinline__ const unsigned short* expw_ptr(const char* ws, int e) {
    return (const unsigned short*)(ws + (e < NEA ? WS_EXPA + (size_t)e * 1572864 : WS_EXPB + (size_t)(e - NEA) * 1572864));
}
constexpr size_t WS_ONSA = WS_B + 64 * MBY, WS_OMLA = WS_B + 96 * MBY, WS_OMEM = WS_B + 128 * MBY;
constexpr size_t WS_LOGITS = WS_A + 128 * MBY, WS_LIST = WS_B + 208 * MBY + MBY / 2;
constexpr size_t WS_MERGED = WS_B + 160 * MBY;
constexpr size_t WS_KCS = WS_B + 224 * MBY, WS_VCS = WS_KCS + 8 * MBY, WS_KSLC = WS_KCS + 16 * MBY, WS_KWIN = WS_KCS + 24 * MBY,
                 WS_VTSLC = WS_KCS + 32 * MBY, WS_VTWIN = WS_KCS + 40 * MBY;
constexpr size_t WS_SCR = WS_B + 416 * MBY;
constexpr size_t WS_SCR2 = WS_B + 240 * MBY + MBY / 2;
constexpr size_t WS_WB = WS_B + 448 * MBY;
constexpr size_t WB_WIN = WS_WB, WB_WUQ = WB_WIN + 12582912, WB_WUKV = WB_WUQ + 1179648, WB_WMEM = WB_WUKV + 524288, WB_WBR = WB_WMEM + 2097152,
                 WB_WOUT = WB_WBR + 3145728, WB_WRHI = WB_WOUT + 2097152, WB_WRLO = WB_WRHI + 524288, WB_WS1 = WB_WRLO + 524288, WB_WS3 = WB_WS1 + 524288,
                 WB_WS2 = WB_WS3 + 524288, WB_WCK1 = WB_WS2 + 524288, WB_WCV1 = WB_WCK1 + 1048576, WB_WCK2 = WB_WCV1 + 1048576, WB_WCV2 = WB_WCK2 + 65536,
                 WB_POSP = WB_WCV2 + 65536  , WB_END = WB_POSP + 32768;
static_assert(WB_END <= WS_WB + 32 * MBY, "bf16 weight region");
constexpr size_t WS_END = WS_B + 480 * MBY;
constexpr int H1LD = 2048;

struct Params {
    const float *x, *mem, *ln0_g, *ln0_b, *rel_bias, *w_in, *cmp_pos_k, *cmp_pos_v, *cmp_k_w1, *cmp_k_w2, *cmp_v_w1, *cmp_v_w2,
        *mla_q_norm, *mla_w_uq, *mla_kv_norm, *mla_w_ukv, *mem_w_kv, *w_branch, *w_out, *ln1_g, *ln1_b, *router_w, *router_b,
        *exp_w1, *exp_w3, *exp_w2, *sh_w1, *sh_w3, *sh_w2, *ln2_g, *ln2_b;
    float* out;
    char* ws;
    int ph_lo, ph_hi;
};

#define XB_TMO      128
#define XB_XCNT(j)  (256  + 64 * (j))
#define XB_XSUB(j)  (1280 + 64 * (j))
#define XB_XGEN(j)  (2304 + 64 * (j))
#define XB_TOP      3328
#define XB_TOPGEN   3392
#define XCD_BAR_WORDS 3456
#define XB_SPIN_CAP (1u << 18)
#define LAS __attribute__((address_space(3)))

__device__ __forceinline__ unsigned xb_ld(unsigned* p)              { return __hip_atomic_load(p, __ATOMIC_RELAXED, __HIP_MEMORY_SCOPE_AGENT); }
__device__ __forceinline__ unsigned xb_add(unsigned* p, unsigned v) { return __hip_atomic_fetch_add(p, v, __ATOMIC_RELAXED, __HIP_MEMORY_SCOPE_AGENT); }
__device__ __forceinline__ unsigned xb_xcc_id() { return (unsigned)__builtin_amdgcn_s_getreg((3 << 11) | 20) & 0xFu; }
#define XB_SPIN(cond, bar) do { unsigned _sp = 0; while (cond) { __builtin_amdgcn_s_sleep(1); \
    if ((++_sp & 255u) == 0u) { if (xb_ld(&(bar)[XB_TMO])) break; if (_sp > XB_SPIN_CAP) { atomicAdd(&(bar)[XB_TMO], 1u); break; } } } } while (0)

struct XcdBarrier { unsigned* bar; unsigned x; volatile LAS unsigned* st; };

__device__ __forceinline__ XcdBarrier xcd_barrier_post(unsigned* bar, volatile LAS unsigned* st) {
    XcdBarrier b; b.bar = bar; b.x = xb_xcc_id(); b.st = st;
    if (threadIdx.x == 0) (void)xb_add(&bar[XB_XCNT(b.x)], 1u);
    return b;
}
__device__ __forceinline__ void xcd_barrier_complete(unsigned* bar, unsigned x, unsigned& nloc, unsigned& nx) {
    const unsigned G = gridDim.x * gridDim.y * gridDim.z;
    unsigned sum, cnt, mine, sp = 0u;
    for (;;) {
        sum = 0u; cnt = 0u; mine = 0u;
#pragma unroll
        for (unsigned j = 0; j < 16; ++j) { const unsigned c = xb_ld(&bar[XB_XCNT(j)]); sum += c; cnt += (c > 0u) ? 1u : 0u; mine = (j == x) ? c : mine; }
        if (sum == G) break;
        __builtin_amdgcn_s_sleep(1);
        if ((++sp & 255u) == 0u) { if (xb_ld(&bar[XB_TMO])) break; if (sp > XB_SPIN_CAP) { atomicAdd(&bar[XB_TMO], 1u); break; } }
    }
    nloc = mine > 0u ? mine : 1u; nx = cnt > 0u ? cnt : 1u;
}
__device__ __forceinline__ void xcd_barrier(const XcdBarrier& b) {
    asm volatile("s_waitcnt vmcnt(0)" ::: "memory");
    __syncthreads();
    if (threadIdx.x == 0) {
        unsigned* bar = b.bar;
        __builtin_amdgcn_s_waitcnt(0);
        unsigned nloc = b.st[0], nx = b.st[1];
        if (nloc == 0u) { xcd_barrier_complete(bar, b.x, nloc, nx); b.st[0] = nloc; b.st[1] = nx; }
        const unsigned old = xb_add(&bar[XB_XSUB(b.x)], 1u);
        const unsigned gen = old / nloc;
        if (old + 1u == (gen + 1u) * nloc) {
            __builtin_amdgcn_fence(__ATOMIC_RELEASE, "agent");
            asm volatile("s_waitcnt vmcnt(0)" ::: "memory");
            const unsigned og = xb_add(&bar[XB_TOP], 1u);
            const unsigned tg = og / nx;
            if (og + 1u == (tg + 1u) * nx) xb_add(&bar[XB_TOPGEN], 1u);
            else XB_SPIN(xb_ld(&bar[XB_TOPGEN]) == tg, bar);
            __builtin_amdgcn_fence(__ATOMIC_ACQUIRE, "agent");
            xb_add(&bar[XB_XGEN(b.x)], 1u);
            asm volatile("s_waitcnt vmcnt(0)" ::: "memory");
        } else {
            XB_SPIN(xb_ld(&bar[XB_XGEN(b.x)]) == gen, bar);
            __builtin_amdgcn_fence(__ATOMIC_ACQUIRE, "agent");
            asm volatile("s_waitcnt vmcnt(0)" ::: "memory");
        }
    }
    __syncthreads();
}

__device__ __forceinline__ float bf2f(bf16_t v) { return __uint_as_float(((uint32_t)v) << 16); }
__device__ __forceinline__ float bflo(uint32_t v) { return __uint_as_float(v << 16); }
__device__ __forceinline__ float bfhi(uint32_t v) { return __uint_as_float(v & 0xffff0000u); }
__device__ __forceinline__ uint32_t pack2(float a, float b) {
    typedef __attribute__((ext_vector_type(2))) __bf16 bf2_t; typedef __attribute__((ext_vector_type(2))) float f2_t;
    f2_t v = {a, b}; bf2_t r = __builtin_convertvector(v, bf2_t); return __builtin_bit_cast(uint32_t, r);
}
__device__ __forceinline__ bf16_t f2bf(float a) { return (bf16_t)(pack2(a, 0.f) & 0xffffu); }
__device__ __forceinline__ uint2 pack4(f32x4 v) { return make_uint2(pack2(v[0], v[1]), pack2(v[2], v[3])); }
__device__ __forceinline__ float fexp2(float x) { return __builtin_amdgcn_exp2f(x); }
__device__ __forceinline__ float frcp(float x) { return __builtin_amdgcn_rcpf(x); }
__device__ __forceinline__ float sigmoidf_(float x) { return frcp(1.f + fexp2(-x * LOG2E)); }
__device__ __forceinline__ float siluf_(float x) { return x * frcp(1.f + fexp2(-x * LOG2E)); }
__device__ __forceinline__ float geluf_(float x) {
    const float u = 0.7978845608028654f * (x + 0.044715f * x * x * x);
    const float t = 1.f - 2.f * frcp(1.f + fexp2(2.f * u * LOG2E));
    return 0.5f * x * (1.f + t);
}
__device__ __forceinline__ float wave_sum(float v) {
    v += __uint_as_float(__builtin_amdgcn_update_dpp(0u, __float_as_uint(v), 0xB1, 0xF, 0xF, true));
    v += __uint_as_float(__builtin_amdgcn_update_dpp(0u, __float_as_uint(v), 0x4E, 0xF, 0xF, true));
    v += __uint_as_float(__builtin_amdgcn_update_dpp(0u, __float_as_uint(v), 0x141, 0xF, 0xF, true));
    v += __uint_as_float(__builtin_amdgcn_update_dpp(0u, __float_as_uint(v), 0x140, 0xF, 0xF, true));
    auto r = __builtin_amdgcn_permlane16_swap(__float_as_uint(v), __float_as_uint(v), false, false);
    v = __uint_as_float(r[0]) + __uint_as_float(r[1]);
    auto q = __builtin_amdgcn_permlane32_swap(__float_as_uint(v), __float_as_uint(v), false, false);
    return __uint_as_float(q[0]) + __uint_as_float(q[1]);
}
__device__ __forceinline__ float wave_max(float v) {
    v = fmaxf(v, __uint_as_float(__builtin_amdgcn_update_dpp(0u, __float_as_uint(v), 0xB1, 0xF, 0xF, true)));
    v = fmaxf(v, __uint_as_float(__builtin_amdgcn_update_dpp(0u, __float_as_uint(v), 0x4E, 0xF, 0xF, true)));
    v = fmaxf(v, __uint_as_float(__builtin_amdgcn_update_dpp(0u, __float_as_uint(v), 0x141, 0xF, 0xF, true)));
    v = fmaxf(v, __uint_as_float(__builtin_amdgcn_update_dpp(0u, __float_as_uint(v), 0x140, 0xF, 0xF, true)));
    auto r = __builtin_amdgcn_permlane16_swap(__float_as_uint(v), __float_as_uint(v), false, false);
    v = fmaxf(__uint_as_float(r[0]), __uint_as_float(r[1]));
    auto q = __builtin_amdgcn_permlane32_swap(__float_as_uint(v), __float_as_uint(v), false, false);
    return fmaxf(__uint_as_float(q[0]), __uint_as_float(q[1]));
}
__device__ __forceinline__ float quad_max(float x) {
    auto r = __builtin_amdgcn_permlane16_swap(__float_as_uint(x), __float_as_uint(x), false, false);
    x = fmaxf(__uint_as_float(r[0]), __uint_as_float(r[1]));
    auto q = __builtin_amdgcn_permlane32_swap(__float_as_uint(x), __float_as_uint(x), false, false);
    return fmaxf(__uint_as_float(q[0]), __uint_as_float(q[1]));
}
__device__ __forceinline__ float quad_min(float x) {
    auto r = __builtin_amdgcn_permlane16_swap(__float_as_uint(x), __float_as_uint(x), false, false);
    x = fminf(__uint_as_float(r[0]), __uint_as_float(r[1]));
    auto q = __builtin_amdgcn_permlane32_swap(__float_as_uint(x), __float_as_uint(x), false, false);
    return fminf(__uint_as_float(q[0]), __uint_as_float(q[1]));
}
__device__ __forceinline__ float quad_sum(float x) {
    auto r = __builtin_amdgcn_permlane16_swap(__float_as_uint(x), __float_as_uint(x), false, false);
    x = __uint_as_float(r[0]) + __uint_as_float(r[1]);
    auto q = __builtin_amdgcn_permlane32_swap(__float_as_uint(x), __float_as_uint(x), false, false);
    return __uint_as_float(q[0]) + __uint_as_float(q[1]);
}
__device__ __forceinline__ float quad4_sum(float x) {
    x += __uint_as_float(__builtin_amdgcn_update_dpp(0u, __float_as_uint(x), 0xB1, 0xF, 0xF, true));
    x += __uint_as_float(__builtin_amdgcn_update_dpp(0u, __float_as_uint(x), 0x4E, 0xF, 0xF, true));
    return x;
}
__device__ __forceinline__ float max16(const f32x4 (&s)[4]) {
    const float a = fmaxf(fmaxf(s[0][0], s[0][1]), fmaxf(s[0][2], s[0][3])), b = fmaxf(fmaxf(s[1][0], s[1][1]), fmaxf(s[1][2], s[1][3]));
    const float c = fmaxf(fmaxf(s[2][0], s[2][1]), fmaxf(s[2][2], s[2][3])), d = fmaxf(fmaxf(s[3][0], s[3][1]), fmaxf(s[3][2], s[3][3]));
    return fmaxf(fmaxf(a, b), fmaxf(c, d));
}
__device__ __forceinline__ float sum16(const f32x4 (&s)[4]) {
    const f32x4 v = (s[0] + s[1]) + (s[2] + s[3]);
    return (v[0] + v[1]) + (v[2] + v[3]);
}
__device__ __forceinline__ void lds_fadd(float* p, float v) {
    asm volatile("ds_add_f32 %0, %1" :: "v"((unsigned)(size_t)(LAS float*)p), "v"(v) : "memory");
}
__device__ __forceinline__ f32x4 mfma16(bf16x8 a, bf16x8 b, f32x4 c) { return __builtin_amdgcn_mfma_f32_16x16x32_bf16(a, b, c, 0, 0, 0); }

constexpr int NTHR = 512, NWV = 8;
constexpr int LDS_BYTES = 163840;
constexpr int LDS_MISC = 147456;
constexpr int LDS_LUT = LDS_MISC;
constexpr int LDS_SEL = LDS_MISC + 8192;
constexpr int LDS_WOR = LDS_SEL + 1024;
constexpr int LDS_TL = LDS_WOR + 128;
constexpr int LDS_ITEM = LDS_TL + 256;
constexpr int LDS_ROWS = LDS_ITEM + 64;
constexpr int LDS_PRE = LDS_ROWS + 2048;
constexpr int LDS_KSC = LDS_PRE + 256;
constexpr int LDS_BARW = 163824;
static_assert(LDS_KSC + 1024 <= LDS_BARW, "LDS map");

__device__ __forceinline__ int queue_pop(unsigned* head, char* lds) {
    __syncthreads();
    if (threadIdx.x == 0) *(volatile int*)(lds + LDS_ITEM) = (int)atomicAdd(head, 1u);
    __syncthreads();
    return __builtin_amdgcn_readfirstlane(*(volatile int*)(lds + LDS_ITEM));
}

__device__ __forceinline__ int swz(int row, int chunk) { return (row << 7) + (((chunk ^ (row >> 1) ^ ((row >> 4) & 1)) & 7) << 4); }
constexpr int TILE_B = 16384;

struct GemmA { const char* base; unsigned off[4]; };

constexpr int STAGE_B = 49152, STAGE_BOFF = 32768;
__device__ __forceinline__ int gl_row(int i, int t) { return 8 * ((t >> 6) + 8 * i) + ((t & 63) >> 3); }
__device__ __forceinline__ int gl_chunk(int row, int t) { return ((t & 7) ^ (row >> 1) ^ ((row >> 4) & 1)) & 7; }
__device__ __forceinline__ int perm32_(int rho) { const int n = rho >> 4, i = rho & 15; return 8 * (i >> 2) + 4 * n + (i & 3); }
template <int NP, bool PERM = false>
__device__ __forceinline__ GemmA make_op(const bf16_t* base, long ld, int r0, int rmax) {
    GemmA a; const int t = threadIdx.x;
    a.base = (const char*)base;
#pragma unroll
    for (int i = 0; i < NP; ++i) { const int lr_ = gl_row(i, t); int r = r0 + (PERM ? ((lr_ & ~31) + perm32_(lr_ & 31)) : lr_); r = r < rmax ? r : rmax - 1; a.off[i] = (unsigned)(((size_t)r * ld + gl_chunk(lr_, t) * 8) * 2); }
    return a;
}
__device__ __forceinline__ void gemm_mainloop_g(char* lds, const GemmA& A, const GemmA& B, int nk, f32x4 (&acc)[4][4]) {
    int t = threadIdx.x; asm volatile("" : "+v"(t));
    const int lane = t & 63, w = t >> 6, wm = w >> 1, wn = w & 1;
    const int lr = lane & 15, lq = lane >> 4;
    const int wu = __builtin_amdgcn_readfirstlane(w);
    const int xr = (lr >> 1) & 7;
    unsigned ardA[2][2], ardB[2][2];
#pragma unroll
    for (int kk = 0; kk < 2; ++kk)
#pragma unroll
        for (int par = 0; par < 2; ++par) {
            const int ch = ((kk * 4 + lq) ^ xr ^ par) & 7;
            ardA[kk][par] = (unsigned)((wm * 64 + par * 16 + lr) * 128 + ch * 16);
            ardB[kk][par] = (unsigned)(STAGE_BOFF + (wn * 64 + par * 16 + lr) * 128 + ch * 16);
        }
    const char* abase = A.base; const char* bbase = B.base;
    LAS char* ldsl = (LAS char*)lds;
#define GI_(so_) { \
        _Pragma("unroll") for (int i = 0; i < 4; ++i) \
            __builtin_amdgcn_global_load_lds((const unsigned*)(abase + A.off[i]), (LAS unsigned*)(ldsl + (so_) + (wu + 8 * i) * 1024), 16, 0, 0); \
        _Pragma("unroll") for (int i = 0; i < 2; ++i) \
            __builtin_amdgcn_global_load_lds((const unsigned*)(bbase + B.off[i]), (LAS unsigned*)(ldsl + (so_) + STAGE_BOFF + (wu + 8 * i) * 1024), 16, 0, 0); \
        abase += 128; bbase += 128; }
    __syncthreads();
    GI_(0);
    if (nk > 1) GI_(STAGE_B);
    int cso = 0, lso = 2 * STAGE_B;
#pragma unroll 1
    for (int kt = 0; kt < nk; ++kt) {
        if (kt + 1 < nk) asm volatile("s_waitcnt vmcnt(6)" ::: "memory");
        else asm volatile("s_waitcnt vmcnt(0)" ::: "memory");
        __builtin_amdgcn_s_barrier();
        if (kt + 2 < nk) GI_(lso);
#pragma unroll
        for (int kk = 0; kk < 2; ++kk) {
            bf16x8 af[4], bfr[4];
#pragma unroll
            for (int i = 0; i < 4; ++i) af[i] = *(const bf16x8*)(lds + cso + ardA[kk][i & 1] + (i >> 1) * 4096);
#pragma unroll
            for (int j = 0; j < 4; ++j) bfr[j] = *(const bf16x8*)(lds + cso + ardB[kk][j & 1] + (j >> 1) * 4096);
#pragma unroll
            for (int i = 0; i < 4; ++i)
#pragma unroll
                for (int j = 0; j < 4; ++j) acc[i][j] = mfma16(bfr[j], af[i], acc[i][j]);
        }
        cso = (cso == 2 * STAGE_B) ? 0 : cso + STAGE_B;
        lso = (lso == 2 * STAGE_B) ? 0 : lso + STAGE_B;
    }
    __syncthreads();
#undef GI_
}

template <bool SWAPW1 = false>
__device__ __forceinline__ void gemm_mainloop_c(char* lds, const GemmA& A, const GemmA& B, int nk, f32x4 (&acc)[4][4], int& ring, bool primed, bool chain, const GemmA& An, const GemmA& Bn) {
    int t = threadIdx.x; asm volatile("" : "+v"(t));
    const int lane = t & 63, w = t >> 6, wm = w >> 1, wn = w & 1;
    const int lr = lane & 15, lq = lane >> 4;
    const int wu = __builtin_amdgcn_readfirstlane(w);
    const int xr = (lr >> 1) & 7;
    unsigned ardA[2][2], ardB[2][2];
#pragma unroll
    for (int kk = 0; kk < 2; ++kk)
#pragma unroll
        for (int par = 0; par < 2; ++par) {
            const int ch = ((kk * 4 + lq) ^ xr ^ par) & 7;
            ardA[kk][par] = (unsigned)((wm * 64 + par * 16 + lr) * 128 + ch * 16);
            ardB[kk][par] = (unsigned)(STAGE_BOFF + (wn * 64 + par * 16 + lr) * 128 + ch * 16);
        }
    const char* abase = A.base; const char* bbase = B.base;
    const char* anb = An.base; const char* bnb = Bn.base;
    LAS char* ldsl = (LAS char*)lds;
#define GI_(so_) { \
        _Pragma("unroll") for (int i = 0; i < 4; ++i) \
            __builtin_amdgcn_global_load_lds((const unsigned*)(abase + A.off[i]), (LAS unsigned*)(ldsl + (so_) + (wu + 8 * i) * 1024), 16, 0, 0); \
        _Pragma("unroll") for (int i = 0; i < 2; ++i) \
            __builtin_amdgcn_global_load_lds((const unsigned*)(bbase + B.off[i]), (LAS unsigned*)(ldsl + (so_) + STAGE_BOFF + (wu + 8 * i) * 1024), 16, 0, 0); \
        abase += 128; bbase += 128; }
#define GIN_(so_) { \
        _Pragma("unroll") for (int i = 0; i < 4; ++i) \
            __builtin_amdgcn_global_load_lds((const unsigned*)(anb + An.off[i]), (LAS unsigned*)(ldsl + (so_) + (wu + 8 * i) * 1024), 16, 0, 0); \
        _Pragma("unroll") for (int i = 0; i < 2; ++i) \
            __builtin_amdgcn_global_load_lds((const unsigned*)(bnb + Bn.off[i]), (LAS unsigned*)(ldsl + (so_) + STAGE_BOFF + (wu + 8 * i) * 1024), 16, 0, 0); \
        anb += 128; bnb += 128; }
    int cso = ring, lso = (ring == 0) ? 2 * STAGE_B : ring - STAGE_B;
    if (!primed) {
        __syncthreads();
        GI_(cso);
        { const int s1 = (cso == 2 * STAGE_B) ? 0 : cso + STAGE_B; GI_(s1); }
    } else { abase += 256; bbase += 256; }
#pragma unroll 1
    for (int kt = 0; kt < nk; ++kt) {
        if (kt + 1 < nk || chain) asm volatile("s_waitcnt vmcnt(6)" ::: "memory");
        else asm volatile("s_waitcnt vmcnt(0)" ::: "memory");
        __builtin_amdgcn_s_barrier();
        if (kt + 2 < nk) GI_(lso) else if (chain) GIN_(lso)
#pragma unroll
        for (int kk = 0; kk < 2; ++kk) {
            bf16x8 af[4], bfr[4];
#pragma unroll
            for (int i = 0; i < 4; ++i) af[i] = *(const bf16x8*)(lds + cso + ardA[kk][i & 1] + (i >> 1) * 4096);
#pragma unroll
            for (int j = 0; j < 4; ++j) bfr[j] = *(const bf16x8*)(lds + cso + ardB[kk][j & 1] + (j >> 1) * 4096);
            if (SWAPW1 && wn == 1) {
#pragma unroll
                for (int i = 0; i < 4; ++i)
#pragma unroll
                    for (int j = 0; j < 4; ++j) acc[i][j] = mfma16(af[i], bfr[j], acc[i][j]);
            } else {
#pragma unroll
                for (int i = 0; i < 4; ++i)
#pragma unroll
                    for (int j = 0; j < 4; ++j) acc[i][j] = mfma16(bfr[j], af[i], acc[i][j]);
            }
        }
        cso = (cso == 2 * STAGE_B) ? 0 : cso + STAGE_B;
        lso = (lso == 2 * STAGE_B) ? 0 : lso + STAGE_B;
    }
    ring = cso;
    if (!chain) __syncthreads();
#undef GI_
#undef GIN_
}

template <bool LO>
__device__ __forceinline__ void conv_wT(const float* src, int K, int N, bf16_t* dst, int ldd, const float* gain) {
    const int t = threadIdx.x & 255, kg = t >> 5, n4 = t & 31;
    const int ntn = (N + 127) >> 7, ntiles = (K >> 6) * ntn;
    for (int tile = blockIdx.x * 2 + (threadIdx.x >> 8); tile < ntiles; tile += gridDim.x * 2) {
        const int k0 = (tile / ntn) * 64 + kg * 8, n = (tile % ntn) * 128 + n4 * 4;
        if (n < N) {
            float4 r[8];
#pragma unroll
            for (int kk = 0; kk < 8; ++kk) r[kk] = *(const float4*)(src + (size_t)(k0 + kk) * N + n);
            if (gain) {
#pragma unroll
                for (int kk = 0; kk < 8; ++kk) { const float g = gain[k0 + kk]; r[kk].x *= g; r[kk].y *= g; r[kk].z *= g; r[kk].w *= g; }
            }
#pragma unroll
            for (int c = 0; c < 4; ++c) {
                float v[8];
#pragma unroll
                for (int kk = 0; kk < 8; ++kk) { float f = (c == 0) ? r[kk].x : (c == 1) ? r[kk].y : (c == 2) ? r[kk].z : r[kk].w; if (LO) f = f - bf2f(f2bf(f)); v[kk] = f; }
                *(uint4*)(dst + (size_t)(n + c) * ldd + k0) = make_uint4(pack2(v[0], v[1]), pack2(v[2], v[3]), pack2(v[4], v[5]), pack2(v[6], v[7]));
            }
        }
    }
}

__device__ __forceinline__ void zero_acc(f32x4 (&acc)[4][4]) {
#pragma unroll
    for (int i = 0; i < 4; ++i)
#pragma unroll
        for (int j = 0; j < 4; ++j) acc[i][j] = (f32x4){0.f, 0.f, 0.f, 0.f};
}

namespace pg8 {
constexpr int BM = 256, BK = 64, HALF = 128, HTB = HALF * BK * 2, STAGE_BYTES = 8 * HTB;
__device__ __forceinline__ int lds_byte(int r, int c) { const int st = (r >> 4) * 2 + (c >> 5), rr = r & 15, cc = c & 31, ob = rr * 64 + cc * 2; return st * 1024 + (ob ^ (((ob >> 9) & 1) << 5)); }
__device__ __forceinline__ void stage_rc(int b, int& R, int& C) { const int st = b / 1024, sb = b % 1024, swz_ = sb ^ (((sb >> 9) & 1) << 5); R = (st >> 1) * 16 + swz_ / 64; C = (st & 1) * 32 + (swz_ % 64) / 2; }
__device__ __forceinline__ int perm32(int rho) { const int n = rho >> 4, i = rho & 15; return 8 * (i >> 2) + 4 * n + (i & 3); }
struct Unit { int pm, pn; };
struct Ops { const char* A; const char* B; };
template <class Prov, class Epi>
__device__ __forceinline__ void gemm_phase(LAS unsigned char* lds, const int K, Prov& PV, const Epi& E) {
    int tid = threadIdx.x; asm volatile("" : "+v"(tid));
    const int wid = __builtin_amdgcn_readfirstlane(tid >> 6), lane = tid & 63, wr = wid >> 2, wc = wid & 3, fr = lane & 15, fq = lane >> 4;
    int nt = K / BK; asm volatile("" : "+s"(nt));
    int sR[2], sC[2];
#pragma unroll
    for (int i = 0; i < 2; ++i) stage_rc(tid * 16 + i * 8192, sR[i], sC[i]);
    const size_t kstep = (size_t)(BK * 2);
    const unsigned ldsw = (unsigned)wid * 1024u;
    const int aoff = lds_byte(wr * 64 + fr, fq * 8), boff = lds_byte(wc * 32 + fr, fq * 8);
#define PG8_SA(b, h) (((b) * 2 + (h)) * HTB)
#define PG8_SB(b, h) ((4 + (b) * 2 + (h)) * HTB)
#define PG8_STAGE(bufoff, gbase, voff) do { _Pragma("unroll") for (int _i = 0; _i < 2; ++_i) \
        __builtin_amdgcn_global_load_lds((const unsigned*)((const char*)(gbase) + (voff)[_i]), (LAS unsigned*)(lds + (bufoff) + ldsw + _i * 8192), 16, 0, 0); } while (0)
#define PG8_LDA(dst, b, h) do { _Pragma("unroll") for (int m = 0; m < 4; ++m) _Pragma("unroll") for (int k = 0; k < 2; ++k) dst[m][k] = *(const LAS bf16x8*)(lds + PG8_SA(b, h) + aoff + m * 2048 + k * 1024); } while (0)
#define PG8_LDB(dst, b, h) do { _Pragma("unroll") for (int n = 0; n < 2; ++n) _Pragma("unroll") for (int k = 0; k < 2; ++k) dst[n][k] = *(const LAS bf16x8*)(lds + PG8_SB(b, h) + boff + n * 2048 + k * 1024); } while (0)
#define PG8_MMA(ai, bj, At, Bt) do { __builtin_amdgcn_s_setprio(1); _Pragma("unroll") for (int m = 0; m < 4; ++m) _Pragma("unroll") for (int n = 0; n < 2; ++n) _Pragma("unroll") for (int k = 0; k < 2; ++k) \
        acc[ai][bj][m][n] = __builtin_amdgcn_mfma_f32_16x16x32_bf16(Bt[n][k], At[m][k], acc[ai][bj][m][n], 0, 0, 0); __builtin_amdgcn_s_setprio(0); } while (0)
#define PG8_WAIT_V(n) asm volatile("s_waitcnt vmcnt(" #n ")" ::: "memory")
#define PG8_WAIT_L(n) asm volatile("s_waitcnt lgkmcnt(" #n ")" ::: "memory")
#define PG8_BAR __builtin_amdgcn_s_barrier()
#define PG8_SCHED __builtin_amdgcn_sched_barrier(0)
    Unit cur, nxt; Ops oc, on; int ui = 0;
    unsigned va[2][2], vb[2][2];
    PV.offsets(va, vb, sR, sC);
    if (!PV.get(0, cur, oc)) return;
    f32x4 acc[2][2][4][2];
#pragma unroll
    for (int a = 0; a < 2; ++a)
#pragma unroll
        for (int b = 0; b < 2; ++b)
#pragma unroll
            for (int m = 0; m < 4; ++m)
#pragma unroll
                for (int n = 0; n < 2; ++n) acc[a][b][m][n] = (f32x4){0.f, 0.f, 0.f, 0.f};
    bf16x8 At[4][2], B0[2][2], B1[2][2];
    PG8_STAGE(PG8_SB(0, 0), oc.B, vb[0]); PG8_STAGE(PG8_SA(0, 0), oc.A, va[0]); PG8_STAGE(PG8_SB(0, 1), oc.B, vb[1]); PG8_STAGE(PG8_SA(0, 1), oc.A, va[1]);
    if (wr == 1) PG8_BAR;
    PG8_WAIT_V(4); PG8_BAR;
    PG8_STAGE(PG8_SB(1, 0), oc.B + kstep, vb[0]); PG8_STAGE(PG8_SA(1, 0), oc.A + kstep, va[0]); PG8_STAGE(PG8_SB(1, 1), oc.B + kstep, vb[1]);
    PG8_WAIT_V(6); PG8_BAR;
    for (;;) {
        const bool has_next = PV.get(ui + 1, nxt, on);
        if (!has_next) on = oc;
#pragma unroll 1
        for (int t = 0; t < nt; t += 2) {
            const bool last = (t == nt - 2);
            const char* a1 = oc.A + (size_t)(t + 1) * kstep;
            const char* a2 = last ? on.A : oc.A + (size_t)(t + 2) * kstep; const char* b2 = last ? on.B : oc.B + (size_t)(t + 2) * kstep;
            const char* a3 = a2 + kstep; const char* b3 = b2 + kstep;
            PG8_LDB(B0, 0, 0); PG8_SCHED; PG8_LDA(At, 0, 0); PG8_STAGE(PG8_SA(1, 1), a1, va[1]);
            PG8_WAIT_L(8); PG8_BAR; PG8_WAIT_L(0); PG8_MMA(0, 0, At, B0); PG8_BAR; PG8_SCHED;
            PG8_LDB(B1, 0, 1); PG8_STAGE(PG8_SB(0, 0), b2, vb[0]);
            PG8_BAR; PG8_WAIT_L(0); PG8_MMA(0, 1, At, B1); PG8_BAR;
            PG8_LDA(At, 0, 1); PG8_STAGE(PG8_SA(0, 0), a2, va[0]);
            PG8_BAR; PG8_WAIT_L(0); PG8_MMA(1, 0, At, B0); PG8_BAR; PG8_SCHED;
            PG8_STAGE(PG8_SB(0, 1), b2, vb[1]);
            PG8_WAIT_V(6); PG8_BAR; PG8_MMA(1, 1, At, B1); PG8_BAR;
            PG8_LDB(B0, 1, 0); PG8_SCHED; PG8_LDA(At, 1, 0); PG8_STAGE(PG8_SA(0, 1), a2, va[1]);
            PG8_WAIT_L(8); PG8_BAR; PG8_WAIT_L(0); PG8_MMA(0, 0, At, B0); PG8_BAR; PG8_SCHED;
            PG8_LDB(B1, 1, 1); PG8_STAGE(PG8_SB(1, 0), b3, vb[0]);
            PG8_BAR; PG8_WAIT_L(0); PG8_MMA(0, 1, At, B1); PG8_BAR;
            PG8_LDA(At, 1, 1); PG8_STAGE(PG8_SA(1, 0), a3, va[0]);
            PG8_BAR; PG8_WAIT_L(0); PG8_MMA(1, 0, At, B0); PG8_BAR; PG8_SCHED;
            PG8_STAGE(PG8_SB(1, 1), b3, vb[1]);
            PG8_WAIT_V(6); PG8_BAR; PG8_MMA(1, 1, At, B1); PG8_BAR;
        }
        bool keep;
        { int tz = threadIdx.x; asm volatile("" : "+v"(tz));
          keep = E(acc, cur, ui, wr, wc, tz & 15, (tz >> 4) & 3); }
        if (!has_next) break;
        if (!keep)
#pragma unroll
        for (int a = 0; a < 2; ++a)
#pragma unroll
            for (int b = 0; b < 2; ++b)
#pragma unroll
                for (int m = 0; m < 4; ++m)
#pragma unroll
                    for (int n = 0; n < 2; ++n) acc[a][b][m][n] = (f32x4){0.f, 0.f, 0.f, 0.f};
        cur = nxt; oc = on; ++ui;
    }
    PG8_WAIT_V(0);
    if (wr == 0) PG8_BAR;
    PG8_BAR;
#undef PG8_SA
#undef PG8_SB
#undef PG8_STAGE
#undef PG8_LDA
#undef PG8_LDB
#undef PG8_MMA
#undef PG8_WAIT_V
#undef PG8_WAIT_L
#undef PG8_BAR
#undef PG8_SCHED
}
struct StaticOrder {
    int nM, nN, nwg, G, c;
    __device__ void init(int M, int N, int G_, int c_) { nM = M / BM; nN = N / BM; nwg = nM * nN; G = G_; c = c_; }
    __device__ bool next(int i, Unit& u) const {
        const long L = (long)i * G + c; if (L >= nwg) return false;
        int wgid = (int)L; { const int q = nwg / 8, r = nwg % 8, xcd = wgid % 8, off = wgid / 8; wgid = (xcd < r ? xcd * (q + 1) : r * (q + 1) + (xcd - r) * q) + off; }
        const int nig = 8 * nN, gid = wgid / nig, fm = gid * 8, gsz = (nM - fm) < 8 ? (nM - fm) : 8;
        u.pm = fm + ((wgid % nig) % gsz); u.pn = (wgid % nig) / gsz; return true;
    }
};
struct DenseProv {
    StaticOrder S; const bf16_t* A; const bf16_t* Bt; long lda, ldb; bool perm;
    __device__ __forceinline__ void offsets(unsigned (&va)[2][2], unsigned (&vb)[2][2], const int (&sR)[2], const int (&sC)[2]) const {
#pragma unroll
        for (int h = 0; h < 2; ++h)
#pragma unroll
            for (int p = 0; p < 2; ++p) { const int rb = perm ? ((sR[p] & ~31) + perm32(sR[p] & 31)) : sR[p];
                va[h][p] = (unsigned)(((size_t)(h * HALF + sR[p]) * lda + sC[p]) * 2); vb[h][p] = (unsigned)(((size_t)(h * HALF + rb) * ldb + sC[p]) * 2); }
    }
    __device__ __forceinline__ bool get(int i, Unit& u, Ops& o) const {
        if (!S.next(i, u)) return false;
        o.A = (const char*)(A + (size_t)u.pm * BM * lda); o.B = (const char*)(Bt + (size_t)u.pn * BM * ldb);
        return true;
    }
};
}

__device__ __forceinline__ void phase0(const Params& P) {
    const int t = threadIdx.x, lane = t & 63, w = t >> 6;
    const int gw = blockIdx.x * NWV + w, nw = gridDim.x * NWV;
    bf16_t* H0 = (bf16_t*)(P.ws + WS_H0);
    for (int row0 = gw; row0 < NTOK; row0 += 2 * nw) {
        const int row1 = row0 + nw; const bool has1 = row1 < NTOK;
        const float* xr[2] = {P.x + (size_t)row0 * DM, P.x + (size_t)(has1 ? row1 : row0) * DM};
        float4 v[2][4];
#pragma unroll
        for (int u = 0; u < 2; ++u)
#pragma unroll
            for (int i = 0; i < 2; ++i) { v[u][2 * i] = *(const float4*)(xr[u] + i * 512 + 8 * lane); v[u][2 * i + 1] = *(const float4*)(xr[u] + i * 512 + 8 * lane + 4); }
        float s_[2] = {0.f, 0.f};
#pragma unroll
        for (int u = 0; u < 2; ++u)
#pragma unroll
            for (int i = 0; i < 4; ++i) s_[u] += v[u][i].x + v[u][i].y + v[u][i].z + v[u][i].w;
        const float mu[2] = {wave_sum(s_[0]) * (1.f / DM), wave_sum(s_[1]) * (1.f / DM)};
        float q_[2] = {0.f, 0.f};
#pragma unroll
        for (int u = 0; u < 2; ++u)
#pragma unroll
            for (int i = 0; i < 4; ++i) { float a = v[u][i].x - mu[u], b = v[u][i].y - mu[u], c = v[u][i].z - mu[u], d = v[u][i].w - mu[u]; q_[u] += a * a + b * b + c * c + d * d; }
        const float rstd[2] = {rsqrtf(wave_sum(q_[0]) * (1.f / DM) + 1e-5f), rsqrtf(wave_sum(q_[1]) * (1.f / DM) + 1e-5f)};
#pragma unroll
        for (int i = 0; i < 2; ++i) {
            const float4 g0 = *(const float4*)(P.ln0_g + i * 512 + 8 * lane), g1 = *(const float4*)(P.ln0_g + i * 512 + 8 * lane + 4);
            const float4 b0 = *(const float4*)(P.ln0_b + i * 512 + 8 * lane), b1 = *(const float4*)(P.ln0_b + i * 512 + 8 * lane + 4);
#pragma unroll
            for (int u = 0; u < 2; ++u) {
                const float4 a = v[u][2 * i], c = v[u][2 * i + 1];
                const uint4 o = make_uint4(pack2((a.x - mu[u]) * rstd[u] * g0.x + b0.x, (a.y - mu[u]) * rstd[u] * g0.y + b0.y), pack2((a.z - mu[u]) * rstd[u] * g0.z + b0.z, (a.w - mu[u]) * rstd[u] * g0.w + b0.w),
                                           pack2((c.x - mu[u]) * rstd[u] * g1.x + b1.x, (c.y - mu[u]) * rstd[u] * g1.y + b1.y), pack2((c.z - mu[u]) * rstd[u] * g1.z + b1.z, (c.w - mu[u]) * rstd[u] * g1.w + b1.w));
                if (u == 0 || has1) *(uint4*)(H0 + (size_t)(u ? row1 : row0) * DM + i * 512 + 8 * lane) = o;
            }
        }
    }
    const int gt = blockIdx.x * NTHR + t, nt = gridDim.x * NTHR;
    bf16_t* MEMB = (bf16_t*)(P.ws + WS_MEMB);
    for (int i = gt; i < 4 * 256 * DM / 4; i += nt) {
        const float4 v = ((const float4*)P.mem)[i];
        *(uint2*)(MEMB + (size_t)i * 4) = make_uint2(pack2(v.x, v.y), pack2(v.z, v.w));
    }
    float* COS = (float*)(P.ws + WS_COS); float* SIN = (float*)(P.ws + WS_SIN);
    for (int i = gt; i < SEQ * 16; i += nt) {
        const int pos = i >> 4, j = i & 15;
        const float freq = exp2f(-(float)j * (13.287712379549449f / 16.f));
        const float ang = (float)pos * freq;
        float sn, cs; sincosf(ang, &sn, &cs);
        COS[i] = cs; SIN[i] = sn;
    }
    {
        char* wsb = P.ws;
        const int tt = t & 255, kg = tt >> 5, n4 = tt & 31;
        constexpr int NJ = 17;
        const int jK[NJ]  = {1024, 768, 256, 1024, 512, 512, 512, 1024, 1024, 1024, 1024, 1024, 256, 2048, 2048, 256, 256};
        const int jN[NJ]  = {DIN, 768, 1024, 1024, 1024, 1024, 1024, 1024, 256, 256, 256, 256, 1024, 256, 256, 64, 64};
        int first[NJ + 1]; first[0] = 0;
#pragma unroll
        for (int j = 0; j < NJ; ++j) first[j + 1] = first[j] + (jK[j] >> 6) * ((jN[j] + 127) >> 7);
        for (int g = blockIdx.x * 2 + (t >> 8); g < first[NJ]; g += gridDim.x * 2) {
            int j = 0;
#pragma unroll
            for (int q = 1; q < NJ; ++q) j += (g >= first[q]) ? 1 : 0;
            const float* src; bf16_t* dst; const float* gain = nullptr; bool lo = false; int K, N, ldd, f0;
            switch (j) {
                case 0: src = P.w_in; dst = (bf16_t*)(wsb + WB_WIN); break;
                case 1: src = P.mla_w_uq; dst = (bf16_t*)(wsb + WB_WUQ); gain = P.mla_q_norm; break;
                case 2: src = P.mla_w_ukv; dst = (bf16_t*)(wsb + WB_WUKV); gain = P.mla_kv_norm; break;
                case 3: src = P.mem_w_kv; dst = (bf16_t*)(wsb + WB_WMEM); break;
                case 4: src = P.w_branch; dst = (bf16_t*)(wsb + WB_WBR); break;
                case 5: src = P.w_branch + 512 * 1024; dst = (bf16_t*)(wsb + WB_WBR) + 1024 * 512; break;
                case 6: src = P.w_branch + 2 * 512 * 1024; dst = (bf16_t*)(wsb + WB_WBR) + 2 * 1024 * 512; break;
                case 7: src = P.w_out; dst = (bf16_t*)(wsb + WB_WOUT); break;
                case 8: src = P.router_w; dst = (bf16_t*)(wsb + WB_WRHI); break;
                case 9: src = P.router_w; dst = (bf16_t*)(wsb + WB_WRLO); lo = true; break;
                case 10: src = P.sh_w1; dst = (bf16_t*)(wsb + WB_WS1); break;
                case 11: src = P.sh_w3; dst = (bf16_t*)(wsb + WB_WS3); break;
                case 12: src = P.sh_w2; dst = (bf16_t*)(wsb + WB_WS2); break;
                case 13: src = P.cmp_k_w1; dst = (bf16_t*)(wsb + WB_WCK1); break;
                case 14: src = P.cmp_v_w1; dst = (bf16_t*)(wsb + WB_WCV1); break;
                case 15: src = P.cmp_k_w2; dst = (bf16_t*)(wsb + WB_WCK2); break;
                default: src = P.cmp_v_w2; dst = (bf16_t*)(wsb + WB_WCV2); break;
            }
            K = jK[0]; N = jN[0]; f0 = first[0];
#pragma unroll
            for (int q = 1; q < NJ; ++q) if (j == q) { K = jK[q]; N = jN[q]; f0 = first[q]; }
            ldd = K;
            const int ntn = (N + 127) >> 7, tile = g - f0;
            const int k0 = (tile / ntn) * 64 + kg * 8, n = (tile % ntn) * 128 + n4 * 4;
            if (n < N) {
                float4 r[8];
#pragma unroll
                for (int kk = 0; kk < 8; ++kk) r[kk] = *(const float4*)(src + (size_t)(k0 + kk) * N + n);
                if (gain) {
#pragma unroll
                    for (int kk = 0; kk < 8; ++kk) { const float gg = gain[k0 + kk]; r[kk].x *= gg; r[kk].y *= gg; r[kk].z *= gg; r[kk].w *= gg; }
                }
#pragma unroll
                for (int c = 0; c < 4; ++c) {
                    float v[8];
#pragma unroll
                    for (int kk = 0; kk < 8; ++kk) { float f = (c == 0) ? r[kk].x : (c == 1) ? r[kk].y : (c == 2) ? r[kk].z : r[kk].w; if (lo) f = f - bf2f(f2bf(f)); v[kk] = f; }
                    *(uint4*)(dst + (size_t)(n + c) * ldd + k0) = make_uint4(pack2(v[0], v[1]), pack2(v[2], v[3]), pack2(v[4], v[5]), pack2(v[6], v[7]));
                }
            }
        }
        float* POSP = (float*)(wsb + WB_POSP);
        for (int i = gt; i < 2 * 16 * 256 * 16; i += nt) {
            const int o = i >> 4, part = i & 15, kv = o >> 12, kc = (o >> 8) & 15, c = o & 255;
            const float* pos = kv ? P.cmp_pos_v : P.cmp_pos_k; const float* w1 = kv ? P.cmp_v_w1 : P.cmp_k_w1;
            float a = 0.f;
#pragma unroll
            for (int k8 = 0; k8 < 8; ++k8) { const int k = kc * 128 + part * 8 + k8; a += pos[k] * w1[(size_t)k * 256 + c]; }
            a += __uint_as_float(__builtin_amdgcn_update_dpp(0u, __float_as_uint(a), 0xB1, 0xF, 0xF, true));
            a += __uint_as_float(__builtin_amdgcn_update_dpp(0u, __float_as_uint(a), 0x4E, 0xF, 0xF, true));
            a += __uint_as_float(__builtin_amdgcn_update_dpp(0u, __float_as_uint(a), 0x141, 0xF, 0xF, true));
            a += __uint_as_float(__builtin_amdgcn_update_dpp(0u, __float_as_uint(a), 0x140, 0xF, 0xF, true));
            if (part == 0) POSP[o] = a;
        }
    }
    bf16_t* KC = (bf16_t*)(P.ws + WS_KC); bf16_t* VTC = (bf16_t*)(P.ws + WS_VTC);
    for (int i = gt; i < 8 * 64; i += nt) { const int bg = i >> 6, d = i & 63; KC[((size_t)bg * 512 + 511) * 64 + d] = 0; VTC[((size_t)bg * 64 + d) * 512 + 511] = 0; }
}

__device__ __forceinline__ void proj_store8(const Params& P, int tok, int n0, f32x4 v0, f32x4 v1) {
    if (n0 >= DIN) return;
    const int nt = n0 >> 7;
    if (nt >= 4 && nt < 10) {
        const int j = nt - 4, g = (n0 >> 6) & 1, d = n0 & 63, b = tok >> 13, sq = tok & 8191;
        bf16_t* dstk = (bf16_t*)(P.ws + (j == 0 ? WS_KCS : j == 1 ? WS_VCS : j == 2 ? WS_KSLC : j == 4 ? WS_KWIN : j == 3 ? WS_VTSLC : WS_VTWIN));
        if (j == 3 || j == 5) {
            int ln = threadIdx.x; asm volatile("" : "+v"(ln));
            const int f7 = ln & 7;
            unsigned w0 = pack2(v0[0], v0[1]), w1 = pack2(v0[2], v0[3]), w2 = pack2(v1[0], v1[1]), w3 = pack2(v1[2], v1[3]);
            {   const bool hb = (f7 & 4) != 0;
                const unsigned r0 = (unsigned)__builtin_amdgcn_ds_swizzle((int)(hb ? w0 : w2), 0x101F), r1 = (unsigned)__builtin_amdgcn_ds_swizzle((int)(hb ? w1 : w3), 0x101F);
                if (hb) { w0 = r0; w1 = r1; } else { w2 = r0; w3 = r1; } }
            {   const bool hb = (f7 & 2) != 0;
                const unsigned r0 = (unsigned)__builtin_amdgcn_ds_swizzle((int)(hb ? w0 : w1), 0x081F), r1 = (unsigned)__builtin_amdgcn_ds_swizzle((int)(hb ? w2 : w3), 0x081F);
                if (hb) { w0 = r0; w2 = r1; } else { w1 = r0; w3 = r1; } }
            {   const bool hb = (f7 & 1) != 0;
                const unsigned r0 = (unsigned)__builtin_amdgcn_ds_swizzle((int)w0, 0x041F), r1 = (unsigned)__builtin_amdgcn_ds_swizzle((int)w1, 0x041F);
                const unsigned r2 = (unsigned)__builtin_amdgcn_ds_swizzle((int)w2, 0x041F), r3 = (unsigned)__builtin_amdgcn_ds_swizzle((int)w3, 0x041F);
                w0 = hb ? ((r0 >> 16) | (w0 & 0xffff0000u)) : ((w0 & 0xffffu) | (r0 << 16));
                w1 = hb ? ((r1 >> 16) | (w1 & 0xffff0000u)) : ((w1 & 0xffffu) | (r1 << 16));
                w2 = hb ? ((r2 >> 16) | (w2 & 0xffff0000u)) : ((w2 & 0xffffu) | (r2 << 16));
                w3 = hb ? ((r3 >> 16) | (w3 & 0xffff0000u)) : ((w3 & 0xffffu) | (r3 << 16)); }
            const int sq8 = sq - (ln & 15) + (ln & 8);
            *(uint4*)(dstk + ((size_t)(b * 2 + g) * 64 + d + f7) * SEQ + sq8) = make_uint4(w0, w1, w2, w3);
        } else { const uint2 a = pack4(v0), c = pack4(v1); *(uint4*)(dstk + (((size_t)(b * 2 + g) * SEQ + sq) * 64 + d)) = make_uint4(a.x, a.y, c.x, c.y); }
    } else {
        float sc = 1.f;
        if (nt < 4) sc = 0.125f * LOG2E;
        else if (n0 >= C_QMEM && n0 < C_GMERGE) sc = 0.08838834764831845f * LOG2E;
        v0 *= sc; v1 *= sc;
        if (n0 >= C_GMERGE || (n0 >= C_GNSA && n0 < C_CQ)) {
#pragma unroll
            for (int r = 0; r < 4; ++r) { v0[r] = sigmoidf_(v0[r]); v1[r] = sigmoidf_(v1[r]); }
        }
        const uint2 a = pack4(v0), c = pack4(v1);
        *(uint4*)((bf16_t*)(P.ws + WS_PROJ) + (size_t)tok * DIN + n0) = make_uint4(a.x, a.y, c.x, c.y);
    }
}
template <bool LIGHT>
struct EpiProj {
    const Params* P;
    __device__ __forceinline__ bool operator()(f32x4 (&acc)[2][2][4][2], const pg8::Unit& u, int, int wr, int wc, int fr, int fq) const {
#pragma unroll
        for (int ai = 0; ai < 2; ++ai)
#pragma unroll
            for (int m = 0; m < 4; ++m) {
                const int tok = u.pm * 256 + ai * 128 + wr * 64 + m * 16 + fr;
#pragma unroll
                for (int bj = 0; bj < 2; ++bj) {
                    if (!LIGHT) proj_store8(*P, tok, u.pn * 256 + bj * 128 + wc * 32 + 8 * fq, acc[ai][bj][m][0], acc[ai][bj][m][1]);
                    else asm volatile("" :: "v"(acc[ai][bj][m][0][0]), "v"(acc[ai][bj][m][1][3]));
                }
            }
        return false;
    }
};
template <bool LIGHT>
__device__ __forceinline__ void phase1(const Params& P, char* lds) {
    {
        pg8::DenseProv PV; PV.S.init(NTOK, 6144, gridDim.x, blockIdx.x);
        PV.A = (const bf16_t*)(P.ws + WS_H0); PV.Bt = (const bf16_t*)(P.ws + WB_WIN); PV.lda = DM; PV.ldb = DM; PV.perm = true;
        EpiProj<LIGHT> E; E.P = &P;
        pg8::gemm_phase((LAS unsigned char*)lds, DM, PV, E);
    }
}

template <int NP>
__device__ __forceinline__ void store_row16(bf16_t* row, const uint2 (&pk)[2 * NP], int lq) {
#pragma unroll
    for (int p2 = 0; p2 < NP; ++p2) {
        auto sx = __builtin_amdgcn_permlane16_swap(pk[2 * p2].x, pk[2 * p2 + 1].x, false, false);
        auto sy = __builtin_amdgcn_permlane16_swap(pk[2 * p2].y, pk[2 * p2 + 1].y, false, false);
        *(uint4*)(row + 16 * (2 * p2 + (lq & 1)) + 8 * (lq >> 1)) = make_uint4(sx[0], sy[0], sx[1], sy[1]);
    }
}
template <int LEN>
__device__ __forceinline__ void rows_rstd(const bf16_t* base, long ld, int m0, float* dst) {
    const int t = threadIdx.x, row = t >> 1, part = t & 1;
    const uint4* p = (const uint4*)(base + (size_t)(m0 + row) * ld + part * (LEN / 2));
    float ss = 0.f;
#pragma unroll 1
    for (int i0 = 0; i0 < LEN / 16; i0 += 16) {
        uint4 v[16];
#pragma unroll
        for (int i = 0; i < 16; ++i) v[i] = p[i0 + i];
#pragma unroll
        for (int i = 0; i < 16; ++i) {
            float a;
            a = bflo(v[i].x); ss += a * a; a = bfhi(v[i].x); ss += a * a; a = bflo(v[i].y); ss += a * a; a = bfhi(v[i].y); ss += a * a;
            a = bflo(v[i].z); ss += a * a; a = bfhi(v[i].z); ss += a * a; a = bflo(v[i].w); ss += a * a; a = bfhi(v[i].w); ss += a * a;
        }
    }
    ss += __shfl_xor(ss, 1);
    if (part == 0) dst[row] = rsqrtf(ss * (1.f / LEN) + 1e-6f);
}

template <int QOFF>
__device__ __forceinline__ void phase2(const Params& P, char* lds) {
    unsigned* ctl = (unsigned*)(P.ws + WS_CTL);
    bf16_t* PROJ = (bf16_t*)(P.ws + WS_PROJ);
    float* rsc = (float*)(lds + LDS_ROWS + 1024);
    float* gsc = (float*)(lds + LDS_KSC);
    const float* COS = (const float*)(P.ws + WS_COS); const float* SIN = (const float*)(P.ws + WS_SIN);
#define P2_TID int t = threadIdx.x; asm volatile("" : "+v"(t)); const int lane = t & 63, w = t >> 6, wm = w >> 1, wn = w & 1, lr = lane & 15, lq = lane >> 4;
#ifndef P2SEL
#define P2SEL 7
#endif
    if (P2SEL & 1) for (;;) {
        const int it = queue_pop(&ctl[QOFF + CTL_Q + 0], lds);
        if (it >= 32) break;
        P2_TID
        {
            const int kv = it >> 4, mt = it & 15, m0 = mt * 256;
            const bf16_t* SRC = (const bf16_t*)(P.ws + (kv ? WS_VCS : WS_KCS));
            const bf16_t* w1t = (const bf16_t*)(P.ws + (kv ? WB_WCV1 : WB_WCK1)); const bf16_t* w2t = (const bf16_t*)(P.ws + (kv ? WB_WCV2 : WB_WCK2));
            {
                const float* pp = (const float*)(P.ws + WB_POSP) + kv * 4096 + (t & 255);
                float a = 0.f;
#pragma unroll
                for (int kc = 0; kc < 16; ++kc) a += pp[kc * 256];
                if (t < 256) gsc[t] = a;
            }
            __syncthreads();
            bf16_t* HID = (bf16_t*)(P.ws + WS_SCR + (size_t)blockIdx.x * 131072);
            GemmA A;
#pragma unroll
            for (int i = 0; i < 4; ++i) {
                const int lr_ = gl_row(i, t); int r = m0 + lr_; r = r < 4088 ? r : 4087;
                const int b = r / 1022, rem = r - b * 1022, n = rem >> 1, g = rem & 1;
                A.off[i] = (unsigned)((((size_t)(b * 2 + g) * SEQ + 16 * n) * 64 + gl_chunk(lr_, t) * 8) * 2);
            }
            A.base = (const char*)SRC;
            for (int nt = 0; nt < 2; ++nt) {
                f32x4 acc[4][4]; zero_acc(acc);
                GemmA B = make_op<2>(w1t, 2048, nt * 128, 256);
                gemm_mainloop_g(lds, A, B, 2048 / 64, acc);
#pragma unroll
                for (int i = 0; i < 4; ++i)
                    { uint2 pk[4];
#pragma unroll
                      for (int j = 0; j < 4; ++j) {
                        f32x4 v = acc[i][j];
                        const f32x4 pb = *(const f32x4*)(gsc + nt * 128 + wn * 64 + j * 16 + 4 * lq);
#pragma unroll
                        for (int r = 0; r < 4; ++r) v[r] = geluf_(v[r] + pb[r]);
                        pk[j] = pack4(v);
                      }
                      store_row16<2>(HID + (wm * 64 + i * 16 + lr) * 256 + nt * 128 + wn * 64, pk, lq); }
            }
            asm volatile("s_waitcnt vmcnt(0)" ::: "memory");
            __syncthreads();
            {
                f32x4 acc[4][4]; zero_acc(acc);
                GemmA A2 = make_op<4>(HID, 256, 0, 256);
                GemmA B2 = make_op<2>(w2t, 256, 0, 64);
                gemm_mainloop_g(lds, A2, B2, 256 / 64, acc);
                if (wn == 0) {
                    bf16_t* KC = (bf16_t*)(P.ws + WS_KC); bf16_t* VTC = (bf16_t*)(P.ws + WS_VTC);
#pragma unroll
                    for (int i = 0; i < 4; ++i) {
                        const int r = m0 + wm * 64 + i * 16 + lr;
                        if (r < 4088) {
                            const int b = r / 1022, rem = r - b * 1022, n = rem >> 1, g = rem & 1;
#pragma unroll
                            for (int j = 0; j < 4; ++j) {
                                const int d = j * 16 + 4 * lq;
                                if (!kv) *(uint2*)(KC + ((size_t)(b * 2 + g) * 512 + n) * 64 + d) = pack4(acc[i][j]);
                                else {
#pragma unroll
                                    for (int rr = 0; rr < 4; ++rr) VTC[((size_t)(b * 2 + g) * 64 + d + rr) * 512 + n] = f2bf(acc[i][j][rr]);
                                }
                            }
                        }
                    }
                }
            }
        }
    }
    if (P2SEL & 2) for (;;) {
        const int it = queue_pop(&ctl[QOFF + CTL_Q + 256], lds);
        if (it >= 256) break;
        P2_TID
        {
            const int mt = it >> 1, half = it & 1, m0 = mt * 256;
            rows_rstd<768>(PROJ + C_CQ, DIN, m0, rsc);
            __syncthreads();
            GemmA A = make_op<4>(PROJ + C_CQ, DIN, m0, NTOK);
            bf16_t* QM = (bf16_t*)(P.ws + WS_QM);
            int ring = 0;
#pragma unroll 1
            for (int k3 = 0; k3 < 3; ++k3) {
                const int n0 = (half * 3 + k3) * 128;
                f32x4 acc[4][4]; zero_acc(acc);
                GemmA B = make_op<2>((const bf16_t*)(P.ws + WB_WUQ), 768, n0, 768);
                GemmA Bn = make_op<2>((const bf16_t*)(P.ws + WB_WUQ), 768, n0 + (k3 < 2 ? 128 : 0), 768);
                gemm_mainloop_c(lds, A, B, 768 / 64, acc, ring, k3 > 0, k3 < 2, A, Bn);
                const int c16 = (n0 + wn * 64) >> 4;
                const bool rp0 = (c16 % 6) == 4, rp2 = ((c16 + 2) % 6) == 4;
                int lrz = lr; asm volatile("" : "+v"(lrz));
#pragma unroll
                for (int i = 0; i < 4; ++i) {
                    const int tl = wm * 64 + i * 16 + lrz, tok = m0 + tl, pos = tok & (SEQ - 1);
                    const float sc = rsc[tl] * (0.10206207261596575f * LOG2E);
                    const float4 cs = *(const float4*)(COS + pos * 16 + 4 * lq), sn = *(const float4*)(SIN + pos * 16 + 4 * lq);
                    const float csa[4] = {cs.x, cs.y, cs.z, cs.w}, sna[4] = {sn.x, sn.y, sn.z, sn.w};
#pragma unroll
                    for (int j = 0; j < 4; ++j) acc[i][j] *= sc;
#pragma unroll
                    for (int j = 0; j < 4; j += 2) {
                        if (j == 0 ? rp0 : rp2) {
#pragma unroll
                            for (int r = 0; r < 4; ++r) {
                                const float x1 = acc[i][j][r], x2 = acc[i][j + 1][r];
                                acc[i][j][r] = x1 * csa[r] - x2 * sna[r]; acc[i][j + 1][r] = x2 * csa[r] + x1 * sna[r];
                            }
                        }
                    }
                    { uint2 pk[4];
#pragma unroll
                      for (int j = 0; j < 4; ++j) pk[j] = pack4(acc[i][j]);
                      store_row16<2>(QM + (size_t)tok * 768 + n0 + wn * 64, pk, lq); }
                }
            }
        }
    }
    if (P2SEL & 4) for (;;) {
        const int it = queue_pop(&ctl[QOFF + CTL_Q + 320], lds);
        if (it >= 128) break;
        P2_TID
        {
            const int mt = it, m0 = mt * 256;
            rows_rstd<256>(PROJ + C_CKV, DIN, m0, rsc);
            __syncthreads();
            GemmA A = make_op<4>(PROJ + C_CKV, DIN, m0, NTOK);
            bf16_t* KM = (bf16_t*)(P.ws + WS_KM); bf16_t* VTM = (bf16_t*)(P.ws + WS_VTM);
            int ring = 0;
#pragma unroll 1
            for (int h = 0; h < 8; ++h) {
                f32x4 acc[4][4]; zero_acc(acc);
                GemmA B = make_op<2>((const bf16_t*)(P.ws + WB_WUKV), 256, h * 128, 1024);
                GemmA Bn = make_op<2>((const bf16_t*)(P.ws + WB_WUKV), 256, (h < 7 ? h + 1 : h) * 128, 1024);
                gemm_mainloop_c<true>(lds, A, B, 256 / 64, acc, ring, h > 0, h < 7, A, Bn);
                if (wn == 0) {
#pragma unroll
                    for (int i = 0; i < 4; ++i) {
                        const int tl = wm * 64 + i * 16 + lr, tok = m0 + tl, b = tok >> 13, s = tok & (SEQ - 1);
                        const float sc = rsc[tl];
                        uint2 pk[4];
#pragma unroll
                        for (int j = 0; j < 4; ++j) pk[j] = pack4(acc[i][j] * sc);
                        store_row16<2>(KM + ((size_t)(b * 8 + h) * SEQ + s) * 96, pk, lq);
                    }
                } else {
                    const int tok0 = m0 + wm * 64, b = tok0 >> 13, s0 = tok0 & (SEQ - 1);
                    f32x4 sc[4];
#pragma unroll
                    for (int i = 0; i < 4; ++i) sc[i] = *(const f32x4*)(rsc + wm * 64 + i * 16 + 4 * lq);
#pragma unroll
                    for (int j = 0; j < 4; ++j) {
                        uint2 pk[4];
#pragma unroll
                        for (int i = 0; i < 4; ++i) pk[i] = pack4(acc[i][j] * sc[i]);
                        store_row16<2>(VTM + ((size_t)(b * 8 + h) * 64 + j * 16 + lr) * SEQ + s0, pk, lq);
                    }
                }
            }
        }
    }
    for (;;) {
        const int tile = queue_pop(&ctl[QOFF + CTL_Q + 384], lds);
        if (tile >= 32) break;
        int t = threadIdx.x; asm volatile("" : "+v"(t)); const int lane = t & 63, w = t >> 6, wm = w >> 1, wn = w & 1, lr = lane & 15, lq = lane >> 4;
        f32x4 acc[4][4]; zero_acc(acc);
        {
            const int mt = tile >> 3, nt = tile & 7, m0 = mt * 256, n0 = nt * 128;
            GemmA A = make_op<4>((const bf16_t*)(P.ws + WS_MEMB), DM, m0, 1024);
            GemmA B = make_op<2>((const bf16_t*)(P.ws + WB_WMEM), 1024, n0, 1024);
            gemm_mainloop_g(lds, A, B, DM / 64, acc);
            bf16_t* KMEM = (bf16_t*)(P.ws + WS_KMEM); bf16_t* VTMEM = (bf16_t*)(P.ws + WS_VTMEM);
#pragma unroll
            for (int i = 0; i < 4; ++i) {
                const int row = m0 + wm * 64 + i * 16 + lr, b = row >> 8, m = row & 255;
#pragma unroll
                for (int jj = 0; jj < 4; ++jj) {
                    const int n = n0 + wn * 64 + jj * 16 + 4 * lq;
                    const int two = n >> 9, h = (n >> 7) & 3, d = n & 127;
                    if (two == 0) *(uint2*)(KMEM + (((size_t)(b * 4 + h) * 256 + m) * 128 + d)) = pack4(acc[i][jj]);
                    else {
#pragma unroll
                        for (int r = 0; r < 4; ++r) VTMEM[((size_t)(b * 4 + h) * 128 + d + r) * 256 + m] = f2bf(acc[i][jj][r]);
                    }
                }
            }
        }
    }
    {
        const int t = threadIdx.x;
        bf16_t* KM = (bf16_t*)(P.ws + WS_KM);
        const int gt = blockIdx.x * NTHR + t, nt = gridDim.x * NTHR;
        for (int i = gt; i < NTOK * 4; i += nt) {
            const int tok = i >> 2, c = i & 3, half = c >> 1, j0 = (c & 1) * 8, b = tok >> 13, s = tok & (SEQ - 1);
            const uint4 xa = *(const uint4*)(PROJ + (size_t)tok * DIN + C_KROPE + j0), xb = *(const uint4*)(PROJ + (size_t)tok * DIN + C_KROPE + 16 + j0);
            const float4 c0 = *(const float4*)(COS + s * 16 + j0), c1 = *(const float4*)(COS + s * 16 + j0 + 4);
            const float4 n0 = *(const float4*)(SIN + s * 16 + j0), n1 = *(const float4*)(SIN + s * 16 + j0 + 4);
            const float x1[8] = {bflo(xa.x), bfhi(xa.x), bflo(xa.y), bfhi(xa.y), bflo(xa.z), bfhi(xa.z), bflo(xa.w), bfhi(xa.w)};
            const float x2[8] = {bflo(xb.x), bfhi(xb.x), bflo(xb.y), bfhi(xb.y), bflo(xb.z), bfhi(xb.z), bflo(xb.w), bfhi(xb.w)};
            const float cs[8] = {c0.x, c0.y, c0.z, c0.w, c1.x, c1.y, c1.z, c1.w}, sn[8] = {n0.x, n0.y, n0.z, n0.w, n1.x, n1.y, n1.z, n1.w};
            float o[8];
#pragma unroll
            for (int k = 0; k < 8; ++k) o[k] = half ? (x2[k] * cs[k] + x1[k] * sn[k]) : (x1[k] * cs[k] - x2[k] * sn[k]);
            const uint4 ov = make_uint4(pack2(o[0], o[1]), pack2(o[2], o[3]), pack2(o[4], o[5]), pack2(o[6], o[7]));
#pragma unroll
            for (int h = 0; h < 8; ++h) *(uint4*)(KM + ((size_t)(b * 8 + h) * SEQ + s) * 96 + 64 + half * 16 + j0) = ov;
        }
    }
}

__device__ __forceinline__ int offk(int sub, int key, int c) { return sub * 4096 + key * 64 + (((c ^ (-(key >> 2))) & 3) << 4); }
__device__ __forceinline__ int offv(int dv, int ch) { return dv * 128 + (((ch ^ (dv >> 1)) & 7) << 4); }

template <int DK, int DV, bool NEEDV, class KP, class VP, class TL, class FN>
__device__ __forceinline__ void kv_loop(char* lds, int n, KP kp, VP vp, TL tl, FN fn) {
    if (n <= 0) return;
    int t = threadIdx.x; asm volatile("" : "+v"(t));
    const int lane = t & 63, wu = __builtin_amdgcn_readfirstlane(t >> 6);
    constexpr int KPN = DK / 8, VPN = DV / 8, KPT = (KPN + 7) / 8, VPT = (VPN + 7) / 8;
    constexpr int KB = DK * 128, VB = DV * 128;
    LAS char* ldsl = (LAS char*)lds;
#define KVI_(tile, buf) { \
        _Pragma("unroll") for (int i = 0; i < KPT; ++i) { const int p_ = wu + 8 * i, key_ = 16 * (p_ & 3) + (lane >> 2), c_ = ((lane & 3) ^ (-(key_ >> 2))) & 3; \
            if (p_ < KPN) __builtin_amdgcn_global_load_lds((const unsigned*)(kp(tile, key_) + (p_ >> 2) * 32 + c_ * 8), (LAS unsigned*)(ldsl + (buf) * KB + p_ * 1024), 16, 0, 0); } \
        if (NEEDV) { _Pragma("unroll") for (int i = 0; i < VPT; ++i) { const int p_ = wu + 8 * i, dv_ = 8 * p_ + (lane >> 3), ch_ = ((lane & 7) ^ (dv_ >> 1)) & 7; \
            if (p_ < VPN) __builtin_amdgcn_global_load_lds((const unsigned*)(vp(tile, dv_) + ch_ * 8), (LAS unsigned*)(ldsl + 2 * KB + (buf) * VB + p_ * 1024), 16, 0, 0); } } }
    __syncthreads();
    { const int t0 = tl(0); KVI_(t0, 0); }
    asm volatile("s_waitcnt vmcnt(0)" ::: "memory");
    __syncthreads();
#pragma unroll 1
    for (int i = 0; i < n; ++i) {
        const int cur = i & 1, tile = tl(i);
        if (i + 1 < n) { const int tn = tl(i + 1); if (cur) KVI_(tn, 0) else KVI_(tn, 1) }
        fn(tile, (const char*)(lds + cur * KB), (const char*)(lds + 2 * KB + cur * VB));
        asm volatile("s_waitcnt vmcnt(0)" ::: "memory");
        __syncthreads();
    }
#undef KVI_
}

template <int DK, int DV, class KP, class VP, class TL, class FN>
__device__ __forceinline__ void kv_loop2(char* lds, int n, KP kp, VP vp, TL tl, FN fn) {
    if (n <= 0) return;
    int t = threadIdx.x; asm volatile("" : "+v"(t));
    const int lane = t & 63, wu = __builtin_amdgcn_readfirstlane(t >> 6);
    constexpr int KPN = DK / 8, VPN = DV / 8, KPT = (KPN + 7) / 8, VPT = (VPN + 7) / 8;
    constexpr int KB = DK * 128, VB = DV * 128, TB = KB + VB, SB = 2 * TB;
    LAS char* ldsl = (LAS char*)lds;
#define KVI2_(tile, off_) { \
        _Pragma("unroll") for (int i = 0; i < KPT; ++i) { const int p_ = wu + 8 * i, key_ = 16 * (p_ & 3) + (lane >> 2), c_ = ((lane & 3) ^ (-(key_ >> 2))) & 3; \
            if (p_ < KPN) __builtin_amdgcn_global_load_lds((const unsigned*)(kp(tile, key_) + (p_ >> 2) * 32 + c_ * 8), (LAS unsigned*)(ldsl + (off_) + p_ * 1024), 16, 0, 0); } \
        _Pragma("unroll") for (int i = 0; i < VPT; ++i) { const int p_ = wu + 8 * i, dv_ = 8 * p_ + (lane >> 3), ch_ = ((lane & 7) ^ (dv_ >> 1)) & 7; \
            if (p_ < VPN) __builtin_amdgcn_global_load_lds((const unsigned*)(vp(tile, dv_) + ch_ * 8), (LAS unsigned*)(ldsl + (off_) + KB + p_ * 1024), 16, 0, 0); } }
    const int np = (n + 1) >> 1;
    __syncthreads();
    { const int ta = tl(0), tb = tl(n > 1 ? 1 : 0); KVI2_(ta, 0); KVI2_(tb, TB); }
    asm volatile("s_waitcnt vmcnt(0)" ::: "memory");
    __syncthreads();
#pragma unroll 1
    for (int i = 0; i < np; ++i) {
        const int cur = i & 1;
        if (i + 1 < np) { const int ia = 2 * i + 2, ib = (2 * i + 3 < n) ? 2 * i + 3 : ia; const int ta = tl(ia), tb = tl(ib);
            if (cur) { KVI2_(ta, 0); KVI2_(tb, TB); } else { KVI2_(ta, SB); KVI2_(tb, SB + TB); } }
        const char* base = lds + cur * SB;
        const bool hasB = 2 * i + 1 < n;
        fn(tl(2 * i), base, base + KB, tl(hasB ? 2 * i + 1 : 2 * i), base + TB, base + TB + KB, hasB);
        asm volatile("s_waitcnt vmcnt(0)" ::: "memory");
        __syncthreads();
    }
#undef KVI2_
}

template <int DK, int NST>
__device__ __forceinline__ void qk_tile(const char* Kb, const bf16x8 (&qf)[NST][DK / 32], f32x4 (&s)[NST][4], int lane) {
    const int lr = lane & 15, lq = lane >> 4;
#pragma unroll
    for (int kt = 0; kt < 4; ++kt) {
#pragma unroll
        for (int st = 0; st < NST; ++st) s[st][kt] = (f32x4){0.f, 0.f, 0.f, 0.f};
#pragma unroll
        for (int ks = 0; ks < DK / 32; ++ks) {
            const bf16x8 kf = *(const bf16x8*)(Kb + offk(ks, kt * 16 + lr, lq));
#pragma unroll
            for (int st = 0; st < NST; ++st) s[st][kt] = mfma16(kf, qf[st][ks], s[st][kt]);
        }
    }
}
template <int DV, int NST>
__device__ __forceinline__ void pv_tile(const char* Vb, const f32x4 (&p)[NST][4], f32x4 (&O)[NST][DV / 16], int lane) {
    const int lr = lane & 15, lq = lane >> 4;
#pragma unroll
    for (int h2 = 0; h2 < 2; ++h2) {
        bf16x8 pf[NST];
#pragma unroll
        for (int st = 0; st < NST; ++st) {
            const uint2 a = pack4(p[st][2 * h2]), b = pack4(p[st][2 * h2 + 1]);
            const uint4 u = make_uint4(a.x, a.y, b.x, b.y);
            pf[st] = __builtin_bit_cast(bf16x8, u);
        }
#pragma unroll
        for (int dvt = 0; dvt < DV / 16; ++dvt) {
            const int dv = dvt * 16 + lr;
            const bf16x4 v0 = *(const bf16x4*)(Vb + offv(dv, 4 * h2 + (lq >> 1)) + (lq & 1) * 8);
            const bf16x4 v1 = *(const bf16x4*)(Vb + offv(dv, 4 * h2 + 2 + (lq >> 1)) + (lq & 1) * 8);
            const bf16x8 vf = __builtin_shufflevector(v0, v1, 0, 1, 2, 3, 4, 5, 6, 7);
#pragma unroll
            for (int st = 0; st < NST; ++st) O[st][dvt] = mfma16(vf, pf[st], O[st][dvt]);
        }
    }
}
constexpr float RESCALE_AT = 1099511627776.f, RESCALE_BY = 1.f / 1099511627776.f;
template <int DV, int NST>
__device__ __forceinline__ void softmax_online(f32x4 (&s)[NST][4], float (&c)[NST], float (&l)[NST], f32x4 (&O)[NST][DV / 16]) {
    bool scaled = false, big = false;
#pragma unroll
    for (int st = 0; st < NST; ++st) scaled = scaled || (c[st] != 1.f);
#pragma unroll
    for (int st = 0; st < NST; ++st)
#pragma unroll
        for (int kt = 0; kt < 4; ++kt)
#pragma unroll
            for (int r = 0; r < 4; ++r) s[st][kt][r] = fexp2(s[st][kt][r]);
    if (__any(scaled)) {
#pragma unroll
        for (int st = 0; st < NST; ++st)
#pragma unroll
            for (int kt = 0; kt < 4; ++kt) s[st][kt] *= c[st];
    }
#pragma unroll
    for (int st = 0; st < NST; ++st) { l[st] += sum16(s[st]); big = big || (l[st] > RESCALE_AT); }
    if (__any(big)) {
#pragma unroll
        for (int st = 0; st < NST; ++st) {
            const float f = l[st] > RESCALE_AT ? RESCALE_BY : 1.f;
            const float g = quad_min(f);
            l[st] *= g; c[st] *= g;
#pragma unroll
            for (int kt = 0; kt < 4; ++kt) s[st][kt] *= g;
#pragma unroll
            for (int dvt = 0; dvt < DV / 16; ++dvt) O[st][dvt] *= g;
        }
    }
}
__device__ __forceinline__ float quad_lsum(float l) { return quad_sum(l); }

__device__ __forceinline__ void mla_item(const Params& P, char* lds, int b, int h, int qblk) {
    int t = threadIdx.x; asm volatile("" : "+v"(t));
    const int lane = t & 63, w = t >> 6, lr = lane & 15, lq = lane >> 4;
    const bf16_t* QM = (const bf16_t*)(P.ws + WS_QM);
    const bf16_t* KM = (const bf16_t*)(P.ws + WS_KM) + (size_t)(b * 8 + h) * SEQ * 96;
    const bf16_t* VTM = (const bf16_t*)(P.ws + WS_VTM) + (size_t)(b * 8 + h) * 64 * SEQ;
    const int wq0 = qblk * 256 + w * 32;
    bf16x8 qf[2][3];
#pragma unroll
    for (int st = 0; st < 2; ++st)
#pragma unroll
        for (int ks = 0; ks < 3; ++ks) qf[st][ks] = *(const bf16x8*)(QM + (size_t)(b * SEQ + wq0 + st * 16 + lr) * 768 + h * 96 + ks * 32 + lq * 8);
    float m[2] = {1.f, 1.f}, l[2] = {0.f, 0.f};
    f32x4 O[2][4];
#pragma unroll
    for (int st = 0; st < 2; ++st)
#pragma unroll
        for (int d = 0; d < 4; ++d) O[st][d] = (f32x4){0.f, 0.f, 0.f, 0.f};
    auto mla_tile = [&](int tile, const char* Kb, const char* Vb) __attribute__((always_inline)) {
        if (tile * 64 > wq0 + 31) return;
        f32x4 s[2][4];
        qk_tile<96, 2>(Kb, qf, s, lane);
        if (tile * 64 + 63 > wq0) {
#pragma unroll
            for (int st = 0; st < 2; ++st)
#pragma unroll
                for (int kt = 0; kt < 4; ++kt)
#pragma unroll
                    for (int r = 0; r < 4; ++r)
                        if (tile * 64 + kt * 16 + 4 * lq + r > wq0 + st * 16 + lr) s[st][kt][r] = NEGBIG;
        }
        softmax_online<64, 2>(s, m, l, O);
        pv_tile<64, 2>(Vb, s, O, lane);
    };
    kv_loop2<96, 64>(lds, 4 * qblk + 4,
        [&](int tile, int key) __attribute__((always_inline)) { return KM + (size_t)(tile * 64 + key) * 96; },
        [&](int tile, int dv) __attribute__((always_inline)) { return VTM + (size_t)dv * SEQ + tile * 64; },
        [&](int i) __attribute__((always_inline)) { return i; },
        [&](int ta, const char* Ka, const char* Va, int tb, const char* Kb, const char* Vb, bool hasB) __attribute__((always_inline)) {
            mla_tile(ta, Ka, Va);
            if (hasB) mla_tile(tb, Kb, Vb);
        });
    bf16_t* OM = (bf16_t*)(P.ws + WS_OMLA);
#pragma unroll
    for (int st = 0; st < 2; ++st) {
        const float inv = 1.f / quad_lsum(l[st]);
        const size_t tok = (size_t)b * SEQ + wq0 + st * 16 + lr;
        uint2 pk[4];
#pragma unroll
        for (int d = 0; d < 4; ++d) pk[d] = pack4(O[st][d] * inv);
        store_row16<2>(OM + tok * 512 + h * 64, pk, lq);
    }
}

__device__ __forceinline__ void mem_item(const Params& P, char* lds, int b, int h, int qblk) {
    int t = threadIdx.x; asm volatile("" : "+v"(t));
    const int lane = t & 63, w = t >> 6, lr = lane & 15, lq = lane >> 4;
    const bf16_t* PROJ = (const bf16_t*)(P.ws + WS_PROJ);
    const bf16_t* KMEM = (const bf16_t*)(P.ws + WS_KMEM) + (size_t)(b * 4 + h) * 256 * 128;
    const bf16_t* VTMEM = (const bf16_t*)(P.ws + WS_VTMEM) + (size_t)(b * 4 + h) * 128 * 256;
    const size_t tok = (size_t)b * SEQ + qblk * 128 + w * 16 + lr;
    bf16x8 qf[1][4];
#pragma unroll
    for (int ks = 0; ks < 4; ++ks) qf[0][ks] = *(const bf16x8*)(PROJ + tok * DIN + C_QMEM + h * 128 + ks * 32 + lq * 8);
    float m[1] = {1.f}, l[1] = {0.f};
    f32x4 O[1][8];
#pragma unroll
    for (int d = 0; d < 8; ++d) O[0][d] = (f32x4){0.f, 0.f, 0.f, 0.f};
    kv_loop<128, 128, true>(lds, 4,
        [&](int tile, int key) __attribute__((always_inline)) { return KMEM + (size_t)(tile * 64 + key) * 128; },
        [&](int tile, int dv) __attribute__((always_inline)) { return VTMEM + (size_t)dv * 256 + tile * 64; },
        [&](int i) __attribute__((always_inline)) { return i; },
        [&](int tile, const char* Kb, const char* Vb) __attribute__((always_inline)) {
            f32x4 s[1][4];
            qk_tile<128, 1>(Kb, qf, s, lane);
            softmax_online<128, 1>(s, m, l, O);
            pv_tile<128, 1>(Vb, s, O, lane);
        });
    bf16_t* OM = (bf16_t*)(P.ws + WS_OMEM);
    const float inv = 1.f / quad_lsum(l[0]);
    uint2 pk[8];
#pragma unroll
    for (int d = 0; d < 8; ++d) pk[d] = pack4(O[0][d] * inv);
    store_row16<4>(OM + tok * 512 + h * 128, pk, lq);
}

__device__ __forceinline__ void softmax_stats(const f32x4 (&s)[2][4], float (&c)[2], float (&l)[2]) {
#pragma unroll
    for (int st = 0; st < 2; ++st) {
        f32x4 e[4];
#pragma unroll
        for (int kt = 0; kt < 4; ++kt)
#pragma unroll
            for (int r = 0; r < 4; ++r) e[kt][r] = fexp2(s[st][kt][r]);
        l[st] += sum16(e) * c[st];
        const float g = quad_min(l[st] > RESCALE_AT ? RESCALE_BY : 1.f);
        l[st] *= g; c[st] *= g;
    }
}

template <int NMASK>
__device__ __forceinline__ void nsa_item(const Params& P, char* lds, int b, int g, int q0) {
    int t = threadIdx.x; asm volatile("" : "+v"(t));
    const int lane = t & 63, w = t >> 6, lr = lane & 15, lq = lane >> 4;
    const int hg = g * 4 + (lr & 3);
    const bf16_t* PROJ = (const bf16_t*)(P.ws + WS_PROJ);
    const size_t bg = (size_t)(b * 2 + g);
    const bf16_t* KC = (const bf16_t*)(P.ws + WS_KC) + bg * 512 * 64;
    const bf16_t* VTC = (const bf16_t*)(P.ws + WS_VTC) + bg * 64 * 512;
    const bf16_t* KSLC = (const bf16_t*)(P.ws + WS_KSLC) + bg * SEQ * 64;
    const bf16_t* VTSLC = (const bf16_t*)(P.ws + WS_VTSLC) + bg * 64 * SEQ;
    const bf16_t* KWIN = (const bf16_t*)(P.ws + WS_KWIN) + bg * SEQ * 64;
    const bf16_t* VTWIN = (const bf16_t*)(P.ws + WS_VTWIN) + bg * 64 * SEQ;
    float* imp = (float*)(lds + 65536);
    const float* LUT = (const float*)(lds + LDS_LUT) + 64 * 8;
    unsigned* SEL = (unsigned*)(lds + LDS_SEL);
    unsigned* WOR = (unsigned*)(lds + LDS_WOR);
    unsigned char* TL = (unsigned char*)(lds + LDS_TL);
    int* TLN = (int*)(lds + LDS_TL + 128);
    int tpos[2];
    tpos[0] = q0 + 8 * w + (lr >> 2); tpos[1] = tpos[0] + 4;
    bf16x8 qf[2][2];
#pragma unroll
    for (int st = 0; st < 2; ++st)
#pragma unroll
        for (int ks = 0; ks < 2; ++ks) qf[st][ks] = *(const bf16x8*)(PROJ + (size_t)(b * SEQ + tpos[st]) * DIN + C_QNSA + hg * 64 + ks * 32 + lq * 8);
    auto gate = [&](int st, int k) __attribute__((always_inline)) { return bf2f(PROJ[(size_t)(b * SEQ + tpos[st]) * DIN + C_GNSA + hg * 3 + k]); };
    f32x4 OT[2][4];
#pragma unroll
    for (int i = 0; i < 16; ++i) imp[(8 * w) * 128 + i * 64 + lane] = 0.f;

    const float bfar = LUT[128 * 8 + hg];
    const int ntc = (((q0 + 32) >> 4) >> 6) + 1;
    float m[2] = {1.f, 1.f}, l[2] = {0.f, 0.f};
    auto cmp_mask = [&](int tile, f32x4 (&s)[2][4]) __attribute__((always_inline)) {
#pragma unroll
        for (int st = 0; st < 2; ++st)
#pragma unroll
            for (int kt = 0; kt < 4; ++kt)
#pragma unroll
                for (int r = 0; r < 4; ++r) {
                    const int n = tile * 64 + kt * 16 + 4 * lq + r;
                    const int dist = tpos[st] - (16 * n + 31);
                    const int di = dist < -1 ? -1 : (dist < 128 ? dist : 128);
                    s[st][kt][r] += LUT[di * 8 + hg];
                }
    };
    kv_loop<64, 64, false>(lds, ntc,
        [&](int tile, int key) __attribute__((always_inline)) { return KC + (size_t)(tile * 64 + key) * 64; },
        [&](int tile, int dv) __attribute__((always_inline)) { return VTC; },
        [&](int i) __attribute__((always_inline)) { return i; },
        [&](int tile, const char* Kb, const char* Vb) __attribute__((always_inline)) {
            f32x4 s[2][4];
            const bool farc = q0 + 8 * w - (16 * (tile * 64 + 63) + 31) >= 128;
            qk_tile<64, 2>(Kb, qf, s, lane);
            if (farc) {
#pragma unroll
                for (int st = 0; st < 2; ++st)
#pragma unroll
                    for (int kt = 0; kt < 4; ++kt) s[st][kt] += bfar;
            } else cmp_mask(tile, s);
            softmax_stats(s, m, l);
        });
    float invl[2];
#pragma unroll
    for (int st = 0; st < 2; ++st) { const float lt = quad_lsum(l[st]); invl[st] = lt > 0.f ? m[st] / lt : 0.f; }
#pragma unroll
    for (int st = 0; st < 2; ++st)
#pragma unroll
        for (int d = 0; d < 4; ++d) OT[st][d] = (f32x4){0.f, 0.f, 0.f, 0.f};
    kv_loop<64, 64, true>(lds, ntc,
        [&](int tile, int key) __attribute__((always_inline)) { return KC + (size_t)(tile * 64 + key) * 64; },
        [&](int tile, int dv) __attribute__((always_inline)) { return VTC + (size_t)dv * 512 + tile * 64; },
        [&](int i) __attribute__((always_inline)) { return i; },
        [&](int tile, const char* Kb, const char* Vb) __attribute__((always_inline)) {
            f32x4 s[2][4];
            const bool farc = q0 + 8 * w - (16 * (tile * 64 + 63) + 31) >= 128;
            qk_tile<64, 2>(Kb, qf, s, lane);
            if (farc) {
#pragma unroll
                for (int st = 0; st < 2; ++st)
#pragma unroll
                    for (int kt = 0; kt < 4; ++kt) s[st][kt] += bfar;
            } else cmp_mask(tile, s);
#pragma unroll
            for (int st = 0; st < 2; ++st)
#pragma unroll
                for (int kt = 0; kt < 4; ++kt) {
#pragma unroll
                    for (int r = 0; r < 4; ++r) {
                        s[st][kt][r] = fexp2(s[st][kt][r]) * invl[st];
                    }
                    float ps = (s[st][kt][0] + s[st][kt][1]) + (s[st][kt][2] + s[st][kt][3]);
                    float pc = s[st][kt][3];
                    ps = quad4_sum(ps);
                    pc = quad4_sum(pc);
                    const int j = tile * 16 + kt * 4 + lq;
                    float* row = imp + (8 * w + 4 * st + (lr >> 2)) * 128;
                    if ((lr & 3) == 0) lds_fadd(&row[j], ps);
                    if ((lr & 3) == 0 && j + 1 < 128) lds_fadd(&row[j + 1], pc);
                }
            pv_tile<64, 2>(Vb, s, OT, lane);
        });
#pragma unroll
    for (int st = 0; st < 2; ++st) {
        const float g0 = gate(st, 0);
#pragma unroll
        for (int d = 0; d < 4; ++d) OT[st][d] *= g0;
    }

    {
        unsigned wo0 = 0, wo1 = 0, wo2 = 0, wo3 = 0;
        for (int qi = 0; qi < 8; ++qi) {
            const int tq = q0 + 8 * w + qi, cur = tq >> 6;
            const float v0 = imp[(8 * w + qi) * 128 + lane], v1 = imp[(8 * w + qi) * 128 + 64 + lane];
            const int j0 = lane, j1 = lane + 64;
            bool s0 = (j0 == 0) || (j0 == cur) || (j0 + 1 == cur);
            bool s1 = (j1 == cur) || (j1 + 1 == cur);
            const bool c0 = (j0 >= 1) && (j0 + 2 <= cur), c1 = (j1 + 2 <= cur);
            if (cur - 2 <= 13) { s0 = s0 || c0; s1 = s1 || c1; }
            else {
                const unsigned k0 = c0 ? __float_as_uint(v0) + 1u : 0u, k1 = c1 ? __float_as_uint(v1) + 1u : 0u;
                unsigned T = 0u;
                for (int bit = 30; bit >= 0; --bit) {
                    const unsigned cand = T | (1u << bit);
                    const int cnt = __popcll(__ballot(k0 >= cand)) + __popcll(__ballot(k1 >= cand));
                    if (cnt >= 13) { T = cand; if (cnt == 13) break; }
                }
                const unsigned long long gt0 = __ballot(k0 > T), gt1 = __ballot(k1 > T);
                unsigned long long eq0 = __ballot(k0 == T), eq1 = __ballot(k1 == T);
                int need = 13 - (__popcll(gt0) + __popcll(gt1));
                unsigned long long tk0 = 0ull, tk1 = 0ull;
                while (need > 0 && eq0) { const unsigned long long lowb = eq0 & (0ull - eq0); tk0 |= lowb; eq0 ^= lowb; --need; }
                while (need > 0 && eq1) { const unsigned long long lowb = eq1 & (0ull - eq1); tk1 |= lowb; eq1 ^= lowb; --need; }
                s0 = s0 || ((gt0 | tk0) >> lane) & 1ull;
                s1 = s1 || ((gt1 | tk1) >> lane) & 1ull;
            }
            const unsigned long long b0 = __ballot(s0), b1 = __ballot(s1);
            if (lane == 0) {
                SEL[(8 * w + qi) * 4 + 0] = (unsigned)b0; SEL[(8 * w + qi) * 4 + 1] = (unsigned)(b0 >> 32);
                SEL[(8 * w + qi) * 4 + 2] = (unsigned)b1; SEL[(8 * w + qi) * 4 + 3] = (unsigned)(b1 >> 32);
            }
            wo0 |= (unsigned)b0; wo1 |= (unsigned)(b0 >> 32); wo2 |= (unsigned)b1; wo3 |= (unsigned)(b1 >> 32);
        }
        if (lane == 0) { WOR[w * 4 + 0] = wo0; WOR[w * 4 + 1] = wo1; WOR[w * 4 + 2] = wo2; WOR[w * 4 + 3] = wo3; }
    }
    __syncthreads();
    if (w == 0) {
        unsigned o0 = 0u, o1 = 0u, o2 = 0u, o3 = 0u;
#pragma unroll
        for (int ww = 0; ww < NWV; ++ww) { o0 |= WOR[ww * 4 + 0]; o1 |= WOR[ww * 4 + 1]; o2 |= WOR[ww * 4 + 2]; o3 |= WOR[ww * 4 + 3]; }
        const bool n0 = ((lane < 32 ? o0 : o1) >> (lane & 31)) & 1u, n1 = ((lane < 32 ? o2 : o3) >> (lane & 31)) & 1u;
        const unsigned long long m0 = __ballot(n0), m1 = __ballot(n1);
        const unsigned long long below = (1ull << lane) - 1ull;
        const int c0 = __popcll(m0);
        if (n0) TL[__popcll(m0 & below)] = (unsigned char)lane;
        if (n1) TL[c0 + __popcll(m1 & below)] = (unsigned char)(64 + lane);
        if (lane == 0) *TLN = c0 + __popcll(m1);
    }
    __syncthreads();
    const int nts = *TLN;
    f32x4* ST = (f32x4*)(lds + 65536);
#pragma unroll
    for (int k = 0; k < 8; ++k) ST[k * NTHR + t] = OT[k >> 2][k & 3];

    if (NMASK & 2)
    {
        f32x4 Oa[1][4], Ob[1][4];
#pragma unroll
        for (int d = 0; d < 4; ++d) { Oa[0][d] = (f32x4){0.f, 0.f, 0.f, 0.f}; Ob[0][d] = (f32x4){0.f, 0.f, 0.f, 0.f}; }
        float ca[1] = {1.f}, cb[1] = {1.f}, la[1] = {0.f}, lb[1] = {0.f};
        bf16x8 qfa[1][2], qfb[1][2];
#pragma unroll
        for (int ks = 0; ks < 2; ++ks) { qfa[0][ks] = qf[0][ks]; qfb[0][ks] = qf[1][ks]; }
        auto proc = [&](int tile, const char* Kb, const char* Vb, const bf16x8 (&q1)[1][2], f32x4 (&O1)[1][4], float (&c1)[1], float (&l1)[1], bool on, int tp) __attribute__((always_inline)) {
            f32x4 s[1][4];
            qk_tile<64, 1>(Kb, q1, s, lane);
            const bool far = tile * 64 + 63 + 128 <= q0 + 8 * w;
            if (far) {
                const float ab = on ? bfar : NEGBIG;
#pragma unroll
                for (int kt = 0; kt < 4; ++kt) s[0][kt] += ab;
            } else {
                int D = tp - (tile * 64 + 4 * lq); D = D < 191 ? D : 191; D = on ? D : -1;
                const float* lp = LUT + (D - 63) * 8 + hg;
#pragma unroll
                for (int kt = 0; kt < 4; ++kt)
#pragma unroll
                    for (int r = 0; r < 4; ++r) s[0][kt][r] += lp[(63 - (kt * 16 + r)) * 8];
            }
            softmax_online<64, 1>(s, c1, l1, O1);
            pv_tile<64, 1>(Vb, s, O1, lane);
        };
        auto s_tile = [&](int tile, const char* Kb, const char* Vb) __attribute__((always_inline)) {
            const unsigned wv = WOR[w * 4 + (tile >> 5)];
            if (!((wv >> (tile & 31)) & 1u)) return;
            const bool on0 = (SEL[(8 * w + (lr >> 2)) * 4 + (tile >> 5)] >> (tile & 31)) & 1u;
            const bool on1 = (SEL[(8 * w + 4 + (lr >> 2)) * 4 + (tile >> 5)] >> (tile & 31)) & 1u;
            if (__any(on0)) proc(tile, Kb, Vb, qfa, Oa, ca, la, on0, tpos[0]);
            if (__any(on1)) proc(tile, Kb, Vb, qfb, Ob, cb, lb, on1, tpos[1]);
        };
        kv_loop2<64, 64>(lds, nts,
            [&](int tile, int key) __attribute__((always_inline)) { return KSLC + (size_t)(tile * 64 + key) * 64; },
            [&](int tile, int dv) __attribute__((always_inline)) { return VTSLC + (size_t)dv * SEQ + tile * 64; },
            [&](int i) __attribute__((always_inline)) { return (int)TL[i]; },
            [&](int ta, const char* Ka, const char* Va, int tb, const char* Kb, const char* Vb, bool hasB) __attribute__((always_inline)) {
                s_tile(ta, Ka, Va);
                if (hasB) s_tile(tb, Kb, Vb);
            });
        {
            const float lt = quad_lsum(la[0]);
            const float f = lt > 0.f ? gate(0, 1) / lt : 0.f;
#pragma unroll
            for (int d = 0; d < 4; ++d) ST[d * NTHR + t] += Oa[0][d] * f;
        }
        {
            const float lt = quad_lsum(lb[0]);
            const float f = lt > 0.f ? gate(1, 1) / lt : 0.f;
#pragma unroll
            for (int d = 0; d < 4; ++d) ST[(4 + d) * NTHR + t] += Ob[0][d] * f;
        }
    }
    if (NMASK & 4) {
        f32x4 O[2][4];
#pragma unroll
        for (int st = 0; st < 2; ++st)
#pragma unroll
            for (int d = 0; d < 4; ++d) O[st][d] = (f32x4){0.f, 0.f, 0.f, 0.f};
        m[0] = 1.f; m[1] = 1.f; l[0] = 0.f; l[1] = 0.f;
        const int tw0 = (q0 - 511 > 0 ? q0 - 511 : 0) >> 6, tw1 = (q0 + 63) >> 6;
        kv_loop<64, 64, true>(lds, tw1 - tw0 + 1,
            [&](int tile, int key) __attribute__((always_inline)) { return KWIN + (size_t)(tile * 64 + key) * 64; },
            [&](int tile, int dv) __attribute__((always_inline)) { return VTWIN + (size_t)dv * SEQ + tile * 64; },
            [&](int i) __attribute__((always_inline)) { return tw0 + i; },
            [&](int tile, const char* Kb, const char* Vb) __attribute__((always_inline)) {
                f32x4 s[2][4];
                const bool mid = q0 + 8 * w - (tile * 64 + 63) >= 128 && q0 + 8 * w + 7 - tile * 64 < 512;
                qk_tile<64, 2>(Kb, qf, s, lane);
                if (mid) {
#pragma unroll
                    for (int st = 0; st < 2; ++st)
#pragma unroll
                        for (int kt = 0; kt < 4; ++kt) s[st][kt] += bfar;
                } else if (q0 + 8 * w - (tile * 64 + 63) < 128) {
#pragma unroll
                    for (int st = 0; st < 2; ++st) {
                        int D = tpos[st] - (tile * 64 + 4 * lq); D = D < 191 ? D : 191;
                        const float* lp = LUT + (D - 63) * 8 + hg;
#pragma unroll
                        for (int kt = 0; kt < 4; ++kt)
#pragma unroll
                            for (int r = 0; r < 4; ++r) s[st][kt][r] += lp[(63 - (kt * 16 + r)) * 8];
                    }
                } else {
#pragma unroll
                    for (int st = 0; st < 2; ++st)
#pragma unroll
                        for (int kt = 0; kt < 4; ++kt)
#pragma unroll
                            for (int r = 0; r < 4; ++r) {
                                const int dist = tpos[st] - (tile * 64 + kt * 16 + 4 * lq + r);
                                s[st][kt][r] = dist < 512 ? s[st][kt][r] + bfar : NEGBIG;
                            }
                }
                softmax_online<64, 2>(s, m, l, O);
                pv_tile<64, 2>(Vb, s, O, lane);
            });
#pragma unroll
        for (int st = 0; st < 2; ++st) {
            const float lt = quad_lsum(l[st]);
            const float f = lt > 0.f ? gate(st, 2) / lt : 0.f;
            bf16_t* ON = (bf16_t*)(P.ws + WS_ONSA);
            uint2 pk[4];
#pragma unroll
            for (int d = 0; d < 4; ++d) pk[d] = pack4(ST[(st * 4 + d) * NTHR + t] + O[st][d] * f);
            store_row16<2>(ON + (size_t)(b * SEQ + tpos[st]) * 512 + hg * 64, pk, lq);
        }
    }
}

#ifndef P3SEL
#define P3SEL 7
#endif
#ifndef NSADUP
#define NSADUP 7
#endif
__device__ __forceinline__ void convert_experts(const Params& P, char* lds, int tbeg, int tend, int b0, int st);
constexpr int CONV_CHUNKS3 = NEA * 96 / 4;
template <int QOFF, int SEL>
__device__ __forceinline__ void phase3(const Params& P, char* lds) {
    unsigned* ctl = (unsigned*)(P.ws + WS_CTL);
    unsigned* chead = &ctl[QOFF + CTL_Q + 448];
#define P3_QUEUE(head_, n_, call_) { int it = queue_pop(head_, lds); while (it < (n_)) { \
        unsigned nx_ = 0u, cx_ = 0u; if (threadIdx.x == 0) { nx_ = atomicAdd(head_, 1u); cx_ = atomicAdd(chead, 1u); } \
        call_; \
        __syncthreads(); if (threadIdx.x == 0) { *(volatile int*)(lds + LDS_ITEM) = (int)nx_; *(volatile int*)(lds + LDS_ITEM + 4) = (int)cx_; } __syncthreads(); \
        it = __builtin_amdgcn_readfirstlane(*(volatile int*)(lds + LDS_ITEM)); \
        { const int cc_ = __builtin_amdgcn_readfirstlane(*(volatile int*)(lds + LDS_ITEM + 4)); if (cc_ < CONV_CHUNKS3) convert_experts(P, lds, cc_ * 4, cc_ * 4 + 4, 0, 1); } } }
    if (SEL & 1) P3_QUEUE(&ctl[QOFF + CTL_Q + 64], 1024, mla_item(P, lds, (it & 31) >> 3, it & 7, 31 - (it >> 5)))
    if (SEL & 2) P3_QUEUE(&ctl[QOFF + CTL_Q + 128], 1024, (nsa_item<(QOFF == 0 ? 7 : NSADUP)>(P, lds, (it & 7) >> 1, it & 1, (127 - (it >> 3)) * 64)))
    if (SEL & 4) P3_QUEUE(&ctl[QOFF + CTL_Q + 192], 1024, mem_item(P, lds, it >> 8, (it >> 6) & 3, it & 63))
#undef P3_QUEUE
    for (;;) { const int cc = queue_pop(chead, lds); if (cc >= CONV_CHUNKS3) break; convert_experts(P, lds, cc * 4, cc * 4 + 4, 0, 1); }
}

__device__ __forceinline__ void phase4(const Params& P, char* lds) {
    const bf16_t* PROJ = (const bf16_t*)(P.ws + WS_PROJ);
    bf16_t* MERGED = (bf16_t*)(P.ws + WS_MERGED);
    int ring = 0; bool primed = false;
    auto tile_mn = [&](int tile, int& m0, int& n0) __attribute__((always_inline)) {
        const int bb = tile & 255, rnd = tile >> 8, xg = bb & 7, rr = bb >> 3;
        const int mt = (xg + 8 * rnd) * 4 + (rr & 3), nt = rr >> 2; m0 = mt * 256; n0 = nt * 128;
    };
    for (int tile = blockIdx.x; tile < 1024; tile += gridDim.x) {
        int t = threadIdx.x; asm volatile("" : "+v"(t)); const int lane = t & 63, w = t >> 6, wm = w >> 1, wn = w & 1, lr = lane & 15, lq = lane >> 4;
        int m0, n0; tile_mn(tile, m0, n0);
        const bool last_tile = tile + (int)gridDim.x >= 1024;
        f32x4 tot[4][4]; zero_acc(tot);
#pragma unroll 1
        for (int br = 0; br < 3; ++br) {
            f32x4 acc[4][4]; zero_acc(acc);
            GemmA A = make_op<4>((const bf16_t*)(P.ws + WS_ONSA + (size_t)br * 32 * MBY), 512, m0, NTOK);
            GemmA B = make_op<2, true>((const bf16_t*)(P.ws + WB_WBR) + (size_t)br * 1024 * 512, 512, n0, 1024);
            const bool chain = !(br == 2 && last_tile);
            int m1 = m0, n1 = n0; const int br1 = br == 2 ? 0 : br + 1;
            if (br == 2 && !last_tile) tile_mn(tile + gridDim.x, m1, n1);
            GemmA An = make_op<4>((const bf16_t*)(P.ws + WS_ONSA + (size_t)br1 * 32 * MBY), 512, m1, NTOK);
            GemmA Bn = make_op<2, true>((const bf16_t*)(P.ws + WB_WBR) + (size_t)br1 * 1024 * 512, 512, n1, 1024);
            gemm_mainloop_c(lds, A, B, 512 / 64, acc, ring, primed, chain, An, Bn);
            primed = chain;
#pragma unroll
            for (int i = 0; i < 4; ++i) {
                const size_t tok = m0 + wm * 64 + i * 16 + lr;
#pragma unroll
                for (int jp = 0; jp < 2; ++jp) {
                    const int n = n0 + wn * 64 + jp * 32 + 8 * lq;
                    const uint4 gv = *(const uint4*)(PROJ + tok * DIN + C_GMERGE + br * 1024 + n);
                    tot[i][2 * jp][0] += bflo(gv.x) * acc[i][2 * jp][0]; tot[i][2 * jp][1] += bfhi(gv.x) * acc[i][2 * jp][1];
                    tot[i][2 * jp][2] += bflo(gv.y) * acc[i][2 * jp][2]; tot[i][2 * jp][3] += bfhi(gv.y) * acc[i][2 * jp][3];
                    tot[i][2 * jp + 1][0] += bflo(gv.z) * acc[i][2 * jp + 1][0]; tot[i][2 * jp + 1][1] += bfhi(gv.z) * acc[i][2 * jp + 1][1];
                    tot[i][2 * jp + 1][2] += bflo(gv.w) * acc[i][2 * jp + 1][2]; tot[i][2 * jp + 1][3] += bfhi(gv.w) * acc[i][2 * jp + 1][3];
                }
            }
        }
#pragma unroll
        for (int i = 0; i < 4; ++i) {
            const size_t tok = m0 + wm * 64 + i * 16 + lr;
#pragma unroll
            for (int jp = 0; jp < 2; ++jp) { const uint2 x = pack4(tot[i][2 * jp]), y = pack4(tot[i][2 * jp + 1]); *(uint4*)(MERGED + tok * DM + n0 + wn * 64 + jp * 32 + 8 * lq) = make_uint4(x.x, x.y, y.x, y.y); }
        }
    }
}

struct EpiY1 {
    const bf16_t* H0; bf16_t* Y1;
    __device__ __forceinline__ bool operator()(f32x4 (&acc)[2][2][4][2], const pg8::Unit& u, int, int wr, int wc, int fr, int fq) const {
#pragma unroll
        for (int ai = 0; ai < 2; ++ai)
#pragma unroll
            for (int m = 0; m < 4; ++m) {
                const size_t tok = (size_t)u.pm * 256 + ai * 128 + wr * 64 + m * 16 + fr;
#pragma unroll
                for (int bj = 0; bj < 2; ++bj) {
                    const int col = u.pn * 256 + bj * 128 + wc * 32 + 8 * fq;
                    const uint4 hv = *(const uint4*)(H0 + tok * DM + col);
                    f32x4 v0 = acc[ai][bj][m][0], v1 = acc[ai][bj][m][1];
                    v0[0] += ALPHA * bflo(hv.x); v0[1] += ALPHA * bfhi(hv.x); v0[2] += ALPHA * bflo(hv.y); v0[3] += ALPHA * bfhi(hv.y);
                    v1[0] += ALPHA * bflo(hv.z); v1[1] += ALPHA * bfhi(hv.z); v1[2] += ALPHA * bflo(hv.w); v1[3] += ALPHA * bfhi(hv.w);
                    const uint2 a = pack4(v0), c = pack4(v1);
                    *(uint4*)(Y1 + tok * H1LD + col) = make_uint4(a.x, a.y, c.x, c.y);
                }
            }
        return false;
    }
};
__device__ __forceinline__ void phase5a(const Params& P, char* lds) {
    pg8::DenseProv PV; PV.S.init(NTOK, DM, gridDim.x, blockIdx.x);
    PV.A = (const bf16_t*)(P.ws + WS_MERGED); PV.Bt = (const bf16_t*)(P.ws + WB_WOUT); PV.lda = DM; PV.ldb = DM; PV.perm = true;
    EpiY1 E; E.H0 = (const bf16_t*)(P.ws + WS_H0); E.Y1 = (bf16_t*)(P.ws + WS_Y1);
    pg8::gemm_phase((LAS unsigned char*)lds, DM, PV, E);
}

template <int MODE>
__device__ __forceinline__ void phase5b(const Params& P, char* lds) {
    const int t = threadIdx.x, lane = t & 63, w = t >> 6;
    const int gw = blockIdx.x * NWV + w, nw = gridDim.x * NWV;
    bf16_t* H1 = (bf16_t*)P.out; bf16_t* H1LO = (bf16_t*)(P.ws + WS_Y1);
    if (MODE == 0) for (int row0 = gw; row0 < NTOK; row0 += 2 * nw) {
        const int row1 = row0 + nw; const bool has1 = row1 < NTOK;
        const bf16_t* yb = (const bf16_t*)(P.ws + WS_Y1);
        uint4 raw[2][2];
#pragma unroll
        for (int u = 0; u < 2; ++u)
#pragma unroll
            for (int i = 0; i < 2; ++i) raw[u][i] = *(const uint4*)(yb + (size_t)((u && has1) ? row1 : row0) * H1LD + i * 512 + 8 * lane);
        float v[2][16]; float s[2] = {0.f, 0.f};
#pragma unroll
        for (int u = 0; u < 2; ++u)
#pragma unroll
            for (int i = 0; i < 2; ++i) {
                v[u][8 * i + 0] = bflo(raw[u][i].x); v[u][8 * i + 1] = bfhi(raw[u][i].x); v[u][8 * i + 2] = bflo(raw[u][i].y); v[u][8 * i + 3] = bfhi(raw[u][i].y);
                v[u][8 * i + 4] = bflo(raw[u][i].z); v[u][8 * i + 5] = bfhi(raw[u][i].z); v[u][8 * i + 6] = bflo(raw[u][i].w); v[u][8 * i + 7] = bfhi(raw[u][i].w);
            }
#pragma unroll
        for (int u = 0; u < 2; ++u)
#pragma unroll
            for (int k = 0; k < 16; ++k) s[u] += v[u][k];
        const float mu[2] = {wave_sum(s[0]) * (1.f / DM), wave_sum(s[1]) * (1.f / DM)};
        float q[2] = {0.f, 0.f};
#pragma unroll
        for (int u = 0; u < 2; ++u)
#pragma unroll
            for (int k = 0; k < 16; ++k) { const float d = v[u][k] - mu[u]; q[u] += d * d; }
        const float rstd[2] = {rsqrtf(wave_sum(q[0]) * (1.f / DM) + 1e-5f), rsqrtf(wave_sum(q[1]) * (1.f / DM) + 1e-5f)};
#pragma unroll
        for (int i = 0; i < 2; ++i) {
            const float4 g0 = ((const float4*)P.ln1_g)[i * 128 + 2 * lane], g1 = ((const float4*)P.ln1_g)[i * 128 + 2 * lane + 1];
            const float4 b0 = ((const float4*)P.ln1_b)[i * 128 + 2 * lane], b1 = ((const float4*)P.ln1_b)[i * 128 + 2 * lane + 1];
            const float gg[8] = {g0.x, g0.y, g0.z, g0.w, g1.x, g1.y, g1.z, g1.w}, bb[8] = {b0.x, b0.y, b0.z, b0.w, b1.x, b1.y, b1.z, b1.w};
#pragma unroll
            for (int u = 0; u < 2; ++u) {
                const int row = u ? row1 : row0;
                float h[8];
#pragma unroll
                for (int k = 0; k < 8; ++k) h[k] = (v[u][8 * i + k] - mu[u]) * rstd[u] * gg[k] + bb[k];
                const uint4 hi = make_uint4(pack2(h[0], h[1]), pack2(h[2], h[3]), pack2(h[4], h[5]), pack2(h[6], h[7]));
                const uint4 lo = make_uint4(pack2(h[0] - bflo(hi.x), h[1] - bfhi(hi.x)), pack2(h[2] - bflo(hi.y), h[3] - bfhi(hi.y)),
                                            pack2(h[4] - bflo(hi.z), h[5] - bfhi(hi.z)), pack2(h[6] - bflo(hi.w), h[7] - bfhi(hi.w)));
                if (u == 0 || has1) {
                    *(uint4*)(H1 + (size_t)row * H1LD + i * 512 + 8 * lane) = hi;
                    *(uint4*)(H1LO + (size_t)row * H1LD + i * 512 + 8 * lane) = lo;
                }
            }
        }
    }
}

#ifndef CONV_SPLIT
#define CONV_SPLIT 18432
#endif
__device__ __forceinline__ void convert_experts(const Params& P, char* lds, int tbeg, int tend, int b0, int st) {
    const int t = threadIdx.x;
    const int tt = t & 255, sub = t >> 8, kg = tt >> 5, n4 = tt & 31;
    char* tb = lds + sub * 16384;
    const int NT_ = tend, step = st * 2;
    __syncthreads();
    for (int tile0 = tbeg + b0 * 2; tile0 < NT_; tile0 += 2 * step) {
        float4 r[2][8]; const float* srcs[2]; bf16_t* dsts[2]; int lddv[2], kt0v[2], nt0v[2]; bool hasv[2];
#pragma unroll
        for (int q = 0; q < 2; ++q) {
            const int tile_ = tile0 + q * step + sub; hasv[q] = tile_ < NT_;
            const int tile = hasv[q] ? tile_ : tile0 + sub;
            const int mat = tile >> 5, loc = tile & 31, e = mat / 3, which = mat - e * 3;
            srcs[q] = (which == 0 ? P.exp_w1 : which == 1 ? P.exp_w3 : P.exp_w2) + (size_t)e * 262144;
            dsts[q] = (bf16_t*)expw_ptr(P.ws, e) + which * 262144;
            const int N = which == 2 ? 1024 : 256; lddv[q] = which == 2 ? 256 : 1024;
            kt0v[q] = (which == 2 ? (loc >> 3) : (loc >> 1)) * 64; nt0v[q] = (which == 2 ? (loc & 7) : (loc & 1)) * 128;
            const int k0 = kt0v[q] + kg * 8, n = nt0v[q] + n4 * 4;
#pragma unroll
            for (int kk = 0; kk < 8; ++kk) r[q][kk] = *(const float4*)(srcs[q] + (size_t)(k0 + kk) * N + n);
        }
#pragma unroll
        for (int q = 0; q < 2; ++q) {
#pragma unroll
            for (int c = 0; c < 4; ++c) {
                float v[8];
#pragma unroll
                for (int kk = 0; kk < 8; ++kk) v[kk] = (c == 0) ? r[q][kk].x : (c == 1) ? r[q][kk].y : (c == 2) ? r[q][kk].z : r[q][kk].w;
                *(uint4*)(tb + swz(4 * n4 + c, kg)) = make_uint4(pack2(v[0], v[1]), pack2(v[2], v[3]), pack2(v[4], v[5]), pack2(v[6], v[7]));
            }
            __syncthreads();
            if (hasv[q]) {
#pragma unroll
                for (int i = 0; i < 4; ++i) {
                    const int row = (tt >> 3) + 32 * i, ch = tt & 7;
                    *(uint4*)(dsts[q] + (size_t)(nt0v[q] + row) * lddv[q] + kt0v[q] + ch * 8) = *(const uint4*)(tb + swz(row, ch));
                }
            }
            __syncthreads();
        }
    }
}

__device__ __forceinline__ unsigned long long ord_key(float v, int e) {
    unsigned u = __float_as_uint(v); u = (u & 0x80000000u) ? ~u : (u | 0x80000000u);
    return ((unsigned long long)u << 8) | (unsigned)(255 - e);
}
template <bool NOWRITE>
__device__ __forceinline__ void phase5d(const Params& P, char* lds) {
    const bool conv_first5 = ((blockIdx.x >> 3) & 1) != 0;
    if (!NOWRITE && conv_first5) convert_experts(P, lds, CONV_SPLIT, 768 * 32, blockIdx.x, gridDim.x);
    const int t = threadIdx.x, lane = t & 63, w = t >> 6;
    const int gw = blockIdx.x * NWV + w, nw = gridDim.x * NWV;
    const float* LOGITS = (const float*)(P.ws + WS_LOGITS);
    unsigned* ctl = (unsigned*)(P.ws + WS_CTL);
    int* EID = (int*)(P.ws + WS_EID); float* EW = (float*)(P.ws + WS_EW); int* LIST = (int*)(P.ws + WS_LIST);
    const float4 rb = ((const float4*)P.router_b)[lane];
    float4 lgn = ((const float4*)(LOGITS + (size_t)(gw < NTOK ? gw : 0) * 256))[lane];
    for (int tok = gw; tok < NTOK; tok += nw) {
        const float4 lg = lgn;
        { const int tn = tok + nw < NTOK ? tok + nw : tok; lgn = ((const float4*)(LOGITS + (size_t)tn * 256))[lane]; }
        float s[4] = {sigmoidf_(lg.x), sigmoidf_(lg.y), sigmoidf_(lg.z), sigmoidf_(lg.w)};
        float sb[4] = {s[0] + rb.x, s[1] + rb.y, s[2] + rb.z, s[3] + rb.w};
        float a = fmaxf(sb[0], sb[1]), bq = fminf(sb[0], sb[1]);
        { const float a2 = fmaxf(sb[2], sb[3]), b2 = fminf(sb[2], sb[3]); const float na = fmaxf(a, a2); bq = fmaxf(fminf(a, a2), fmaxf(bq, b2)); a = na; }
#define DPPF_(x, ctrl) __uint_as_float(__builtin_amdgcn_update_dpp(0u, __float_as_uint(x), ctrl, 0xF, 0xF, true))
        { const float a2 = DPPF_(a, 0xB1), b2 = DPPF_(bq, 0xB1); const float na = fmaxf(a, a2); bq = fmaxf(fminf(a, a2), fmaxf(bq, b2)); a = na; }
        { const float a2 = DPPF_(a, 0x4E), b2 = DPPF_(bq, 0x4E); const float na = fmaxf(a, a2); bq = fmaxf(fminf(a, a2), fmaxf(bq, b2)); a = na; }
        { const float a2 = DPPF_(a, 0x141), b2 = DPPF_(bq, 0x141); const float na = fmaxf(a, a2); bq = fmaxf(fminf(a, a2), fmaxf(bq, b2)); a = na; }
#undef DPPF_
        const float gs = a + bq; const int grp = lane >> 3;
        int rank = 0;
#pragma unroll
        for (int g2 = 0; g2 < 8; ++g2) { const float o = __uint_as_float(__builtin_amdgcn_readlane(__float_as_uint(gs), g2 * 8)); rank += (o > gs || (o == gs && g2 < grp)) ? 1 : 0; }
        const bool gsel = rank < 4;
        float v[4];
#pragma unroll
        for (int i = 0; i < 4; ++i) v[i] = gsel ? sb[i] : -3.0e38f;
        int my_e = 0; float my_s = 0.f, wsum = 0.f;
        for (int r = 0; r < 8; ++r) {
            float bv = v[0]; int bi = 0;
#pragma unroll
            for (int i = 1; i < 4; ++i) if (v[i] > bv) { bv = v[i]; bi = i; }
            const float wm = wave_max(bv);
            const int wl = __builtin_amdgcn_readfirstlane(__ffsll((long long)__ballot(bv == wm)) - 1);
            const int wi = __builtin_amdgcn_readlane(bi, wl);
            const float mine = bi == 0 ? s[0] : bi == 1 ? s[1] : bi == 2 ? s[2] : s[3];
            const float sv = __uint_as_float(__builtin_amdgcn_readlane(__float_as_uint(mine), wl));
            if (lane == wl) { if (bi == 0) v[0] = -3.0e38f; else if (bi == 1) v[1] = -3.0e38f; else if (bi == 2) v[2] = -3.0e38f; else v[3] = -3.0e38f; }
            wsum += sv;
            if (lane == r) { my_e = wl * 4 + wi; my_s = sv; }
        }
        if (NOWRITE) { asm volatile("" :: "v"(my_e), "v"(my_s), "v"(wsum)); }
        else if (lane < 8) {
            const float wv = my_s / wsum * 2.5f;
            EID[tok * 8 + lane] = my_e; EW[tok * 8 + lane] = wv;
            const unsigned pos = atomicAdd(&ctl[CTL_CNT + my_e * 16], 1u);
            LIST[(size_t)my_e * NTOK + pos] = tok * 8 + lane;
        }
    }
    if (!NOWRITE && !conv_first5) convert_experts(P, lds, CONV_SPLIT, 768 * 32, blockIdx.x, gridDim.x);
}

struct ProvUp {
    const char* h1; const char* wb; const int* aid;
    __device__ __forceinline__ void offsets(unsigned (&va)[2][2], unsigned (&vb)[2][2], const int (&sR)[2], const int (&sC)[2]) const {
#pragma unroll
        for (int h = 0; h < 2; ++h)
#pragma unroll
            for (int p = 0; p < 2; ++p) {
                va[h][p] = (unsigned)(((size_t)(aid[h * 128 + sR[p]] >> 3) * H1LD + sC[p]) * 2);
                vb[h][p] = (unsigned)(((size_t)h * 262144 + (size_t)((sR[p] & ~31) + pg8::perm32(sR[p] & 31)) * 1024 + sC[p]) * 2);
            }
    }
    __device__ __forceinline__ bool get(int i, pg8::Unit& u, pg8::Ops& o) const {
        if (i >= 2) return false;
        u.pm = 0; u.pn = i; o.A = h1; o.B = wb + (size_t)i * 128 * 1024 * 2;
        return true;
    }
};
struct EpiUp {
    bf16_t* scr;
    __device__ __forceinline__ bool operator()(f32x4 (&acc)[2][2][4][2], const pg8::Unit& u, int, int wr, int wc, int fr, int fq) const {
#pragma unroll
        for (int ai = 0; ai < 2; ++ai)
#pragma unroll
            for (int m = 0; m < 4; ++m) {
                const int row = ai * 128 + wr * 64 + m * 16 + fr;
                f32x4 v0, v1;
#pragma unroll
                for (int r = 0; r < 4; ++r) { v0[r] = siluf_(acc[ai][0][m][0][r]) * acc[ai][1][m][0][r]; v1[r] = siluf_(acc[ai][0][m][1][r]) * acc[ai][1][m][1][r]; }
                const uint2 a = pack4(v0), c = pack4(v1);
                *(uint4*)(scr + row * 256 + u.pn * 128 + wc * 32 + 8 * fq) = make_uint4(a.x, a.y, c.x, c.y);
            }
        return false;
    }
};
struct ProvDown {
    const char* scr; const char* w2t;
    __device__ __forceinline__ void offsets(unsigned (&va)[2][2], unsigned (&vb)[2][2], const int (&sR)[2], const int (&sC)[2]) const {
#pragma unroll
        for (int h = 0; h < 2; ++h)
#pragma unroll
            for (int p = 0; p < 2; ++p) { va[h][p] = (unsigned)(((h * 128 + sR[p]) * 256 + sC[p]) * 2); vb[h][p] = (unsigned)(((h * 128 + (sR[p] & ~31) + pg8::perm32(sR[p] & 31)) * 256 + sC[p]) * 2); }
    }
    __device__ __forceinline__ bool get(int i, pg8::Unit& u, pg8::Ops& o) const {
        if (i >= 4) return false;
        u.pm = 0; u.pn = i; o.A = scr; o.B = w2t + (size_t)i * 256 * 256 * 2;
        return true;
    }
};
struct EpiDown {
    bf16_t* Y; bf16_t* SHOUT; const int* aid; int rows; bool routed;
    __device__ __forceinline__ bool operator()(f32x4 (&acc)[2][2][4][2], const pg8::Unit& u, int, int wr, int wc, int fr, int fq) const {
#pragma unroll
        for (int ai = 0; ai < 2; ++ai)
#pragma unroll
            for (int m = 0; m < 4; ++m) {
                const int row = ai * 128 + wr * 64 + m * 16 + fr;
                if (row < rows) {
                    const int a = aid[row];
                    bf16_t* dst = (routed ? (Y + (size_t)a * DM) : (SHOUT + (size_t)(a >> 3) * H1LD)) + u.pn * 256 + wc * 32 + 8 * fq;
#pragma unroll
                    for (int bj = 0; bj < 2; ++bj) { const uint2 x = pack4(acc[ai][bj][m][0]), y = pack4(acc[ai][bj][m][1]); *(uint4*)(dst + bj * 128) = make_uint4(x.x, x.y, y.x, y.y); }
                }
            }
        return false;
    }
};
struct ProvRouter {
    const char* hi; const char* lo; const char* whi; const char* wlo; int tile0, tstep;
    __device__ __forceinline__ void offsets(unsigned (&va)[2][2], unsigned (&vb)[2][2], const int (&sR)[2], const int (&sC)[2]) const {
#pragma unroll
        for (int h = 0; h < 2; ++h)
#pragma unroll
            for (int p = 0; p < 2; ++p) { va[h][p] = (unsigned)(((size_t)(h * 128 + sR[p]) * H1LD + sC[p]) * 2); vb[h][p] = (unsigned)(((size_t)(h * 128 + sR[p]) * 1024 + sC[p]) * 2); }
    }
    __device__ __forceinline__ bool get(int i, pg8::Unit& u, pg8::Ops& o) const {
        const int q = i / 3, seg = i - q * 3, ot = tile0 + q * tstep;
        if (ot >= 128) return false;
        u.pm = ot; u.pn = seg;
        o.A = (seg == 1 ? lo : hi) + (size_t)ot * 256 * H1LD * 2; o.B = seg == 0 ? wlo : whi;
        return true;
    }
};
struct EpiRouter {
    float* LOGITS;
    __device__ __forceinline__ bool operator()(f32x4 (&acc)[2][2][4][2], const pg8::Unit& u, int, int wr, int wc, int fr, int fq) const {
        if (u.pn < 2) return true;
#pragma unroll
        for (int ai = 0; ai < 2; ++ai)
#pragma unroll
            for (int m = 0; m < 4; ++m) {
                const size_t tok = (size_t)u.pm * 256 + ai * 128 + wr * 64 + m * 16 + fr;
#pragma unroll
                for (int bj = 0; bj < 2; ++bj)
#pragma unroll
                    for (int n = 0; n < 2; ++n) *(f32x4*)(LOGITS + tok * 256 + bj * 128 + wc * 32 + n * 16 + 4 * fq) = acc[ai][bj][m][n];
            }
        return false;
    }
};
__device__ __forceinline__ void phase5c(const Params& P, char* lds) {
    const int xg = blockIdx.x & 7, rk = blockIdx.x >> 3, G8 = gridDim.x >> 3;
    const bool two = G8 >= 2; const int nr = two ? (G8 >> 1) : G8, ns = two ? G8 - nr : G8;
    const bool conv_first = (rk & 1) != 0;
    if (conv_first) convert_experts(P, lds, NEA * 96, CONV_SPLIT, blockIdx.x, gridDim.x);
    if (!two || rk < nr) {
        ProvRouter PV; PV.hi = (const char*)P.out; PV.lo = (const char*)(P.ws + WS_Y1); PV.whi = (const char*)(P.ws + WB_WRHI); PV.wlo = (const char*)(P.ws + WB_WRLO);
        PV.tile0 = xg * 16 + rk; PV.tstep = 0;
        EpiRouter E; E.LOGITS = (float*)(P.ws + WS_LOGITS);
        for (int j = rk; j < 16; j += nr) { PV.tile0 = xg * 16 + j; PV.tstep = 128; pg8::gemm_phase((LAS unsigned char*)lds, DM, PV, E); }
    }
    if (!two || rk >= nr) {
        int* aid = (int*)(lds + LDS_ROWS);
        bf16_t* SCR = (bf16_t*)(P.ws + WS_SCR2 + (size_t)blockIdx.x * 131072);
        const bf16_t* wb = (const bf16_t*)(P.ws + WB_WS1);
        for (int j = two ? rk - nr : rk; j < 16; j += ns) {
            const int t = threadIdx.x;
            __syncthreads();
            if (t < 256) aid[t] = ((xg * 16 + j) * 256 + t) * 8;
            __syncthreads();
            {
                ProvUp PV; PV.h1 = (const char*)P.out; PV.wb = (const char*)wb; PV.aid = aid;
                EpiUp E; E.scr = SCR;
                pg8::gemm_phase((LAS unsigned char*)lds, DM, PV, E);
            }
            asm volatile("s_waitcnt vmcnt(0)" ::: "memory");
            __syncthreads();
            {
                ProvDown PV; PV.scr = (const char*)SCR; PV.w2t = (const char*)(wb + 524288);
                EpiDown E; E.Y = (bf16_t*)(P.ws + WS_Y); E.SHOUT = (bf16_t*)P.out + 1024; E.aid = aid; E.rows = 256; E.routed = false;
                pg8::gemm_phase((LAS unsigned char*)lds, 256, PV, E);
            }
            __syncthreads();
        }
    }
    if (!conv_first) convert_experts(P, lds, NEA * 96, CONV_SPLIT, blockIdx.x, gridDim.x);
}

__device__ __forceinline__ void phase7(const Params& P, char* lds) {
    const int t0_ = threadIdx.x;
    unsigned* ctl = (unsigned*)(P.ws + WS_CTL);
    int* pre = (int*)(lds + LDS_PRE);
    int* aid = (int*)(lds + LDS_ROWS);
    const int* LIST = (const int*)(P.ws + WS_LIST);
    bf16_t* SCR = (bf16_t*)(P.ws + WS_SCR2 + (size_t)blockIdx.x * 131072);
    const int xg = blockIdx.x & 7, rk = blockIdx.x >> 3, G8 = gridDim.x >> 3;
    __syncthreads();
    if (t0_ == 0) {
        int s = 0;
        for (int k = 0; k < 32; ++k) { pre[k] = s; s += ((int)ctl[CTL_CNT + (xg + 8 * k) * 16] + 255) >> 8; }
        pre[32] = s;
    }
    __syncthreads();
    const int T = pre[32];
    for (int g = rk; g < T; g += G8) {
        const int t = threadIdx.x;
        const bf16_t* wb; int rows; const bool routed = true;
        {
            int lo = 0, hi = 32;
            while (hi - lo > 1) { const int mid = (lo + hi) >> 1; if (pre[mid] <= g) lo = mid; else hi = mid; }
            const int e = xg + 8 * lo, tile = g - pre[lo], cnt = (int)ctl[CTL_CNT + e * 16];
            rows = cnt - tile * 256; rows = rows < 256 ? rows : 256; rows = __builtin_amdgcn_readfirstlane(rows);
            if (t < 256) aid[t] = LIST[(size_t)e * NTOK + tile * 256 + (t < rows ? t : rows - 1)];
            wb = (const bf16_t*)expw_ptr(P.ws, e);
        }
        __syncthreads();
        {
            ProvUp PV; PV.h1 = (const char*)P.out; PV.wb = (const char*)wb; PV.aid = aid;
            EpiUp E; E.scr = SCR;
            pg8::gemm_phase((LAS unsigned char*)lds, DM, PV, E);
        }
        asm volatile("s_waitcnt vmcnt(0)" ::: "memory");
        __syncthreads();
        {
            ProvDown PV; PV.scr = (const char*)SCR; PV.w2t = (const char*)(wb + 524288);
            EpiDown E; E.Y = (bf16_t*)(P.ws + WS_Y); E.SHOUT = (bf16_t*)P.out + 1024; E.aid = aid; E.rows = rows; E.routed = routed;
            pg8::gemm_phase((LAS unsigned char*)lds, 256, PV, E);
        }
        __syncthreads();
    }
}

__device__ __forceinline__ void phase8(const Params& P) {
    const int t = threadIdx.x, lane = t & 63, w = t >> 6;
    const int gw = blockIdx.x * NWV + w, nw = gridDim.x * NWV;
    const bf16_t* H1 = (const bf16_t*)P.out; const bf16_t* SHOUT = (const bf16_t*)P.out + 1024;
    const bf16_t* Y = (const bf16_t*)(P.ws + WS_Y); const float* EW = (const float*)(P.ws + WS_EW);
    for (int tok = gw; tok < NTOK; tok += nw) {
        float v[4][4];
#pragma unroll
        for (int i = 0; i < 4; ++i) {
            const uint2 h = *(const uint2*)(H1 + (size_t)tok * H1LD + 4 * (lane + 64 * i));
            const uint2 s = *(const uint2*)(SHOUT + (size_t)tok * H1LD + 4 * (lane + 64 * i));
            v[i][0] = ALPHA * bflo(h.x) + bflo(s.x); v[i][1] = ALPHA * bfhi(h.x) + bfhi(s.x);
            v[i][2] = ALPHA * bflo(h.y) + bflo(s.y); v[i][3] = ALPHA * bfhi(h.y) + bfhi(s.y);
        }
#pragma unroll
        for (int k = 0; k < 8; ++k) {
            const float wk = EW[tok * 8 + k];
            const bf16_t* yr = Y + ((size_t)tok * 8 + k) * DM;
#pragma unroll
            for (int i = 0; i < 4; ++i) {
                const uint2 y = *(const uint2*)(yr + 4 * (lane + 64 * i));
                v[i][0] += wk * bflo(y.x); v[i][1] += wk * bfhi(y.x); v[i][2] += wk * bflo(y.y); v[i][3] += wk * bfhi(y.y);
            }
        }
        float s = 0.f;
#pragma unroll
        for (int i = 0; i < 4; ++i) s += v[i][0] + v[i][1] + v[i][2] + v[i][3];
        const float mu = wave_sum(s) * (1.f / DM);
        float q = 0.f;
#pragma unroll
        for (int i = 0; i < 4; ++i)
#pragma unroll
            for (int c = 0; c < 4; ++c) { const float d = v[i][c] - mu; q += d * d; }
        const float rstd = rsqrtf(wave_sum(q) * (1.f / DM) + 1e-5f);
#pragma unroll
        for (int i = 0; i < 4; ++i) {
            const float4 g = ((const float4*)P.ln2_g)[lane + 64 * i], bb = ((const float4*)P.ln2_b)[lane + 64 * i];
            float4 o;
            o.x = (v[i][0] - mu) * rstd * g.x + bb.x; o.y = (v[i][1] - mu) * rstd * g.y + bb.y;
            o.z = (v[i][2] - mu) * rstd * g.z + bb.z; o.w = (v[i][3] - mu) * rstd * g.w + bb.w;
            ((float4*)(P.out + (size_t)tok * DM))[lane + 64 * i] = o;
        }
    }
}

constexpr int N_PHASES = 11;
__global__ void __launch_bounds__(512, 2) fwd_kernel(Params P) {
    extern __shared__ __attribute__((aligned(16))) char lds[];
    const int t = threadIdx.x;
    if (t == 0) *(uint4*)(lds + LDS_BARW) = make_uint4(0u, 0u, 0u, 0u);
    {
        float* LUT = (float*)(lds + LDS_LUT);
        for (int i = t; i < 256 * 8; i += NTHR) {
            const int d = (i >> 3) - 64, h = i & 7;
            float v = NEGBIG;
            if (d >= 0) {
                int bucket = d;
                if (d >= 16) { bucket = 16 + (int)(log2f((float)d * (1.f / 16.f)) * (16.f / 3.f)); bucket = bucket < 31 ? bucket : 31; }
                v = P.rel_bias[bucket * 8 + h] * LOG2E;
            }
            LUT[i] = v;
        }
    }
    __syncthreads();
    XcdBarrier bar = xcd_barrier_post((unsigned*)(P.ws + WS_CTL), (volatile LAS unsigned*)(lds + LDS_BARW));
#ifndef ONLY_PHASE
#define ONLY_PHASE -1
#endif
#ifndef PROBE_DUP
#define PROBE_DUP -1
#endif
#define PHASE(k, call) if ((ONLY_PHASE < 0 || ONLY_PHASE == (k)) && P.ph_lo <= (k) && (k) < P.ph_hi) { call; if ((k) + 1 < P.ph_hi) xcd_barrier(bar); }
#define PHASE_DUP(k, call) if (PROBE_DUP == (k)) { call; xcd_barrier(bar); }
    PHASE(0, phase0(P))
    PHASE_DUP(1, phase1<true>(P, lds))
    PHASE(1, phase1<false>(P, lds))
    PHASE_DUP(2, phase2<1024>(P, lds))
    PHASE(2, phase2<0>(P, lds))
#ifndef P3DUP
#define P3DUP 7
#endif
    PHASE_DUP(3, (phase3<1024, P3DUP>(P, lds)))
    PHASE(3, (phase3<0, 7>(P, lds)))
    PHASE_DUP(4, phase4(P, lds))
    PHASE(4, phase4(P, lds))
    PHASE_DUP(5, phase5a(P, lds))
    PHASE(5, phase5a(P, lds))
#ifndef P6DUP
#define P6DUP 1
#endif
    PHASE_DUP(6, phase5b<P6DUP>(P, lds))
    PHASE(6, phase5b<0>(P, lds))
    PHASE_DUP(7, phase5c(P, lds))
    PHASE(7, phase5c(P, lds))
    PHASE_DUP(8, phase5d<true>(P, lds))
    PHASE(8, phase5d<false>(P, lds))
    PHASE_DUP(9, phase7(P, lds))
    PHASE(9, phase7(P, lds))
    PHASE_DUP(10, phase8(P))
#ifdef PROBE_BAR
    for (int i = 0; i < 16; ++i) xcd_barrier(bar);
#endif
    PHASE(10, phase8(P))
#undef PHASE
}

#ifndef MK_LAUNCHES
#define MK_LAUNCHES 1
#endif

extern "C" void kernel_launch(void* const* d_in, const int* in_sizes, int n_in, void* d_out, int out_size, void* d_ws, size_t ws_size,
                              hipStream_t stream) {
    static int grid = 0;
    if (grid == 0) {
        if (n_in != 31 || in_sizes[0] != NTOK * DM || out_size != NTOK * DM || ws_size < WS_END) {
            fprintf(stderr, "kernel_launch: unexpected shapes (n_in %d, in0 %d, out %d, ws %zu < %zu)\n", n_in, n_in > 0 ? in_sizes[0] : -1, out_size, ws_size, (size_t)WS_END);
            grid = -1; return;
        }
        int dev = 0, cus = 0, per_cu = 0;
        if (hipGetDevice(&dev) != hipSuccess || hipDeviceGetAttribute(&cus, hipDeviceAttributeMultiprocessorCount, dev) != hipSuccess) { grid = -1; return; }
        if (hipFuncSetAttribute((const void*)fwd_kernel, hipFuncAttributeMaxDynamicSharedMemorySize, LDS_BYTES) != hipSuccess) { grid = -1; return; }
        if (hipOccupancyMaxActiveBlocksPerMultiprocessor(&per_cu, (const void*)fwd_kernel, NTHR, LDS_BYTES) != hipSuccess || per_cu < 1) per_cu = 1;
        (void)hipGetLastError();
        grid = cus;
    }
    if (grid < 0) return;
    if (hipMemsetAsync((char*)d_ws + WS_CTL, 0, CTL_BYTES, stream) != hipSuccess) return;
    Params p{};
    const float** pp = (const float**)&p;
    for (int i = 0; i < 31; ++i) pp[i] = (const float*)d_in[i];
    p.out = (float*)d_out; p.ws = (char*)d_ws;
#if MK_LAUNCHES == 1
    p.ph_lo = 0; p.ph_hi = N_PHASES;
    hipLaunchKernelGGL(fwd_kernel, dim3(grid), dim3(NTHR), LDS_BYTES, stream, p);
#else
    for (int k = 0; k < N_PHASES; ++k) { p.ph_lo = k; p.ph_hi = k + 1; hipLaunchKernelGGL(fwd_kernel, dim3(grid), dim3(NTHR), LDS_BYTES, stream, p); }
#endif
}
```
